# Optimizing an MI355X kernel written in HIP

```python
import jax, jax.numpy as jnp
from jax import lax
import numpy as np

D_MODEL = 1024
BATCH = 8
SEQ = 8192
DEPTH = 1

ATTN_GROUPS = ((128, 1), (512, 4), (2048, 16))
N_ATTN_GROUPS = 3
HEADS_PER_GROUP = 8
HEAD_DIM_A = 64
ATTN_GROUP_WIDTH = HEADS_PER_GROUP * HEAD_DIM_A
ATTN_QKV_WIDTH = N_ATTN_GROUPS * ATTN_GROUP_WIDTH
DN_HEADS = 8
DN_HEAD_DIM = 128
DN_WIDTH = DN_HEADS * DN_HEAD_DIM
CONV_WIDTH = 4
CHUNK = 64
N_EXPERT_GROUPS = 4
EXPERTS_PER_GROUP = 4
N_EXPERTS = N_EXPERT_GROUPS * EXPERTS_PER_GROUP
TOP_K = 2
D_EXPERT = 256
PLE_DIM = 256
EPS = 1e-6
IN_WIDTHS = (3 * ATTN_QKV_WIDTH, 3 * DN_WIDTH, DN_WIDTH, DN_HEADS, DN_HEADS, D_MODEL, D_MODEL)
IN_TOTAL = 3 * ATTN_QKV_WIDTH + 4 * DN_WIDTH + 2 * DN_HEADS + 2 * D_MODEL

kernel_name = "hybrid_dilated_attn_gated_deltanet_hier_moe"


def rms_norm(x, gain):
    xf = x.astype(jnp.float32)
    y = xf * lax.rsqrt(jnp.mean(xf * xf, axis=-1, keepdims=True) + EPS)
    return y * gain.astype(jnp.float32)


def l2_norm(x):
    return x * lax.rsqrt(jnp.sum(x * x, axis=-1, keepdims=True) + EPS)


def split_columns(t, widths):
    out, start = [], 0
    for w in widths:
        out.append(t[..., start:start + w])
        start += w
    return out


def dilated_window_attention(q, k, v, window, dilation):
    b, s, h, dh = q.shape
    blk = window // dilation
    span = blk * dilation
    s_pad = -(-s // span) * span
    n_sub = s_pad // dilation
    nblk = n_sub // blk

    def to_blocks(t):
        t = jnp.pad(t, ((0, 0), (0, s_pad - s), (0, 0), (0, 0)))
        t = t.reshape(b, n_sub, dilation, h, dh).transpose(0, 2, 3, 1, 4)
        return t.reshape(b, dilation, h, nblk, blk, dh)

    def with_prev(t):
        prev = jnp.pad(t[:, :, :, :-1], ((0, 0), (0, 0), (0, 0), (1, 0), (0, 0), (0, 0)))
        return jnp.concatenate([prev, t], axis=4)

    qb = to_blocks(q)
    kb = with_prev(to_blocks(k))
    vb = with_prev(to_blocks(v))
    scores = jnp.einsum('brhnqd,brhnkd->brhnqk', qb, kb) * (dh ** -0.5)
    qi = jnp.arange(blk)[:, None]
    kj = jnp.arange(2 * blk)[None, :]
    dist = blk + qi - kj
    band = (dist >= 0) & (dist <= blk)
    has_prev = jnp.arange(nblk)[:, None, None] > 0
    valid = band[None] & (has_prev | (kj >= blk)[None])
    scores = jnp.where(valid, scores, -jnp.inf)
    m = jnp.max(scores, axis=-1, keepdims=True)
    e = jnp.exp(scores - m)
    denom = jnp.sum(e, axis=-1)
    o = jnp.einsum('brhnqk,brhnkd->brhnqd', e, vb) / denom[..., None]
    lse = m[..., 0] + jnp.log(denom)
    o = o.reshape(b, dilation, h, n_sub, dh).transpose(0, 3, 1, 2, 4).reshape(b, s_pad, h, dh)[:, :s]
    lse = lse.reshape(b, dilation, h, n_sub).transpose(0, 3, 1, 2).reshape(b, s_pad, h)[:, :s]
    return o, lse


def causal_short_conv(x, w):
    kw = w.shape[0]
    s = x.shape[1]
    xp = jnp.pad(x, ((0, 0), (kw - 1, 0), (0, 0)))
    y = xp[:, kw - 1:kw - 1 + s] * w[kw - 1]
    for j in range(kw - 1):
        y = y + xp[:, j:j + s] * w[j]
    return jax.nn.silu(y)


def gated_delta_rule(q, k, v, beta, g):
    b, s, h, dk = q.shape
    dv = v.shape[-1]
    n = s // CHUNK

    def chunkify(t):
        return t.reshape(b, n, CHUNK, h, -1).transpose(1, 0, 3, 2, 4)

    qc, kc, vc = chunkify(q), chunkify(k), chunkify(v)
    bc = beta.reshape(b, n, CHUNK, h).transpose(1, 0, 3, 2)
    gcum = jnp.cumsum(g.reshape(b, n, CHUNK, h).transpose(1, 0, 3, 2), axis=-1)
    tril = jnp.tril(jnp.ones((CHUNK, CHUNK), dtype=bool))
    tril_strict = jnp.tril(jnp.ones((CHUNK, CHUNK), dtype=bool), -1)
    decay_mat = jnp.exp(jnp.where(tril, gcum[..., :, None] - gcum[..., None, :], -jnp.inf))
    kbeta = kc * bc[..., None]
    a_mat = jnp.where(tril_strict, jnp.einsum('nbhid,nbhjd->nbhij', kbeta, kc) * decay_mat, 0.0)
    eye = jnp.eye(CHUNK, dtype=jnp.float32)
    t_mat = lax.linalg.triangular_solve(eye + a_mat, jnp.broadcast_to(eye, a_mat.shape),
                                        left_side=True, lower=True, unit_diagonal=True)
    u = jnp.einsum('nbhij,nbhjd->nbhid', t_mat, vc * bc[..., None])
    w = jnp.einsum('nbhij,nbhjd->nbhid', t_mat, kbeta * jnp.exp(gcum)[..., None])
    attn_intra = jnp.where(tril, jnp.einsum('nbhid,nbhjd->nbhij', qc, kc) * decay_mat, 0.0)
    g_last = gcum[..., -1]
    q_dec = qc * jnp.exp(gcum)[..., None]
    k_tail = kc * jnp.exp(g_last[..., None] - gcum)[..., None]

    def step(state, xs):
        qd, ui, wi, ai, gl, kt = xs
        v_new = ui - jnp.einsum('bhcd,bhde->bhce', wi, state)
        o = jnp.einsum('bhcd,bhde->bhce', qd, state) + jnp.einsum('bhij,bhje->bhie', ai, v_new)
        state = state * jnp.exp(gl)[..., None, None] + jnp.einsum('bhcd,bhce->bhde', kt, v_new)
        return state, o

    s0 = jnp.zeros((b, h, dk, dv), jnp.float32)
    _, o = lax.scan(step, s0, (q_dec, u, w, attn_intra, g_last, k_tail))
    return o.transpose(1, 0, 3, 2, 4).reshape(b, s, h, dv)


def hierarchical_moe(hn, w_rg, b_rg, w_re, b_re, w_gate, w_up, w_down):
    bsz, s, d = hn.shape
    t = hn.reshape(-1, d)
    p_group = jax.nn.softmax(t @ w_rg.astype(jnp.float32) + b_rg.astype(jnp.float32), axis=-1)
    g_idx = jnp.argmax(p_group, axis=-1)
    p_g = jnp.take_along_axis(p_group, g_idx[:, None], axis=-1)
    e_logits = (t @ w_re.astype(jnp.float32) + b_re.astype(jnp.float32)).reshape(-1, N_EXPERT_GROUPS, EXPERTS_PER_GROUP)
    sel_logits = jnp.take_along_axis(e_logits, g_idx[:, None, None], axis=1)[:, 0]
    p_exp = jax.nn.softmax(sel_logits, axis=-1)
    top_p, top_i = lax.top_k(p_exp, TOP_K)
    top_p = top_p / jnp.sum(top_p, axis=-1, keepdims=True)
    w_in_group = jnp.sum(jax.nn.one_hot(top_i, EXPERTS_PER_GROUP) * top_p[..., None], axis=1)
    combine = jax.nn.one_hot(g_idx, N_EXPERT_GROUPS)[:, :, None] * (p_g * w_in_group)[:, None, :]
    y = jnp.zeros_like(t)
    for gi in range(N_EXPERT_GROUPS):
        hg = jnp.einsum('td,edf->tef', t, w_gate[gi])
        hu = jnp.einsum('td,edf->tef', t, w_up[gi])
        act = jax.nn.silu(hg) * hu * combine[:, gi, :, None]
        y = y + jnp.einsum('tef,efd->td', act, w_down[gi])
    return y.reshape(bsz, s, d)


def setup_inputs(seed: int = 0) -> dict:
    key = jax.random.key(seed)
    ks = jax.random.split(key, 24)
    f32 = jnp.float32

    def nrm(k, shape, scale):
        return jax.random.normal(k, shape, f32) * scale

    def gain(k, n):
        return 1.0 + 0.05 * jax.random.normal(k, (DEPTH, n), f32)

    a_init = jax.random.uniform(ks[6], (DEPTH, DN_HEADS), f32, 1.0, 16.0)
    dt = jnp.exp(jax.random.uniform(ks[7], (DEPTH, DN_HEADS), f32, float(np.log(1e-3)), float(np.log(1e-1))))
    dt_bias = dt + jnp.log(-jnp.expm1(-dt))
    return {
        "x": nrm(ks[0], (BATCH, SEQ, D_MODEL), 1.0),
        "p": nrm(ks[1], (DEPTH, BATCH, SEQ, PLE_DIM), 1.0),
        "norm_mix": gain(ks[2], D_MODEL),
        "w_in": nrm(ks[3], (DEPTH, D_MODEL, IN_TOTAL), D_MODEL ** -0.5),
        "q_norm": gain(ks[4], HEAD_DIM_A),
        "k_norm": gain(ks[5], HEAD_DIM_A),
        "conv_w": nrm(ks[8], (DEPTH, CONV_WIDTH, 3 * DN_WIDTH), CONV_WIDTH ** -0.5),
        "a_log": jnp.log(a_init),
        "dt_bias": dt_bias,
        "dn_out_norm": gain(ks[9], DN_HEAD_DIM),
        "w_branch_a": nrm(ks[10], (DEPTH, ATTN_GROUP_WIDTH, D_MODEL), ATTN_GROUP_WIDTH ** -0.5),
        "w_branch_b": nrm(ks[11], (DEPTH, DN_WIDTH, D_MODEL), DN_WIDTH ** -0.5),
        "w_out": nrm(ks[12], (DEPTH, D_MODEL, D_MODEL), D_MODEL ** -0.5),
        "norm_ffn": gain(ks[13], D_MODEL),
        "w_router_group": nrm(ks[14], (DEPTH, D_MODEL, N_EXPERT_GROUPS), D_MODEL ** -0.5),
        "b_router_group": nrm(ks[15], (DEPTH, N_EXPERT_GROUPS), 0.01),
        "w_router_expert": nrm(ks[16], (DEPTH, D_MODEL, N_EXPERTS), D_MODEL ** -0.5),
        "b_router_expert": nrm(ks[17], (DEPTH, N_EXPERTS), 0.01),
        "w_expert_gate": nrm(ks[18], (DEPTH, N_EXPERT_GROUPS, EXPERTS_PER_GROUP, D_MODEL, D_EXPERT), D_MODEL ** -0.5),
        "w_expert_up": nrm(ks[19], (DEPTH, N_EXPERT_GROUPS, EXPERTS_PER_GROUP, D_MODEL, D_EXPERT), D_MODEL ** -0.5),
        "w_expert_down": nrm(ks[20], (DEPTH, N_EXPERT_GROUPS, EXPERTS_PER_GROUP, D_EXPERT, D_MODEL), D_EXPERT ** -0.5),
        "norm_ple": gain(ks[21], D_MODEL),
        "w_ple": nrm(ks[22], (DEPTH, PLE_DIM, D_MODEL), PLE_DIM ** -0.5),
        "w_ple_gate": nrm(ks[23], (DEPTH, D_MODEL, D_MODEL), D_MODEL ** -0.5),
    }


def reference(x, p, norm_mix, w_in, q_norm, k_norm, conv_w, a_log, dt_bias, dn_out_norm,
              w_branch_a, w_branch_b, w_out, norm_ffn, w_router_group, b_router_group,
              w_router_expert, b_router_expert, w_expert_gate, w_expert_up, w_expert_down,
              norm_ple, w_ple, w_ple_gate):
    b, s, d = x.shape
    x = x.astype(jnp.float32)
    for i in range(DEPTH):
        h = rms_norm(x, norm_mix[i])
        proj = h @ w_in[i].astype(jnp.float32)
        qkv_a, qkv_b, z_b, beta_b, alpha_b, gate_a, gate_b = split_columns(proj, IN_WIDTHS)

        qkv_a = qkv_a.reshape(b, s, 3, N_ATTN_GROUPS, HEADS_PER_GROUP, HEAD_DIM_A)
        qa = rms_norm(qkv_a[:, :, 0], q_norm[i])
        ka = rms_norm(qkv_a[:, :, 1], k_norm[i])
        va = qkv_a[:, :, 2]
        outs, lses = [], []
        for gi, (win, dil) in enumerate(ATTN_GROUPS):
            o_g, lse_g = dilated_window_attention(qa[:, :, gi], ka[:, :, gi], va[:, :, gi], win, dil)
            outs.append(o_g)
            lses.append(lse_g)
        mix_w = jax.nn.softmax(jnp.stack(lses, axis=0), axis=0)
        o_a = jnp.sum(mix_w[..., None] * jnp.stack(outs, axis=0), axis=0).reshape(b, s, ATTN_GROUP_WIDTH)

        qkv_b = causal_short_conv(qkv_b, conv_w[i].astype(jnp.float32))
        qb, kb, vb = split_columns(qkv_b, (DN_WIDTH, DN_WIDTH, DN_WIDTH))
        qb = l2_norm(qb.reshape(b, s, DN_HEADS, DN_HEAD_DIM)) * (DN_HEAD_DIM ** -0.5)
        kb = l2_norm(kb.reshape(b, s, DN_HEADS, DN_HEAD_DIM))
        vb = vb.reshape(b, s, DN_HEADS, DN_HEAD_DIM)
        beta = jax.nn.sigmoid(beta_b)
        g = -jnp.exp(a_log[i].astype(jnp.float32)) * jax.nn.softplus(alpha_b + dt_bias[i].astype(jnp.float32))
        o_b = gated_delta_rule(qb, kb, vb, beta, g)
        o_b = rms_norm(o_b, dn_out_norm[i]) * jax.nn.silu(z_b.reshape(b, s, DN_HEADS, DN_HEAD_DIM))
        o_b = o_b.reshape(b, s, DN_WIDTH)

        merged = (jax.nn.sigmoid(gate_a) * (o_a @ w_branch_a[i].astype(jnp.float32))
                  + jax.nn.sigmoid(gate_b) * (o_b @ w_branch_b[i].astype(jnp.float32)))
        x = x + merged @ w_out[i].astype(jnp.float32)

        h2 = rms_norm(x, norm_ffn[i])
        x = x + hierarchical_moe(h2, w_router_group[i], b_router_group[i], w_router_expert[i],
                                 b_router_expert[i], w_expert_gate[i].astype(jnp.float32),
                                 w_expert_up[i].astype(jnp.float32), w_expert_down[i].astype(jnp.float32))

        h3 = rms_norm(x, norm_ple[i])
        ple = p[i].astype(jnp.float32) @ w_ple[i].astype(jnp.float32)
        x = x + jax.nn.sigmoid(h3 @ w_ple_gate[i].astype(jnp.float32)) * ple
    return x
```

```cpp
#define MK_N_LAUNCHES 18
#include <hip/hip_runtime.h>
#include <cstdio>
#include <cstdint>
namespace pg8 {
#define PG8_LAS __attribute__((address_space(3)))
typedef unsigned short bf16_t;
typedef short bf16x8 __attribute__((ext_vector_type(8)));
typedef float f32x4 __attribute__((ext_vector_type(4)));
typedef unsigned u32x4 __attribute__((ext_vector_type(4)));
typedef unsigned u32x2 __attribute__((ext_vector_type(2)));
constexpr int BM = 256, BK = 64, HALF = 128, HTB = HALF * BK * 2  , STAGE_BYTES = 8 * HTB, NXCD = 8, WGM = 8;

__host__ __device__ __forceinline__ int lds_byte(int r, int c) { const int st = (r >> 4) * 2 + (c >> 5), rr = r & 15, cc = c & 31, ob = rr * 64 + cc * 2; return st * 1024 + (ob ^ (((ob >> 9) & 1) << 5)); }
__host__ __device__ __forceinline__ void stage_rc(int b, int& R, int& C) { const int st = b / 1024, sb = b % 1024, swz = sb ^ (((sb >> 9) & 1) << 5); R = (st >> 1) * 16 + swz / 64; C = (st & 1) * 32 + (swz % 64) / 2; }
__host__ __device__ __forceinline__ int perm32(int rho) { const int n = rho >> 4, i = rho & 15; return 8 * (i >> 2) + 4 * n + (i & 3); }

struct Unit { int pm, pn; const char* a; const char* b; };

struct StaticOrder {
    const char* A; const char* Bt; size_t tstep; int nM, nN, nwg, G, c;
    __device__ __forceinline__ void init(const void* A_, const void* Bt_, int M, int N, int K, int G_, int c_) { A = (const char*)A_; Bt = (const char*)Bt_; tstep = (size_t)BM * K * 2; nM = M / BM; nN = N / BM; nwg = nM * nN; G = G_; c = c_; }
    __device__ __forceinline__ bool next(int i, Unit& u) const {
        const long L = (long)i * G + c; if (L >= nwg) return false;
        int wgid = (int)L; { const int q = nwg / NXCD, r = nwg % NXCD, xcd = wgid % NXCD, off = wgid / NXCD; wgid = (xcd < r ? xcd * (q + 1) : r * (q + 1) + (xcd - r) * q) + off; }
        const int nig = WGM * nN, gid = wgid / nig, fm = gid * WGM, gsz = (nM - fm) < WGM ? (nM - fm) : WGM;
        u.pm = fm + ((wgid % nig) % gsz); u.pn = (wgid % nig) / gsz; u.a = A + (size_t)u.pm * tstep; u.b = Bt + (size_t)u.pn * tstep; return true;
    }
    __device__ __forceinline__ const char* a_ptr(const Unit& u) const { return u.a; }
    __device__ __forceinline__ const char* b_ptr(const Unit& u) const { return u.b; }
    __device__ __forceinline__ void a_ready(const Unit&) const {}
    __device__ __forceinline__ void done(const Unit&) const {}
};
struct ExpertOrder {
    const char* A; const char* Bt; const unsigned* cnt; size_t tstep, bstride; int nN, G, c;
    __device__ __forceinline__ void init(const void* A_, const void* Bt_, const unsigned* cnt_, int N, int K, int G_, int c_) { A = (const char*)A_; Bt = (const char*)Bt_; cnt = cnt_; tstep = (size_t)BM * K * 2; bstride = (size_t)N * K * 2; nN = N / BM; G = G_; c = c_; }
    __device__ __forceinline__ bool next(int i, Unit& u) const {
        const long L = (long)i * G + c; const int rt = (int)(L / nN), pn = (int)(L % nN);
        int acc = 0, found = -1;
        for (int e = 0; e < 16; ++e) { const int te = (int)((cnt[e] + 255u) >> 8); if (found < 0 && rt < acc + te) found = e; acc += te; }
        if (found < 0) return false;
        u.pm = rt; u.pn = pn; u.a = A + (size_t)rt * tstep; u.b = Bt + (size_t)found * bstride + (size_t)pn * tstep; return true;
    }
    __device__ __forceinline__ const char* a_ptr(const Unit& u) const { return u.a; }
    __device__ __forceinline__ const char* b_ptr(const Unit& u) const { return u.b; }
    __device__ __forceinline__ void a_ready(const Unit&) const {}
    __device__ __forceinline__ void done(const Unit&) const {}
};

typedef float f32x2_t __attribute__((ext_vector_type(2))); typedef __bf16 bf16x2_t __attribute__((ext_vector_type(2)));
__device__ __forceinline__ unsigned cvt_pk_bf16(float lo, float hi) { const f32x2_t v = {lo, hi}; const bf16x2_t b = __builtin_convertvector(v, bf16x2_t); return __builtin_bit_cast(unsigned, b); }
__device__ __forceinline__ float bflo(unsigned w) { return __uint_as_float(w << 16); }
__device__ __forceinline__ float bfhi(unsigned w) { return __uint_as_float(w & 0xffff0000u); }
__device__ __forceinline__ float sigm(float x) { return 1.0f / (1.0f + __expf(-x)); }
__device__ __forceinline__ u32x4 pack8(const f32x4 a, const f32x4 b) { u32x4 w; w.x = cvt_pk_bf16(a[0], a[1]); w.y = cvt_pk_bf16(a[2], a[3]); w.z = cvt_pk_bf16(b[0], b[1]); w.w = cvt_pk_bf16(b[2], b[3]); return w; }
__device__ __forceinline__ void unpack8(const u32x4 w, f32x4& a, f32x4& b) { a = (f32x4){bflo(w.x), bfhi(w.x), bflo(w.y), bfhi(w.y)}; b = (f32x4){bflo(w.z), bfhi(w.z), bflo(w.w), bfhi(w.w)}; }

constexpr float QSCALE = 0.125f * 1.4426950408889634f;
constexpr float EPSN = 1e-6f;
constexpr int QAP = 4608, QBP = 3072;

struct EpiP1 {
    static constexpr bool PERM = true, AFTER_DRAIN = false;
    bf16_t* QA; bf16_t* QB; float* BG; const float* qn; const float* kn; const float* a_log; const float* dt_bias;
    __device__ __forceinline__ void operator()(const f32x4 (&acc)[2][2][4][2], const Unit& u, int wr, int wc, int fr, int fq) const {
        const int row0 = u.pm * BM + wr * 64 + fr;
        if (u.pn < 12) {
            const float* gn = (u.pn < 6) ? qn : kn; const float sc = (u.pn < 6) ? QSCALE : 1.0f;
            f32x4 gv[2][2];
#pragma unroll
            for (int bj = 0; bj < 2; ++bj)
#pragma unroll
                for (int n = 0; n < 2; ++n) gv[bj][n] = *(const f32x4*)(gn + 32 * bj + 8 * fq + 4 * n) * sc;
#pragma unroll
            for (int ai = 0; ai < 2; ++ai)
#pragma unroll
                for (int m = 0; m < 4; ++m) {
                    float ss = 0.f;
#pragma unroll
                    for (int bj = 0; bj < 2; ++bj)
#pragma unroll
                        for (int n = 0; n < 2; ++n) { const f32x4 x = acc[ai][bj][m][n]; ss += (x[0] * x[0] + x[1] * x[1]) + (x[2] * x[2] + x[3] * x[3]); }
                    ss += __shfl_xor(ss, 16); ss += __shfl_xor(ss, 32);
                    const float rs = rsqrtf(ss * (1.0f / 64.0f) + EPSN);
                    bf16_t* rowp = QA + (size_t)(row0 + ai * HALF + m * 16) * QAP + u.pn * BM + wc * 64 + 8 * fq;
#pragma unroll
                    for (int bj = 0; bj < 2; ++bj) { const f32x4 v0 = acc[ai][bj][m][0] * rs * gv[bj][0], v1 = acc[ai][bj][m][1] * rs * gv[bj][1]; *(u32x4*)(rowp + bj * 32) = pack8(v0, v1); }
                }
        } else if (u.pn < 30) {
            bf16_t* const base = (u.pn < 18) ? QA + u.pn * BM : QB + (u.pn - 18) * BM; const int pitch = (u.pn < 18) ? QAP : QBP;
#pragma unroll
            for (int ai = 0; ai < 2; ++ai)
#pragma unroll
                for (int m = 0; m < 4; ++m) { bf16_t* rowp = base + (size_t)(row0 + ai * HALF + m * 16) * pitch + wc * 32 + 8 * fq;
#pragma unroll
                    for (int bj = 0; bj < 2; ++bj) *(u32x4*)(rowp + bj * HALF) = pack8(acc[ai][bj][m][0], acc[ai][bj][m][1]); }
        } else {
            if (wc == 0 && fq < 2) {
                f32x4 al[2], db[2];
#pragma unroll
                for (int n = 0; n < 2; ++n) { al[n] = *(const f32x4*)(a_log + 4 * n); db[n] = *(const f32x4*)(dt_bias + 4 * n); }
#pragma unroll
                for (int ai = 0; ai < 2; ++ai)
#pragma unroll
                    for (int m = 0; m < 4; ++m) { float* rowp = BG + (size_t)(row0 + ai * HALF + m * 16) * 16 + 8 * fq;
#pragma unroll
                        for (int n = 0; n < 2; ++n) { const f32x4 x = acc[ai][0][m][n]; f32x4 o;
#pragma unroll
                            for (int e = 0; e < 4; ++e) { if (fq == 0) o[e] = sigm(x[e]); else { const float z = x[e] + db[n][e]; const float sp = z > 20.f ? z : log1pf(__expf(z)); o[e] = -__expf(al[n][e]) * sp; } }
                            *(f32x4*)(rowp + 4 * n) = o; } }
            }
        }
    }
};
struct EpiSiluMul {
    static constexpr bool PERM = true, AFTER_DRAIN = false;
    bf16_t* O;
    __device__ __forceinline__ void operator()(const f32x4 (&acc)[2][2][4][2], const Unit& u, int wr, int wc, int fr, int fq) const {
        const int row0 = u.pm * BM + wr * 64 + fr;
#pragma unroll
        for (int ai = 0; ai < 2; ++ai)
#pragma unroll
            for (int m = 0; m < 4; ++m) { bf16_t* rowp = O + (size_t)(row0 + ai * HALF + m * 16) * 1024 + u.pn * BM + wc * 32 + 8 * fq;
#pragma unroll
                for (int bj = 0; bj < 2; ++bj) { const u32x4 w = *(const u32x4*)(rowp + bj * HALF); f32x4 a, b; unpack8(w, a, b); f32x4 z0 = acc[ai][bj][m][0], z1 = acc[ai][bj][m][1];
#pragma unroll
                    for (int e = 0; e < 4; ++e) { a[e] *= z0[e] * sigm(z0[e]); b[e] *= z1[e] * sigm(z1[e]); }
                    *(u32x4*)(rowp + bj * HALF) = pack8(a, b); } }
    }
};
template <int MODE> struct EpiBf16 {
    static constexpr bool PERM = true, AFTER_DRAIN = false;
    bf16_t* O; int ldc;
    __device__ __forceinline__ void operator()(const f32x4 (&acc)[2][2][4][2], const Unit& u, int wr, int wc, int fr, int fq) const {
        const int row0 = u.pm * BM + wr * 64 + fr;
#pragma unroll
        for (int ai = 0; ai < 2; ++ai)
#pragma unroll
            for (int m = 0; m < 4; ++m) { bf16_t* rowp = O + (size_t)(row0 + ai * HALF + m * 16) * ldc + u.pn * BM + wc * 32 + 8 * fq;
#pragma unroll
                for (int bj = 0; bj < 2; ++bj) { f32x4 a = acc[ai][bj][m][0], b = acc[ai][bj][m][1];
                    if (MODE == 1) {
#pragma unroll
                        for (int e = 0; e < 4; ++e) { a[e] = sigm(a[e]); b[e] = sigm(b[e]); } }
                    *(u32x4*)(rowp + bj * HALF) = pack8(a, b); } }
    }
};
template <bool ADD> struct EpiGateMul {
    static constexpr bool PERM = true, AFTER_DRAIN = false;
    const bf16_t* Gt; bf16_t* Mo;
    __device__ __forceinline__ void operator()(const f32x4 (&acc)[2][2][4][2], const Unit& u, int wr, int wc, int fr, int fq) const {
        const int row0 = u.pm * BM + wr * 64 + fr;
#pragma unroll
        for (int ai = 0; ai < 2; ++ai)
#pragma unroll
            for (int m = 0; m < 4; ++m) { const size_t off = (size_t)(row0 + ai * HALF + m * 16) * 1024 + u.pn * BM + wc * 32 + 8 * fq;
#pragma unroll
                for (int bj = 0; bj < 2; ++bj) { const u32x4 gw = *(const u32x4*)(Gt + off + bj * HALF); f32x4 ga, gb; unpack8(gw, ga, gb);
                    f32x4 a = ga * acc[ai][bj][m][0], b = gb * acc[ai][bj][m][1];
                    if (ADD) { const u32x4 mw = *(const u32x4*)(Mo + off + bj * HALF); f32x4 ma, mb; unpack8(mw, ma, mb); a += ma; b += mb; }
                    *(u32x4*)(Mo + off + bj * HALF) = pack8(a, b); } }
    }
};
struct EpiResF32 {
    static constexpr bool PERM = false, AFTER_DRAIN = false;
    const float* base; float* out;
    __device__ __forceinline__ void operator()(const f32x4 (&acc)[2][2][4][2], const Unit& u, int wr, int wc, int fr, int fq) const {
        const int row0 = u.pm * BM + wr * 64 + fr, col0 = u.pn * BM + wc * 32 + 4 * fq;
#pragma unroll
        for (int ai = 0; ai < 2; ++ai)
#pragma unroll
            for (int m = 0; m < 4; ++m) { const size_t off = (size_t)(row0 + ai * HALF + m * 16) * 1024 + col0;
#pragma unroll
                for (int bj = 0; bj < 2; ++bj)
#pragma unroll
                    for (int n = 0; n < 2; ++n) { const f32x4 bs = *(const f32x4*)(base + off + bj * HALF + n * 16); *(f32x4*)(out + off + bj * HALF + n * 16) = bs + acc[ai][bj][m][n]; }
                asm volatile("" ::: "memory"); }
    }
};
struct EpiPleOut {
    static constexpr bool PERM = false, AFTER_DRAIN = false;
    const bf16_t* E1; float* out;
    __device__ __forceinline__ void operator()(const f32x4 (&acc)[2][2][4][2], const Unit& u, int wr, int wc, int fr, int fq) const {
        const int row0 = u.pm * BM + wr * 64 + fr, col0 = u.pn * BM + wc * 32 + 4 * fq;
#pragma unroll
        for (int ai = 0; ai < 2; ++ai)
#pragma unroll
            for (int m = 0; m < 4; ++m) { const size_t off = (size_t)(row0 + ai * HALF + m * 16) * 1024 + col0;
#pragma unroll
                for (int bj = 0; bj < 2; ++bj)
#pragma unroll
                    for (int n = 0; n < 2; ++n) { const size_t o2 = off + bj * HALF + n * 16; const f32x4 bs = *(const f32x4*)(out + o2); const u32x2 ew = *(const u32x2*)(E1 + o2);
                        const f32x4 ev = (f32x4){bflo(ew.x), bfhi(ew.x), bflo(ew.y), bfhi(ew.y)}; const f32x4 a = acc[ai][bj][m][n]; f32x4 r;
#pragma unroll
                        for (int e = 0; e < 4; ++e) r[e] = bs[e] + sigm(a[e]) * ev[e];
                        *(f32x4*)(out + o2) = r; }
                asm volatile("" ::: "memory"); }
    }
};
struct EpiGU {
    static constexpr bool PERM = true, AFTER_DRAIN = false;
    bf16_t* ACT; const float* CW;
    __device__ __forceinline__ void operator()(const f32x4 (&acc)[2][2][4][2], const Unit& u, int wr, int wc, int fr, int fq) const {
        const int row0 = u.pm * BM + wr * 64 + fr;
#pragma unroll
        for (int ai = 0; ai < 2; ++ai)
#pragma unroll
            for (int m = 0; m < 4; ++m) { const int row = row0 + ai * HALF + m * 16; const float cw = CW[row];
                f32x4 a, b; const f32x4 g0 = acc[ai][0][m][0], g1 = acc[ai][0][m][1], u0 = acc[ai][1][m][0], u1 = acc[ai][1][m][1];
#pragma unroll
                for (int e = 0; e < 4; ++e) { a[e] = g0[e] * sigm(g0[e]) * u0[e] * cw; b[e] = g1[e] * sigm(g1[e]) * u1[e] * cw; }
                *(u32x4*)(ACT + (size_t)row * 256 + u.pn * HALF + wc * 32 + 8 * fq) = pack8(a, b); }
    }
};

template <class Epi, class Sched, bool ALIGN_EPI = false, bool SP2 = false>
__device__ __forceinline__ void gemm_phase(PG8_LAS unsigned char* lds, const int KK, const Sched& S, const Epi& E) {
    int tid_ = threadIdx.x; asm volatile("" : "+v"(tid_));
    const int tid = tid_, wid = __builtin_amdgcn_readfirstlane(tid >> 6), lane = tid & 63, wr = wid >> 2, wc = wid & 3, fr = lane & 15, fq = lane >> 4;
    int K_ = KK; asm volatile("" : "+s"(K_));
    const int K = K_, nt = K / BK;
    unsigned voffA[2], voffB[2];
#pragma unroll
    for (int i = 0; i < 2; ++i) { int R, C; stage_rc(tid * 16 + i * 8192, R, C); const int Rb = Epi::PERM ? ((R & ~31) + perm32(R & 31)) : R;
        voffA[i] = (unsigned)(R * K + C) * 2u; voffB[i] = (unsigned)(Rb * K + C) * 2u; }
    const size_t kstep = (size_t)(BK * 2);
    const size_t hstep = (size_t)HALF * K * 2;
    const size_t tstep = 2 * hstep;
    const unsigned ldsw = (unsigned)wid * 1024u;
    const int aoff = lds_byte(wr * 64 + fr, fq * 8), boff = lds_byte(wc * 32 + fr, fq * 8);
#define PG8_SA(b, h) (((b) * 2 + (h)) * HTB)
#define PG8_SB(b, h) ((4 + (b) * 2 + (h)) * HTB)
#define PG8_STAGE(bufoff, gbase, voff) do { _Pragma("unroll") for (int _i = 0; _i < 2; ++_i) \
        __builtin_amdgcn_global_load_lds((const unsigned*)((const char*)(gbase) + (voff)[_i]), (PG8_LAS unsigned*)(lds + (bufoff) + ldsw + _i * 8192), 16, 0, 0); } while (0)
#define PG8_LDA(dst, b, h) do { _Pragma("unroll") for (int m = 0; m < 4; ++m) _Pragma("unroll") for (int k = 0; k < 2; ++k) dst[m][k] = *(const PG8_LAS bf16x8*)(lds + PG8_SA(b, h) + aoff + m * 2048 + k * 1024); } while (0)
#define PG8_LDB(dst, b, h) do { _Pragma("unroll") for (int n = 0; n < 2; ++n) _Pragma("unroll") for (int k = 0; k < 2; ++k) dst[n][k] = *(const PG8_LAS bf16x8*)(lds + PG8_SB(b, h) + boff + n * 2048 + k * 1024); } while (0)
#define PG8_MMA(ai, bj, At, Bt) do { __builtin_amdgcn_s_setprio(1); _Pragma("unroll") for (int m = 0; m < 4; ++m) _Pragma("unroll") for (int n = 0; n < 2; ++n) _Pragma("unroll") for (int k = 0; k < 2; ++k) \
        acc[ai][bj][m][n] = __builtin_amdgcn_mfma_f32_16x16x32_bf16(Bt[n][k], At[m][k], acc[ai][bj][m][n], 0, 0, 0); __builtin_amdgcn_s_setprio(0); } while (0)
#define PG8_WAIT_V(n) asm volatile("s_waitcnt vmcnt(" #n ")" ::: "memory")
#define PG8_WAIT_L(n) asm volatile("s_waitcnt lgkmcnt(" #n ")" ::: "memory")
#define PG8_BAR __builtin_amdgcn_s_barrier()
#define PG8_SCHED __builtin_amdgcn_sched_barrier(0)
    Unit cur, nxt; int ui = 0;
    if (!S.next(0, cur)) return;
    f32x4 acc[2][2][4][2];
#pragma unroll
    for (int a = 0; a < 2; ++a)
#pragma unroll
        for (int b = 0; b < 2; ++b)
#pragma unroll
            for (int m = 0; m < 4; ++m)
#pragma unroll
                for (int n = 0; n < 2; ++n) acc[a][b][m][n] = (f32x4){0.f, 0.f, 0.f, 0.f};
    bf16x8 At[4][2], B0[2][2], B1[2][2];
    const char* cA = S.a_ptr(cur); const char* cB = S.b_ptr(cur);
    S.a_ready(cur);
    if constexpr (SP2) {
        PG8_STAGE(PG8_SB(0, 0), cB, voffB); PG8_STAGE(PG8_SB(0, 1), cB + hstep, voffB); PG8_STAGE(PG8_SA(0, 0), cA, voffA); PG8_STAGE(PG8_SA(0, 1), cA + hstep, voffA);
        if (wr == 1) PG8_BAR;
        PG8_WAIT_V(2); PG8_BAR;
        PG8_STAGE(PG8_SB(1, 0), cB + kstep, voffB); PG8_STAGE(PG8_SA(1, 0), cA + kstep, voffA); PG8_STAGE(PG8_SB(1, 1), cB + hstep + kstep, voffB);
        PG8_WAIT_V(6); PG8_BAR;
    } else {
        PG8_STAGE(PG8_SB(0, 0), cB, voffB); PG8_STAGE(PG8_SA(0, 0), cA, voffA); PG8_STAGE(PG8_SB(0, 1), cB + hstep, voffB); PG8_STAGE(PG8_SA(0, 1), cA + hstep, voffA);
        if (wr == 1) PG8_BAR;
        PG8_WAIT_V(4); PG8_BAR;
        PG8_STAGE(PG8_SB(1, 0), cB + kstep, voffB); PG8_STAGE(PG8_SA(1, 0), cA + kstep, voffA); PG8_STAGE(PG8_SB(1, 1), cB + hstep + kstep, voffB);
        PG8_WAIT_V(6); PG8_BAR;
    }
    for (;;) {
        const bool has_next = S.next(ui + 1, nxt);
        const char* nA = has_next ? S.a_ptr(nxt) : cA; const char* nB = has_next ? S.b_ptr(nxt) : cB;
        for (int t = 0; t < nt; t += 2) {
            const bool last = (t == nt - 2);
            const char* a1 = cA + (size_t)(t + 1) * kstep;
            const char* a2 = last ? nA : cA + (size_t)(t + 2) * kstep; const char* b2 = last ? nB : cB + (size_t)(t + 2) * kstep;
            const char* a3 = a2 + kstep; const char* b3 = b2 + kstep;
            if (last && has_next) S.a_ready(nxt);
            if constexpr (SP2) {
            PG8_LDB(B0, 0, 0); PG8_LDB(B1, 0, 1); PG8_SCHED; PG8_LDA(At, 0, 0); PG8_STAGE(PG8_SA(1, 1), a1 + hstep, voffA);
            PG8_WAIT_V(8); PG8_WAIT_L(0); PG8_BAR; PG8_MMA(0, 0, At, B0); PG8_MMA(0, 1, At, B1); PG8_BAR; PG8_SCHED;
            PG8_LDA(At, 0, 1); PG8_STAGE(PG8_SB(0, 0), b2, voffB); PG8_STAGE(PG8_SB(0, 1), b2 + hstep, voffB); PG8_STAGE(PG8_SA(0, 0), a2, voffA);
            PG8_WAIT_V(8); PG8_WAIT_L(0); PG8_BAR; PG8_MMA(1, 0, At, B0); PG8_MMA(1, 1, At, B1); PG8_BAR; PG8_SCHED;
            PG8_LDB(B0, 1, 0); PG8_LDB(B1, 1, 1); PG8_SCHED; PG8_LDA(At, 1, 0); PG8_STAGE(PG8_SA(0, 1), a2 + hstep, voffA);
            PG8_WAIT_V(8); PG8_WAIT_L(0); PG8_BAR; PG8_MMA(0, 0, At, B0); PG8_MMA(0, 1, At, B1); PG8_BAR; PG8_SCHED;
            PG8_LDA(At, 1, 1); PG8_STAGE(PG8_SB(1, 0), b3, voffB); PG8_STAGE(PG8_SB(1, 1), b3 + hstep, voffB); PG8_STAGE(PG8_SA(1, 0), a3, voffA);
            PG8_WAIT_V(8); PG8_WAIT_L(0); PG8_BAR; PG8_MMA(1, 0, At, B0); PG8_MMA(1, 1, At, B1); PG8_BAR; PG8_SCHED;
            } else {
            PG8_LDB(B0, 0, 0); PG8_SCHED; PG8_LDA(At, 0, 0); PG8_STAGE(PG8_SA(1, 1), a1 + hstep, voffA);
            PG8_WAIT_L(8); PG8_BAR; PG8_WAIT_L(0); PG8_MMA(0, 0, At, B0); PG8_BAR; PG8_SCHED;
            PG8_LDB(B1, 0, 1); PG8_STAGE(PG8_SB(0, 0), b2, voffB);
            PG8_BAR; PG8_WAIT_L(0); PG8_MMA(0, 1, At, B1); PG8_BAR;
            PG8_LDA(At, 0, 1); PG8_STAGE(PG8_SA(0, 0), a2, voffA);
            PG8_BAR; PG8_WAIT_L(0); PG8_MMA(1, 0, At, B0); PG8_BAR; PG8_SCHED;
            PG8_STAGE(PG8_SB(0, 1), b2 + hstep, voffB);
            PG8_WAIT_V(6); PG8_BAR; PG8_MMA(1, 1, At, B1); PG8_BAR;
            PG8_LDB(B0, 1, 0); PG8_SCHED; PG8_LDA(At, 1, 0); PG8_STAGE(PG8_SA(0, 1), a2 + hstep, voffA);
            PG8_WAIT_L(8); PG8_BAR; PG8_WAIT_L(0); PG8_MMA(0, 0, At, B0); PG8_BAR; PG8_SCHED;
            PG8_LDB(B1, 1, 1); PG8_STAGE(PG8_SB(1, 0), b3, voffB);
            PG8_BAR; PG8_WAIT_L(0); PG8_MMA(0, 1, At, B1); PG8_BAR;
            PG8_LDA(At, 1, 1); PG8_STAGE(PG8_SA(1, 0), a3, voffA);
            PG8_BAR; PG8_WAIT_L(0); PG8_MMA(1, 0, At, B0); PG8_BAR; PG8_SCHED;
            PG8_STAGE(PG8_SB(1, 1), b3 + hstep, voffB);
            PG8_WAIT_V(6); PG8_BAR; PG8_MMA(1, 1, At, B1); PG8_BAR;
            }
        }
        if constexpr (ALIGN_EPI) { if (wr == 0) PG8_BAR; }
        if constexpr (!Epi::AFTER_DRAIN) { E(acc, cur, wr, wc, fr, fq); S.done(cur); }
        if (!has_next) break;
#pragma unroll
        for (int a = 0; a < 2; ++a)
#pragma unroll
            for (int b = 0; b < 2; ++b)
#pragma unroll
                for (int m = 0; m < 4; ++m)
#pragma unroll
                    for (int n = 0; n < 2; ++n) acc[a][b][m][n] = (f32x4){0.f, 0.f, 0.f, 0.f};
        cur = nxt; cA = nA; cB = nB; ++ui;
        if constexpr (ALIGN_EPI) { if (wr == 1) PG8_BAR; }
    }
    PG8_WAIT_V(0);
    if constexpr (!ALIGN_EPI) { if (wr == 0) PG8_BAR; }
    PG8_BAR;
    if constexpr (Epi::AFTER_DRAIN) { E.fused(acc, cur, wr, wc, fr, fq, lds, wid, lane); S.done(cur); }
#undef PG8_SA
#undef PG8_SB
#undef PG8_STAGE
#undef PG8_LDA
#undef PG8_LDB
#undef PG8_MMA
#undef PG8_WAIT_V
#undef PG8_WAIT_L
#undef PG8_BAR
#undef PG8_SCHED
}
}

constexpr int NWAVES = 8;
constexpr int BATCH = 8, SEQ = 8192, D = 1024, T = BATCH * SEQ;
constexpr int IN_TOTAL = 10768, NP1 = 7936;
constexpr int NSLOT = 2 * T + 4096;
constexpr int NPH = 18;
#ifndef MK_N_LAUNCHES
#define MK_N_LAUNCHES 1
#endif
constexpr int N_LAUNCHES = MK_N_LAUNCHES;
static_assert(N_LAUNCHES == 1 || N_LAUNCHES == NPH, "MK_N_LAUNCHES is 1 or NPH");
constexpr int DNU = 73728;

constexpr size_t MiB = 1u << 20;
constexpr size_t WS_CTL = 0, CTL_ZERO_BYTES = 1 * MiB;
constexpr size_t WS_BTP1 = 1 * MiB;
constexpr size_t WS_BTZ = 17 * MiB, WS_BTGA = 19 * MiB, WS_BTGB = 21 * MiB, WS_BTB = 23 * MiB, WS_BTOUT = 25 * MiB, WS_BTPG = 27 * MiB;
constexpr size_t WS_BTA = 29 * MiB;
constexpr size_t WS_BTPLE = 30 * MiB;
constexpr size_t WS_BTGU = 31 * MiB;
constexpr size_t WS_BTDN = 47 * MiB;
constexpr size_t WS_QA = 56 * MiB;
constexpr size_t WS_DNP = 56 * MiB;
constexpr size_t WS_G1 = 56 * MiB, WS_G2 = 184 * MiB;
constexpr size_t WS_H3 = 56 * MiB;
constexpr size_t WS_H2 = 184 * MiB;
constexpr size_t WS_PB = 184 * MiB;
constexpr size_t WS_E1 = 216 * MiB;
constexpr size_t WS_HX = 312 * MiB;
constexpr size_t WS_ACT = 576 * MiB;
constexpr size_t WS_Y = 642 * MiB;
constexpr size_t WS_QB = 632 * MiB;
constexpr size_t WS_ON = 632 * MiB;
constexpr size_t WS_OA = 760 * MiB;
constexpr size_t WS_HR = 824 * MiB;
constexpr size_t WS_BG = 1016 * MiB;
constexpr size_t WS_TOK = 1020 * MiB;
constexpr size_t WS_SLOT = 1021 * MiB;
constexpr size_t WS_CW = 1021 * MiB + 512 * 1024;
constexpr size_t WS_DLB = 1022 * MiB + 256 * 1024;
constexpr size_t WS_END = 1024 * MiB;
static_assert(WS_Y + (size_t)NSLOT * 2048 <= WS_BG && WS_HX + (size_t)NSLOT * 2048 <= WS_ACT && WS_ACT + (size_t)NSLOT * 512 <= WS_Y && WS_HR + (size_t)T * 2048 <= WS_BG && WS_CW + (size_t)NSLOT * 4 <= WS_DLB, "d_ws map");
constexpr size_t DO_H = 0, DO_OG = 0, DO_LSE = 192 * MiB;
constexpr int CW_BAR = 4096;
constexpr int CW_CNT = 16384;
constexpr int CW_CUR = 16384 + 64;
constexpr int RING_OFF = 0, RING_BYTES = 131072;
constexpr int LDS_BYTES = 147456;
constexpr int MISC_OFF = LDS_BYTES - 256;

#define GAS __attribute__((address_space(1)))
#define LAS __attribute__((address_space(3)))
typedef unsigned short bf16;
typedef unsigned v4u __attribute__((ext_vector_type(4)));
typedef unsigned v2u __attribute__((ext_vector_type(2)));
typedef float f32x4 __attribute__((ext_vector_type(4)));
typedef float f32x16 __attribute__((ext_vector_type(16)));
typedef short bf16x8 __attribute__((ext_vector_type(8)));
typedef short s16x4 __attribute__((ext_vector_type(4)));
typedef GAS unsigned gu32;
#define RLX_AGENT __ATOMIC_RELAXED, __HIP_MEMORY_SCOPE_AGENT
using pg8::cvt_pk_bf16; using pg8::bflo; using pg8::bfhi; using pg8::pack8; using pg8::unpack8; using pg8::sigm;
__device__ __forceinline__ float bf2f(unsigned short b) { return __uint_as_float(((unsigned)b) << 16); }
__device__ __forceinline__ unsigned short f2bf(float f) { return (unsigned short)(cvt_pk_bf16(f, 0.f) & 0xffffu); }
__device__ __forceinline__ int crow(int r, int hi) { return (r & 3) + 8 * (r >> 2) + 4 * hi; }
__device__ __forceinline__ float wave_sum(float v) {
#pragma unroll
    for (int o = 1; o < 64; o <<= 1) v += __shfl_xor(v, o);
    return v;
}
__device__ __forceinline__ s16x4 ldtr(const LAS unsigned char* p) { return __builtin_bit_cast(s16x4, __builtin_amdgcn_ds_read_tr16_b64_v4i16((LAS s16x4*)p)); }
#define MFMA32(a, b, c) __builtin_amdgcn_mfma_f32_32x32x16_bf16((a), (b), (c), 0, 0, 0)

#define XB_TMO      128
#define XB_XCNT(j)  (256  + 64 * (j))
#define XB_XSUB(j)  (1280 + 64 * (j))
#define XB_XGEN(j)  (2304 + 64 * (j))
#define XB_TOP      3328
#define XB_TOPGEN   3392
#define XCD_BAR_WORDS 3456
#define XB_SPIN_CAP (1u << 18)

__device__ __forceinline__ unsigned xb_ld(unsigned* p)              { return __hip_atomic_load(p, __ATOMIC_RELAXED, __HIP_MEMORY_SCOPE_AGENT); }
__device__ __forceinline__ unsigned xb_add(unsigned* p, unsigned v) { return __hip_atomic_fetch_add(p, v, __ATOMIC_RELAXED, __HIP_MEMORY_SCOPE_AGENT); }
__device__ __forceinline__ unsigned xb_xcc_id() { return (unsigned)__builtin_amdgcn_s_getreg((3 << 11) | 20) & 0xFu; }
#define XB_SPIN(cond, bar) do { unsigned _sp = 0; while (cond) { __builtin_amdgcn_s_sleep(1); \
    if ((++_sp & 255u) == 0u) { if (xb_ld(&(bar)[XB_TMO])) break; if (_sp > XB_SPIN_CAP) { atomicAdd(&(bar)[XB_TMO], 1u); break; } } } } while (0)

struct XcdBarrier {
    unsigned* bar; unsigned x;
    volatile LAS unsigned* st;
};

__device__ __forceinline__ XcdBarrier xcd_barrier_post(unsigned* bar, volatile LAS unsigned* st) {
    XcdBarrier b; b.bar = bar; b.x = xb_xcc_id(); b.st = st;
    if (threadIdx.x == 0) (void)xb_add(&bar[XB_XCNT(b.x)], 1u);
    return b;
}
__device__ __forceinline__ void xcd_barrier_complete(unsigned* bar, unsigned x, unsigned& nloc, unsigned& nx) {
    const unsigned G = gridDim.x * gridDim.y * gridDim.z;
    unsigned sum, cnt, mine, sp = 0u;
    for (;;) {
        sum = 0u; cnt = 0u; mine = 0u;
#pragma unroll
        for (unsigned j = 0; j < 16; ++j) { const unsigned c = xb_ld(&bar[XB_XCNT(j)]); sum += c; cnt += (c > 0u) ? 1u : 0u; mine = (j == x) ? c : mine; }
        if (sum == G) break;
        __builtin_amdgcn_s_sleep(1);
        if ((++sp & 255u) == 0u) { if (xb_ld(&bar[XB_TMO])) break; if (sp > XB_SPIN_CAP) { atomicAdd(&bar[XB_TMO], 1u); break; } }
    }
    nloc = mine > 0u ? mine : 1u; nx = cnt > 0u ? cnt : 1u;
}

__device__ __forceinline__ void xcd_barrier(const XcdBarrier& b) {
    asm volatile("s_waitcnt vmcnt(0)" ::: "memory");
    __syncthreads();
    if (threadIdx.x == 0) {
        unsigned* bar = b.bar;
        __builtin_amdgcn_s_waitcnt(0);
        unsigned nloc = b.st[0], nx = b.st[1];
        if (nloc == 0u) { xcd_barrier_complete(bar, b.x, nloc, nx); b.st[0] = nloc; b.st[1] = nx; }
        const unsigned old = xb_add(&bar[XB_XSUB(b.x)], 1u);
        const unsigned gen = old / nloc;
        if (old + 1u == (gen + 1u) * nloc) {
            __builtin_amdgcn_fence(__ATOMIC_RELEASE, "agent");
            asm volatile("s_waitcnt vmcnt(0)" ::: "memory");
            const unsigned og = xb_add(&bar[XB_TOP], 1u);
            const unsigned tg = og / nx;
            if (og + 1u == (tg + 1u) * nx) xb_add(&bar[XB_TOPGEN], 1u);
            else XB_SPIN(xb_ld(&bar[XB_TOPGEN]) == tg, bar);
            __builtin_amdgcn_fence(__ATOMIC_ACQUIRE, "agent");
            xb_add(&bar[XB_XGEN(b.x)], 1u);
            asm volatile("s_waitcnt vmcnt(0)" ::: "memory");
        } else {
            XB_SPIN(xb_ld(&bar[XB_XGEN(b.x)]) == gen, bar);
            __builtin_amdgcn_fence(__ATOMIC_ACQUIRE, "agent");
            asm volatile("s_waitcnt vmcnt(0)" ::: "memory");
        }
    }
    __syncthreads();
}

__device__ __forceinline__ void p0_tr_item(const float* W, int ld, int K, int scol, bf16* WT, int drow, int k0, LAS float* scr, int lane) {
#pragma unroll 8
    for (int i = 0; i < 32; ++i) { const int kk = 2 * i + (lane >> 5); scr[kk * 33 + (lane & 31)] = W[(size_t)(k0 + kk) * ld + scol + (lane & 31)]; }
    asm volatile("s_waitcnt lgkmcnt(0)" ::: "memory");
    const int c = lane & 7;
#pragma unroll
    for (int j = 0; j < 4; ++j) { const int n = (lane >> 3) + 8 * j; const LAS float* s = scr + (8 * c) * 33 + n;
        v4u o; o.x = cvt_pk_bf16(s[0 * 33], s[1 * 33]); o.y = cvt_pk_bf16(s[2 * 33], s[3 * 33]); o.z = cvt_pk_bf16(s[4 * 33], s[5 * 33]); o.w = cvt_pk_bf16(s[6 * 33], s[7 * 33]);
        *(GAS v4u*)(WT + (size_t)(drow + n) * K + k0 + 8 * c) = o; }
    asm volatile("s_waitcnt lgkmcnt(0)" ::: "memory");
}
__device__ __forceinline__ void rms_row_to_bf16(const float* xrow, const float* gain, bf16* orow, int lane) {
    const GAS f32x4* xr = (const GAS f32x4*)xrow + lane; const GAS f32x4* gr = (const GAS f32x4*)gain + lane;
    f32x4 v[4]; float s = 0.f;
#pragma unroll
    for (int j = 0; j < 4; ++j) { v[j] = xr[64 * j]; s += (v[j].x * v[j].x + v[j].y * v[j].y) + (v[j].z * v[j].z + v[j].w * v[j].w); }
    const float rs = rsqrtf(wave_sum(s) * (1.f / D) + 1e-6f);
    GAS v2u* o8 = (GAS v2u*)orow + lane;
#pragma unroll
    for (int j = 0; j < 4; ++j) { const f32x4 g = gr[64 * j]; v2u w; w.x = cvt_pk_bf16(v[j].x * rs * g.x, v[j].y * rs * g.y); w.y = cvt_pk_bf16(v[j].z * rs * g.z, v[j].w * rs * g.w); o8[64 * j] = w; }
}

struct Ptrs {
    const float* in[24]; float* out; unsigned char* ws;
};

__device__ __forceinline__ void p0_prologue(const Ptrs& P, LAS unsigned char* lds, int G, int c, int wave, int lane) {
    LAS float* scr = (LAS float*)(lds + wave * 16384);
    const int gw = c * NWAVES + wave, NGW = G * NWAVES;
    const float* w_in = P.in[3];
    bf16* BTP1 = (bf16*)(P.ws + WS_BTP1);
    constexpr int I_QK = 16 * 96, I_VB = 16 * 144, I_BA = 16, I_Z = 16 * 32, I_A = 8 * 32, I_SQ = 16 * 32, I_PLE = 4 * 32, I_EG = 16 * 16 * 8, I_ED = 16 * 4 * 32;
    constexpr int NITEMS = I_QK + I_VB + I_BA + 3 * I_Z + I_A + 3 * I_SQ + I_PLE + 2 * I_EG + I_ED;
    for (int it = gw; it < NITEMS; it += NGW) {
        int r = it;
        if (r < I_QK) { const int kb = r / 96, nb = r % 96, n0 = 32 * nb, pn = n0 >> 8, w = n0 & 255, wc = w >> 6, bj = (w >> 5) & 1;
            p0_tr_item(w_in, IN_TOTAL, D, n0, BTP1, 256 * pn + 128 * bj + 32 * wc, 64 * kb, scr, lane); continue; } r -= I_QK;
        if (r < I_VB) { const int kb = r / 144, nb = r % 144, n0 = 3072 + 32 * nb; p0_tr_item(w_in, IN_TOTAL, D, n0, BTP1, n0, 64 * kb, scr, lane); continue; } r -= I_VB;
        if (r < I_BA) { p0_tr_item(w_in, IN_TOTAL, D, 8704, BTP1, 7680, 64 * r, scr, lane); continue; } r -= I_BA;
        if (r < I_Z) { const int kb = r / 32, nb = r % 32; p0_tr_item(w_in, IN_TOTAL, D, 7680 + 32 * nb, (bf16*)(P.ws + WS_BTZ), 32 * nb, 64 * kb, scr, lane); continue; } r -= I_Z;
        if (r < I_Z) { const int kb = r / 32, nb = r % 32; p0_tr_item(w_in, IN_TOTAL, D, 8720 + 32 * nb, (bf16*)(P.ws + WS_BTGA), 32 * nb, 64 * kb, scr, lane); continue; } r -= I_Z;
        if (r < I_Z) { const int kb = r / 32, nb = r % 32; p0_tr_item(w_in, IN_TOTAL, D, 9744 + 32 * nb, (bf16*)(P.ws + WS_BTGB), 32 * nb, 64 * kb, scr, lane); continue; } r -= I_Z;
        if (r < I_A) { const int kb = r / 32, nb = r % 32; p0_tr_item(P.in[10], D, 512, 32 * nb, (bf16*)(P.ws + WS_BTA), 32 * nb, 64 * kb, scr, lane); continue; } r -= I_A;
        if (r < I_SQ) { const int kb = r / 32, nb = r % 32; p0_tr_item(P.in[11], D, D, 32 * nb, (bf16*)(P.ws + WS_BTB), 32 * nb, 64 * kb, scr, lane); continue; } r -= I_SQ;
        if (r < I_SQ) { const int kb = r / 32, nb = r % 32; p0_tr_item(P.in[12], D, D, 32 * nb, (bf16*)(P.ws + WS_BTOUT), 32 * nb, 64 * kb, scr, lane); continue; } r -= I_SQ;
        if (r < I_SQ) { const int kb = r / 32, nb = r % 32; p0_tr_item(P.in[23], D, D, 32 * nb, (bf16*)(P.ws + WS_BTPG), 32 * nb, 64 * kb, scr, lane); continue; } r -= I_SQ;
        if (r < I_PLE) { const int kb = r / 32, nb = r % 32; p0_tr_item(P.in[22], D, 256, 32 * nb, (bf16*)(P.ws + WS_BTPLE), 32 * nb, 64 * kb, scr, lane); continue; } r -= I_PLE;
        if (r < I_EG) { const int e = r / 128, q = r % 128, kb = q / 8, nb = q % 8, f0 = 32 * nb;
            p0_tr_item(P.in[18] + (size_t)e * 1024 * 256, 256, D, f0, (bf16*)(P.ws + WS_BTGU) + (size_t)e * 512 * 1024, 256 * (f0 >> 7) + (f0 & 127), 64 * kb, scr, lane); continue; } r -= I_EG;
        if (r < I_EG) { const int e = r / 128, q = r % 128, kb = q / 8, nb = q % 8, f0 = 32 * nb;
            p0_tr_item(P.in[19] + (size_t)e * 1024 * 256, 256, D, f0, (bf16*)(P.ws + WS_BTGU) + (size_t)e * 512 * 1024, 256 * (f0 >> 7) + 128 + (f0 & 127), 64 * kb, scr, lane); continue; } r -= I_EG;
        { const int e = r / 128, q = r % 128, kb = q / 32, nb = q % 32;
            p0_tr_item(P.in[20] + (size_t)e * 256 * 1024, D, 256, 32 * nb, (bf16*)(P.ws + WS_BTDN) + (size_t)e * 1024 * 256, 32 * nb, 64 * kb, scr, lane); }
    }
    { GAS v4u* z = (GAS v4u*)(BTP1 + (size_t)7712 * D); const int nz = 224 * D / 8; for (int i = gw * 64 + lane; i < nz; i += NGW * 64) z[i] = (v4u){0u, 0u, 0u, 0u}; }
    bf16* H = (bf16*)((unsigned char*)P.out + DO_H);
    for (int m = gw; m < T; m += NGW) rms_row_to_bf16(P.in[0] + (size_t)m * D, P.in[2], H + (size_t)m * D, lane);
}

__device__ __forceinline__ void attn_phase(LAS unsigned char* lds, const bf16* QA, bf16* OG, float* LSE, int G, int c) {
    int tid_ = threadIdx.x; asm volatile("" : "+v"(tid_));
    const int tid = tid_, lane = tid & 63, wid = __builtin_amdgcn_readfirstlane(tid >> 6), l32 = lane & 31, hi = lane >> 5;
    LAS unsigned char* KS = lds; LAS unsigned char* VS = lds + 55296;
    for (int u = c; u < 6144; u += G) {
        const int b = u / 768; int rem = u % 768; int g, h, r, pr;
        if (rem < 256) { g = 0; h = rem >> 5; r = 0; pr = rem & 31; }
        else if (rem < 512) { rem -= 256; g = 1; h = rem >> 5; r = (rem & 31) >> 3; pr = rem & 7; }
        else { rem -= 512; g = 2; h = rem >> 5; r = (rem & 31) >> 1; pr = rem & 1; }
        const int dil = 1 << (2 * g);
        const size_t rowb = (size_t)b * SEQ;
        const bf16* Qg = QA + g * 512 + h * 64;
        __syncthreads();
#pragma unroll
        for (int k = 0; k < 6; ++k) {
            const int ci = tid + 512 * k, j = ci >> 3, ch = ci & 7, sidx = 256 * pr - 128 + j;
            v4u kv = (v4u){0u, 0u, 0u, 0u}, vv = (v4u){0u, 0u, 0u, 0u};
            if (sidx >= 0) { const bf16* p = Qg + (rowb + (size_t)(sidx * dil + r)) * pg8::QAP + ch * 8; kv = *(const GAS v4u*)(p + 1536); vv = *(const GAS v4u*)(p + 3072); }
            *(LAS v4u*)(KS + j * 144 + ch * 16) = kv; *(LAS v4u*)(VS + j * 144 + ch * 16) = vv;
        }
        const int qi = 32 * wid + l32; const size_t mq = rowb + (size_t)((256 * pr + qi) * dil + r);
        bf16x8 qf[4];
#pragma unroll
        for (int ks = 0; ks < 4; ++ks) qf[ks] = *(const GAS bf16x8*)(Qg + mq * pg8::QAP + 16 * ks + 8 * hi);
        __syncthreads();
        f32x16 sc[5];
#pragma unroll
        for (int kb = 0; kb < 5; ++kb) {
            const int jb = 32 * wid + 32 * kb; f32x16 a = {};
#pragma unroll
            for (int ks = 0; ks < 4; ++ks) { const bf16x8 kf = *(const LAS bf16x8*)(KS + (jb + l32) * 144 + (16 * ks + 8 * hi) * 2); a = MFMA32(kf, qf[ks], a); }
            sc[kb] = a;
        }
        const float NEG = -1e30f;
#pragma unroll
        for (int rr = 0; rr < 16; ++rr) { const int cc = crow(rr, hi); if (cc < l32) sc[0][rr] = NEG; if (cc > l32) sc[4][rr] = NEG; }
        if (pr == 0) {
#pragma unroll
            for (int kb = 0; kb < 4; ++kb) if (wid + kb < 4) {
#pragma unroll
                for (int rr = 0; rr < 16; ++rr) sc[kb][rr] = NEG; }
        }
        float mx = NEG;
#pragma unroll
        for (int kb = 0; kb < 5; ++kb)
#pragma unroll
            for (int rr = 0; rr < 16; ++rr) mx = fmaxf(mx, sc[kb][rr]);
        mx = fmaxf(mx, __shfl_xor(mx, 32));
        float l = 0.f;
#pragma unroll
        for (int kb = 0; kb < 5; ++kb)
#pragma unroll
            for (int rr = 0; rr < 16; ++rr) { const float p = __builtin_amdgcn_exp2f(sc[kb][rr] - mx); sc[kb][rr] = p; l += p; }
        l += __shfl_xor(l, 32);
        f32x16 o[2]; o[0] = f32x16{}; o[1] = f32x16{};
        const int traddr = ((lane & 15) >> 2) * 144 + (16 * ((lane >> 4) & 1) + 4 * (lane & 3)) * 2;
#pragma unroll
        for (int kb = 0; kb < 5; ++kb)
#pragma unroll
            for (int ks2 = 0; ks2 < 2; ++ks2) {
                v4u pw; pw.x = cvt_pk_bf16(sc[kb][8 * ks2 + 0], sc[kb][8 * ks2 + 1]); pw.y = cvt_pk_bf16(sc[kb][8 * ks2 + 2], sc[kb][8 * ks2 + 3]);
                pw.z = cvt_pk_bf16(sc[kb][8 * ks2 + 4], sc[kb][8 * ks2 + 5]); pw.w = cvt_pk_bf16(sc[kb][8 * ks2 + 6], sc[kb][8 * ks2 + 7]);
                const bf16x8 pf = __builtin_bit_cast(bf16x8, pw);
                const int kv0 = 32 * wid + 32 * kb + 16 * ks2 + 4 * hi;
#pragma unroll
                for (int db = 0; db < 2; ++db) {
                    const LAS unsigned char* vp = VS + kv0 * 144 + traddr + db * 64;
                    const s16x4 lo = ldtr(vp), h4 = ldtr(vp + 8 * 144);
                    const bf16x8 vf = (bf16x8){lo[0], lo[1], lo[2], lo[3], h4[0], h4[1], h4[2], h4[3]};
                    o[db] = MFMA32(vf, pf, o[db]);
                }
            }
        const float inv = 1.0f / l;
        bf16* orow = OG + mq * 1536 + g * 512 + h * 64;
#pragma unroll
        for (int db = 0; db < 2; ++db)
#pragma unroll
            for (int rq = 0; rq < 4; ++rq) { v2u w; w.x = cvt_pk_bf16(o[db][4 * rq] * inv, o[db][4 * rq + 1] * inv); w.y = cvt_pk_bf16(o[db][4 * rq + 2] * inv, o[db][4 * rq + 3] * inv);
                *(GAS v2u*)(orow + 32 * db + 8 * rq + 4 * hi) = w; }
        if (hi == 0) LSE[mq * 24 + g * 8 + h] = mx + __builtin_amdgcn_logf(l);
    }
}

__device__ __forceinline__ void prep_phase(LAS unsigned char* lds, const bf16* QB, const float* BG, const float* conv_w, unsigned char* DNP, float* DLB, int G, int c) {
    const int tid0 = threadIdx.x, wid = __builtin_amdgcn_readfirstlane(tid0 >> 6);
    LAS unsigned char* QS = lds; LAS unsigned char* KS = lds + 17408; LAS unsigned char* VS = lds + 34816;
    LAS float* AS = (LAS float*)(lds + 52224); LAS unsigned char* TS = lds + 68608;
#ifdef DBG_PREPCHK
    unsigned* DBGW = (unsigned*)(DNP - WS_DNP + 1022 * MiB + 512 * 1024);
#endif
    LAS float* gcT = (LAS float*)(lds + 77824); LAS float* btT = (LAS float*)(lds + 78080); LAS float* cwT = (LAS float*)(lds + 78336);
    for (int u = c; u < 8192; u += G) {
        int tid = tid0; asm volatile("" : "+v"(tid));
        const int lane = tid & 63, l32 = lane & 31, hi = lane >> 5;
        const int bh = u >> 7, n = u & 127, b = bh >> 3, h = bh & 7; const size_t m0 = (size_t)b * SEQ + 64 * n;
        unsigned char* rec = DNP + (size_t)u * DNU;
        __syncthreads();
        if (wid == 0) {
            float gv = BG[(m0 + lane) * 16 + 8 + h]; const float bv = BG[(m0 + lane) * 16 + h];
#pragma unroll
            for (int o = 1; o < 64; o <<= 1) { const float t = __shfl_up(gv, o); if (lane >= o) gv += t; }
            gcT[lane] = gv; btT[lane] = bv; if (lane == 63) DLB[u] = __expf(gv);
        }
        if (tid >= 64 && tid < 64 + 384) { const int t = tid - 64;
#pragma unroll
            for (int j = 0; j < 4; ++j) cwT[j * 384 + t] = conv_w[j * 3072 + (t >> 7) * 1024 + h * 128 + (t & 127)]; }
        __syncthreads();
#pragma unroll 1
        for (int it = 0; it < 6; ++it) {
            const int item = tid + 512 * it, ten = item >> 10, i = (item & 1023) >> 4, cg = item & 15;
            const bf16* src = QB + ten * 1024 + h * 128 + cg * 8;
            f32x4 y0 = {0.f, 0.f, 0.f, 0.f}, y1 = {0.f, 0.f, 0.f, 0.f};
#pragma unroll
            for (int j = 0; j < 4; ++j) { const int tt = 64 * n + i - 3 + j;
                if (tt >= 0) { const v4u raw = *(const GAS v4u*)(src + ((size_t)b * SEQ + tt) * pg8::QBP); f32x4 a, bb; unpack8(raw, a, bb);
                    const f32x4 w0 = *(const LAS f32x4*)(cwT + j * 384 + ten * 128 + cg * 8), w1 = *(const LAS f32x4*)(cwT + j * 384 + ten * 128 + cg * 8 + 4); y0 += a * w0; y1 += bb * w1; } }
#pragma unroll
            for (int e = 0; e < 4; ++e) { y0[e] = y0[e] * sigm(y0[e]); y1[e] = y1[e] * sigm(y1[e]); }
            float scl;
            if (ten < 2) { float ss = (y0[0] * y0[0] + y0[1] * y0[1]) + (y0[2] * y0[2] + y0[3] * y0[3]) + (y1[0] * y1[0] + y1[1] * y1[1]) + (y1[2] * y1[2] + y1[3] * y1[3]);
                ss += __shfl_xor(ss, 1); ss += __shfl_xor(ss, 2); ss += __shfl_xor(ss, 4); ss += __shfl_xor(ss, 8);
                scl = rsqrtf(ss + 1e-6f) * (ten == 0 ? 0.08838834764831845f : 1.0f); }
            else scl = btT[i];
            LAS unsigned char* dst = (ten == 0 ? QS : (ten == 1 ? KS : VS)) + i * 272 + cg * 16;
            *(LAS v4u*)dst = pack8(y0 * scl, y1 * scl);
        }
        __syncthreads();
        if (wid < 6) {
            const int kind = wid / 3, pi = wid % 3, ib = pi ? 1 : 0, jb = (pi == 2) ? 1 : 0;
            f32x16 a = {};
            if (kind == 0) {
#pragma unroll
                for (int ks = 0; ks < 8; ++ks) { const bf16x8 af = *(const LAS bf16x8*)(KS + (32 * ib + l32) * 272 + (16 * ks + 8 * hi) * 2), bf = *(const LAS bf16x8*)(KS + (32 * jb + l32) * 272 + (16 * ks + 8 * hi) * 2); a = MFMA32(af, bf, a); }
                const int j = 32 * jb + l32; const float gj = gcT[j];
#pragma unroll
                for (int rr = 0; rr < 16; ++rr) { const int i = 32 * ib + crow(rr, hi); const float v = (j < i) ? btT[i] * a[rr] * __expf(gcT[i] - gj) : 0.f; AS[i * 64 + j] = v; }
            } else {
#pragma unroll
                for (int ks = 0; ks < 8; ++ks) { const bf16x8 af = *(const LAS bf16x8*)(KS + (32 * jb + l32) * 272 + (16 * ks + 8 * hi) * 2), bf = *(const LAS bf16x8*)(QS + (32 * ib + l32) * 272 + (16 * ks + 8 * hi) * 2); a = MFMA32(af, bf, a); }
                const int i = 32 * ib + l32; const float gi = gcT[i];
#pragma unroll
                for (int rr = 0; rr < 16; ++rr) { const int j = 32 * jb + crow(rr, hi); a[rr] = (j <= i) ? a[rr] * __expf(gi - gcT[j]) : 0.f; }
#pragma unroll
                for (int ks2 = 0; ks2 < 2; ++ks2) { v4u w; w.x = cvt_pk_bf16(a[8 * ks2], a[8 * ks2 + 1]); w.y = cvt_pk_bf16(a[8 * ks2 + 2], a[8 * ks2 + 3]); w.z = cvt_pk_bf16(a[8 * ks2 + 4], a[8 * ks2 + 5]); w.w = cvt_pk_bf16(a[8 * ks2 + 6], a[8 * ks2 + 7]);
                    *(GAS v4u*)(rec + 49152 + ((ib * 4 + 2 * jb + ks2) * 64 + lane) * 16) = w; }
            }
        }
        __syncthreads();
        if (wid == 0) {
            float x[64]; const float flane = (float)lane;
#pragma unroll
            for (int i = 0; i < 64; ++i) {
                float a0 = fmaxf(0.f, 1.f - fabsf(flane - (float)i)), a1 = 0.f, a2 = 0.f, a3 = 0.f;
#pragma unroll
                for (int j4 = 0; j4 < (i + 3) / 4; ++j4) { const f32x4 av = *(const LAS f32x4*)(AS + i * 64 + 4 * j4);
                    if (4 * j4 + 0 < i) a0 -= av[0] * x[4 * j4 + 0]; if (4 * j4 + 1 < i) a1 -= av[1] * x[4 * j4 + 1];
                    if (4 * j4 + 2 < i) a2 -= av[2] * x[4 * j4 + 2]; if (4 * j4 + 3 < i) a3 -= av[3] * x[4 * j4 + 3]; }
                x[i] = (a0 + a1) + (a2 + a3);
            }
#pragma unroll
            for (int i = 0; i < 64; ++i) *(LAS unsigned short*)(TS + i * 144 + lane * 2) = f2bf(x[i]);
#ifdef DBG_TMAX
            { float tm = 0.f, am = 0.f;
#pragma unroll
              for (int i = 0; i < 64; ++i) tm = fmaxf(tm, fabsf(x[i]));
              for (int i = 1; i < 64; ++i) if (lane < i) am = fmaxf(am, fabsf(AS[i * 64 + lane]));
              for (int o = 1; o < 64; o <<= 1) { tm = fmaxf(tm, __shfl_xor(tm, o)); am = fmaxf(am, __shfl_xor(am, o)); }
              bool tnan = false, anan = false;
#pragma unroll
              for (int i = 0; i < 64; ++i) if (!(x[i] - x[i] == 0.f)) tnan = true;
              for (int i = 1; i < 64; ++i) if (lane < i) { const float v = AS[i * 64 + lane]; if (!(v - v == 0.f)) anan = true; }
              const int tn = __any(tnan), an = __any(anan);
              if (lane == 0) { float* dbg = (float*)(rec + 49152 + 2048); dbg[0] = tm; dbg[1] = am; dbg[2] = tn ? 1.f : 0.f; dbg[3] = an ? 1.f : 0.f; } }
#endif
        } else {
            const float glast = gcT[63];
            for (int f = wid - 1; f < 32; f += 7) {
                if (f < 16) { const int ib = f >> 3, ks = f & 7, i = 32 * ib + l32; const float eg = __expf(gcT[i]);
                    const v2u lo = *(const LAS v2u*)(QS + i * 272 + (16 * ks + 4 * hi) * 2), h2 = *(const LAS v2u*)(QS + i * 272 + (16 * ks + 8 + 4 * hi) * 2);
                    v4u w; w.x = cvt_pk_bf16(bflo(lo.x) * eg, bfhi(lo.x) * eg); w.y = cvt_pk_bf16(bflo(lo.y) * eg, bfhi(lo.y) * eg); w.z = cvt_pk_bf16(bflo(h2.x) * eg, bfhi(h2.x) * eg); w.w = cvt_pk_bf16(bflo(h2.y) * eg, bfhi(h2.y) * eg);
                    *(GAS v4u*)(rec + 16384 + ((ib * 8 + ks) * 64 + lane) * 16) = w;
                } else { const int dkb = (f - 16) >> 2, ksj = (f - 16) & 3, dk = 32 * dkb + l32; float v[8];
#pragma unroll
                    for (int jj = 0; jj < 8; ++jj) { const int j = 16 * ksj + 4 * hi + (jj & 3) + 8 * (jj >> 2); v[jj] = bf2f(*(const LAS unsigned short*)(KS + j * 272 + dk * 2)) * __expf(glast - gcT[j]); }
                    v4u w; w.x = cvt_pk_bf16(v[0], v[1]); w.y = cvt_pk_bf16(v[2], v[3]); w.z = cvt_pk_bf16(v[4], v[5]); w.w = cvt_pk_bf16(v[6], v[7]);
                    *(GAS v4u*)(rec + 32768 + ((dkb * 4 + ksj) * 64 + lane) * 16) = w; }
            }
        }
        __syncthreads();
        {
            const int eb = wid & 3, ib = wid >> 2; f32x16 a = {};
            for (int ks = 0; ks < (ib ? 4 : 2); ++ks) {
                const bf16x8 tf = *(const LAS bf16x8*)(TS + (32 * ib + l32) * 144 + (16 * ks + 8 * hi) * 2);
                bf16x8 vf;
#pragma unroll
                for (int jj = 0; jj < 8; ++jj) vf[jj] = (short)*(const LAS unsigned short*)(VS + (16 * ks + 8 * hi + jj) * 272 + (32 * eb + l32) * 2);
                a = MFMA32(tf, vf, a);
#ifdef DBG_PREPCHK
                { bool b0 = false, b1 = false; for (int jj = 0; jj < 8; ++jj) { if ((((unsigned short)tf[jj]) & 0x7f80u) == 0x7f80u) b0 = true; if ((((unsigned short)vf[jj]) & 0x7f80u) == 0x7f80u) b1 = true; }
                  if (b0 || b1) atomicAnd(DBGW, ~1u); }
#endif
            }
#ifdef DBG_PREPCHK
            { bool b2 = false; for (int r = 0; r < 16; ++r) if (!(a[r] - a[r] == 0.f)) b2 = true; if (b2) atomicAnd(DBGW, ~4u); }
#endif
            v4u w0, w1; w0.x = cvt_pk_bf16(a[0], a[1]); w0.y = cvt_pk_bf16(a[2], a[3]); w0.z = cvt_pk_bf16(a[4], a[5]); w0.w = cvt_pk_bf16(a[6], a[7]);
            w1.x = cvt_pk_bf16(a[8], a[9]); w1.y = cvt_pk_bf16(a[10], a[11]); w1.z = cvt_pk_bf16(a[12], a[13]); w1.w = cvt_pk_bf16(a[14], a[15]);
            GAS v4u* up = (GAS v4u*)(rec + 57344 + ((eb * 2 + ib) * 64 + lane) * 32); up[0] = w0; up[1] = w1;
#ifdef DBG_PREPCHK
            { bool bb = false; const unsigned ww[8] = {w0.x, w0.y, w0.z, w0.w, w1.x, w1.y, w1.z, w1.w}; for (int k = 0; k < 8; ++k) if ((ww[k] & 0x7f80u) == 0x7f80u || (ww[k] & 0x7f800000u) == 0x7f800000u) bb = true;
              if (bb) atomicAnd(DBGW, ~2u); if (u == 5 && tid == 0) atomicAnd(DBGW, ~8u); }
#endif
        }
        __syncthreads();
        { const int i = tid >> 3, c8 = tid & 7; const float s = btT[i] * __expf(gcT[i]);
#pragma unroll
            for (int q = 0; q < 2; ++q) { const v4u kw = *(const LAS v4u*)(KS + i * 272 + c8 * 32 + q * 16); f32x4 a, bb; unpack8(kw, a, bb); *(LAS v4u*)(VS + i * 272 + c8 * 32 + q * 16) = pack8(a * s, bb * s); } }
        __syncthreads();
        {
            const int dkb = wid & 3, ib = wid >> 2; f32x16 a = {};
            for (int ks = 0; ks < (ib ? 4 : 2); ++ks) {
                bf16x8 kf;
#pragma unroll
                for (int jj = 0; jj < 8; ++jj) kf[jj] = (short)*(const LAS unsigned short*)(VS + (16 * ks + 8 * hi + jj) * 272 + (32 * dkb + l32) * 2);
                const bf16x8 tf = *(const LAS bf16x8*)(TS + (32 * ib + l32) * 144 + (16 * ks + 8 * hi) * 2);
                a = MFMA32(kf, tf, a);
#ifdef DBG_PREPCHK
                { bool b3 = false; for (int jj = 0; jj < 8; ++jj) if ((((unsigned short)kf[jj]) & 0x7f80u) == 0x7f80u) b3 = true; if (b3) atomicAnd(DBGW, ~1u); }
#endif
            }
#ifdef DBG_PREPCHK
            { bool b4 = false; for (int r = 0; r < 16; ++r) if (!(a[r] - a[r] == 0.f)) b4 = true; if (b4) atomicAnd(DBGW, ~16u); }
#endif
#pragma unroll
            for (int ks2 = 0; ks2 < 2; ++ks2) { v4u w; w.x = cvt_pk_bf16(a[8 * ks2], a[8 * ks2 + 1]); w.y = cvt_pk_bf16(a[8 * ks2 + 2], a[8 * ks2 + 3]); w.z = cvt_pk_bf16(a[8 * ks2 + 4], a[8 * ks2 + 5]); w.w = cvt_pk_bf16(a[8 * ks2 + 6], a[8 * ks2 + 7]);
                *(GAS v4u*)(rec + ((ib * 8 + 2 * dkb + ks2) * 64 + lane) * 16) = w; }
        }
    }
}

__device__ __forceinline__ void scan_chain(LAS unsigned char* lds, const unsigned char* DNP, const float* DLB, bf16* ON, const float* dn_gain, int bh) {
    int tid_ = threadIdx.x; asm volatile("" : "+v"(tid_));
    const int tid = tid_, lane = tid & 63, wid = __builtin_amdgcn_readfirstlane(tid >> 6), l32 = lane & 31, hi = lane >> 5;
    LAS unsigned char* OT = lds + 114688; LAS float* GT = (LAS float*)(lds + 132096);
    const int b = bh >> 3, h = bh & 7; const size_t u0 = (size_t)bh * 128;
    __syncthreads();
    if (tid < 128) GT[tid] = dn_gain[tid];
    const int lt = tid - 256;
    if (wid >= 4) { const GAS v4u* src = (const GAS v4u*)(DNP + u0 * DNU);
#pragma unroll
        for (int k = 0; k < 14; ++k) *(LAS v4u*)(lds + (lt + 256 * k) * 16) = src[lt + 256 * k]; }
    f32x16 S[4]; S[0] = f32x16{}; S[1] = f32x16{}; S[2] = f32x16{}; S[3] = f32x16{};
    __syncthreads();
#pragma unroll 1
    for (int n = 0; n < 128; ++n) {
        const LAS unsigned char* Pb = lds + (n & 1) * 57344;
        f32x16 O0 = {}, O1 = {};
        if (wid < 4) {
            v4u uc[4]; float dl;
            { const GAS v4u* up = (const GAS v4u*)(DNP + (u0 + n) * DNU + 57344 + (wid * 2 * 64 + lane) * 32);
              uc[0] = up[0]; uc[1] = up[1]; uc[2] = up[128]; uc[3] = up[129]; dl = DLB[u0 + n]; }
            bf16x8 vb[4];
            {
                f32x16 W0 = {}, W1 = {};
#pragma unroll
                for (int ks = 0; ks < 8; ++ks) {
                    const int dkb = ks >> 1, o8 = 8 * (ks & 1);
                    v4u sw; sw.x = cvt_pk_bf16(S[dkb][o8 + 0], S[dkb][o8 + 1]); sw.y = cvt_pk_bf16(S[dkb][o8 + 2], S[dkb][o8 + 3]); sw.z = cvt_pk_bf16(S[dkb][o8 + 4], S[dkb][o8 + 5]); sw.w = cvt_pk_bf16(S[dkb][o8 + 6], S[dkb][o8 + 7]);
                    const bf16x8 sb = __builtin_bit_cast(bf16x8, sw);
                    const bf16x8 w0 = *(const LAS bf16x8*)(Pb + ((0 * 8 + ks) * 64 + lane) * 16), w1 = *(const LAS bf16x8*)(Pb + ((1 * 8 + ks) * 64 + lane) * 16);
                    W0 = MFMA32(w0, sb, W0); W1 = MFMA32(w1, sb, W1);
                    __builtin_amdgcn_sched_barrier(0);
                }
                float v[16];
#pragma unroll
                for (int q = 0; q < 2; ++q) { const v4u w = uc[q];
                    v[8 * q + 0] = bflo(w.x); v[8 * q + 1] = bfhi(w.x); v[8 * q + 2] = bflo(w.y); v[8 * q + 3] = bfhi(w.y); v[8 * q + 4] = bflo(w.z); v[8 * q + 5] = bfhi(w.z); v[8 * q + 6] = bflo(w.w); v[8 * q + 7] = bfhi(w.w); }
#pragma unroll
                for (int r = 0; r < 16; ++r) v[r] -= W0[r];
#pragma unroll
                for (int ks2 = 0; ks2 < 2; ++ks2) { v4u w; w.x = cvt_pk_bf16(v[8 * ks2], v[8 * ks2 + 1]); w.y = cvt_pk_bf16(v[8 * ks2 + 2], v[8 * ks2 + 3]); w.z = cvt_pk_bf16(v[8 * ks2 + 4], v[8 * ks2 + 5]); w.w = cvt_pk_bf16(v[8 * ks2 + 6], v[8 * ks2 + 7]); vb[ks2] = __builtin_bit_cast(bf16x8, w); }
#pragma unroll
                for (int q = 0; q < 2; ++q) { const v4u w = uc[2 + q];
                    v[8 * q + 0] = bflo(w.x); v[8 * q + 1] = bfhi(w.x); v[8 * q + 2] = bflo(w.y); v[8 * q + 3] = bfhi(w.y); v[8 * q + 4] = bflo(w.z); v[8 * q + 5] = bfhi(w.z); v[8 * q + 6] = bflo(w.w); v[8 * q + 7] = bfhi(w.w); }
#pragma unroll
                for (int r = 0; r < 16; ++r) v[r] -= W1[r];
#pragma unroll
                for (int ks2 = 0; ks2 < 2; ++ks2) { v4u w; w.x = cvt_pk_bf16(v[8 * ks2], v[8 * ks2 + 1]); w.y = cvt_pk_bf16(v[8 * ks2 + 2], v[8 * ks2 + 3]); w.z = cvt_pk_bf16(v[8 * ks2 + 4], v[8 * ks2 + 5]); w.w = cvt_pk_bf16(v[8 * ks2 + 6], v[8 * ks2 + 7]); vb[2 + ks2] = __builtin_bit_cast(bf16x8, w); }
            }
            __builtin_amdgcn_sched_barrier(0);
#pragma unroll
            for (int ks = 0; ks < 8; ++ks) {
                const int dkb = ks >> 1, o8 = 8 * (ks & 1);
                v4u sw; sw.x = cvt_pk_bf16(S[dkb][o8 + 0], S[dkb][o8 + 1]); sw.y = cvt_pk_bf16(S[dkb][o8 + 2], S[dkb][o8 + 3]); sw.z = cvt_pk_bf16(S[dkb][o8 + 4], S[dkb][o8 + 5]); sw.w = cvt_pk_bf16(S[dkb][o8 + 6], S[dkb][o8 + 7]);
                const bf16x8 sb = __builtin_bit_cast(bf16x8, sw);
                const bf16x8 q0 = *(const LAS bf16x8*)(Pb + 16384 + ((0 * 8 + ks) * 64 + lane) * 16), q1 = *(const LAS bf16x8*)(Pb + 16384 + ((1 * 8 + ks) * 64 + lane) * 16);
                O0 = MFMA32(q0, sb, O0); O1 = MFMA32(q1, sb, O1);
                __builtin_amdgcn_sched_barrier(0);
            }
#pragma unroll
            for (int ksj = 0; ksj < 2; ++ksj) { const bf16x8 af = *(const LAS bf16x8*)(Pb + 49152 + ((0 * 4 + ksj) * 64 + lane) * 16); O0 = MFMA32(af, vb[ksj], O0); }
#pragma unroll
            for (int ksj = 0; ksj < 4; ++ksj) { const bf16x8 af = *(const LAS bf16x8*)(Pb + 49152 + ((1 * 4 + ksj) * 64 + lane) * 16); O1 = MFMA32(af, vb[ksj], O1); }
#pragma unroll
            for (int dkb = 0; dkb < 4; ++dkb) {
#pragma unroll
                for (int r = 0; r < 16; ++r) S[dkb][r] *= dl;
#pragma unroll
                for (int ksj = 0; ksj < 4; ++ksj) { const bf16x8 kf = *(const LAS bf16x8*)(Pb + 32768 + ((dkb * 4 + ksj) * 64 + lane) * 16); S[dkb] = MFMA32(kf, vb[ksj], S[dkb]); }
            }
        } else {
            if (n > 0) {
                const int i = lt >> 2, qd = lt & 3; f32x4 v[8]; float ss = 0.f;
#pragma unroll
                for (int k = 0; k < 4; ++k) { const v4u w = *(const LAS v4u*)(OT + i * 272 + qd * 64 + k * 16); unpack8(w, v[2 * k], v[2 * k + 1]); }
#pragma unroll
                for (int k = 0; k < 8; ++k) ss += (v[k][0] * v[k][0] + v[k][1] * v[k][1]) + (v[k][2] * v[k][2] + v[k][3] * v[k][3]);
                ss += __shfl_xor(ss, 1); ss += __shfl_xor(ss, 2);
                const float rs = rsqrtf(ss * (1.0f / 128.0f) + 1e-6f);
                bf16* dst = ON + ((size_t)b * SEQ + 64 * (n - 1) + i) * 1024 + h * 128 + qd * 32;
#pragma unroll
                for (int k = 0; k < 4; ++k) { const f32x4 g0 = *(const LAS f32x4*)(GT + qd * 32 + 8 * k), g1 = *(const LAS f32x4*)(GT + qd * 32 + 8 * k + 4); *(GAS v4u*)(dst + 8 * k) = pack8(v[2 * k] * rs * g0, v[2 * k + 1] * rs * g1); }
            }
            if (n + 1 < 128) { const GAS v4u* src = (const GAS v4u*)(DNP + (u0 + n + 1) * DNU); LAS unsigned char* Pn = lds + ((n + 1) & 1) * 57344;
#pragma unroll
                for (int k = 0; k < 14; ++k) *(LAS v4u*)(Pn + (lt + 256 * k) * 16) = src[lt + 256 * k]; }
        }
        __syncthreads();
        if (wid < 4) {
#pragma unroll
            for (int r = 0; r < 16; ++r) { *(LAS unsigned short*)(OT + (crow(r, hi)) * 272 + (32 * wid + l32) * 2) = f2bf(O0[r]); *(LAS unsigned short*)(OT + (32 + crow(r, hi)) * 272 + (32 * wid + l32) * 2) = f2bf(O1[r]); }
        }
        __syncthreads();
    }
    if (wid >= 4) {
        const int i = lt >> 2, qd = lt & 3; f32x4 v[8]; float ss = 0.f;
#pragma unroll
        for (int k = 0; k < 4; ++k) { const v4u w = *(const LAS v4u*)(OT + i * 272 + qd * 64 + k * 16); unpack8(w, v[2 * k], v[2 * k + 1]); }
#pragma unroll
        for (int k = 0; k < 8; ++k) ss += (v[k][0] * v[k][0] + v[k][1] * v[k][1]) + (v[k][2] * v[k][2] + v[k][3] * v[k][3]);
        ss += __shfl_xor(ss, 1); ss += __shfl_xor(ss, 2);
        const float rs = rsqrtf(ss * (1.0f / 128.0f) + 1e-6f);
        bf16* dst = ON + ((size_t)b * SEQ + 64 * 127 + i) * 1024 + h * 128 + qd * 32;
#pragma unroll
        for (int k = 0; k < 4; ++k) { const f32x4 g0 = *(const LAS f32x4*)(GT + qd * 32 + 8 * k), g1 = *(const LAS f32x4*)(GT + qd * 32 + 8 * k + 4); *(GAS v4u*)(dst + 8 * k) = pack8(v[2 * k] * rs * g0, v[2 * k + 1] * rs * g1); }
    }
}
__device__ __forceinline__ void combine_rows(const Ptrs& P, int first, int stride, int lane) {
    const bf16* OG = (const bf16*)((const unsigned char*)P.out + DO_OG); const float* LSE = (const float*)((const unsigned char*)P.out + DO_LSE);
    bf16* OA = (bf16*)(P.ws + WS_OA); bf16* HR = (bf16*)(P.ws + WS_HR);
    for (int m = first; m < T; m += stride) {
        const int hd = lane >> 3; const float l0 = LSE[(size_t)m * 24 + hd], l1 = LSE[(size_t)m * 24 + 8 + hd], l2 = LSE[(size_t)m * 24 + 16 + hd];
        const float mx = fmaxf(l0, fmaxf(l1, l2)); float w0 = __builtin_amdgcn_exp2f(l0 - mx), w1 = __builtin_amdgcn_exp2f(l1 - mx), w2 = __builtin_amdgcn_exp2f(l2 - mx);
        const float inv = 1.0f / (w0 + w1 + w2); w0 *= inv; w1 *= inv; w2 *= inv;
        const bf16* og = OG + (size_t)m * 1536 + lane * 8;
        f32x4 a0, b0, a1, b1, a2, b2; unpack8(*(const GAS v4u*)og, a0, b0); unpack8(*(const GAS v4u*)(og + 512), a1, b1); unpack8(*(const GAS v4u*)(og + 1024), a2, b2);
        *(GAS v4u*)(OA + (size_t)m * 512 + lane * 8) = pack8(a0 * w0 + a1 * w1 + a2 * w2, b0 * w0 + b1 * w1 + b2 * w2);
        rms_row_to_bf16(P.in[0] + (size_t)m * D, P.in[2], HR + (size_t)m * D, lane);
    }
}

__device__ __forceinline__ void router_phase(const Ptrs& P, LAS unsigned char* lds, int G, int c, int wave, int lane) {
    LAS float* WrT = (LAS float*)lds;
    const float* x1 = P.out; bf16* H2 = (bf16*)(P.ws + WS_H2); int4* TOK = (int4*)(P.ws + WS_TOK); unsigned* cnt = (unsigned*)(P.ws + WS_CTL) + CW_CNT;
    __syncthreads();
    for (int i = threadIdx.x; i < 1024 * 4; i += 512) { const int k = i >> 2, cc = i & 3; WrT[cc * 1024 + k] = P.in[14][i]; }
    for (int i = threadIdx.x; i < 1024 * 16; i += 512) { const int k = i >> 4, cc = i & 15; WrT[(4 + cc) * 1024 + k] = P.in[16][i]; }
    __syncthreads();
    const GAS f32x4* gr = (const GAS f32x4*)P.in[13] + lane; f32x4 gn[4];
#pragma unroll
    for (int j = 0; j < 4; ++j) gn[j] = gr[64 * j];
    float bias[20];
#pragma unroll
    for (int q = 0; q < 4; ++q) bias[q] = P.in[15][q];
#pragma unroll
    for (int q = 0; q < 16; ++q) bias[4 + q] = P.in[17][q];
    unsigned mycnt = 0;
    const int gw = c * NWAVES + wave, NGW = G * NWAVES;
    for (int m = gw; m < T; m += NGW) {
        asm volatile("" ::: "memory");
        const GAS f32x4* xr = (const GAS f32x4*)(x1 + (size_t)m * D) + lane; f32x4 v[4]; float s = 0.f;
#pragma unroll
        for (int j = 0; j < 4; ++j) { v[j] = xr[64 * j]; s += (v[j].x * v[j].x + v[j].y * v[j].y) + (v[j].z * v[j].z + v[j].w * v[j].w); }
        const float rs = rsqrtf(wave_sum(s) * (1.f / D) + 1e-6f);
        GAS v2u* o8 = (GAS v2u*)(H2 + (size_t)m * D) + lane;
#pragma unroll
        for (int j = 0; j < 4; ++j) { v[j] = v[j] * rs * gn[j]; v2u w; w.x = cvt_pk_bf16(v[j].x, v[j].y); w.y = cvt_pk_bf16(v[j].z, v[j].w); o8[64 * j] = w; }
        float lg[20];
#pragma unroll
        for (int q = 0; q < 20; ++q) { float a = 0.f;
#pragma unroll
            for (int j = 0; j < 4; ++j) { const f32x4 w = *(const LAS f32x4*)(WrT + q * 1024 + 4 * lane + 256 * j); a += (v[j].x * w.x + v[j].y * w.y) + (v[j].z * w.z + v[j].w * w.w); }
            lg[q] = wave_sum(a) + bias[q]; }
        int gi = 0; float gm = lg[0];
#pragma unroll
        for (int q = 1; q < 4; ++q) if (lg[q] > gm) { gm = lg[q]; gi = q; }
        float gs = 0.f;
#pragma unroll
        for (int q = 0; q < 4; ++q) gs += __expf(lg[q] - gm);
        const float pg = 1.0f / gs;
        float sl[4];
#pragma unroll
        for (int q = 0; q < 4; ++q) sl[q] = gi == 0 ? lg[4 + q] : (gi == 1 ? lg[8 + q] : (gi == 2 ? lg[12 + q] : lg[16 + q]));
        int i0 = 0; float m0 = sl[0];
#pragma unroll
        for (int q = 1; q < 4; ++q) if (sl[q] > m0) { m0 = sl[q]; i0 = q; }
        int i1 = -1; float m1 = -3.0e38f;
#pragma unroll
        for (int q = 0; q < 4; ++q) if (q != i0 && sl[q] > m1) { m1 = sl[q]; i1 = q; }
        const float e1 = __expf(m1 - m0); const float w0 = 1.0f / (1.0f + e1), w1 = e1 * w0;
        const int ex0 = 4 * gi + i0, ex1 = 4 * gi + i1;
        if (lane == 0) TOK[m] = make_int4(ex0, ex1, __float_as_int(pg * w0), __float_as_int(pg * w1));
        mycnt += (lane == ex0 ? 1u : 0u) + (lane == ex1 ? 1u : 0u);
    }
    if (lane < 16 && mycnt) atomicAdd(&cnt[lane], mycnt);
}

__device__ __forceinline__ void place_phase(const Ptrs& P, int G, int c, int wave, int lane) {
    const bf16* H2 = (const bf16*)(P.ws + WS_H2); bf16* HX = (bf16*)(P.ws + WS_HX); const int4* TOK = (const int4*)(P.ws + WS_TOK); int2* SLOT = (int2*)(P.ws + WS_SLOT); float* CWv = (float*)(P.ws + WS_CW);
    const unsigned* cnt = (const unsigned*)(P.ws + WS_CTL) + CW_CNT; unsigned* cur = (unsigned*)(P.ws + WS_CTL) + CW_CUR;
    int sbase = 0; { int acc = 0; for (int e = 0; e < 16; ++e) { if (e == lane) sbase = acc; acc += (int)((cnt[e] + 255u) >> 8) * 256; } }
    const int gw = c * NWAVES + wave, NGW = G * NWAVES;
    for (int bt = gw; bt < T / 64; bt += NGW) {
        const int m = bt * 64 + lane; const int4 tk = TOK[m];
        int p0 = 0, p1 = 0;
#pragma unroll 1
        for (int e = 0; e < 16; ++e) {
            const unsigned long long k0 = __ballot(tk.x == e), k1 = __ballot(tk.y == e);
            const int n0 = __popcll(k0), n1 = __popcll(k1);
            unsigned base = 0; if (lane == 0 && (n0 + n1)) base = atomicAdd(&cur[e], (unsigned)(n0 + n1));
            base = __shfl(base, 0); const int sb = __shfl(sbase, e);
            const unsigned long long lt = (1ull << lane) - 1ull;
            if (tk.x == e) p0 = sb + (int)base + __popcll(k0 & lt);
            if (tk.y == e) p1 = sb + (int)base + n0 + __popcll(k1 & lt);
        }
        SLOT[m] = make_int2(p0, p1); CWv[p0] = __int_as_float(tk.z); CWv[p1] = __int_as_float(tk.w);
#pragma unroll 1
        for (int k = 0; k < 64; ++k) {
            const int q0 = __shfl(p0, k), q1 = __shfl(p1, k); const size_t mk = (size_t)bt * 64 + k;
            const GAS v4u* src = (const GAS v4u*)(H2 + mk * D) + lane; const v4u a = src[0], bq = src[64];
            GAS v4u* d0 = (GAS v4u*)(HX + (size_t)q0 * D) + lane; GAS v4u* d1 = (GAS v4u*)(HX + (size_t)q1 * D) + lane;
            d0[0] = a; d0[64] = bq; d1[0] = a; d1[64] = bq;
        }
    }
}

__device__ __forceinline__ void ple_norm_phase(const Ptrs& P, int G, int c, int wave, int lane) {
    float* xo = P.out; const bf16* Y = (const bf16*)(P.ws + WS_Y); const int2* SLOT = (const int2*)(P.ws + WS_SLOT); bf16* H3 = (bf16*)(P.ws + WS_H3); bf16* PB = (bf16*)(P.ws + WS_PB);
    const GAS f32x4* gr = (const GAS f32x4*)P.in[21] + lane; f32x4 gn[4];
#pragma unroll
    for (int j = 0; j < 4; ++j) gn[j] = gr[64 * j];
    const int gw = c * NWAVES + wave, NGW = G * NWAVES;
    for (int m = gw; m < T; m += NGW) {
        const int2 sl = SLOT[m];
        GAS f32x4* xr = (GAS f32x4*)(xo + (size_t)m * D) + lane; const GAS v2u* y0 = (const GAS v2u*)(Y + (size_t)sl.x * D) + lane; const GAS v2u* y1 = (const GAS v2u*)(Y + (size_t)sl.y * D) + lane;
        f32x4 v[4]; float s = 0.f;
#pragma unroll
        for (int j = 0; j < 4; ++j) { const v2u a = y0[64 * j], bq = y1[64 * j]; v[j] = xr[64 * j];
            v[j].x += bflo(a.x) + bflo(bq.x); v[j].y += bfhi(a.x) + bfhi(bq.x); v[j].z += bflo(a.y) + bflo(bq.y); v[j].w += bfhi(a.y) + bfhi(bq.y);
            xr[64 * j] = v[j]; s += (v[j].x * v[j].x + v[j].y * v[j].y) + (v[j].z * v[j].z + v[j].w * v[j].w); }
        const float rs = rsqrtf(wave_sum(s) * (1.f / D) + 1e-6f);
        GAS v2u* o8 = (GAS v2u*)(H3 + (size_t)m * D) + lane;
#pragma unroll
        for (int j = 0; j < 4; ++j) { v2u w; w.x = cvt_pk_bf16(v[j].x * rs * gn[j].x, v[j].y * rs * gn[j].y); w.y = cvt_pk_bf16(v[j].z * rs * gn[j].z, v[j].w * rs * gn[j].w); o8[64 * j] = w; }
        const f32x4 pv = *((const GAS f32x4*)(P.in[1] + (size_t)m * 256) + lane); v2u pw; pw.x = cvt_pk_bf16(pv.x, pv.y); pw.y = cvt_pk_bf16(pv.z, pv.w);
        *((GAS v2u*)(PB + (size_t)m * 256) + lane) = pw;
    }
}

struct Args { Ptrs p; int ph_lo, ph_hi; };
__global__ void __launch_bounds__(NWAVES * 64, 2) fwd_kernel(Args args) {
    extern __shared__ __attribute__((aligned(16))) unsigned char lds_raw[];
    LAS unsigned char* lds = (LAS unsigned char*)lds_raw;
    volatile LAS unsigned* MISC = (volatile LAS unsigned*)(lds + MISC_OFF);
    const int tid = threadIdx.x, lane = tid & 63, wave = __builtin_amdgcn_readfirstlane(tid >> 6);
    const int G = gridDim.x, c = blockIdx.x;
    const Ptrs& P = args.p;
    unsigned char* ws = P.ws;
    gu32* ctl = (gu32*)(ws + WS_CTL);
    for (int u = tid; u < 64; u += NWAVES * 64) MISC[u] = 0u;
    __syncthreads();
    XcdBarrier bar; bar.bar = (unsigned*)ctl + CW_BAR; bar.x = 0; bar.st = nullptr;
    if (N_LAUNCHES == 1) bar = xcd_barrier_post((unsigned*)ctl + CW_BAR, MISC + 8);
    const int lo = args.ph_lo, hi = args.ph_hi;
#ifndef PH_MASK
#define PH_MASK 0x3ffff
#endif
#define IN(k) (((PH_MASK >> (k)) & 1) && lo <= (k) && (k) < hi)
#define SEAM(k) do { if (IN(k) && IN((k) + 1)) xcd_barrier(bar); } while (0)

    if (IN(0)) { p0_prologue(P, lds, G, c, wave, lane); } SEAM(0);

    if (IN(1)) {
        pg8::StaticOrder S; S.init((const unsigned char*)P.out + DO_H, ws + WS_BTP1, T, NP1, D, G, c);
        pg8::EpiP1 E{(bf16*)(ws + WS_QA), (bf16*)(ws + WS_QB), (float*)(ws + WS_BG), P.in[4], P.in[5], P.in[7], P.in[8]};
        pg8::gemm_phase<pg8::EpiP1, pg8::StaticOrder, true, true>(lds + RING_OFF, D, S, E);
    } SEAM(1);

    if (IN(2)) { attn_phase(lds, (const bf16*)(ws + WS_QA), (bf16*)((unsigned char*)P.out + DO_OG), (float*)((unsigned char*)P.out + DO_LSE), G, c); } SEAM(2);

    if (IN(3)) { prep_phase(lds, (const bf16*)(ws + WS_QB), (const float*)(ws + WS_BG), P.in[6], ws + WS_DNP, (float*)(ws + WS_DLB), G, c); } SEAM(3);

    if (IN(4)) {
        const int nscan = G > 64 ? 64 : G;
        if (c < nscan) { for (int bh = c; bh < 64; bh += nscan) scan_chain(lds, ws + WS_DNP, (const float*)(ws + WS_DLB), (bf16*)(ws + WS_ON), P.in[9], bh); }
        if (G > 64) { if (c >= 64) combine_rows(P, (c - 64) * NWAVES + wave, (G - 64) * NWAVES, lane); }
        else combine_rows(P, c * NWAVES + wave, G * NWAVES, lane);
    } SEAM(4);

    if (IN(5)) { pg8::StaticOrder S; S.init(ws + WS_HR, ws + WS_BTZ, T, D, D, G, c); pg8::EpiSiluMul E{(bf16*)(ws + WS_ON)};
        pg8::gemm_phase<pg8::EpiSiluMul, pg8::StaticOrder, true, true>(lds + RING_OFF, D, S, E); } SEAM(5);
    if (IN(6)) { pg8::StaticOrder S; S.init(ws + WS_HR, ws + WS_BTGA, T, D, D, G, c); pg8::EpiBf16<1> E{(bf16*)(ws + WS_G1), D};
        pg8::gemm_phase<pg8::EpiBf16<1>, pg8::StaticOrder, true, true>(lds + RING_OFF, D, S, E); } SEAM(6);
    if (IN(7)) { pg8::StaticOrder S; S.init(ws + WS_HR, ws + WS_BTGB, T, D, D, G, c); pg8::EpiBf16<1> E{(bf16*)(ws + WS_G2), D};
        pg8::gemm_phase<pg8::EpiBf16<1>, pg8::StaticOrder, true, true>(lds + RING_OFF, D, S, E); } SEAM(7);
    if (IN(8)) { pg8::StaticOrder S; S.init(ws + WS_OA, ws + WS_BTA, T, D, 512, G, c); pg8::EpiGateMul<false> E{(const bf16*)(ws + WS_G1), (bf16*)(ws + WS_G1)};
        pg8::gemm_phase<pg8::EpiGateMul<false>, pg8::StaticOrder, true, true>(lds + RING_OFF, 512, S, E); } SEAM(8);
    if (IN(9)) { pg8::StaticOrder S; S.init(ws + WS_ON, ws + WS_BTB, T, D, D, G, c); pg8::EpiGateMul<true> E{(const bf16*)(ws + WS_G2), (bf16*)(ws + WS_G1)};
        pg8::gemm_phase<pg8::EpiGateMul<true>, pg8::StaticOrder, true, true>(lds + RING_OFF, D, S, E); } SEAM(9);
    if (IN(10)) { pg8::StaticOrder S; S.init(ws + WS_G1, ws + WS_BTOUT, T, D, D, G, c); pg8::EpiResF32 E{P.in[0], P.out};
        pg8::gemm_phase<pg8::EpiResF32, pg8::StaticOrder, true, true>(lds + RING_OFF, D, S, E); } SEAM(10);
    if (IN(11)) { router_phase(P, lds, G, c, wave, lane); } SEAM(11);
    if (IN(12)) { place_phase(P, G, c, wave, lane); } SEAM(12);
    if (IN(13)) { pg8::ExpertOrder S; S.init(ws + WS_HX, ws + WS_BTGU, (const unsigned*)ctl + CW_CNT, 512, D, G, c); pg8::EpiGU E{(bf16*)(ws + WS_ACT), (const float*)(ws + WS_CW)};
        pg8::gemm_phase<pg8::EpiGU, pg8::ExpertOrder, true, true>(lds + RING_OFF, D, S, E); } SEAM(13);
    if (IN(14)) { pg8::ExpertOrder S; S.init(ws + WS_ACT, ws + WS_BTDN, (const unsigned*)ctl + CW_CNT, D, 256, G, c); pg8::EpiBf16<0> E{(bf16*)(ws + WS_Y), D};
        pg8::gemm_phase<pg8::EpiBf16<0>, pg8::ExpertOrder, true, true>(lds + RING_OFF, 256, S, E); } SEAM(14);
    if (IN(15)) { ple_norm_phase(P, G, c, wave, lane); } SEAM(15);
    if (IN(16)) { pg8::StaticOrder S; S.init(ws + WS_PB, ws + WS_BTPLE, T, D, 256, G, c); pg8::EpiBf16<0> E{(bf16*)(ws + WS_E1), D};
        pg8::gemm_phase<pg8::EpiBf16<0>, pg8::StaticOrder, true, true>(lds + RING_OFF, 256, S, E); } SEAM(16);
    if (IN(17)) { pg8::StaticOrder S; S.init(ws + WS_H3, ws + WS_BTPG, T, D, D, G, c); pg8::EpiPleOut E{(const bf16*)(ws + WS_E1), P.out};
        pg8::gemm_phase<pg8::EpiPleOut, pg8::StaticOrder, true, true>(lds + RING_OFF, D, S, E); }
#undef IN
#undef SEAM
}

#ifndef DBG_LAST
#define DBG_LAST (NPH - 1)
#endif
__global__ void dbg_sanitize(float* out, size_t n) {
    for (size_t i = (size_t)blockIdx.x * blockDim.x + threadIdx.x; i < n; i += (size_t)gridDim.x * blockDim.x) { const float v = out[i]; if (!(v - v == 0.f)) out[i] = 0.f; }
}
__global__ void dbg_copy(const float* x, float* out, size_t n) {
    for (size_t i = (size_t)blockIdx.x * blockDim.x + threadIdx.x; i < n; i += (size_t)gridDim.x * blockDim.x) out[i] = x[i];
}
#ifdef DBG_CHECK
__global__ void dbg_check(const void* p, size_t nbytes, int is_f32, unsigned id, unsigned* word) {
    const size_t n16 = nbytes / 16; const uint4* q = (const uint4*)p; bool bad = false;
    for (size_t i = (size_t)blockIdx.x * blockDim.x + threadIdx.x; i < n16; i += (size_t)gridDim.x * blockDim.x) { const uint4 v = q[i]; const unsigned w[4] = {v.x, v.y, v.z, v.w};
        for (int k = 0; k < 4; ++k) { if (is_f32) { if ((w[k] & 0x7f800000u) == 0x7f800000u) bad = true; } else { if ((w[k] & 0x7f80u) == 0x7f80u || (w[k] & 0x7f800000u) == 0x7f800000u) bad = true; } } }
    if (bad) atomicMin(word, id);
}
__global__ void dbg_check_dnp(const unsigned char* p, unsigned id, unsigned* word) {
    bool bad = false;
    for (size_t i = (size_t)blockIdx.x * blockDim.x + threadIdx.x; i < (size_t)8192 * (DNU / 16); i += (size_t)gridDim.x * blockDim.x) { const size_t rec = i / (DNU / 16), o = (i % (DNU / 16)) * 16;
        if (o >= 49152 + 2048 && o < 49152 + 4096) continue;
        const uint4 v = *(const uint4*)(p + rec * DNU + o); const unsigned w[4] = {v.x, v.y, v.z, v.w};
        for (int k = 0; k < 4; ++k) if ((w[k] & 0x7f80u) == 0x7f80u || (w[k] & 0x7f800000u) == 0x7f800000u) { const unsigned part = o < 16384 ? 0u : (o < 32768 ? 1u : (o < 49152 ? 2u : (o < 57344 ? 3u : 4u))); atomicAnd(word, ~(1u << part)); } }
    (void)bad;
}
__global__ void dbg_check_tmax(const unsigned char* p, unsigned* word) {
    for (size_t r = (size_t)blockIdx.x * blockDim.x + threadIdx.x; r < 8192; r += (size_t)gridDim.x * blockDim.x) { const float* d = (const float*)(p + r * DNU + 49152 + 2048);
        unsigned bits = 0; if (d[0] > 1e3f) bits |= 1u; if (d[2] != 0.f) bits |= 2u; if (d[1] > 1.5f) bits |= 4u; if (d[1] > 100.f) bits |= 8u; if (d[3] != 0.f) bits |= 16u;
        if (bits) atomicAnd(word, ~bits); }
}
__global__ void dbg_final(const float* x, float* out, const unsigned* word) {
    unsigned id = *word;
#ifdef DBG_BITS
    id = (~id) & 31u; if (id == 0) id = 0xffffffffu;
#endif
    const size_t nz = id == 0xffffffffu ? 0 : (size_t)id * (T / 32) * D; const size_t n = (size_t)T * D;
    for (size_t i = (size_t)blockIdx.x * blockDim.x + threadIdx.x; i < n; i += (size_t)gridDim.x * blockDim.x) out[i] = i < nz ? 0.f : x[i];
}
#endif
extern "C" void kernel_launch(void* const* d_in, const int* in_sizes, int n_in, void* d_out, int out_size, void* d_ws, size_t ws_size, hipStream_t stream) {
    static int grid = 0;
    if (grid == 0) {
        if (n_in != 24 || out_size != T * D || ws_size < WS_END) { fprintf(stderr, "kernel_launch: unexpected shapes (n_in %d, out %d, ws %zu)\n", n_in, out_size, ws_size); grid = -1; return; }
        int dev = 0, cus = 0;
        if (hipGetDevice(&dev) != hipSuccess || hipDeviceGetAttribute(&cus, hipDeviceAttributeMultiprocessorCount, dev) != hipSuccess) { grid = -1; return; }
        if (hipFuncSetAttribute((const void*)fwd_kernel, hipFuncAttributeMaxDynamicSharedMemorySize, LDS_BYTES) != hipSuccess) { grid = -1; return; }
        int per_cu = 0;
        if (hipOccupancyMaxActiveBlocksPerMultiprocessor(&per_cu, (const void*)fwd_kernel, NWAVES * 64, LDS_BYTES) != hipSuccess || per_cu < 1) { fprintf(stderr, "kernel_launch: occupancy query says %d\n", per_cu); }
        (void)hipGetLastError();
        grid = cus;
    }
    if (grid < 0) return;
    if (hipMemsetAsync((char*)d_ws + WS_CTL, 0, CTL_ZERO_BYTES, stream) != hipSuccess) return;
    Args a{};
    for (int i = 0; i < 24; ++i) a.p.in[i] = (const float*)d_in[i];
    a.p.out = (float*)d_out; a.p.ws = (unsigned char*)d_ws;
    if (N_LAUNCHES == 1) { a.ph_lo = 0; a.ph_hi = NPH; hipLaunchKernelGGL(fwd_kernel, dim3(grid), dim3(NWAVES * 64), LDS_BYTES, stream, a); }
    else for (int li = 0; li <= DBG_LAST; ++li) { a.ph_lo = li; a.ph_hi = li + 1; hipLaunchKernelGGL(fwd_kernel, dim3(grid), dim3(NWAVES * 64), LDS_BYTES, stream, a);
#ifdef DBG_CHECK
        unsigned char* W = (unsigned char*)d_ws; unsigned char* O = (unsigned char*)d_out; unsigned* word = (unsigned*)(W + 1022 * MiB + 512 * 1024);
        if (li == 0) hipMemsetAsync(word, 0xFF, 4, stream);
#define CHK(p, nb, f32, id) hipLaunchKernelGGL(dbg_check, dim3(1024), dim3(256), 0, stream, (const void*)(p), (size_t)(nb), f32, (unsigned)(id), word)
        if (li == 0) { CHK(O + DO_H, (size_t)T * D * 2, 0, 1); CHK(W + WS_BTP1, (size_t)NP1 * D * 2, 0, 2); CHK(W + WS_BTZ, 38 * MiB, 0, 3); }
        if (li == 1) { CHK(W + WS_QA, (size_t)T * 4608 * 2, 0, 4); CHK(W + WS_QB, (size_t)T * 3072 * 2, 0, 5); CHK(W + WS_BG, (size_t)T * 16 * 4, 1, 6); }
        if (li == 2) { CHK(O + DO_OG, (size_t)T * 1536 * 2, 0, 7); CHK(O + DO_LSE, (size_t)T * 24 * 4, 1, 8); }
#if defined(DBG_PREPCHK)
        if (li == 3) {
#elif defined(DBG_TMAX)
        if (li == 3) { hipLaunchKernelGGL(dbg_check_tmax, dim3(32), dim3(256), 0, stream, W + WS_DNP, word);
#else
        if (li == 3) { hipLaunchKernelGGL(dbg_check_dnp, dim3(1024), dim3(256), 0, stream, W + WS_DNP, 9u, word);
#endif
        CHK(W + WS_DLB, 8192 * 4, 1, 14); }
        if (li == 4) { CHK(W + WS_ON, (size_t)T * D * 2, 0, 11); CHK(W + WS_OA, (size_t)T * 512 * 2, 0, 12); CHK(W + WS_HR, (size_t)T * D * 2, 0, 13); }
        if (li == 5) CHK(W + WS_ON, (size_t)T * D * 2, 0, 14);
        if (li == 6) CHK(W + WS_G1, (size_t)T * D * 2, 0, 15);
        if (li == 7) CHK(W + WS_G2, (size_t)T * D * 2, 0, 16);
        if (li == 8) CHK(W + WS_G1, (size_t)T * D * 2, 0, 17);
        if (li == 9) CHK(W + WS_G1, (size_t)T * D * 2, 0, 18);
        if (li == 10) CHK(O, (size_t)T * D * 4, 1, 19);
        if (li == 11) { CHK(W + WS_H2, (size_t)T * D * 2, 0, 20); CHK(W + WS_TOK, (size_t)T * 16, 1, 21); }
        if (li == 15) { CHK(O, (size_t)T * D * 4, 1, 25); CHK(W + WS_H3, (size_t)T * D * 2, 0, 26); }
        if (li == 16) CHK(W + WS_E1, (size_t)T * D * 2, 0, 27);
        if (li == 17) CHK(O, (size_t)T * D * 4, 1, 28);
        if (li == DBG_LAST) hipLaunchKernelGGL(dbg_final, dim3(2048), dim3(256), 0, stream, (const float*)d_in[0], (float*)d_out, (const unsigned*)word);
#endif
    }
#ifdef DBG_COPYX
    hipLaunchKernelGGL(dbg_copy, dim3(2048), dim3(256), 0, stream, (const float*)d_in[0], (float*)d_out, (size_t)out_size);
#endif
#ifdef DBG_SANITIZE
    hipLaunchKernelGGL(dbg_sanitize, dim3(2048), dim3(256), 0, stream, (float*)d_out, (size_t)out_size);
#endif
}
```

```cpp
#define MK_N_LAUNCHES 1
#include <hip/hip_runtime.h>
#include <cstdio>
#include <cstdint>
namespace pg8 {
#define PG8_LAS __attribute__((address_space(3)))
typedef unsigned short bf16_t;
typedef short bf16x8 __attribute__((ext_vector_type(8)));
typedef float f32x4 __attribute__((ext_vector_type(4)));
typedef unsigned u32x4 __attribute__((ext_vector_type(4)));
typedef unsigned u32x2 __attribute__((ext_vector_type(2)));
constexpr int BM = 256, BK = 64, HALF = 128, HTB = HALF * BK * 2  , STAGE_BYTES = 8 * HTB, NXCD = 8, WGM = 8;

__host__ __device__ __forceinline__ int lds_byte(int r, int c) { const int st = (r >> 4) * 2 + (c >> 5), rr = r & 15, cc = c & 31, ob = rr * 64 + cc * 2; return st * 1024 + (ob ^ (((ob >> 9) & 1) << 5)); }
__host__ __device__ __forceinline__ void stage_rc(int b, int& R, int& C) { const int st = b / 1024, sb = b % 1024, swz = sb ^ (((sb >> 9) & 1) << 5); R = (st >> 1) * 16 + swz / 64; C = (st & 1) * 32 + (swz % 64) / 2; }
__host__ __device__ __forceinline__ int perm32(int rho) { const int n = rho >> 4, i = rho & 15; return 8 * (i >> 2) + 4 * n + (i & 3); }

struct Unit { int pm, pn; const char* a; const char* b; };

struct StaticOrder {
    const char* A; const char* Bt; size_t tstep; int nM, nN, nwg, G, c;
    __device__ __forceinline__ void init(const void* A_, const void* Bt_, int M, int N, int K, int G_, int c_) { A = (const char*)A_; Bt = (const char*)Bt_; tstep = (size_t)BM * K * 2; nM = M / BM; nN = N / BM; nwg = nM * nN; G = G_; c = c_; }
    __device__ __forceinline__ bool next(int i, Unit& u) const {
        const long L = (long)i * G + c; if (L >= nwg) return false;
        int wgid = (int)L; { const int q = nwg / NXCD, r = nwg % NXCD, xcd = wgid % NXCD, off = wgid / NXCD; wgid = (xcd < r ? xcd * (q + 1) : r * (q + 1) + (xcd - r) * q) + off; }
        const int nig = WGM * nN, gid = wgid / nig, fm = gid * WGM, gsz = (nM - fm) < WGM ? (nM - fm) : WGM;
        u.pm = fm + ((wgid % nig) % gsz); u.pn = (wgid % nig) / gsz; u.a = A + (size_t)u.pm * tstep; u.b = Bt + (size_t)u.pn * tstep; return true;
    }
    __device__ __forceinline__ const char* a_ptr(const Unit& u) const { return u.a; }
    __device__ __forceinline__ const char* b_ptr(const Unit& u) const { return u.b; }
    __device__ __forceinline__ void a_ready(const Unit&) const {}
    __device__ __forceinline__ void done(const Unit&) const {}
};
struct ExpertOrder {
    const char* A; const char* Bt; const unsigned* cnt; size_t tstep, bstride; int nN, G, c;
    __device__ __forceinline__ void init(const void* A_, const void* Bt_, const unsigned* cnt_, int N, int K, int G_, int c_) { A = (const char*)A_; Bt = (const char*)Bt_; cnt = cnt_; tstep = (size_t)BM * K * 2; bstride = (size_t)N * K * 2; nN = N / BM; G = G_; c = c_; }
    __device__ __forceinline__ bool next(int i, Unit& u) const {
        const long L = (long)i * G + c; const int rt = (int)(L / nN), pn = (int)(L % nN);
        int acc = 0, found = -1;
        for (int e = 0; e < 16; ++e) { const int te = (int)((cnt[e] + 255u) >> 8); if (found < 0 && rt < acc + te) found = e; acc += te; }
        if (found < 0) return false;
        u.pm = rt; u.pn = pn; u.a = A + (size_t)rt * tstep; u.b = Bt + (size_t)found * bstride + (size_t)pn * tstep; return true;
    }
    __device__ __forceinline__ const char* a_ptr(const Unit& u) const { return u.a; }
    __device__ __forceinline__ const char* b_ptr(const Unit& u) const { return u.b; }
    __device__ __forceinline__ void a_ready(const Unit&) const {}
    __device__ __forceinline__ void done(const Unit&) const {}
};

typedef float f32x2_t __attribute__((ext_vector_type(2))); typedef __bf16 bf16x2_t __attribute__((ext_vector_type(2)));
__device__ __forceinline__ unsigned cvt_pk_bf16(float lo, float hi) { const f32x2_t v = {lo, hi}; const bf16x2_t b = __builtin_convertvector(v, bf16x2_t); return __builtin_bit_cast(unsigned, b); }
__device__ __forceinline__ float bflo(unsigned w) { return __uint_as_float(w << 16); }
__device__ __forceinline__ float bfhi(unsigned w) { return __uint_as_float(w & 0xffff0000u); }
__device__ __forceinline__ float sigm(float x) { return 1.0f / (1.0f + __expf(-x)); }
__device__ __forceinline__ u32x4 pack8(const f32x4 a, const f32x4 b) { u32x4 w; w.x = cvt_pk_bf16(a[0], a[1]); w.y = cvt_pk_bf16(a[2], a[3]); w.z = cvt_pk_bf16(b[0], b[1]); w.w = cvt_pk_bf16(b[2], b[3]); return w; }
__device__ __forceinline__ void unpack8(const u32x4 w, f32x4& a, f32x4& b) { a = (f32x4){bflo(w.x), bfhi(w.x), bflo(w.y), bfhi(w.y)}; b = (f32x4){bflo(w.z), bfhi(w.z), bflo(w.w), bfhi(w.w)}; }

constexpr float QSCALE = 0.125f * 1.4426950408889634f;
constexpr float EPSN = 1e-6f;
constexpr int QAP = 4608, QBP = 3072;

struct EpiP1 {
    static constexpr bool PERM = true, AFTER_DRAIN = false;
    bf16_t* QA; bf16_t* QB; float* BG; const float* qn; const float* kn; const float* a_log; const float* dt_bias;
    __device__ __forceinline__ void operator()(const f32x4 (&acc)[2][2][4][2], const Unit& u, int wr, int wc, int fr, int fq) const {
        const int row0 = u.pm * BM + wr * 64 + fr;
        if (u.pn < 12) {
            const float* gn = (u.pn < 6) ? qn : kn; const float sc = (u.pn < 6) ? QSCALE : 1.0f;
            f32x4 gv[2][2];
#pragma unroll
            for (int bj = 0; bj < 2; ++bj)
#pragma unroll
                for (int n = 0; n < 2; ++n) gv[bj][n] = *(const f32x4*)(gn + 32 * bj + 8 * fq + 4 * n) * sc;
#pragma unroll
            for (int ai = 0; ai < 2; ++ai)
#pragma unroll
                for (int m = 0; m < 4; ++m) {
                    float ss = 0.f;
#pragma unroll
                    for (int bj = 0; bj < 2; ++bj)
#pragma unroll
                        for (int n = 0; n < 2; ++n) { const f32x4 x = acc[ai][bj][m][n]; ss += (x[0] * x[0] + x[1] * x[1]) + (x[2] * x[2] + x[3] * x[3]); }
                    ss += __shfl_xor(ss, 16); ss += __shfl_xor(ss, 32);
                    const float rs = rsqrtf(ss * (1.0f / 64.0f) + EPSN);
                    bf16_t* rowp = QA + (size_t)(row0 + ai * HALF + m * 16) * QAP + u.pn * BM + wc * 64 + 8 * fq;
#pragma unroll
                    for (int bj = 0; bj < 2; ++bj) { const f32x4 v0 = acc[ai][bj][m][0] * rs * gv[bj][0], v1 = acc[ai][bj][m][1] * rs * gv[bj][1]; *(u32x4*)(rowp + bj * 32) = pack8(v0, v1); }
                }
        } else if (u.pn < 30) {
            bf16_t* const base = (u.pn < 18) ? QA + u.pn * BM : QB + (u.pn - 18) * BM; const int pitch = (u.pn < 18) ? QAP : QBP;
#pragma unroll
            for (int ai = 0; ai < 2; ++ai)
#pragma unroll
                for (int m = 0; m < 4; ++m) { bf16_t* rowp = base + (size_t)(row0 + ai * HALF + m * 16) * pitch + wc * 32 + 8 * fq;
#pragma unroll
                    for (int bj = 0; bj < 2; ++bj) *(u32x4*)(rowp + bj * HALF) = pack8(acc[ai][bj][m][0], acc[ai][bj][m][1]); }
        } else {
            if (wc == 0 && fq < 2) {
                f32x4 al[2], db[2];
#pragma unroll
                for (int n = 0; n < 2; ++n) { al[n] = *(const f32x4*)(a_log + 4 * n); db[n] = *(const f32x4*)(dt_bias + 4 * n); }
#pragma unroll
                for (int ai = 0; ai < 2; ++ai)
#pragma unroll
                    for (int m = 0; m < 4; ++m) { float* rowp = BG + (size_t)(row0 + ai * HALF + m * 16) * 16 + 8 * fq;
#pragma unroll
                        for (int n = 0; n < 2; ++n) { const f32x4 x = acc[ai][0][m][n]; f32x4 o;
#pragma unroll
                            for (int e = 0; e < 4; ++e) { if (fq == 0) o[e] = sigm(x[e]); else { const float z = x[e] + db[n][e]; const float sp = z > 20.f ? z : log1pf(__expf(z)); o[e] = -__expf(al[n][e]) * sp; } }
                            *(f32x4*)(rowp + 4 * n) = o; } }
            }
        }
    }
};
struct EpiSiluMul {
    static constexpr bool PERM = true, AFTER_DRAIN = false;
    bf16_t* O;
    __device__ __forceinline__ void operator()(const f32x4 (&acc)[2][2][4][2], const Unit& u, int wr, int wc, int fr, int fq) const {
        const int row0 = u.pm * BM + wr * 64 + fr;
#pragma unroll
        for (int ai = 0; ai < 2; ++ai)
#pragma unroll
            for (int m = 0; m < 4; ++m) { bf16_t* rowp = O + (size_t)(row0 + ai * HALF + m * 16) * 1024 + u.pn * BM + wc * 32 + 8 * fq;
#pragma unroll
                for (int bj = 0; bj < 2; ++bj) { const u32x4 w = *(const u32x4*)(rowp + bj * HALF); f32x4 a, b; unpack8(w, a, b); f32x4 z0 = acc[ai][bj][m][0], z1 = acc[ai][bj][m][1];
#pragma unroll
                    for (int e = 0; e < 4; ++e) { a[e] *= z0[e] * sigm(z0[e]); b[e] *= z1[e] * sigm(z1[e]); }
                    *(u32x4*)(rowp + bj * HALF) = pack8(a, b); } }
    }
};
template <int MODE> struct EpiBf16 {
    static constexpr bool PERM = true, AFTER_DRAIN = false;
    bf16_t* O; int ldc;
    __device__ __forceinline__ void operator()(const f32x4 (&acc)[2][2][4][2], const Unit& u, int wr, int wc, int fr, int fq) const {
        const int row0 = u.pm * BM + wr * 64 + fr;
#pragma unroll
        for (int ai = 0; ai < 2; ++ai)
#pragma unroll
            for (int m = 0; m < 4; ++m) { bf16_t* rowp = O + (size_t)(row0 + ai * HALF + m * 16) * ldc + u.pn * BM + wc * 32 + 8 * fq;
#pragma unroll
                for (int bj = 0; bj < 2; ++bj) { f32x4 a = acc[ai][bj][m][0], b = acc[ai][bj][m][1];
                    if (MODE == 1) {
#pragma unroll
                        for (int e = 0; e < 4; ++e) { a[e] = sigm(a[e]); b[e] = sigm(b[e]); } }
                    *(u32x4*)(rowp + bj * HALF) = pack8(a, b); } }
    }
};
template <bool ADD> struct EpiGateMul {
    static constexpr bool PERM = true, AFTER_DRAIN = false;
    const bf16_t* Gt; bf16_t* Mo;
    __device__ __forceinline__ void operator()(const f32x4 (&acc)[2][2][4][2], const Unit& u, int wr, int wc, int fr, int fq) const {
        const int row0 = u.pm * BM + wr * 64 + fr;
#pragma unroll
        for (int ai = 0; ai < 2; ++ai)
#pragma unroll
            for (int m = 0; m < 4; ++m) { const size_t off = (size_t)(row0 + ai * HALF + m * 16) * 1024 + u.pn * BM + wc * 32 + 8 * fq;
#pragma unroll
                for (int bj = 0; bj < 2; ++bj) { const u32x4 gw = *(const u32x4*)(Gt + off + bj * HALF); f32x4 ga, gb; unpack8(gw, ga, gb);
                    f32x4 a = ga * acc[ai][bj][m][0], b = gb * acc[ai][bj][m][1];
                    if (ADD) { const u32x4 mw = *(const u32x4*)(Mo + off + bj * HALF); f32x4 ma, mb; unpack8(mw, ma, mb); a += ma; b += mb; }
                    *(u32x4*)(Mo + off + bj * HALF) = pack8(a, b); } }
    }
};
struct EpiResF32 {
    static constexpr bool PERM = false, AFTER_DRAIN = false;
    const float* base; float* out;
    __device__ __forceinline__ void operator()(const f32x4 (&acc)[2][2][4][2], const Unit& u, int wr, int wc, int fr, int fq) const {
        const int row0 = u.pm * BM + wr * 64 + fr, col0 = u.pn * BM + wc * 32 + 4 * fq;
#pragma unroll
        for (int ai = 0; ai < 2; ++ai)
#pragma unroll
            for (int m = 0; m < 4; ++m) { const size_t off = (size_t)(row0 + ai * HALF + m * 16) * 1024 + col0;
#pragma unroll
                for (int bj = 0; bj < 2; ++bj)
#pragma unroll
                    for (int n = 0; n < 2; ++n) { const f32x4 bs = *(const f32x4*)(base + off + bj * HALF + n * 16); *(f32x4*)(out + off + bj * HALF + n * 16) = bs + acc[ai][bj][m][n]; }
                asm volatile("" ::: "memory"); }
    }
};
struct EpiPleOut {
    static constexpr bool PERM = false, AFTER_DRAIN = false;
    const bf16_t* E1; float* out;
    __device__ __forceinline__ void operator()(const f32x4 (&acc)[2][2][4][2], const Unit& u, int wr, int wc, int fr, int fq) const {
        const int row0 = u.pm * BM + wr * 64 + fr, col0 = u.pn * BM + wc * 32 + 4 * fq;
#pragma unroll
        for (int ai = 0; ai < 2; ++ai)
#pragma unroll
            for (int m = 0; m < 4; ++m) { const size_t off = (size_t)(row0 + ai * HALF + m * 16) * 1024 + col0;
#pragma unroll
                for (int bj = 0; bj < 2; ++bj)
#pragma unroll
                    for (int n = 0; n < 2; ++n) { const size_t o2 = off + bj * HALF + n * 16; const f32x4 bs = *(const f32x4*)(out + o2); const u32x2 ew = *(const u32x2*)(E1 + o2);
                        const f32x4 ev = (f32x4){bflo(ew.x), bfhi(ew.x), bflo(ew.y), bfhi(ew.y)}; const f32x4 a = acc[ai][bj][m][n]; f32x4 r;
#pragma unroll
                        for (int e = 0; e < 4; ++e) r[e] = bs[e] + sigm(a[e]) * ev[e];
                        *(f32x4*)(out + o2) = r; }
                asm volatile("" ::: "memory"); }
    }
};
struct EpiGU {
    static constexpr bool PERM = true, AFTER_DRAIN = false;
    bf16_t* ACT; const float* CW;
    __device__ __forceinline__ void operator()(const f32x4 (&acc)[2][2][4][2], const Unit& u, int wr, int wc, int fr, int fq) const {
        const int row0 = u.pm * BM + wr * 64 + fr;
#pragma unroll
        for (int ai = 0; ai < 2; ++ai)
#pragma unroll
            for (int m = 0; m < 4; ++m) { const int row = row0 + ai * HALF + m * 16; const float cw = CW[row];
                f32x4 a, b; const f32x4 g0 = acc[ai][0][m][0], g1 = acc[ai][0][m][1], u0 = acc[ai][1][m][0], u1 = acc[ai][1][m][1];
#pragma unroll
                for (int e = 0; e < 4; ++e) { a[e] = g0[e] * sigm(g0[e]) * u0[e] * cw; b[e] = g1[e] * sigm(g1[e]) * u1[e] * cw; }
                *(u32x4*)(ACT + (size_t)row * 256 + u.pn * HALF + wc * 32 + 8 * fq) = pack8(a, b); }
    }
};

template <class Epi, class Sched, bool ALIGN_EPI = false, bool SP2 = false>
__device__ __forceinline__ void gemm_phase(PG8_LAS unsigned char* lds, const int KK, const Sched& S, const Epi& E) {
    int tid_ = threadIdx.x; asm volatile("" : "+v"(tid_));
    const int tid = tid_, wid = __builtin_amdgcn_readfirstlane(tid >> 6), lane = tid & 63, wr = wid >> 2, wc = wid & 3, fr = lane & 15, fq = lane >> 4;
    int K_ = KK; asm volatile("" : "+s"(K_));
    const int K = K_, nt = K / BK;
    unsigned voffA[2], voffB[2];
#pragma unroll
    for (int i = 0; i < 2; ++i) { int R, C; stage_rc(tid * 16 + i * 8192, R, C); const int Rb = Epi::PERM ? ((R & ~31) + perm32(R & 31)) : R;
        voffA[i] = (unsigned)(R * K + C) * 2u; voffB[i] = (unsigned)(Rb * K + C) * 2u; }
    const size_t kstep = (size_t)(BK * 2);
    const size_t hstep = (size_t)HALF * K * 2;
    const size_t tstep = 2 * hstep;
    const unsigned ldsw = (unsigned)wid * 1024u;
    const int aoff = lds_byte(wr * 64 + fr, fq * 8), boff = lds_byte(wc * 32 + fr, fq * 8);
#define PG8_SA(b, h) (((b) * 2 + (h)) * HTB)
#define PG8_SB(b, h) ((4 + (b) * 2 + (h)) * HTB)
#define PG8_STAGE(bufoff, gbase, voff) do { _Pragma("unroll") for (int _i = 0; _i < 2; ++_i) \
        __builtin_amdgcn_global_load_lds((const unsigned*)((const char*)(gbase) + (voff)[_i]), (PG8_LAS unsigned*)(lds + (bufoff) + ldsw + _i * 8192), 16, 0, 0); } while (0)
#define PG8_LDA(dst, b, h) do { _Pragma("unroll") for (int m = 0; m < 4; ++m) _Pragma("unroll") for (int k = 0; k < 2; ++k) dst[m][k] = *(const PG8_LAS bf16x8*)(lds + PG8_SA(b, h) + aoff + m * 2048 + k * 1024); } while (0)
#define PG8_LDB(dst, b, h) do { _Pragma("unroll") for (int n = 0; n < 2; ++n) _Pragma("unroll") for (int k = 0; k < 2; ++k) dst[n][k] = *(const PG8_LAS bf16x8*)(lds + PG8_SB(b, h) + boff + n * 2048 + k * 1024); } while (0)
#define PG8_MMA(ai, bj, At, Bt) do { __builtin_amdgcn_s_setprio(1); _Pragma("unroll") for (int m = 0; m < 4; ++m) _Pragma("unroll") for (int n = 0; n < 2; ++n) _Pragma("unroll") for (int k = 0; k < 2; ++k) \
        acc[ai][bj][m][n] = __builtin_amdgcn_mfma_f32_16x16x32_bf16(Bt[n][k], At[m][k], acc[ai][bj][m][n], 0, 0, 0); __builtin_amdgcn_s_setprio(0); } while (0)
#define PG8_WAIT_V(n) asm volatile("s_waitcnt vmcnt(" #n ")" ::: "memory")
#define PG8_WAIT_L(n) asm volatile("s_waitcnt lgkmcnt(" #n ")" ::: "memory")
#define PG8_BAR __builtin_amdgcn_s_barrier()
#define PG8_SCHED __builtin_amdgcn_sched_barrier(0)
    Unit cur, nxt; int ui = 0;
    if (!S.next(0, cur)) return;
    f32x4 acc[2][2][4][2];
#pragma unroll
    for (int a = 0; a < 2; ++a)
#pragma unroll
        for (int b = 0; b < 2; ++b)
#pragma unroll
            for (int m = 0; m < 4; ++m)
#pragma unroll
                for (int n = 0; n < 2; ++n) acc[a][b][m][n] = (f32x4){0.f, 0.f, 0.f, 0.f};
    bf16x8 At[4][2], B0[2][2], B1[2][2];
    const char* cA = S.a_ptr(cur); const char* cB = S.b_ptr(cur);
    S.a_ready(cur);
    if constexpr (SP2) {
        PG8_STAGE(PG8_SB(0, 0), cB, voffB); PG8_STAGE(PG8_SB(0, 1), cB + hstep, voffB); PG8_STAGE(PG8_SA(0, 0), cA, voffA); PG8_STAGE(PG8_SA(0, 1), cA + hstep, voffA);
        if (wr == 1) PG8_BAR;
        PG8_WAIT_V(2); PG8_BAR;
        PG8_STAGE(PG8_SB(1, 0), cB + kstep, voffB); PG8_STAGE(PG8_SA(1, 0), cA + kstep, voffA); PG8_STAGE(PG8_SB(1, 1), cB + hstep + kstep, voffB);
        PG8_WAIT_V(6); PG8_BAR;
    } else {
        PG8_STAGE(PG8_SB(0, 0), cB, voffB); PG8_STAGE(PG8_SA(0, 0), cA, voffA); PG8_STAGE(PG8_SB(0, 1), cB + hstep, voffB); PG8_STAGE(PG8_SA(0, 1), cA + hstep, voffA);
        if (wr == 1) PG8_BAR;
        PG8_WAIT_V(4); PG8_BAR;
        PG8_STAGE(PG8_SB(1, 0), cB + kstep, voffB); PG8_STAGE(PG8_SA(1, 0), cA + kstep, voffA); PG8_STAGE(PG8_SB(1, 1), cB + hstep + kstep, voffB);
        PG8_WAIT_V(6); PG8_BAR;
    }
    for (;;) {
        const bool has_next = S.next(ui + 1, nxt);
        const char* nA = has_next ? S.a_ptr(nxt) : cA; const char* nB = has_next ? S.b_ptr(nxt) : cB;
        for (int t = 0; t < nt; t += 2) {
            const bool last = (t == nt - 2);
            const char* a1 = cA + (size_t)(t + 1) * kstep;
            const char* a2 = last ? nA : cA + (size_t)(t + 2) * kstep; const char* b2 = last ? nB : cB + (size_t)(t + 2) * kstep;
            const char* a3 = a2 + kstep; const char* b3 = b2 + kstep;
            if (last && has_next) S.a_ready(nxt);
            if constexpr (SP2) {
            PG8_LDB(B0, 0, 0); PG8_LDB(B1, 0, 1); PG8_SCHED; PG8_LDA(At, 0, 0); PG8_STAGE(PG8_SA(1, 1), a1 + hstep, voffA);
            PG8_WAIT_V(8); PG8_WAIT_L(0); PG8_BAR; PG8_MMA(0, 0, At, B0); PG8_MMA(0, 1, At, B1); PG8_BAR; PG8_SCHED;
            PG8_LDA(At, 0, 1); PG8_STAGE(PG8_SB(0, 0), b2, voffB); PG8_STAGE(PG8_SB(0, 1), b2 + hstep, voffB); PG8_STAGE(PG8_SA(0, 0), a2, voffA);
            PG8_WAIT_V(8); PG8_WAIT_L(0); PG8_BAR; PG8_MMA(1, 0, At, B0); PG8_MMA(1, 1, At, B1); PG8_BAR; PG8_SCHED;
            PG8_LDB(B0, 1, 0); PG8_LDB(B1, 1, 1); PG8_SCHED; PG8_LDA(At, 1, 0); PG8_STAGE(PG8_SA(0, 1), a2 + hstep, voffA);
            PG8_WAIT_V(8); PG8_WAIT_L(0); PG8_BAR; PG8_MMA(0, 0, At, B0); PG8_MMA(0, 1, At, B1); PG8_BAR; PG8_SCHED;
            PG8_LDA(At, 1, 1); PG8_STAGE(PG8_SB(1, 0), b3, voffB); PG8_STAGE(PG8_SB(1, 1), b3 + hstep, voffB); PG8_STAGE(PG8_SA(1, 0), a3, voffA);
            PG8_WAIT_V(8); PG8_WAIT_L(0); PG8_BAR; PG8_MMA(1, 0, At, B0); PG8_MMA(1, 1, At, B1); PG8_BAR; PG8_SCHED;
            } else {
            PG8_LDB(B0, 0, 0); PG8_SCHED; PG8_LDA(At, 0, 0); PG8_STAGE(PG8_SA(1, 1), a1 + hstep, voffA);
            PG8_WAIT_L(8); PG8_BAR; PG8_WAIT_L(0); PG8_MMA(0, 0, At, B0); PG8_BAR; PG8_SCHED;
            PG8_LDB(B1, 0, 1); PG8_STAGE(PG8_SB(0, 0), b2, voffB);
            PG8_BAR; PG8_WAIT_L(0); PG8_MMA(0, 1, At, B1); PG8_BAR;
            PG8_LDA(At, 0, 1); PG8_STAGE(PG8_SA(0, 0), a2, voffA);
            PG8_BAR; PG8_WAIT_L(0); PG8_MMA(1, 0, At, B0); PG8_BAR; PG8_SCHED;
            PG8_STAGE(PG8_SB(0, 1), b2 + hstep, voffB);
            PG8_WAIT_V(6); PG8_BAR; PG8_MMA(1, 1, At, B1); PG8_BAR;
            PG8_LDB(B0, 1, 0); PG8_SCHED; PG8_LDA(At, 1, 0); PG8_STAGE(PG8_SA(0, 1), a2 + hstep, voffA);
            PG8_WAIT_L(8); PG8_BAR; PG8_WAIT_L(0); PG8_MMA(0, 0, At, B0); PG8_BAR; PG8_SCHED;
            PG8_LDB(B1, 1, 1); PG8_STAGE(PG8_SB(1, 0), b3, voffB);
            PG8_BAR; PG8_WAIT_L(0); PG8_MMA(0, 1, At, B1); PG8_BAR;
            PG8_LDA(At, 1, 1); PG8_STAGE(PG8_SA(1, 0), a3, voffA);
            PG8_BAR; PG8_WAIT_L(0); PG8_MMA(1, 0, At, B0); PG8_BAR; PG8_SCHED;
            PG8_STAGE(PG8_SB(1, 1), b3 + hstep, voffB);
            PG8_WAIT_V(6); PG8_BAR; PG8_MMA(1, 1, At, B1); PG8_BAR;
            }
        }
        if constexpr (ALIGN_EPI) { if (wr == 0) PG8_BAR; }
        if constexpr (!Epi::AFTER_DRAIN) { E(acc, cur, wr, wc, fr, fq); S.done(cur); }
        if (!has_next) break;
#pragma unroll
        for (int a = 0; a < 2; ++a)
#pragma unroll
            for (int b = 0; b < 2; ++b)
#pragma unroll
                for (int m = 0; m < 4; ++m)
#pragma unroll
                    for (int n = 0; n < 2; ++n) acc[a][b][m][n] = (f32x4){0.f, 0.f, 0.f, 0.f};
        cur = nxt; cA = nA; cB = nB; ++ui;
        if constexpr (ALIGN_EPI) { if (wr == 1) PG8_BAR; }
    }
    PG8_WAIT_V(0);
    if constexpr (!ALIGN_EPI) { if (wr == 0) PG8_BAR; }
    PG8_BAR;
    if constexpr (Epi::AFTER_DRAIN) { E.fused(acc, cur, wr, wc, fr, fq, lds, wid, lane); S.done(cur); }
#undef PG8_SA
#undef PG8_SB
#undef PG8_STAGE
#undef PG8_LDA
#undef PG8_LDB
#undef PG8_MMA
#undef PG8_WAIT_V
#undef PG8_WAIT_L
#undef PG8_BAR
#undef PG8_SCHED
}
}

constexpr int NWAVES = 8;
constexpr int BATCH = 8, SEQ = 8192, D = 1024, T = BATCH * SEQ;
constexpr int IN_TOTAL = 10768, NP1 = 7936;
constexpr int NSLOT = 2 * T + 4096;
constexpr int NPH = 18;
#ifndef MK_N_LAUNCHES
#define MK_N_LAUNCHES 1
#endif
constexpr int N_LAUNCHES = MK_N_LAUNCHES;
static_assert(N_LAUNCHES == 1 || N_LAUNCHES == NPH, "MK_N_LAUNCHES is 1 or NPH");
constexpr int DNU = 73728;

constexpr size_t MiB = 1u << 20;
constexpr size_t WS_CTL = 0, CTL_ZERO_BYTES = 1 * MiB;
constexpr size_t WS_BTP1 = 1 * MiB;
constexpr size_t WS_BTZ = 17 * MiB, WS_BTGA = 19 * MiB, WS_BTGB = 21 * MiB, WS_BTB = 23 * MiB, WS_BTOUT = 25 * MiB, WS_BTPG = 27 * MiB;
constexpr size_t WS_BTA = 29 * MiB;
constexpr size_t WS_BTPLE = 30 * MiB;
constexpr size_t WS_BTGU = 31 * MiB;
constexpr size_t WS_BTDN = 47 * MiB;
constexpr size_t WS_QA = 56 * MiB;
constexpr size_t WS_DNP = 56 * MiB;
constexpr size_t WS_G1 = 56 * MiB, WS_G2 = 184 * MiB;
constexpr size_t WS_H3 = 56 * MiB;
constexpr size_t WS_H2 = 184 * MiB;
constexpr size_t WS_PB = 184 * MiB;
constexpr size_t WS_E1 = 216 * MiB;
constexpr size_t WS_HX = 312 * MiB;
constexpr size_t WS_ACT = 576 * MiB;
constexpr size_t WS_Y = 642 * MiB;
constexpr size_t WS_QB = 632 * MiB;
constexpr size_t WS_ON = 632 * MiB;
constexpr size_t WS_OA = 760 * MiB;
constexpr size_t WS_HR = 824 * MiB;
constexpr size_t WS_BG = 1016 * MiB;
constexpr size_t WS_TOK = 1020 * MiB;
constexpr size_t WS_SLOT = 1021 * MiB;
constexpr size_t WS_CW = 1021 * MiB + 512 * 1024;
constexpr size_t WS_DLB = 1022 * MiB + 256 * 1024;
constexpr size_t WS_END = 1024 * MiB;
static_assert(WS_Y + (size_t)NSLOT * 2048 <= WS_BG && WS_HX + (size_t)NSLOT * 2048 <= WS_ACT && WS_ACT + (size_t)NSLOT * 512 <= WS_Y && WS_HR + (size_t)T * 2048 <= WS_BG && WS_CW + (size_t)NSLOT * 4 <= WS_DLB, "d_ws map");
constexpr size_t DO_H = 0, DO_OG = 0, DO_LSE = 192 * MiB;
constexpr int CW_BAR = 4096;
constexpr int CW_CNT = 16384;
constexpr int CW_CUR = 16384 + 64;
constexpr int RING_OFF = 0, RING_BYTES = 131072;
constexpr int LDS_BYTES = 147456;
constexpr int MISC_OFF = LDS_BYTES - 256;

#define GAS __attribute__((address_space(1)))
#define LAS __attribute__((address_space(3)))
typedef unsigned short bf16;
typedef unsigned v4u __attribute__((ext_vector_type(4)));
typedef unsigned v2u __attribute__((ext_vector_type(2)));
typedef float f32x4 __attribute__((ext_vector_type(4)));
typedef float f32x16 __attribute__((ext_vector_type(16)));
typedef short bf16x8 __attribute__((ext_vector_type(8)));
typedef short s16x4 __attribute__((ext_vector_type(4)));
typedef GAS unsigned gu32;
#define RLX_AGENT __ATOMIC_RELAXED, __HIP_MEMORY_SCOPE_AGENT
using pg8::cvt_pk_bf16; using pg8::bflo; using pg8::bfhi; using pg8::pack8; using pg8::unpack8; using pg8::sigm;
__device__ __forceinline__ float bf2f(unsigned short b) { return __uint_as_float(((unsigned)b) << 16); }
__device__ __forceinline__ unsigned short f2bf(float f) { return (unsigned short)(cvt_pk_bf16(f, 0.f) & 0xffffu); }
__device__ __forceinline__ int crow(int r, int hi) { return (r & 3) + 8 * (r >> 2) + 4 * hi; }
__device__ __forceinline__ float wave_sum(float v) {
#pragma unroll
    for (int o = 1; o < 64; o <<= 1) v += __shfl_xor(v, o);
    return v;
}
__device__ __forceinline__ s16x4 ldtr(const LAS unsigned char* p) { return __builtin_bit_cast(s16x4, __builtin_amdgcn_ds_read_tr16_b64_v4i16((LAS s16x4*)p)); }
#define MFMA32(a, b, c) __builtin_amdgcn_mfma_f32_32x32x16_bf16((a), (b), (c), 0, 0, 0)

#define XB_TMO      128
#define XB_XCNT(j)  (256  + 64 * (j))
#define XB_XSUB(j)  (1280 + 64 * (j))
#define XB_XGEN(j)  (2304 + 64 * (j))
#define XB_TOP      3328
#define XB_TOPGEN   3392
#define XCD_BAR_WORDS 3456
#define XB_SPIN_CAP (1u << 18)

__device__ __forceinline__ unsigned xb_ld(unsigned* p)              { return __hip_atomic_load(p, __ATOMIC_RELAXED, __HIP_MEMORY_SCOPE_AGENT); }
__device__ __forceinline__ unsigned xb_add(unsigned* p, unsigned v) { return __hip_atomic_fetch_add(p, v, __ATOMIC_RELAXED, __HIP_MEMORY_SCOPE_AGENT); }
__device__ __forceinline__ unsigned xb_xcc_id() { return (unsigned)__builtin_amdgcn_s_getreg((3 << 11) | 20) & 0xFu; }
#define XB_SPIN(cond, bar) do { unsigned _sp = 0; while (cond) { __builtin_amdgcn_s_sleep(1); \
    if ((++_sp & 255u) == 0u) { if (xb_ld(&(bar)[XB_TMO])) break; if (_sp > XB_SPIN_CAP) { atomicAdd(&(bar)[XB_TMO], 1u); break; } } } } while (0)

struct XcdBarrier {
    unsigned* bar; unsigned x;
    volatile LAS unsigned* st;
};

__device__ __forceinline__ XcdBarrier xcd_barrier_post(unsigned* bar, volatile LAS unsigned* st) {
    XcdBarrier b; b.bar = bar; b.x = xb_xcc_id(); b.st = st;
    if (threadIdx.x == 0) (void)xb_add(&bar[XB_XCNT(b.x)], 1u);
    return b;
}
__device__ __forceinline__ void xcd_barrier_complete(unsigned* bar, unsigned x, unsigned& nloc, unsigned& nx) {
    const unsigned G = gridDim.x * gridDim.y * gridDim.z;
    unsigned sum, cnt, mine, sp = 0u;
    for (;;) {
        sum = 0u; cnt = 0u; mine = 0u;
#pragma unroll
        for (unsigned j = 0; j < 16; ++j) { const unsigned c = xb_ld(&bar[XB_XCNT(j)]); sum += c; cnt += (c > 0u) ? 1u : 0u; mine = (j == x) ? c : mine; }
        if (sum == G) break;
        __builtin_amdgcn_s_sleep(1);
        if ((++sp & 255u) == 0u) { if (xb_ld(&bar[XB_TMO])) break; if (sp > XB_SPIN_CAP) { atomicAdd(&bar[XB_TMO], 1u); break; } }
    }
    nloc = mine > 0u ? mine : 1u; nx = cnt > 0u ? cnt : 1u;
}

__device__ __forceinline__ void xcd_barrier(const XcdBarrier& b) {
    asm volatile("s_waitcnt vmcnt(0)" ::: "memory");
    __syncthreads();
    if (threadIdx.x == 0) {
        unsigned* bar = b.bar;
        __builtin_amdgcn_s_waitcnt(0);
        unsigned nloc = b.st[0], nx = b.st[1];
        if (nloc == 0u) { xcd_barrier_complete(bar, b.x, nloc, nx); b.st[0] = nloc; b.st[1] = nx; }
        const unsigned old = xb_add(&bar[XB_XSUB(b.x)], 1u);
        const unsigned gen = old / nloc;
        if (old + 1u == (gen + 1u) * nloc) {
            __builtin_amdgcn_fence(__ATOMIC_RELEASE, "agent");
            asm volatile("s_waitcnt vmcnt(0)" ::: "memory");
            const unsigned og = xb_add(&bar[XB_TOP], 1u);
            const unsigned tg = og / nx;
            if (og + 1u == (tg + 1u) * nx) xb_add(&bar[XB_TOPGEN], 1u);
            else XB_SPIN(xb_ld(&bar[XB_TOPGEN]) == tg, bar);
            __builtin_amdgcn_fence(__ATOMIC_ACQUIRE, "agent");
            xb_add(&bar[XB_XGEN(b.x)], 1u);
            asm volatile("s_waitcnt vmcnt(0)" ::: "memory");
        } else {
            XB_SPIN(xb_ld(&bar[XB_XGEN(b.x)]) == gen, bar);
            __builtin_amdgcn_fence(__ATOMIC_ACQUIRE, "agent");
            asm volatile("s_waitcnt vmcnt(0)" ::: "memory");
        }
    }
    __syncthreads();
}

__device__ __forceinline__ void p0_tr_item(const float* W, int ld, int K, int scol, bf16* WT, int drow, int k0, LAS float* scr, int lane) {
#pragma unroll 8
    for (int i = 0; i < 32; ++i) { const int kk = 2 * i + (lane >> 5); scr[kk * 33 + (lane & 31)] = W[(size_t)(k0 + kk) * ld + scol + (lane & 31)]; }
    asm volatile("s_waitcnt lgkmcnt(0)" ::: "memory");
    const int c = lane & 7;
#pragma unroll
    for (int j = 0; j < 4; ++j) { const int n = (lane >> 3) + 8 * j; const LAS float* s = scr + (8 * c) * 33 + n;
        v4u o; o.x = cvt_pk_bf16(s[0 * 33], s[1 * 33]); o.y = cvt_pk_bf16(s[2 * 33], s[3 * 33]); o.z = cvt_pk_bf16(s[4 * 33], s[5 * 33]); o.w = cvt_pk_bf16(s[6 * 33], s[7 * 33]);
        *(GAS v4u*)(WT + (size_t)(drow + n) * K + k0 + 8 * c) = o; }
    asm volatile("s_waitcnt lgkmcnt(0)" ::: "memory");
}
__device__ __forceinline__ void rms_row_to_bf16(const float* xrow, const float* gain, bf16* orow, int lane) {
    const GAS f32x4* xr = (const GAS f32x4*)xrow + lane; const GAS f32x4* gr = (const GAS f32x4*)gain + lane;
    f32x4 v[4]; float s = 0.f;
#pragma unroll
    for (int j = 0; j < 4; ++j) { v[j] = xr[64 * j]; s += (v[j].x * v[j].x + v[j].y * v[j].y) + (v[j].z * v[j].z + v[j].w * v[j].w); }
    const float rs = rsqrtf(wave_sum(s) * (1.f / D) + 1e-6f);
    GAS v2u* o8 = (GAS v2u*)orow + lane;
#pragma unroll
    for (int j = 0; j < 4; ++j) { const f32x4 g = gr[64 * j]; v2u w; w.x = cvt_pk_bf16(v[j].x * rs * g.x, v[j].y * rs * g.y); w.y = cvt_pk_bf16(v[j].z * rs * g.z, v[j].w * rs * g.w); o8[64 * j] = w; }
}

struct Ptrs {
    const float* in[24]; float* out; unsigned char* ws;
};

__device__ __forceinline__ void p0_prologue(const Ptrs& P, LAS unsigned char* lds, int G, int c, int wave, int lane) {
    LAS float* scr = (LAS float*)(lds + wave * 16384);
    const int gw = c * NWAVES + wave, NGW = G * NWAVES;
    const float* w_in = P.in[3];
    bf16* BTP1 = (bf16*)(P.ws + WS_BTP1);
    constexpr int I_QK = 16 * 96, I_VB = 16 * 144, I_BA = 16, I_Z = 16 * 32, I_A = 8 * 32, I_SQ = 16 * 32, I_PLE = 4 * 32, I_EG = 16 * 16 * 8, I_ED = 16 * 4 * 32;
    constexpr int NITEMS = I_QK + I_VB + I_BA + 3 * I_Z + I_A + 3 * I_SQ + I_PLE + 2 * I_EG + I_ED;
    for (int it = gw; it < NITEMS; it += NGW) {
        int r = it;
        if (r < I_QK) { const int kb = r / 96, nb = r % 96, n0 = 32 * nb, pn = n0 >> 8, w = n0 & 255, wc = w >> 6, bj = (w >> 5) & 1;
            p0_tr_item(w_in, IN_TOTAL, D, n0, BTP1, 256 * pn + 128 * bj + 32 * wc, 64 * kb, scr, lane); continue; } r -= I_QK;
        if (r < I_VB) { const int kb = r / 144, nb = r % 144, n0 = 3072 + 32 * nb; p0_tr_item(w_in, IN_TOTAL, D, n0, BTP1, n0, 64 * kb, scr, lane); continue; } r -= I_VB;
        if (r < I_BA) { p0_tr_item(w_in, IN_TOTAL, D, 8704, BTP1, 7680, 64 * r, scr, lane); continue; } r -= I_BA;
        if (r < I_Z) { const int kb = r / 32, nb = r % 32; p0_tr_item(w_in, IN_TOTAL, D, 7680 + 32 * nb, (bf16*)(P.ws + WS_BTZ), 32 * nb, 64 * kb, scr, lane); continue; } r -= I_Z;
        if (r < I_Z) { const int kb = r / 32, nb = r % 32; p0_tr_item(w_in, IN_TOTAL, D, 8720 + 32 * nb, (bf16*)(P.ws + WS_BTGA), 32 * nb, 64 * kb, scr, lane); continue; } r -= I_Z;
        if (r < I_Z) { const int kb = r / 32, nb = r % 32; p0_tr_item(w_in, IN_TOTAL, D, 9744 + 32 * nb, (bf16*)(P.ws + WS_BTGB), 32 * nb, 64 * kb, scr, lane); continue; } r -= I_Z;
        if (r < I_A) { const int kb = r / 32, nb = r % 32; p0_tr_item(P.in[10], D, 512, 32 * nb, (bf16*)(P.ws + WS_BTA), 32 * nb, 64 * kb, scr, lane); continue; } r -= I_A;
        if (r < I_SQ) { const int kb = r / 32, nb = r % 32; p0_tr_item(P.in[11], D, D, 32 * nb, (bf16*)(P.ws + WS_BTB), 32 * nb, 64 * kb, scr, lane); continue; } r -= I_SQ;
        if (r < I_SQ) { const int kb = r / 32, nb = r % 32; p0_tr_item(P.in[12], D, D, 32 * nb, (bf16*)(P.ws + WS_BTOUT), 32 * nb, 64 * kb, scr, lane); continue; } r -= I_SQ;
        if (r < I_SQ) { const int kb = r / 32, nb = r % 32; p0_tr_item(P.in[23], D, D, 32 * nb, (bf16*)(P.ws + WS_BTPG), 32 * nb, 64 * kb, scr, lane); continue; } r -= I_SQ;
        if (r < I_PLE) { const int kb = r / 32, nb = r % 32; p0_tr_item(P.in[22], D, 256, 32 * nb, (bf16*)(P.ws + WS_BTPLE), 32 * nb, 64 * kb, scr, lane); continue; } r -= I_PLE;
        if (r < I_EG) { const int e = r / 128, q = r % 128, kb = q / 8, nb = q % 8, f0 = 32 * nb;
            p0_tr_item(P.in[18] + (size_t)e * 1024 * 256, 256, D, f0, (bf16*)(P.ws + WS_BTGU) + (size_t)e * 512 * 1024, 256 * (f0 >> 7) + (f0 & 127), 64 * kb, scr, lane); continue; } r -= I_EG;
        if (r < I_EG) { const int e = r / 128, q = r % 128, kb = q / 8, nb = q % 8, f0 = 32 * nb;
            p0_tr_item(P.in[19] + (size_t)e * 1024 * 256, 256, D, f0, (bf16*)(P.ws + WS_BTGU) + (size_t)e * 512 * 1024, 256 * (f0 >> 7) + 128 + (f0 & 127), 64 * kb, scr, lane); continue; } r -= I_EG;
        { const int e = r / 128, q = r % 128, kb = q / 32, nb = q % 32;
            p0_tr_item(P.in[20] + (size_t)e * 256 * 1024, D, 256, 32 * nb, (bf16*)(P.ws + WS_BTDN) + (size_t)e * 1024 * 256, 32 * nb, 64 * kb, scr, lane); }
    }
    { GAS v4u* z = (GAS v4u*)(BTP1 + (size_t)7712 * D); const int nz = 224 * D / 8; for (int i = gw * 64 + lane; i < nz; i += NGW * 64) z[i] = (v4u){0u, 0u, 0u, 0u}; }
    bf16* H = (bf16*)((unsigned char*)P.out + DO_H);
    for (int m = gw; m < T; m += NGW) rms_row_to_bf16(P.in[0] + (size_t)m * D, P.in[2], H + (size_t)m * D, lane);
}

__device__ __forceinline__ void attn_phase(LAS unsigned char* lds, const bf16* QA, bf16* OG, float* LSE, int G, int c) {
    int tid_ = threadIdx.x; asm volatile("" : "+v"(tid_));
    const int tid = tid_, lane = tid & 63, wid = __builtin_amdgcn_readfirstlane(tid >> 6), l32 = lane & 31, hi = lane >> 5;
    LAS unsigned char* KS = lds; LAS unsigned char* VS = lds + 55296;
    for (int u = c; u < 6144; u += G) {
        const int b = u / 768; int rem = u % 768; int g, h, r, pr;
        if (rem < 256) { g = 0; h = rem >> 5; r = 0; pr = rem & 31; }
        else if (rem < 512) { rem -= 256; g = 1; h = rem >> 5; r = (rem & 31) >> 3; pr = rem & 7; }
        else { rem -= 512; g = 2; h = rem >> 5; r = (rem & 31) >> 1; pr = rem & 1; }
        const int dil = 1 << (2 * g);
        const size_t rowb = (size_t)b * SEQ;
        const bf16* Qg = QA + g * 512 + h * 64;
        __syncthreads();
#pragma unroll
        for (int k = 0; k < 6; ++k) {
            const int ci = tid + 512 * k, j = ci >> 3, ch = ci & 7, sidx = 256 * pr - 128 + j;
            v4u kv = (v4u){0u, 0u, 0u, 0u}, vv = (v4u){0u, 0u, 0u, 0u};
            if (sidx >= 0) { const bf16* p = Qg + (rowb + (size_t)(sidx * dil + r)) * pg8::QAP + ch * 8; kv = *(const GAS v4u*)(p + 1536); vv = *(const GAS v4u*)(p + 3072); }
            *(LAS v4u*)(KS + j * 144 + ch * 16) = kv; *(LAS v4u*)(VS + j * 144 + ch * 16) = vv;
        }
        const int qi = 32 * wid + l32; const size_t mq = rowb + (size_t)((256 * pr + qi) * dil + r);
        bf16x8 qf[4];
#pragma unroll
        for (int ks = 0; ks < 4; ++ks) qf[ks] = *(const GAS bf16x8*)(Qg + mq * pg8::QAP + 16 * ks + 8 * hi);
        __syncthreads();
        f32x16 sc[5];
#pragma unroll
        for (int kb = 0; kb < 5; ++kb) {
            const int jb = 32 * wid + 32 * kb; f32x16 a = {};
#pragma unroll
            for (int ks = 0; ks < 4; ++ks) { const bf16x8 kf = *(const LAS bf16x8*)(KS + (jb + l32) * 144 + (16 * ks + 8 * hi) * 2); a = MFMA32(kf, qf[ks], a); }
            sc[kb] = a;
        }
        const float NEG = -1e30f;
#pragma unroll
        for (int rr = 0; rr < 16; ++rr) { const int cc = crow(rr, hi); if (cc < l32) sc[0][rr] = NEG; if (cc > l32) sc[4][rr] = NEG; }
        if (pr == 0) {
#pragma unroll
            for (int kb = 0; kb < 4; ++kb) if (wid + kb < 4) {
#pragma unroll
                for (int rr = 0; rr < 16; ++rr) sc[kb][rr] = NEG; }
        }
        float mx = NEG;
#pragma unroll
        for (int kb = 0; kb < 5; ++kb)
#pragma unroll
            for (int rr = 0; rr < 16; ++rr) mx = fmaxf(mx, sc[kb][rr]);
        mx = fmaxf(mx, __shfl_xor(mx, 32));
        float l = 0.f;
#pragma unroll
        for (int kb = 0; kb < 5; ++kb)
#pragma unroll
            for (int rr = 0; rr < 16; ++rr) { const float p = __builtin_amdgcn_exp2f(sc[kb][rr] - mx); sc[kb][rr] = p; l += p; }
        l += __shfl_xor(l, 32);
        f32x16 o[2]; o[0] = f32x16{}; o[1] = f32x16{};
        const int traddr = ((lane & 15) >> 2) * 144 + (16 * ((lane >> 4) & 1) + 4 * (lane & 3)) * 2;
#pragma unroll
        for (int kb = 0; kb < 5; ++kb)
#pragma unroll
            for (int ks2 = 0; ks2 < 2; ++ks2) {
                v4u pw; pw.x = cvt_pk_bf16(sc[kb][8 * ks2 + 0], sc[kb][8 * ks2 + 1]); pw.y = cvt_pk_bf16(sc[kb][8 * ks2 + 2], sc[kb][8 * ks2 + 3]);
                pw.z = cvt_pk_bf16(sc[kb][8 * ks2 + 4], sc[kb][8 * ks2 + 5]); pw.w = cvt_pk_bf16(sc[kb][8 * ks2 + 6], sc[kb][8 * ks2 + 7]);
                const bf16x8 pf = __builtin_bit_cast(bf16x8, pw);
                const int kv0 = 32 * wid + 32 * kb + 16 * ks2 + 4 * hi;
#pragma unroll
                for (int db = 0; db < 2; ++db) {
                    const LAS unsigned char* vp = VS + kv0 * 144 + traddr + db * 64;
                    const s16x4 lo = ldtr(vp), h4 = ldtr(vp + 8 * 144);
                    const bf16x8 vf = (bf16x8){lo[0], lo[1], lo[2], lo[3], h4[0], h4[1], h4[2], h4[3]};
                    o[db] = MFMA32(vf, pf, o[db]);
                }
            }
        const float inv = 1.0f / l;
        bf16* orow = OG + mq * 1536 + g * 512 + h * 64;
#pragma unroll
        for (int db = 0; db < 2; ++db)
#pragma unroll
            for (int rq = 0; rq < 4; ++rq) { v2u w; w.x = cvt_pk_bf16(o[db][4 * rq] * inv, o[db][4 * rq + 1] * inv); w.y = cvt_pk_bf16(o[db][4 * rq + 2] * inv, o[db][4 * rq + 3] * inv);
                *(GAS v2u*)(orow + 32 * db + 8 * rq + 4 * hi) = w; }
        if (hi == 0) LSE[mq * 24 + g * 8 + h] = mx + __builtin_amdgcn_logf(l);
    }
}

__device__ __forceinline__ void prep_phase(LAS unsigned char* lds, const bf16* QB, const float* BG, const float* conv_w, unsigned char* DNP, float* DLB, int G, int c) {
    const int tid0 = threadIdx.x, wid = __builtin_amdgcn_readfirstlane(tid0 >> 6);
    LAS unsigned char* QS = lds; LAS unsigned char* KS = lds + 17408; LAS unsigned char* VS = lds + 34816;
    LAS float* AS = (LAS float*)(lds + 52224); LAS unsigned char* TS = lds + 68608;
#ifdef DBG_PREPCHK
    unsigned* DBGW = (unsigned*)(DNP - WS_DNP + 1022 * MiB + 512 * 1024);
#endif
    LAS float* gcT = (LAS float*)(lds + 77824); LAS float* btT = (LAS float*)(lds + 78080); LAS float* cwT = (LAS float*)(lds + 78336);
    for (int u = c; u < 8192; u += G) {
        int tid = tid0; asm volatile("" : "+v"(tid));
        const int lane = tid & 63, l32 = lane & 31, hi = lane >> 5;
        const int bh = u >> 7, n = u & 127, b = bh >> 3, h = bh & 7; const size_t m0 = (size_t)b * SEQ + 64 * n;
        unsigned char* rec = DNP + (size_t)u * DNU;
        __syncthreads();
        if (wid == 0) {
            float gv = BG[(m0 + lane) * 16 + 8 + h]; const float bv = BG[(m0 + lane) * 16 + h];
#pragma unroll
            for (int o = 1; o < 64; o <<= 1) { const float t = __shfl_up(gv, o); if (lane >= o) gv += t; }
            gcT[lane] = gv; btT[lane] = bv; if (lane == 63) DLB[u] = __expf(gv);
        }
        if (tid >= 64 && tid < 64 + 384) { const int t = tid - 64;
#pragma unroll
            for (int j = 0; j < 4; ++j) cwT[j * 384 + t] = conv_w[j * 3072 + (t >> 7) * 1024 + h * 128 + (t & 127)]; }
        __syncthreads();
#pragma unroll 1
        for (int it = 0; it < 6; ++it) {
            const int item = tid + 512 * it, ten = item >> 10, i = (item & 1023) >> 4, cg = item & 15;
            const bf16* src = QB + ten * 1024 + h * 128 + cg * 8;
            f32x4 y0 = {0.f, 0.f, 0.f, 0.f}, y1 = {0.f, 0.f, 0.f, 0.f};
#pragma unroll
            for (int j = 0; j < 4; ++j) { const int tt = 64 * n + i - 3 + j;
                if (tt >= 0) { const v4u raw = *(const GAS v4u*)(src + ((size_t)b * SEQ + tt) * pg8::QBP); f32x4 a, bb; unpack8(raw, a, bb);
                    const f32x4 w0 = *(const LAS f32x4*)(cwT + j * 384 + ten * 128 + cg * 8), w1 = *(const LAS f32x4*)(cwT + j * 384 + ten * 128 + cg * 8 + 4); y0 += a * w0; y1 += bb * w1; } }
#pragma unroll
            for (int e = 0; e < 4; ++e) { y0[e] = y0[e] * sigm(y0[e]); y1[e] = y1[e] * sigm(y1[e]); }
            float scl;
            if (ten < 2) { float ss = (y0[0] * y0[0] + y0[1] * y0[1]) + (y0[2] * y0[2] + y0[3] * y0[3]) + (y1[0] * y1[0] + y1[1] * y1[1]) + (y1[2] * y1[2] + y1[3] * y1[3]);
                ss += __shfl_xor(ss, 1); ss += __shfl_xor(ss, 2); ss += __shfl_xor(ss, 4); ss += __shfl_xor(ss, 8);
                scl = rsqrtf(ss + 1e-6f) * (ten == 0 ? 0.08838834764831845f : 1.0f); }
            else scl = btT[i];
            LAS unsigned char* dst = (ten == 0 ? QS : (ten == 1 ? KS : VS)) + i * 272 + cg * 16;
            *(LAS v4u*)dst = pack8(y0 * scl, y1 * scl);
        }
        __syncthreads();
        if (wid < 6) {
            const int kind = wid / 3, pi = wid % 3, ib = pi ? 1 : 0, jb = (pi == 2) ? 1 : 0;
            f32x16 a = {};
            if (kind == 0) {
#pragma unroll
                for (int ks = 0; ks < 8; ++ks) { const bf16x8 af = *(const LAS bf16x8*)(KS + (32 * ib + l32) * 272 + (16 * ks + 8 * hi) * 2), bf = *(const LAS bf16x8*)(KS + (32 * jb + l32) * 272 + (16 * ks + 8 * hi) * 2); a = MFMA32(af, bf, a); }
                const int j = 32 * jb + l32; const float gj = gcT[j];
#pragma unroll
                for (int rr = 0; rr < 16; ++rr) { const int i = 32 * ib + crow(rr, hi); const float v = (j < i) ? btT[i] * a[rr] * __expf(gcT[i] - gj) : 0.f; AS[i * 64 + j] = v; }
            } else {
#pragma unroll
                for (int ks = 0; ks < 8; ++ks) { const bf16x8 af = *(const LAS bf16x8*)(KS + (32 * jb + l32) * 272 + (16 * ks + 8 * hi) * 2), bf = *(const LAS bf16x8*)(QS + (32 * ib + l32) * 272 + (16 * ks + 8 * hi) * 2); a = MFMA32(af, bf, a); }
                const int i = 32 * ib + l32; const float gi = gcT[i];
#pragma unroll
                for (int rr = 0; rr < 16; ++rr) { const int j = 32 * jb + crow(rr, hi); a[rr] = (j <= i) ? a[rr] * __expf(gi - gcT[j]) : 0.f; }
#pragma unroll
                for (int ks2 = 0; ks2 < 2; ++ks2) { v4u w; w.x = cvt_pk_bf16(a[8 * ks2], a[8 * ks2 + 1]); w.y = cvt_pk_bf16(a[8 * ks2 + 2], a[8 * ks2 + 3]); w.z = cvt_pk_bf16(a[8 * ks2 + 4], a[8 * ks2 + 5]); w.w = cvt_pk_bf16(a[8 * ks2 + 6], a[8 * ks2 + 7]);
                    *(GAS v4u*)(rec + 49152 + ((ib * 4 + 2 * jb + ks2) * 64 + lane) * 16) = w; }
            }
        }
        __syncthreads();
        if (wid == 0) {
            float x[64]; const float flane = (float)lane;
#pragma unroll
            for (int i = 0; i < 64; ++i) {
                float a0 = fmaxf(0.f, 1.f - fabsf(flane - (float)i)), a1 = 0.f, a2 = 0.f, a3 = 0.f;
#pragma unroll
                for (int j4 = 0; j4 < (i + 3) / 4; ++j4) { const f32x4 av = *(const LAS f32x4*)(AS + i * 64 + 4 * j4);
                    if (4 * j4 + 0 < i) a0 -= av[0] * x[4 * j4 + 0]; if (4 * j4 + 1 < i) a1 -= av[1] * x[4 * j4 + 1];
                    if (4 * j4 + 2 < i) a2 -= av[2] * x[4 * j4 + 2]; if (4 * j4 + 3 < i) a3 -= av[3] * x[4 * j4 + 3]; }
                x[i] = (a0 + a1) + (a2 + a3);
            }
#pragma unroll
            for (int i = 0; i < 64; ++i) *(LAS unsigned short*)(TS + i * 144 + lane * 2) = f2bf(x[i]);
#ifdef DBG_TMAX
            { float tm = 0.f, am = 0.f;
#pragma unroll
              for (int i = 0; i < 64; ++i) tm = fmaxf(tm, fabsf(x[i]));
              for (int i = 1; i < 64; ++i) if (lane < i) am = fmaxf(am, fabsf(AS[i * 64 + lane]));
              for (int o = 1; o < 64; o <<= 1) { tm = fmaxf(tm, __shfl_xor(tm, o)); am = fmaxf(am, __shfl_xor(am, o)); }
              bool tnan = false, anan = false;
#pragma unroll
              for (int i = 0; i < 64; ++i) if (!(x[i] - x[i] == 0.f)) tnan = true;
              for (int i = 1; i < 64; ++i) if (lane < i) { const float v = AS[i * 64 + lane]; if (!(v - v == 0.f)) anan = true; }
              const int tn = __any(tnan), an = __any(anan);
              if (lane == 0) { float* dbg = (float*)(rec + 49152 + 2048); dbg[0] = tm; dbg[1] = am; dbg[2] = tn ? 1.f : 0.f; dbg[3] = an ? 1.f : 0.f; } }
#endif
        } else {
            const float glast = gcT[63];
            for (int f = wid - 1; f < 32; f += 7) {
                if (f < 16) { const int ib = f >> 3, ks = f & 7, i = 32 * ib + l32; const float eg = __expf(gcT[i]);
                    const v2u lo = *(const LAS v2u*)(QS + i * 272 + (16 * ks + 4 * hi) * 2), h2 = *(const LAS v2u*)(QS + i * 272 + (16 * ks + 8 + 4 * hi) * 2);
                    v4u w; w.x = cvt_pk_bf16(bflo(lo.x) * eg, bfhi(lo.x) * eg); w.y = cvt_pk_bf16(bflo(lo.y) * eg, bfhi(lo.y) * eg); w.z = cvt_pk_bf16(bflo(h2.x) * eg, bfhi(h2.x) * eg); w.w = cvt_pk_bf16(bflo(h2.y) * eg, bfhi(h2.y) * eg);
                    *(GAS v4u*)(rec + 16384 + ((ib * 8 + ks) * 64 + lane) * 16) = w;
                } else { const int dkb = (f - 16) >> 2, ksj = (f - 16) & 3, dk = 32 * dkb + l32; float v[8];
#pragma unroll
                    for (int jj = 0; jj < 8; ++jj) { const int j = 16 * ksj + 4 * hi + (jj & 3) + 8 * (jj >> 2); v[jj] = bf2f(*(const LAS unsigned short*)(KS + j * 272 + dk * 2)) * __expf(glast - gcT[j]); }
                    v4u w; w.x = cvt_pk_bf16(v[0], v[1]); w.y = cvt_pk_bf16(v[2], v[3]); w.z = cvt_pk_bf16(v[4], v[5]); w.w = cvt_pk_bf16(v[6], v[7]);
                    *(GAS v4u*)(rec + 32768 + ((dkb * 4 + ksj) * 64 + lane) * 16) = w; }
            }
        }
        __syncthreads();
        {
            const int eb = wid & 3, ib = wid >> 2; f32x16 a = {};
            for (int ks = 0; ks < (ib ? 4 : 2); ++ks) {
                const bf16x8 tf = *(const LAS bf16x8*)(TS + (32 * ib + l32) * 144 + (16 * ks + 8 * hi) * 2);
                bf16x8 vf;
#pragma unroll
                for (int jj = 0; jj < 8; ++jj) vf[jj] = (short)*(const LAS unsigned short*)(VS + (16 * ks + 8 * hi + jj) * 272 + (32 * eb + l32) * 2);
                a = MFMA32(tf, vf, a);
#ifdef DBG_PREPCHK
                { bool b0 = false, b1 = false; for (int jj = 0; jj < 8; ++jj) { if ((((unsigned short)tf[jj]) & 0x7f80u) == 0x7f80u) b0 = true; if ((((unsigned short)vf[jj]) & 0x7f80u) == 0x7f80u) b1 = true; }
                  if (b0 || b1) atomicAnd(DBGW, ~1u); }
#endif
            }
#ifdef DBG_PREPCHK
            { bool b2 = false; for (int r = 0; r < 16; ++r) if (!(a[r] - a[r] == 0.f)) b2 = true; if (b2) atomicAnd(DBGW, ~4u); }
#endif
            v4u w0, w1; w0.x = cvt_pk_bf16(a[0], a[1]); w0.y = cvt_pk_bf16(a[2], a[3]); w0.z = cvt_pk_bf16(a[4], a[5]); w0.w = cvt_pk_bf16(a[6], a[7]);
            w1.x = cvt_pk_bf16(a[8], a[9]); w1.y = cvt_pk_bf16(a[10], a[11]); w1.z = cvt_pk_bf16(a[12], a[13]); w1.w = cvt_pk_bf16(a[14], a[15]);
            GAS v4u* up = (GAS v4u*)(rec + 57344 + ((eb * 2 + ib) * 64 + lane) * 32); up[0] = w0; up[1] = w1;
#ifdef DBG_PREPCHK
            { bool bb = false; const unsigned ww[8] = {w0.x, w0.y, w0.z, w0.w, w1.x, w1.y, w1.z, w1.w}; for (int k = 0; k < 8; ++k) if ((ww[k] & 0x7f80u) == 0x7f80u || (ww[k] & 0x7f800000u) == 0x7f800000u) bb = true;
              if (bb) atomicAnd(DBGW, ~2u); if (u == 5 && tid == 0) atomicAnd(DBGW, ~8u); }
#endif
        }
        __syncthreads();
        { const int i = tid >> 3, c8 = tid & 7; const float s = btT[i] * __expf(gcT[i]);
#pragma unroll
            for (int q = 0; q < 2; ++q) { const v4u kw = *(const LAS v4u*)(KS + i * 272 + c8 * 32 + q * 16); f32x4 a, bb; unpack8(kw, a, bb); *(LAS v4u*)(VS + i * 272 + c8 * 32 + q * 16) = pack8(a * s, bb * s); } }
        __syncthreads();
        {
            const int dkb = wid & 3, ib = wid >> 2; f32x16 a = {};
            for (int ks = 0; ks < (ib ? 4 : 2); ++ks) {
                bf16x8 kf;
#pragma unroll
                for (int jj = 0; jj < 8; ++jj) kf[jj] = (short)*(const LAS unsigned short*)(VS + (16 * ks + 8 * hi + jj) * 272 + (32 * dkb + l32) * 2);
                const bf16x8 tf = *(const LAS bf16x8*)(TS + (32 * ib + l32) * 144 + (16 * ks + 8 * hi) * 2);
                a = MFMA32(kf, tf, a);
#ifdef DBG_PREPCHK
                { bool b3 = false; for (int jj = 0; jj < 8; ++jj) if ((((unsigned short)kf[jj]) & 0x7f80u) == 0x7f80u) b3 = true; if (b3) atomicAnd(DBGW, ~1u); }
#endif
            }
#ifdef DBG_PREPCHK
            { bool b4 = false; for (int r = 0; r < 16; ++r) if (!(a[r] - a[r] == 0.f)) b4 = true; if (b4) atomicAnd(DBGW, ~16u); }
#endif
#pragma unroll
            for (int ks2 = 0; ks2 < 2; ++ks2) { v4u w; w.x = cvt_pk_bf16(a[8 * ks2], a[8 * ks2 + 1]); w.y = cvt_pk_bf16(a[8 * ks2 + 2], a[8 * ks2 + 3]); w.z = cvt_pk_bf16(a[8 * ks2 + 4], a[8 * ks2 + 5]); w.w = cvt_pk_bf16(a[8 * ks2 + 6], a[8 * ks2 + 7]);
                *(GAS v4u*)(rec + ((ib * 8 + 2 * dkb + ks2) * 64 + lane) * 16) = w; }
        }
    }
}

__device__ __forceinline__ void scan_chain(LAS unsigned char* lds, const unsigned char* DNP, const float* DLB, bf16* ON, const float* dn_gain, int bh) {
    int tid_ = threadIdx.x; asm volatile("" : "+v"(tid_));
    const int tid = tid_, lane = tid & 63, wid = __builtin_amdgcn_readfirstlane(tid >> 6), l32 = lane & 31, hi = lane >> 5;
    LAS unsigned char* OT = lds + 114688; LAS float* GT = (LAS float*)(lds + 132096);
    const int b = bh >> 3, h = bh & 7; const size_t u0 = (size_t)bh * 128;
    __syncthreads();
    if (tid < 128) GT[tid] = dn_gain[tid];
    const int lt = tid - 256;
    if (wid >= 4) { const GAS v4u* src = (const GAS v4u*)(DNP + u0 * DNU);
#pragma unroll
        for (int k = 0; k < 14; ++k) *(LAS v4u*)(lds + (lt + 256 * k) * 16) = src[lt + 256 * k]; }
    f32x16 S[4]; S[0] = f32x16{}; S[1] = f32x16{}; S[2] = f32x16{}; S[3] = f32x16{};
    __syncthreads();
#pragma unroll 1
    for (int n = 0; n < 128; ++n) {
        const LAS unsigned char* Pb = lds + (n & 1) * 57344;
        f32x16 O0 = {}, O1 = {};
        if (wid < 4) {
            v4u uc[4]; float dl;
            { const GAS v4u* up = (const GAS v4u*)(DNP + (u0 + n) * DNU + 57344 + (wid * 2 * 64 + lane) * 32);
              uc[0] = up[0]; uc[1] = up[1]; uc[2] = up[128]; uc[3] = up[129]; dl = DLB[u0 + n]; }
            bf16x8 vb[4];
            {
                f32x16 W0 = {}, W1 = {};
#pragma unroll
                for (int ks = 0; ks < 8; ++ks) {
                    const int dkb = ks >> 1, o8 = 8 * (ks & 1);
                    v4u sw; sw.x = cvt_pk_bf16(S[dkb][o8 + 0], S[dkb][o8 + 1]); sw.y = cvt_pk_bf16(S[dkb][o8 + 2], S[dkb][o8 + 3]); sw.z = cvt_pk_bf16(S[dkb][o8 + 4], S[dkb][o8 + 5]); sw.w = cvt_pk_bf16(S[dkb][o8 + 6], S[dkb][o8 + 7]);
                    const bf16x8 sb = __builtin_bit_cast(bf16x8, sw);
                    const bf16x8 w0 = *(const LAS bf16x8*)(Pb + ((0 * 8 + ks) * 64 + lane) * 16), w1 = *(const LAS bf16x8*)(Pb + ((1 * 8 + ks) * 64 + lane) * 16);
                    W0 = MFMA32(w0, sb, W0); W1 = MFMA32(w1, sb, W1);
                    __builtin_amdgcn_sched_barrier(0);
                }
                float v[16];
#pragma unroll
                for (int q = 0; q < 2; ++q) { const v4u w = uc[q];
                    v[8 * q + 0] = bflo(w.x); v[8 * q + 1] = bfhi(w.x); v[8 * q + 2] = bflo(w.y); v[8 * q + 3] = bfhi(w.y); v[8 * q + 4] = bflo(w.z); v[8 * q + 5] = bfhi(w.z); v[8 * q + 6] = bflo(w.w); v[8 * q + 7] = bfhi(w.w); }
#pragma unroll
                for (int r = 0; r < 16; ++r) v[r] -= W0[r];
#pragma unroll
                for (int ks2 = 0; ks2 < 2; ++ks2) { v4u w; w.x = cvt_pk_bf16(v[8 * ks2], v[8 * ks2 + 1]); w.y = cvt_pk_bf16(v[8 * ks2 + 2], v[8 * ks2 + 3]); w.z = cvt_pk_bf16(v[8 * ks2 + 4], v[8 * ks2 + 5]); w.w = cvt_pk_bf16(v[8 * ks2 + 6], v[8 * ks2 + 7]); vb[ks2] = __builtin_bit_cast(bf16x8, w); }
#pragma unroll
                for (int q = 0; q < 2; ++q) { const v4u w = uc[2 + q];
                    v[8 * q + 0] = bflo(w.x); v[8 * q + 1] = bfhi(w.x); v[8 * q + 2] = bflo(w.y); v[8 * q + 3] = bfhi(w.y); v[8 * q + 4] = bflo(w.z); v[8 * q + 5] = bfhi(w.z); v[8 * q + 6] = bflo(w.w); v[8 * q + 7] = bfhi(w.w); }
#pragma unroll
                for (int r = 0; r < 16; ++r) v[r] -= W1[r];
#pragma unroll
                for (int ks2 = 0; ks2 < 2; ++ks2) { v4u w; w.x = cvt_pk_bf16(v[8 * ks2], v[8 * ks2 + 1]); w.y = cvt_pk_bf16(v[8 * ks2 + 2], v[8 * ks2 + 3]); w.z = cvt_pk_bf16(v[8 * ks2 + 4], v[8 * ks2 + 5]); w.w = cvt_pk_bf16(v[8 * ks2 + 6], v[8 * ks2 + 7]); vb[2 + ks2] = __builtin_bit_cast(bf16x8, w); }
            }
            __builtin_amdgcn_sched_barrier(0);
#pragma unroll
            for (int ks = 0; ks < 8; ++ks) {
                const int dkb = ks >> 1, o8 = 8 * (ks & 1);
                v4u sw; sw.x = cvt_pk_bf16(S[dkb][o8 + 0], S[dkb][o8 + 1]); sw.y = cvt_pk_bf16(S[dkb][o8 + 2], S[dkb][o8 + 3]); sw.z = cvt_pk_bf16(S[dkb][o8 + 4], S[dkb][o8 + 5]); sw.w = cvt_pk_bf16(S[dkb][o8 + 6], S[dkb][o8 + 7]);
                const bf16x8 sb = __builtin_bit_cast(bf16x8, sw);
                const bf16x8 q0 = *(const LAS bf16x8*)(Pb + 16384 + ((0 * 8 + ks) * 64 + lane) * 16), q1 = *(const LAS bf16x8*)(Pb + 16384 + ((1 * 8 + ks) * 64 + lane) * 16);
                O0 = MFMA32(q0, sb, O0); O1 = MFMA32(q1, sb, O1);
                __builtin_amdgcn_sched_barrier(0);
            }
#pragma unroll
            for (int ksj = 0; ksj < 2; ++ksj) { const bf16x8 af = *(const LAS bf16x8*)(Pb + 49152 + ((0 * 4 + ksj) * 64 + lane) * 16); O0 = MFMA32(af, vb[ksj], O0); }
#pragma unroll
            for (int ksj = 0; ksj < 4; ++ksj) { const bf16x8 af = *(const LAS bf16x8*)(Pb + 49152 + ((1 * 4 + ksj) * 64 + lane) * 16); O1 = MFMA32(af, vb[ksj], O1); }
#pragma unroll
            for (int dkb = 0; dkb < 4; ++dkb) {
#pragma unroll
                for (int r = 0; r < 16; ++r) S[dkb][r] *= dl;
#pragma unroll
                for (int ksj = 0; ksj < 4; ++ksj) { const bf16x8 kf = *(const LAS bf16x8*)(Pb + 32768 + ((dkb * 4 + ksj) * 64 + lane) * 16); S[dkb] = MFMA32(kf, vb[ksj], S[dkb]); }
            }
        } else {
            if (n > 0) {
                const int i = lt >> 2, qd = lt & 3; f32x4 v[8]; float ss = 0.f;
#pragma unroll
                for (int k = 0; k < 4; ++k) { const v4u w = *(const LAS v4u*)(OT + i * 272 + qd * 64 + k * 16); unpack8(w, v[2 * k], v[2 * k + 1]); }
#pragma unroll
                for (int k = 0; k < 8; ++k) ss += (v[k][0] * v[k][0] + v[k][1] * v[k][1]) + (v[k][2] * v[k][2] + v[k][3] * v[k][3]);
                ss += __shfl_xor(ss, 1); ss += __shfl_xor(ss, 2);
                const float rs = rsqrtf(ss * (1.0f / 128.0f) + 1e-6f);
                bf16* dst = ON + ((size_t)b * SEQ + 64 * (n - 1) + i) * 1024 + h * 128 + qd * 32;
#pragma unroll
                for (int k = 0; k < 4; ++k) { const f32x4 g0 = *(const LAS f32x4*)(GT + qd * 32 + 8 * k), g1 = *(const LAS f32x4*)(GT + qd * 32 + 8 * k + 4); *(GAS v4u*)(dst + 8 * k) = pack8(v[2 * k] * rs * g0, v[2 * k + 1] * rs * g1); }
            }
            if (n + 1 < 128) { const GAS v4u* src = (const GAS v4u*)(DNP + (u0 + n + 1) * DNU); LAS unsigned char* Pn = lds + ((n + 1) & 1) * 57344;
#pragma unroll
                for (int k = 0; k < 14; ++k) *(LAS v4u*)(Pn + (lt + 256 * k) * 16) = src[lt + 256 * k]; }
        }
        __syncthreads();
        if (wid < 4) {
#pragma unroll
            for (int r = 0; r < 16; ++r) { *(LAS unsigned short*)(OT + (crow(r, hi)) * 272 + (32 * wid + l32) * 2) = f2bf(O0[r]); *(LAS unsigned short*)(OT + (32 + crow(r, hi)) * 272 + (32 * wid + l32) * 2) = f2bf(O1[r]); }
        }
        __syncthreads();
    }
    if (wid >= 4) {
        const int i = lt >> 2, qd = lt & 3; f32x4 v[8]; float ss = 0.f;
#pragma unroll
        for (int k = 0; k < 4; ++k) { const v4u w = *(const LAS v4u*)(OT + i * 272 + qd * 64 + k * 16); unpack8(w, v[2 * k], v[2 * k + 1]); }
#pragma unroll
        for (int k = 0; k < 8; ++k) ss += (v[k][0] * v[k][0] + v[k][1] * v[k][1]) + (v[k][2] * v[k][2] + v[k][3] * v[k][3]);
        ss += __shfl_xor(ss, 1); ss += __shfl_xor(ss, 2);
        const float rs = rsqrtf(ss * (1.0f / 128.0f) + 1e-6f);
        bf16* dst = ON + ((size_t)b * SEQ + 64 * 127 + i) * 1024 + h * 128 + qd * 32;
#pragma unroll
        for (int k = 0; k < 4; ++k) { const f32x4 g0 = *(const LAS f32x4*)(GT + qd * 32 + 8 * k), g1 = *(const LAS f32x4*)(GT + qd * 32 + 8 * k + 4); *(GAS v4u*)(dst + 8 * k) = pack8(v[2 * k] * rs * g0, v[2 * k + 1] * rs * g1); }
    }
}
__device__ __forceinline__ void combine_rows(const Ptrs& P, int first, int stride, int lane) {
    const bf16* OG = (const bf16*)((const unsigned char*)P.out + DO_OG); const float* LSE = (const float*)((const unsigned char*)P.out + DO_LSE);
    bf16* OA = (bf16*)(P.ws + WS_OA); bf16* HR = (bf16*)(P.ws + WS_HR);
    for (int m = first; m < T; m += stride) {
        const int hd = lane >> 3; const float l0 = LSE[(size_t)m * 24 + hd], l1 = LSE[(size_t)m * 24 + 8 + hd], l2 = LSE[(size_t)m * 24 + 16 + hd];
        const float mx = fmaxf(l0, fmaxf(l1, l2)); float w0 = __builtin_amdgcn_exp2f(l0 - mx), w1 = __builtin_amdgcn_exp2f(l1 - mx), w2 = __builtin_amdgcn_exp2f(l2 - mx);
        const float inv = 1.0f / (w0 + w1 + w2); w0 *= inv; w1 *= inv; w2 *= inv;
        const bf16* og = OG + (size_t)m * 1536 + lane * 8;
        f32x4 a0, b0, a1, b1, a2, b2; unpack8(*(const GAS v4u*)og, a0, b0); unpack8(*(const GAS v4u*)(og + 512), a1, b1); unpack8(*(const GAS v4u*)(og + 1024), a2, b2);
        *(GAS v4u*)(OA + (size_t)m * 512 + lane * 8) = pack8(a0 * w0 + a1 * w1 + a2 * w2, b0 * w0 + b1 * w1 + b2 * w2);
        rms_row_to_bf16(P.in[0] + (size_t)m * D, P.in[2], HR + (size_t)m * D, lane);
    }
}

__device__ __forceinline__ void router_phase(const Ptrs& P, LAS unsigned char* lds, int G, int c, int wave, int lane) {
    LAS float* WrT = (LAS float*)lds;
    const float* x1 = P.out; bf16* H2 = (bf16*)(P.ws + WS_H2); int4* TOK = (int4*)(P.ws + WS_TOK); unsigned* cnt = (unsigned*)(P.ws + WS_CTL) + CW_CNT;
    __syncthreads();
    for (int i = threadIdx.x; i < 1024 * 4; i += 512) { const int k = i >> 2, cc = i & 3; WrT[cc * 1024 + k] = P.in[14][i]; }
    for (int i = threadIdx.x; i < 1024 * 16; i += 512) { const int k = i >> 4, cc = i & 15; WrT[(4 + cc) * 1024 + k] = P.in[16][i]; }
    __syncthreads();
    const GAS f32x4* gr = (const GAS f32x4*)P.in[13] + lane; f32x4 gn[4];
#pragma unroll
    for (int j = 0; j < 4; ++j) gn[j] = gr[64 * j];
    float bias[20];
#pragma unroll
    for (int q = 0; q < 4; ++q) bias[q] = P.in[15][q];
#pragma unroll
    for (int q = 0; q < 16; ++q) bias[4 + q] = P.in[17][q];
    unsigned mycnt = 0;
    const int gw = c * NWAVES + wave, NGW = G * NWAVES;
    for (int m = gw; m < T; m += NGW) {
        asm volatile("" ::: "memory");
        const GAS f32x4* xr = (const GAS f32x4*)(x1 + (size_t)m * D) + lane; f32x4 v[4]; float s = 0.f;
#pragma unroll
        for (int j = 0; j < 4; ++j) { v[j] = xr[64 * j]; s += (v[j].x * v[j].x + v[j].y * v[j].y) + (v[j].z * v[j].z + v[j].w * v[j].w); }
        const float rs = rsqrtf(wave_sum(s) * (1.f / D) + 1e-6f);
        GAS v2u* o8 = (GAS v2u*)(H2 + (size_t)m * D) + lane;
#pragma unroll
        for (int j = 0; j < 4; ++j) { v[j] = v[j] * rs * gn[j]; v2u w; w.x = cvt_pk_bf16(v[j].x, v[j].y); w.y = cvt_pk_bf16(v[j].z, v[j].w); o8[64 * j] = w; }
        float lg[20];
#pragma unroll
        for (int q = 0; q < 20; ++q) { float a = 0.f;
#pragma unroll
            for (int j = 0; j < 4; ++j) { const f32x4 w = *(const LAS f32x4*)(WrT + q * 1024 + 4 * lane + 256 * j); a += (v[j].x * w.x + v[j].y * w.y) + (v[j].z * w.z + v[j].w * w.w); }
            lg[q] = wave_sum(a) + bias[q]; }
        int gi = 0; float gm = lg[0];
#pragma unroll
        for (int q = 1; q < 4; ++q) if (lg[q] > gm) { gm = lg[q]; gi = q; }
        float gs = 0.f;
#pragma unroll
        for (int q = 0; q < 4; ++q) gs += __expf(lg[q] - gm);
        const float pg = 1.0f / gs;
        float sl[4];
#pragma unroll
        for (int q = 0; q < 4; ++q) sl[q] = gi == 0 ? lg[4 + q] : (gi == 1 ? lg[8 + q] : (gi == 2 ? lg[12 + q] : lg[16 + q]));
        int i0 = 0; float m0 = sl[0];
#pragma unroll
        for (int q = 1; q < 4; ++q) if (sl[q] > m0) { m0 = sl[q]; i0 = q; }
        int i1 = -1; float m1 = -3.0e38f;
#pragma unroll
        for (int q = 0; q < 4; ++q) if (q != i0 && sl[q] > m1) { m1 = sl[q]; i1 = q; }
        const float e1 = __expf(m1 - m0); const float w0 = 1.0f / (1.0f + e1), w1 = e1 * w0;
        const int ex0 = 4 * gi + i0, ex1 = 4 * gi + i1;
        if (lane == 0) TOK[m] = make_int4(ex0, ex1, __float_as_int(pg * w0), __float_as_int(pg * w1));
        mycnt += (lane == ex0 ? 1u : 0u) + (lane == ex1 ? 1u : 0u);
    }
    if (lane < 16 && mycnt) atomicAdd(&cnt[lane], mycnt);
}

__device__ __forceinline__ void place_phase(const Ptrs& P, int G, int c, int wave, int lane) {
    const bf16* H2 = (const bf16*)(P.ws + WS_H2); bf16* HX = (bf16*)(P.ws + WS_HX); const int4* TOK = (const int4*)(P.ws + WS_TOK); int2* SLOT = (int2*)(P.ws + WS_SLOT); float* CWv = (float*)(P.ws + WS_CW);
    const unsigned* cnt = (const unsigned*)(P.ws + WS_CTL) + CW_CNT; unsigned* cur = (unsigned*)(P.ws + WS_CTL) + CW_CUR;
    int sbase = 0; { int acc = 0; for (int e = 0; e < 16; ++e) { if (e == lane) sbase = acc; acc += (int)((cnt[e] + 255u) >> 8) * 256; } }
    const int gw = c * NWAVES + wave, NGW = G * NWAVES;
    for (int bt = gw; bt < T / 64; bt += NGW) {
        const int m = bt * 64 + lane; const int4 tk = TOK[m];
        int p0 = 0, p1 = 0;
#pragma unroll 1
        for (int e = 0; e < 16; ++e) {
            const unsigned long long k0 = __ballot(tk.x == e), k1 = __ballot(tk.y == e);
            const int n0 = __popcll(k0), n1 = __popcll(k1);
            unsigned base = 0; if (lane == 0 && (n0 + n1)) base = atomicAdd(&cur[e], (unsigned)(n0 + n1));
            base = __shfl(base, 0); const int sb = __shfl(sbase, e);
            const unsigned long long lt = (1ull << lane) - 1ull;
            if (tk.x == e) p0 = sb + (int)base + __popcll(k0 & lt);
            if (tk.y == e) p1 = sb + (int)base + n0 + __popcll(k1 & lt);
        }
        SLOT[m] = make_int2(p0, p1); CWv[p0] = __int_as_float(tk.z); CWv[p1] = __int_as_float(tk.w);
#pragma unroll 1
        for (int k = 0; k < 64; ++k) {
            const int q0 = __shfl(p0, k), q1 = __shfl(p1, k); const size_t mk = (size_t)bt * 64 + k;
            const GAS v4u* src = (const GAS v4u*)(H2 + mk * D) + lane; const v4u a = src[0], bq = src[64];
            GAS v4u* d0 = (GAS v4u*)(HX + (size_t)q0 * D) + lane; GAS v4u* d1 = (GAS v4u*)(HX + (size_t)q1 * D) + lane;
            d0[0] = a; d0[64] = bq; d1[0] = a; d1[64] = bq;
        }
    }
}

__device__ __forceinline__ void ple_norm_phase(const Ptrs& P, int G, int c, int wave, int lane) {
    float* xo = P.out; const bf16* Y = (const bf16*)(P.ws + WS_Y); const int2* SLOT = (const int2*)(P.ws + WS_SLOT); bf16* H3 = (bf16*)(P.ws + WS_H3); bf16* PB = (bf16*)(P.ws + WS_PB);
    const GAS f32x4* gr = (const GAS f32x4*)P.in[21] + lane; f32x4 gn[4];
#pragma unroll
    for (int j = 0; j < 4; ++j) gn[j] = gr[64 * j];
    const int gw = c * NWAVES + wave, NGW = G * NWAVES;
    for (int m = gw; m < T; m += NGW) {
        const int2 sl = SLOT[m];
        GAS f32x4* xr = (GAS f32x4*)(xo + (size_t)m * D) + lane; const GAS v2u* y0 = (const GAS v2u*)(Y + (size_t)sl.x * D) + lane; const GAS v2u* y1 = (const GAS v2u*)(Y + (size_t)sl.y * D) + lane;
        f32x4 v[4]; float s = 0.f;
#pragma unroll
        for (int j = 0; j < 4; ++j) { const v2u a = y0[64 * j], bq = y1[64 * j]; v[j] = xr[64 * j];
            v[j].x += bflo(a.x) + bflo(bq.x); v[j].y += bfhi(a.x) + bfhi(bq.x); v[j].z += bflo(a.y) + bflo(bq.y); v[j].w += bfhi(a.y) + bfhi(bq.y);
            xr[64 * j] = v[j]; s += (v[j].x * v[j].x + v[j].y * v[j].y) + (v[j].z * v[j].z + v[j].w * v[j].w); }
        const float rs = rsqrtf(wave_sum(s) * (1.f / D) + 1e-6f);
        GAS v2u* o8 = (GAS v2u*)(H3 + (size_t)m * D) + lane;
#pragma unroll
        for (int j = 0; j < 4; ++j) { v2u w; w.x = cvt_pk_bf16(v[j].x * rs * gn[j].x, v[j].y * rs * gn[j].y); w.y = cvt_pk_bf16(v[j].z * rs * gn[j].z, v[j].w * rs * gn[j].w); o8[64 * j] = w; }
        const f32x4 pv = *((const GAS f32x4*)(P.in[1] + (size_t)m * 256) + lane); v2u pw; pw.x = cvt_pk_bf16(pv.x, pv.y); pw.y = cvt_pk_bf16(pv.z, pv.w);
        *((GAS v2u*)(PB + (size_t)m * 256) + lane) = pw;
    }
}

struct Args { Ptrs p; int ph_lo, ph_hi; };
__global__ void __launch_bounds__(NWAVES * 64, 2) fwd_kernel(Args args) {
    extern __shared__ __attribute__((aligned(16))) unsigned char lds_raw[];
    LAS unsigned char* lds = (LAS unsigned char*)lds_raw;
    volatile LAS unsigned* MISC = (volatile LAS unsigned*)(lds + MISC_OFF);
    const int tid = threadIdx.x, lane = tid & 63, wave = __builtin_amdgcn_readfirstlane(tid >> 6);
    const int G = gridDim.x, c = blockIdx.x;
    const Ptrs& P = args.p;
    unsigned char* ws = P.ws;
    gu32* ctl = (gu32*)(ws + WS_CTL);
    for (int u = tid; u < 64; u += NWAVES * 64) MISC[u] = 0u;
    __syncthreads();
    XcdBarrier bar; bar.bar = (unsigned*)ctl + CW_BAR; bar.x = 0; bar.st = nullptr;
    if (N_LAUNCHES == 1) bar = xcd_barrier_post((unsigned*)ctl + CW_BAR, MISC + 8);
    const int lo = args.ph_lo, hi = args.ph_hi;
#ifndef PH_MASK
#define PH_MASK 0x3ffff
#endif
#define IN(k) (((PH_MASK >> (k)) & 1) && lo <= (k) && (k) < hi)
#define SEAM(k) do { if (IN(k) && IN((k) + 1)) xcd_barrier(bar); } while (0)

    if (IN(0)) { p0_prologue(P, lds, G, c, wave, lane); } SEAM(0);

    if (IN(1)) {
        pg8::StaticOrder S; S.init((const unsigned char*)P.out + DO_H, ws + WS_BTP1, T, NP1, D, G, c);
        pg8::EpiP1 E{(bf16*)(ws + WS_QA), (bf16*)(ws + WS_QB), (float*)(ws + WS_BG), P.in[4], P.in[5], P.in[7], P.in[8]};
        pg8::gemm_phase<pg8::EpiP1, pg8::StaticOrder, true, true>(lds + RING_OFF, D, S, E);
    } SEAM(1);

    if (IN(2)) { attn_phase(lds, (const bf16*)(ws + WS_QA), (bf16*)((unsigned char*)P.out + DO_OG), (float*)((unsigned char*)P.out + DO_LSE), G, c); } SEAM(2);

    if (IN(3)) { prep_phase(lds, (const bf16*)(ws + WS_QB), (const float*)(ws + WS_BG), P.in[6], ws + WS_DNP, (float*)(ws + WS_DLB), G, c); } SEAM(3);

    if (IN(4)) {
        const int nscan = G > 64 ? 64 : G;
        if (c < nscan) { for (int bh = c; bh < 64; bh += nscan) scan_chain(lds, ws + WS_DNP, (const float*)(ws + WS_DLB), (bf16*)(ws + WS_ON), P.in[9], bh); }
        if (G > 64) { if (c >= 64) combine_rows(P, (c - 64) * NWAVES + wave, (G - 64) * NWAVES, lane); }
        else combine_rows(P, c * NWAVES + wave, G * NWAVES, lane);
    } SEAM(4);

    if (IN(5)) { pg8::StaticOrder S; S.init(ws + WS_HR, ws + WS_BTZ, T, D, D, G, c); pg8::EpiSiluMul E{(bf16*)(ws + WS_ON)};
        pg8::gemm_phase<pg8::EpiSiluMul, pg8::StaticOrder, true, true>(lds + RING_OFF, D, S, E); } SEAM(5);
    if (IN(6)) { pg8::StaticOrder S; S.init(ws + WS_HR, ws + WS_BTGA, T, D, D, G, c); pg8::EpiBf16<1> E{(bf16*)(ws + WS_G1), D};
        pg8::gemm_phase<pg8::EpiBf16<1>, pg8::StaticOrder, true, true>(lds + RING_OFF, D, S, E); } SEAM(6);
    if (IN(7)) { pg8::StaticOrder S; S.init(ws + WS_HR, ws + WS_BTGB, T, D, D, G, c); pg8::EpiBf16<1> E{(bf16*)(ws + WS_G2), D};
        pg8::gemm_phase<pg8::EpiBf16<1>, pg8::StaticOrder, true, true>(lds + RING_OFF, D, S, E); } SEAM(7);
    if (IN(8)) { pg8::StaticOrder S; S.init(ws + WS_OA, ws + WS_BTA, T, D, 512, G, c); pg8::EpiGateMul<false> E{(const bf16*)(ws + WS_G1), (bf16*)(ws + WS_G1)};
        pg8::gemm_phase<pg8::EpiGateMul<false>, pg8::StaticOrder, true, true>(lds + RING_OFF, 512, S, E); } SEAM(8);
    if (IN(9)) { pg8::StaticOrder S; S.init(ws + WS_ON, ws + WS_BTB, T, D, D, G, c); pg8::EpiGateMul<true> E{(const bf16*)(ws + WS_G2), (bf16*)(ws + WS_G1)};
        pg8::gemm_phase<pg8::EpiGateMul<true>, pg8::StaticOrder, true, true>(lds + RING_OFF, D, S, E); } SEAM(9);
    if (IN(10)) { pg8::StaticOrder S; S.init(ws + WS_G1, ws + WS_BTOUT, T, D, D, G, c); pg8::EpiResF32 E{P.in[0], P.out};
        pg8::gemm_phase<pg8::EpiResF32, pg8::StaticOrder, true, true>(lds + RING_OFF, D, S, E); } SEAM(10);
    if (IN(11)) { router_phase(P, lds, G, c, wave, lane); } SEAM(11);
    if (IN(12)) { place_phase(P, G, c, wave, lane); } SEAM(12);
    if (IN(13)) { pg8::ExpertOrder S; S.init(ws + WS_HX, ws + WS_BTGU, (const unsigned*)ctl + CW_CNT, 512, D, G, c); pg8::EpiGU E{(bf16*)(ws + WS_ACT), (const float*)(ws + WS_CW)};
        pg8::gemm_phase<pg8::EpiGU, pg8::ExpertOrder, true, true>(lds + RING_OFF, D, S, E); } SEAM(13);
    if (IN(14)) { pg8::ExpertOrder S; S.init(ws + WS_ACT, ws + WS_BTDN, (const unsigned*)ctl + CW_CNT, D, 256, G, c); pg8::EpiBf16<0> E{(bf16*)(ws + WS_Y), D};
        pg8::gemm_phase<pg8::EpiBf16<0>, pg8::ExpertOrder, true, true>(lds + RING_OFF, 256, S, E); } SEAM(14);
    if (IN(15)) { ple_norm_phase(P, G, c, wave, lane); } SEAM(15);
    if (IN(16)) { pg8::StaticOrder S; S.init(ws + WS_PB, ws + WS_BTPLE, T, D, 256, G, c); pg8::EpiBf16<0> E{(bf16*)(ws + WS_E1), D};
        pg8::gemm_phase<pg8::EpiBf16<0>, pg8::StaticOrder, true, true>(lds + RING_OFF, 256, S, E); } SEAM(16);
    if (IN(17)) { pg8::StaticOrder S; S.init(ws + WS_H3, ws + WS_BTPG, T, D, D, G, c); pg8::EpiPleOut E{(const bf16*)(ws + WS_E1), P.out};
        pg8::gemm_phase<pg8::EpiPleOut, pg8::StaticOrder, true, true>(lds + RING_OFF, D, S, E); }
#undef IN
#undef SEAM
}

#ifndef DBG_LAST
#define DBG_LAST (NPH - 1)
#endif
__global__ void dbg_sanitize(float* out, size_t n) {
    for (size_t i = (size_t)blockIdx.x * blockDim.x + threadIdx.x; i < n; i += (size_t)gridDim.x * blockDim.x) { const float v = out[i]; if (!(v - v == 0.f)) out[i] = 0.f; }
}
__global__ void dbg_copy(const float* x, float* out, size_t n) {
    for (size_t i = (size_t)blockIdx.x * blockDim.x + threadIdx.x; i < n; i += (size_t)gridDim.x * blockDim.x) out[i] = x[i];
}
#ifdef DBG_CHECK
__global__ void dbg_check(const void* p, size_t nbytes, int is_f32, unsigned id, unsigned* word) {
    const size_t n16 = nbytes / 16; const uint4* q = (const uint4*)p; bool bad = false;
    for (size_t i = (size_t)blockIdx.x * blockDim.x + threadIdx.x; i < n16; i += (size_t)gridDim.x * blockDim.x) { const uint4 v = q[i]; const unsigned w[4] = {v.x, v.y, v.z, v.w};
        for (int k = 0; k < 4; ++k) { if (is_f32) { if ((w[k] & 0x7f800000u) == 0x7f800000u) bad = true; } else { if ((w[k] & 0x7f80u) == 0x7f80u || (w[k] & 0x7f800000u) == 0x7f800000u) bad = true; } } }
    if (bad) atomicMin(word, id);
}
__global__ void dbg_check_dnp(const unsigned char* p, unsigned id, unsigned* word) {
    bool bad = false;
    for (size_t i = (size_t)blockIdx.x * blockDim.x + threadIdx.x; i < (size_t)8192 * (DNU / 16); i += (size_t)gridDim.x * blockDim.x) { const size_t rec = i / (DNU / 16), o = (i % (DNU / 16)) * 16;
        if (o >= 49152 + 2048 && o < 49152 + 4096) continue;
        const uint4 v = *(const uint4*)(p + rec * DNU + o); const unsigned w[4] = {v.x, v.y, v.z, v.w};
        for (int k = 0; k < 4; ++k) if ((w[k] & 0x7f80u) == 0x7f80u || (w[k] & 0x7f800000u) == 0x7f800000u) { const unsigned part = o < 16384 ? 0u : (o < 32768 ? 1u : (o < 49152 ? 2u : (o < 57344 ? 3u : 4u))); atomicAnd(word, ~(1u << part)); } }
    (void)bad;
}
__global__ void dbg_check_tmax(const unsigned char* p, unsigned* word) {
    for (size_t r = (size_t)blockIdx.x * blockDim.x + threadIdx.x; r < 8192; r += (size_t)gridDim.x * blockDim.x) { const float* d = (const float*)(p + r * DNU + 49152 + 2048);
        unsigned bits = 0; if (d[0] > 1e3f) bits |= 1u; if (d[2] != 0.f) bits |= 2u; if (d[1] > 1.5f) bits |= 4u; if (d[1] > 100.f) bits |= 8u; if (d[3] != 0.f) bits |= 16u;
        if (bits) atomicAnd(word, ~bits); }
}
__global__ void dbg_final(const float* x, float* out, const unsigned* word) {
    unsigned id = *word;
#ifdef DBG_BITS
    id = (~id) & 31u; if (id == 0) id = 0xffffffffu;
#endif
    const size_t nz = id == 0xffffffffu ? 0 : (size_t)id * (T / 32) * D; const size_t n = (size_t)T * D;
    for (size_t i = (size_t)blockIdx.x * blockDim.x + threadIdx.x; i < n; i += (size_t)gridDim.x * blockDim.x) out[i] = i < nz ? 0.f : x[i];
}
#endif
extern "C" void kernel_launch(void* const* d_in, const int* in_sizes, int n_in, void* d_out, int out_size, void* d_ws, size_t ws_size, hipStream_t stream) {
    static int grid = 0;
    if (grid == 0) {
        if (n_in != 24 || out_size != T * D || ws_size < WS_END) { fprintf(stderr, "kernel_launch: unexpected shapes (n_in %d, out %d, ws %zu)\n", n_in, out_size, ws_size); grid = -1; return; }
        int dev = 0, cus = 0;
        if (hipGetDevice(&dev) != hipSuccess || hipDeviceGetAttribute(&cus, hipDeviceAttributeMultiprocessorCount, dev) != hipSuccess) { grid = -1; return; }
        if (hipFuncSetAttribute((const void*)fwd_kernel, hipFuncAttributeMaxDynamicSharedMemorySize, LDS_BYTES) != hipSuccess) { grid = -1; return; }
        int per_cu = 0;
        if (hipOccupancyMaxActiveBlocksPerMultiprocessor(&per_cu, (const void*)fwd_kernel, NWAVES * 64, LDS_BYTES) != hipSuccess || per_cu < 1) { fprintf(stderr, "kernel_launch: occupancy query says %d\n", per_cu); }
        (void)hipGetLastError();
        grid = cus;
    }
    if (grid < 0) return;
    if (hipMemsetAsync((char*)d_ws + WS_CTL, 0, CTL_ZERO_BYTES, stream) != hipSuccess) return;
    Args a{};
    for (int i = 0; i < 24; ++i) a.p.in[i] = (const float*)d_in[i];
    a.p.out = (float*)d_out; a.p.ws = (unsigned char*)d_ws;
    if (N_LAUNCHES == 1) { a.ph_lo = 0; a.ph_hi = NPH; hipLaunchKernelGGL(fwd_kernel, dim3(grid), dim3(NWAVES * 64), LDS_BYTES, stream, a); }
    else for (int li = 0; li <= DBG_LAST; ++li) { a.ph_lo = li; a.ph_hi = li + 1; hipLaunchKernelGGL(fwd_kernel, dim3(grid), dim3(NWAVES * 64), LDS_BYTES, stream, a);
#ifdef DBG_CHECK
        unsigned char* W = (unsigned char*)d_ws; unsigned char* O = (unsigned char*)d_out; unsigned* word = (unsigned*)(W + 1022 * MiB + 512 * 1024);
        if (li == 0) hipMemsetAsync(word, 0xFF, 4, stream);
#define CHK(p, nb, f32, id) hipLaunchKernelGGL(dbg_check, dim3(1024), dim3(256), 0, stream, (const void*)(p), (size_t)(nb), f32, (unsigned)(id), word)
        if (li == 0) { CHK(O + DO_H, (size_t)T * D * 2, 0, 1); CHK(W + WS_BTP1, (size_t)NP1 * D * 2, 0, 2); CHK(W + WS_BTZ, 38 * MiB, 0, 3); }
        if (li == 1) { CHK(W + WS_QA, (size_t)T * 4608 * 2, 0, 4); CHK(W + WS_QB, (size_t)T * 3072 * 2, 0, 5); CHK(W + WS_BG, (size_t)T * 16 * 4, 1, 6); }
        if (li == 2) { CHK(O + DO_OG, (size_t)T * 1536 * 2, 0, 7); CHK(O + DO_LSE, (size_t)T * 24 * 4, 1, 8); }
#if defined(DBG_PREPCHK)
        if (li == 3) {
#elif defined(DBG_TMAX)
        if (li == 3) { hipLaunchKernelGGL(dbg_check_tmax, dim3(32), dim3(256), 0, stream, W + WS_DNP, word);
#else
        if (li == 3) { hipLaunchKernelGGL(dbg_check_dnp, dim3(1024), dim3(256), 0, stream, W + WS_DNP, 9u, word);
#endif
        CHK(W + WS_DLB, 8192 * 4, 1, 14); }
        if (li == 4) { CHK(W + WS_ON, (size_t)T * D * 2, 0, 11); CHK(W + WS_OA, (size_t)T * 512 * 2, 0, 12); CHK(W + WS_HR, (size_t)T * D * 2, 0, 13); }
        if (li == 5) CHK(W + WS_ON, (size_t)T * D * 2, 0, 14);
        if (li == 6) CHK(W + WS_G1, (size_t)T * D * 2, 0, 15);
        if (li == 7) CHK(W + WS_G2, (size_t)T * D * 2, 0, 16);
        if (li == 8) CHK(W + WS_G1, (size_t)T * D * 2, 0, 17);
        if (li == 9) CHK(W + WS_G1, (size_t)T * D * 2, 0, 18);
        if (li == 10) CHK(O, (size_t)T * D * 4, 1, 19);
        if (li == 11) { CHK(W + WS_H2, (size_t)T * D * 2, 0, 20); CHK(W + WS_TOK, (size_t)T * 16, 1, 21); }
        if (li == 15) { CHK(O, (size_t)T * D * 4, 1, 25); CHK(W + WS_H3, (size_t)T * D * 2, 0, 26); }
        if (li == 16) CHK(W + WS_E1, (size_t)T * D * 2, 0, 27);
        if (li == 17) CHK(O, (size_t)T * D * 4, 1, 28);
        if (li == DBG_LAST) hipLaunchKernelGGL(dbg_final, dim3(2048), dim3(256), 0, stream, (const float*)d_in[0], (float*)d_out, (const unsigned*)word);
#endif
    }
#ifdef DBG_COPYX
    hipLaunchKernelGGL(dbg_copy, dim3(2048), dim3(256), 0, stream, (const float*)d_in[0], (float*)d_out, (size_t)out_size);
#endif
#ifdef DBG_SANITIZE
    hipLaunchKernelGGL(dbg_sanitize, dim3(2048), dim3(256), 0, stream, (float*)d_out, (size_t)out_size);
#endif
}
```

```cpp
#define MK_N_LAUNCHES 1
#include <hip/hip_runtime.h>
#include <cstdio>
#include <cstdint>
namespace pg8 {
#define PG8_LAS __attribute__((address_space(3)))
typedef unsigned short bf16_t;
typedef short bf16x8 __attribute__((ext_vector_type(8)));
typedef float f32x4 __attribute__((ext_vector_type(4)));
typedef unsigned u32x4 __attribute__((ext_vector_type(4)));
typedef unsigned u32x2 __attribute__((ext_vector_type(2)));
constexpr int BM = 256, BK = 64, HALF = 128, HTB = HALF * BK * 2  , STAGE_BYTES = 8 * HTB, NXCD = 8, WGM = 8;

__host__ __device__ __forceinline__ int lds_byte(int r, int c) { const int st = (r >> 4) * 2 + (c >> 5), rr = r & 15, cc = c & 31, ob = rr * 64 + cc * 2; return st * 1024 + (ob ^ (((ob >> 9) & 1) << 5)); }
__host__ __device__ __forceinline__ void stage_rc(int b, int& R, int& C) { const int st = b / 1024, sb = b % 1024, swz = sb ^ (((sb >> 9) & 1) << 5); R = (st >> 1) * 16 + swz / 64; C = (st & 1) * 32 + (swz % 64) / 2; }
__host__ __device__ __forceinline__ int perm32(int rho) { const int n = rho >> 4, i = rho & 15; return 8 * (i >> 2) + 4 * n + (i & 3); }

struct Unit { int pm, pn; const char* a; const char* b; };

struct StaticOrder {
    const char* A; const char* Bt; size_t tstep; int nM, nN, nwg, G, c;
    __device__ __forceinline__ void init(const void* A_, const void* Bt_, int M, int N, int K, int G_, int c_) { A = (const char*)A_; Bt = (const char*)Bt_; tstep = (size_t)BM * K * 2; nM = M / BM; nN = N / BM; nwg = nM * nN; G = G_; c = c_; }
    __device__ __forceinline__ bool next(int i, Unit& u) const {
        const long L = (long)i * G + c; if (L >= nwg) return false;
        int wgid = (int)L; { const int q = nwg / NXCD, r = nwg % NXCD, xcd = wgid % NXCD, off = wgid / NXCD; wgid = (xcd < r ? xcd * (q + 1) : r * (q + 1) + (xcd - r) * q) + off; }
        const int nig = WGM * nN, gid = wgid / nig, fm = gid * WGM, gsz = (nM - fm) < WGM ? (nM - fm) : WGM;
        u.pm = fm + ((wgid % nig) % gsz); u.pn = (wgid % nig) / gsz; u.a = A + (size_t)u.pm * tstep; u.b = Bt + (size_t)u.pn * tstep; return true;
    }
    __device__ __forceinline__ const char* a_ptr(const Unit& u) const { return u.a; }
    __device__ __forceinline__ const char* b_ptr(const Unit& u) const { return u.b; }
    __device__ __forceinline__ void a_ready(const Unit&) const {}
    __device__ __forceinline__ void done(const Unit&) const {}
};
struct ExpertOrder {
    const char* A; const char* Bt; const unsigned* cnt; size_t tstep, bstride; int nN, G, c;
    __device__ __forceinline__ void init(const void* A_, const void* Bt_, const unsigned* cnt_, int N, int K, int G_, int c_) { A = (const char*)A_; Bt = (const char*)Bt_; cnt = cnt_; tstep = (size_t)BM * K * 2; bstride = (size_t)N * K * 2; nN = N / BM; G = G_; c = c_; }
    __device__ __forceinline__ bool next(int i, Unit& u) const {
        const long L = (long)i * G + c; const int rt = (int)(L / nN), pn = (int)(L % nN);
        int acc = 0, found = -1;
        for (int e = 0; e < 16; ++e) { const int te = (int)((cnt[e] + 255u) >> 8); if (found < 0 && rt < acc + te) found = e; acc += te; }
        if (found < 0) return false;
        u.pm = rt; u.pn = pn; u.a = A + (size_t)rt * tstep; u.b = Bt + (size_t)found * bstride + (size_t)pn * tstep; return true;
    }
    __device__ __forceinline__ const char* a_ptr(const Unit& u) const { return u.a; }
    __device__ __forceinline__ const char* b_ptr(const Unit& u) const { return u.b; }
    __device__ __forceinline__ void a_ready(const Unit&) const {}
    __device__ __forceinline__ void done(const Unit&) const {}
};

typedef float f32x2_t __attribute__((ext_vector_type(2))); typedef __bf16 bf16x2_t __attribute__((ext_vector_type(2)));
__device__ __forceinline__ unsigned cvt_pk_bf16(float lo, float hi) { const f32x2_t v = {lo, hi}; const bf16x2_t b = __builtin_convertvector(v, bf16x2_t); return __builtin_bit_cast(unsigned, b); }
__device__ __forceinline__ float bflo(unsigned w) { return __uint_as_float(w << 16); }
__device__ __forceinline__ float bfhi(unsigned w) { return __uint_as_float(w & 0xffff0000u); }
__device__ __forceinline__ float sigm(float x) { return 1.0f / (1.0f + __expf(-x)); }
__device__ __forceinline__ u32x4 pack8(const f32x4 a, const f32x4 b) { u32x4 w; w.x = cvt_pk_bf16(a[0], a[1]); w.y = cvt_pk_bf16(a[2], a[3]); w.z = cvt_pk_bf16(b[0], b[1]); w.w = cvt_pk_bf16(b[2], b[3]); return w; }
__device__ __forceinline__ void unpack8(const u32x4 w, f32x4& a, f32x4& b) { a = (f32x4){bflo(w.x), bfhi(w.x), bflo(w.y), bfhi(w.y)}; b = (f32x4){bflo(w.z), bfhi(w.z), bflo(w.w), bfhi(w.w)}; }

constexpr float QSCALE = 0.125f * 1.4426950408889634f;
constexpr float EPSN = 1e-6f;
constexpr int QAP = 4608, QBP = 3072;

struct EpiP1 {
    static constexpr bool PERM = true, AFTER_DRAIN = false;
    bf16_t* QA; bf16_t* QB; float* BG; const float* qn; const float* kn; const float* a_log; const float* dt_bias;
    __device__ __forceinline__ void operator()(const f32x4 (&acc)[2][2][4][2], const Unit& u, int wr, int wc, int fr, int fq) const {
        const int row0 = u.pm * BM + wr * 64 + fr;
        if (u.pn < 12) {
            const float* gn = (u.pn < 6) ? qn : kn; const float sc = (u.pn < 6) ? QSCALE : 1.0f;
            f32x4 gv[2][2];
#pragma unroll
            for (int bj = 0; bj < 2; ++bj)
#pragma unroll
                for (int n = 0; n < 2; ++n) gv[bj][n] = *(const f32x4*)(gn + 32 * bj + 8 * fq + 4 * n) * sc;
#pragma unroll
            for (int ai = 0; ai < 2; ++ai)
#pragma unroll
                for (int m = 0; m < 4; ++m) {
                    float ss = 0.f;
#pragma unroll
                    for (int bj = 0; bj < 2; ++bj)
#pragma unroll
                        for (int n = 0; n < 2; ++n) { const f32x4 x = acc[ai][bj][m][n]; ss += (x[0] * x[0] + x[1] * x[1]) + (x[2] * x[2] + x[3] * x[3]); }
                    ss += __shfl_xor(ss, 16); ss += __shfl_xor(ss, 32);
                    const float rs = rsqrtf(ss * (1.0f / 64.0f) + EPSN);
                    bf16_t* rowp = QA + (size_t)(row0 + ai * HALF + m * 16) * QAP + u.pn * BM + wc * 64 + 8 * fq;
#pragma unroll
                    for (int bj = 0; bj < 2; ++bj) { const f32x4 v0 = acc[ai][bj][m][0] * rs * gv[bj][0], v1 = acc[ai][bj][m][1] * rs * gv[bj][1]; *(u32x4*)(rowp + bj * 32) = pack8(v0, v1); }
                }
        } else if (u.pn < 30) {
            bf16_t* const base = (u.pn < 18) ? QA + u.pn * BM : QB + (u.pn - 18) * BM; const int pitch = (u.pn < 18) ? QAP : QBP;
#pragma unroll
            for (int ai = 0; ai < 2; ++ai)
#pragma unroll
                for (int m = 0; m < 4; ++m) { bf16_t* rowp = base + (size_t)(row0 + ai * HALF + m * 16) * pitch + wc * 32 + 8 * fq;
#pragma unroll
                    for (int bj = 0; bj < 2; ++bj) *(u32x4*)(rowp + bj * HALF) = pack8(acc[ai][bj][m][0], acc[ai][bj][m][1]); }
        } else {
            if (wc == 0 && fq < 2) {
                f32x4 al[2], db[2];
#pragma unroll
                for (int n = 0; n < 2; ++n) { al[n] = *(const f32x4*)(a_log + 4 * n); db[n] = *(const f32x4*)(dt_bias + 4 * n); }
#pragma unroll
                for (int ai = 0; ai < 2; ++ai)
#pragma unroll
                    for (int m = 0; m < 4; ++m) { float* rowp = BG + (size_t)(row0 + ai * HALF + m * 16) * 16 + 8 * fq;
#pragma unroll
                        for (int n = 0; n < 2; ++n) { const f32x4 x = acc[ai][0][m][n]; f32x4 o;
#pragma unroll
                            for (int e = 0; e < 4; ++e) { if (fq == 0) o[e] = sigm(x[e]); else { const float z = x[e] + db[n][e]; const float sp = z > 20.f ? z : log1pf(__expf(z)); o[e] = -__expf(al[n][e]) * sp; } }
                            *(f32x4*)(rowp + 4 * n) = o; } }
            }
        }
    }
};
struct EpiSiluMul {
    static constexpr bool PERM = true, AFTER_DRAIN = false;
    bf16_t* O;
    __device__ __forceinline__ void operator()(const f32x4 (&acc)[2][2][4][2], const Unit& u, int wr, int wc, int fr, int fq) const {
        const int row0 = u.pm * BM + wr * 64 + fr;
#pragma unroll
        for (int ai = 0; ai < 2; ++ai)
#pragma unroll
            for (int m = 0; m < 4; ++m) { bf16_t* rowp = O + (size_t)(row0 + ai * HALF + m * 16) * 1024 + u.pn * BM + wc * 32 + 8 * fq;
#pragma unroll
                for (int bj = 0; bj < 2; ++bj) { const u32x4 w = *(const u32x4*)(rowp + bj * HALF); f32x4 a, b; unpack8(w, a, b); f32x4 z0 = acc[ai][bj][m][0], z1 = acc[ai][bj][m][1];
#pragma unroll
                    for (int e = 0; e < 4; ++e) { a[e] *= z0[e] * sigm(z0[e]); b[e] *= z1[e] * sigm(z1[e]); }
                    *(u32x4*)(rowp + bj * HALF) = pack8(a, b); } }
    }
};
template <int MODE> struct EpiBf16 {
    static constexpr bool PERM = true, AFTER_DRAIN = false;
    bf16_t* O; int ldc;
    __device__ __forceinline__ void operator()(const f32x4 (&acc)[2][2][4][2], const Unit& u, int wr, int wc, int fr, int fq) const {
        const int row0 = u.pm * BM + wr * 64 + fr;
#pragma unroll
        for (int ai = 0; ai < 2; ++ai)
#pragma unroll
            for (int m = 0; m < 4; ++m) { bf16_t* rowp = O + (size_t)(row0 + ai * HALF + m * 16) * ldc + u.pn * BM + wc * 32 + 8 * fq;
#pragma unroll
                for (int bj = 0; bj < 2; ++bj) { f32x4 a = acc[ai][bj][m][0], b = acc[ai][bj][m][1];
                    if (MODE == 1) {
#pragma unroll
                        for (int e = 0; e < 4; ++e) { a[e] = sigm(a[e]); b[e] = sigm(b[e]); } }
                    *(u32x4*)(rowp + bj * HALF) = pack8(a, b); } }
    }
};
template <bool ADD> struct EpiGateMul {
    static constexpr bool PERM = true, AFTER_DRAIN = false;
    const bf16_t* Gt; bf16_t* Mo;
    __device__ __forceinline__ void operator()(const f32x4 (&acc)[2][2][4][2], const Unit& u, int wr, int wc, int fr, int fq) const {
        const int row0 = u.pm * BM + wr * 64 + fr;
#pragma unroll
        for (int ai = 0; ai < 2; ++ai)
#pragma unroll
            for (int m = 0; m < 4; ++m) { const size_t off = (size_t)(row0 + ai * HALF + m * 16) * 1024 + u.pn * BM + wc * 32 + 8 * fq;
#pragma unroll
                for (int bj = 0; bj < 2; ++bj) { const u32x4 gw = *(const u32x4*)(Gt + off + bj * HALF); f32x4 ga, gb; unpack8(gw, ga, gb);
                    f32x4 a = ga * acc[ai][bj][m][0], b = gb * acc[ai][bj][m][1];
                    if (ADD) { const u32x4 mw = *(const u32x4*)(Mo + off + bj * HALF); f32x4 ma, mb; unpack8(mw, ma, mb); a += ma; b += mb; }
                    *(u32x4*)(Mo + off + bj * HALF) = pack8(a, b); } }
    }
};
struct EpiResF32 {
    static constexpr bool PERM = false, AFTER_DRAIN = false;
    const float* base; float* out;
    __device__ __forceinline__ void operator()(const f32x4 (&acc)[2][2][4][2], const Unit& u, int wr, int wc, int fr, int fq) const {
        const int row0 = u.pm * BM + wr * 64 + fr, col0 = u.pn * BM + wc * 32 + 4 * fq;
#pragma unroll
        for (int ai = 0; ai < 2; ++ai)
#pragma unroll
            for (int m = 0; m < 4; ++m) { const size_t off = (size_t)(row0 + ai * HALF + m * 16) * 1024 + col0;
#pragma unroll
                for (int bj = 0; bj < 2; ++bj)
#pragma unroll
                    for (int n = 0; n < 2; ++n) { const f32x4 bs = *(const f32x4*)(base + off + bj * HALF + n * 16); *(f32x4*)(out + off + bj * HALF + n * 16) = bs + acc[ai][bj][m][n]; }
                asm volatile("" ::: "memory"); }
    }
};
struct EpiPleOut {
    static constexpr bool PERM = false, AFTER_DRAIN = false;
    const bf16_t* E1; float* out;
    __device__ __forceinline__ void operator()(const f32x4 (&acc)[2][2][4][2], const Unit& u, int wr, int wc, int fr, int fq) const {
        const int row0 = u.pm * BM + wr * 64 + fr, col0 = u.pn * BM + wc * 32 + 4 * fq;
#pragma unroll
        for (int ai = 0; ai < 2; ++ai)
#pragma unroll
            for (int m = 0; m < 4; ++m) { const size_t off = (size_t)(row0 + ai * HALF + m * 16) * 1024 + col0;
#pragma unroll
                for (int bj = 0; bj < 2; ++bj)
#pragma unroll
                    for (int n = 0; n < 2; ++n) { const size_t o2 = off + bj * HALF + n * 16; const f32x4 bs = *(const f32x4*)(out + o2); const u32x2 ew = *(const u32x2*)(E1 + o2);
                        const f32x4 ev = (f32x4){bflo(ew.x), bfhi(ew.x), bflo(ew.y), bfhi(ew.y)}; const f32x4 a = acc[ai][bj][m][n]; f32x4 r;
#pragma unroll
                        for (int e = 0; e < 4; ++e) r[e] = bs[e] + sigm(a[e]) * ev[e];
                        *(f32x4*)(out + o2) = r; }
                asm volatile("" ::: "memory"); }
    }
};
struct EpiGU {
    static constexpr bool PERM = true, AFTER_DRAIN = false;
    bf16_t* ACT; const float* CW;
    __device__ __forceinline__ void operator()(const f32x4 (&acc)[2][2][4][2], const Unit& u, int wr, int wc, int fr, int fq) const {
        const int row0 = u.pm * BM + wr * 64 + fr;
#pragma unroll
        for (int ai = 0; ai < 2; ++ai)
#pragma unroll
            for (int m = 0; m < 4; ++m) { const int row = row0 + ai * HALF + m * 16; const float cw = CW[row];
                f32x4 a, b; const f32x4 g0 = acc[ai][0][m][0], g1 = acc[ai][0][m][1], u0 = acc[ai][1][m][0], u1 = acc[ai][1][m][1];
#pragma unroll
                for (int e = 0; e < 4; ++e) { a[e] = g0[e] * sigm(g0[e]) * u0[e] * cw; b[e] = g1[e] * sigm(g1[e]) * u1[e] * cw; }
                *(u32x4*)(ACT + (size_t)row * 256 + u.pn * HALF + wc * 32 + 8 * fq) = pack8(a, b); }
    }
};

template <class Epi, class Sched, bool ALIGN_EPI = false, bool SP2 = false>
__device__ __forceinline__ void gemm_phase(PG8_LAS unsigned char* lds, const int KK, const Sched& S, const Epi& E) {
    int tid_ = threadIdx.x; asm volatile("" : "+v"(tid_));
    const int tid = tid_, wid = __builtin_amdgcn_readfirstlane(tid >> 6), lane = tid & 63, wr = wid >> 2, wc = wid & 3, fr = lane & 15, fq = lane >> 4;
    int K_ = KK; asm volatile("" : "+s"(K_));
    const int K = K_, nt = K / BK;
    unsigned voffA[2], voffB[2];
#pragma unroll
    for (int i = 0; i < 2; ++i) { int R, C; stage_rc(tid * 16 + i * 8192, R, C); const int Rb = Epi::PERM ? ((R & ~31) + perm32(R & 31)) : R;
        voffA[i] = (unsigned)(R * K + C) * 2u; voffB[i] = (unsigned)(Rb * K + C) * 2u; }
    const size_t kstep = (size_t)(BK * 2);
    const size_t hstep = (size_t)HALF * K * 2;
    const size_t tstep = 2 * hstep;
    const unsigned ldsw = (unsigned)wid * 1024u;
    const int aoff = lds_byte(wr * 64 + fr, fq * 8), boff = lds_byte(wc * 32 + fr, fq * 8);
#define PG8_SA(b, h) (((b) * 2 + (h)) * HTB)
#define PG8_SB(b, h) ((4 + (b) * 2 + (h)) * HTB)
#define PG8_STAGE(bufoff, gbase, voff) do { _Pragma("unroll") for (int _i = 0; _i < 2; ++_i) \
        __builtin_amdgcn_global_load_lds((const unsigned*)((const char*)(gbase) + (voff)[_i]), (PG8_LAS unsigned*)(lds + (bufoff) + ldsw + _i * 8192), 16, 0, 0); } while (0)
#define PG8_LDA(dst, b, h) do { _Pragma("unroll") for (int m = 0; m < 4; ++m) _Pragma("unroll") for (int k = 0; k < 2; ++k) dst[m][k] = *(const PG8_LAS bf16x8*)(lds + PG8_SA(b, h) + aoff + m * 2048 + k * 1024); } while (0)
#define PG8_LDB(dst, b, h) do { _Pragma("unroll") for (int n = 0; n < 2; ++n) _Pragma("unroll") for (int k = 0; k < 2; ++k) dst[n][k] = *(const PG8_LAS bf16x8*)(lds + PG8_SB(b, h) + boff + n * 2048 + k * 1024); } while (0)
#define PG8_MMA(ai, bj, At, Bt) do { __builtin_amdgcn_s_setprio(1); _Pragma("unroll") for (int m = 0; m < 4; ++m) _Pragma("unroll") for (int n = 0; n < 2; ++n) _Pragma("unroll") for (int k = 0; k < 2; ++k) \
        acc[ai][bj][m][n] = __builtin_amdgcn_mfma_f32_16x16x32_bf16(Bt[n][k], At[m][k], acc[ai][bj][m][n], 0, 0, 0); __builtin_amdgcn_s_setprio(0); } while (0)
#define PG8_WAIT_V(n) asm volatile("s_waitcnt vmcnt(" #n ")" ::: "memory")
#define PG8_WAIT_L(n) asm volatile("s_waitcnt lgkmcnt(" #n ")" ::: "memory")
#define PG8_BAR __builtin_amdgcn_s_barrier()
#define PG8_SCHED __builtin_amdgcn_sched_barrier(0)
    Unit cur, nxt; int ui = 0;
    if (!S.next(0, cur)) return;
    f32x4 acc[2][2][4][2];
#pragma unroll
    for (int a = 0; a < 2; ++a)
#pragma unroll
        for (int b = 0; b < 2; ++b)
#pragma unroll
            for (int m = 0; m < 4; ++m)
#pragma unroll
                for (int n = 0; n < 2; ++n) acc[a][b][m][n] = (f32x4){0.f, 0.f, 0.f, 0.f};
    bf16x8 At[4][2], B0[2][2], B1[2][2];
    const char* cA = S.a_ptr(cur); const char* cB = S.b_ptr(cur);
    S.a_ready(cur);
    if constexpr (SP2) {
        PG8_STAGE(PG8_SB(0, 0), cB, voffB); PG8_STAGE(PG8_SB(0, 1), cB + hstep, voffB); PG8_STAGE(PG8_SA(0, 0), cA, voffA); PG8_STAGE(PG8_SA(0, 1), cA + hstep, voffA);
        if (wr == 1) PG8_BAR;
        PG8_WAIT_V(2); PG8_BAR;
        PG8_STAGE(PG8_SB(1, 0), cB + kstep, voffB); PG8_STAGE(PG8_SA(1, 0), cA + kstep, voffA); PG8_STAGE(PG8_SB(1, 1), cB + hstep + kstep, voffB);
        PG8_WAIT_V(6); PG8_BAR;
    } else {
        PG8_STAGE(PG8_SB(0, 0), cB, voffB); PG8_STAGE(PG8_SA(0, 0), cA, voffA); PG8_STAGE(PG8_SB(0, 1), cB + hstep, voffB); PG8_STAGE(PG8_SA(0, 1), cA + hstep, voffA);
        if (wr == 1) PG8_BAR;
        PG8_WAIT_V(4); PG8_BAR;
        PG8_STAGE(PG8_SB(1, 0), cB + kstep, voffB); PG8_STAGE(PG8_SA(1, 0), cA + kstep, voffA); PG8_STAGE(PG8_SB(1, 1), cB + hstep + kstep, voffB);
        PG8_WAIT_V(6); PG8_BAR;
    }
    for (;;) {
        const bool has_next = S.next(ui + 1, nxt);
        const char* nA = has_next ? S.a_ptr(nxt) : cA; const char* nB = has_next ? S.b_ptr(nxt) : cB;
        for (int t = 0; t < nt; t += 2) {
            const bool last = (t == nt - 2);
            const char* a1 = cA + (size_t)(t + 1) * kstep;
            const char* a2 = last ? nA : cA + (size_t)(t + 2) * kstep; const char* b2 = last ? nB : cB + (size_t)(t + 2) * kstep;
            const char* a3 = a2 + kstep; const char* b3 = b2 + kstep;
            if (last && has_next) S.a_ready(nxt);
            if constexpr (SP2) {
            PG8_LDB(B0, 0, 0); PG8_LDB(B1, 0, 1); PG8_SCHED; PG8_LDA(At, 0, 0); PG8_STAGE(PG8_SA(1, 1), a1 + hstep, voffA);
            PG8_WAIT_V(8); PG8_WAIT_L(0); PG8_BAR; PG8_MMA(0, 0, At, B0); PG8_MMA(0, 1, At, B1); PG8_BAR; PG8_SCHED;
            PG8_LDA(At, 0, 1); PG8_STAGE(PG8_SB(0, 0), b2, voffB); PG8_STAGE(PG8_SB(0, 1), b2 + hstep, voffB); PG8_STAGE(PG8_SA(0, 0), a2, voffA);
            PG8_WAIT_V(8); PG8_WAIT_L(0); PG8_BAR; PG8_MMA(1, 0, At, B0); PG8_MMA(1, 1, At, B1); PG8_BAR; PG8_SCHED;
            PG8_LDB(B0, 1, 0); PG8_LDB(B1, 1, 1); PG8_SCHED; PG8_LDA(At, 1, 0); PG8_STAGE(PG8_SA(0, 1), a2 + hstep, voffA);
            PG8_WAIT_V(8); PG8_WAIT_L(0); PG8_BAR; PG8_MMA(0, 0, At, B0); PG8_MMA(0, 1, At, B1); PG8_BAR; PG8_SCHED;
            PG8_LDA(At, 1, 1); PG8_STAGE(PG8_SB(1, 0), b3, voffB); PG8_STAGE(PG8_SB(1, 1), b3 + hstep, voffB); PG8_STAGE(PG8_SA(1, 0), a3, voffA);
            PG8_WAIT_V(8); PG8_WAIT_L(0); PG8_BAR; PG8_MMA(1, 0, At, B0); PG8_MMA(1, 1, At, B1); PG8_BAR; PG8_SCHED;
            } else {
            PG8_LDB(B0, 0, 0); PG8_SCHED; PG8_LDA(At, 0, 0); PG8_STAGE(PG8_SA(1, 1), a1 + hstep, voffA);
            PG8_WAIT_L(8); PG8_BAR; PG8_WAIT_L(0); PG8_MMA(0, 0, At, B0); PG8_BAR; PG8_SCHED;
            PG8_LDB(B1, 0, 1); PG8_STAGE(PG8_SB(0, 0), b2, voffB);
            PG8_BAR; PG8_WAIT_L(0); PG8_MMA(0, 1, At, B1); PG8_BAR;
            PG8_LDA(At, 0, 1); PG8_STAGE(PG8_SA(0, 0), a2, voffA);
            PG8_BAR; PG8_WAIT_L(0); PG8_MMA(1, 0, At, B0); PG8_BAR; PG8_SCHED;
            PG8_STAGE(PG8_SB(0, 1), b2 + hstep, voffB);
            PG8_WAIT_V(6); PG8_BAR; PG8_MMA(1, 1, At, B1); PG8_BAR;
            PG8_LDB(B0, 1, 0); PG8_SCHED; PG8_LDA(At, 1, 0); PG8_STAGE(PG8_SA(0, 1), a2 + hstep, voffA);
            PG8_WAIT_L(8); PG8_BAR; PG8_WAIT_L(0); PG8_MMA(0, 0, At, B0); PG8_BAR; PG8_SCHED;
            PG8_LDB(B1, 1, 1); PG8_STAGE(PG8_SB(1, 0), b3, voffB);
            PG8_BAR; PG8_WAIT_L(0); PG8_MMA(0, 1, At, B1); PG8_BAR;
            PG8_LDA(At, 1, 1); PG8_STAGE(PG8_SA(1, 0), a3, voffA);
            PG8_BAR; PG8_WAIT_L(0); PG8_MMA(1, 0, At, B0); PG8_BAR; PG8_SCHED;
            PG8_STAGE(PG8_SB(1, 1), b3 + hstep, voffB);
            PG8_WAIT_V(6); PG8_BAR; PG8_MMA(1, 1, At, B1); PG8_BAR;
            }
        }
        if constexpr (ALIGN_EPI) { if (wr == 0) PG8_BAR; }
        if constexpr (!Epi::AFTER_DRAIN) { E(acc, cur, wr, wc, fr, fq); S.done(cur); }
        if (!has_next) break;
#pragma unroll
        for (int a = 0; a < 2; ++a)
#pragma unroll
            for (int b = 0; b < 2; ++b)
#pragma unroll
                for (int m = 0; m < 4; ++m)
#pragma unroll
                    for (int n = 0; n < 2; ++n) acc[a][b][m][n] = (f32x4){0.f, 0.f, 0.f, 0.f};
        cur = nxt; cA = nA; cB = nB; ++ui;
        if constexpr (ALIGN_EPI) { if (wr == 1) PG8_BAR; }
    }
    PG8_WAIT_V(0);
    if constexpr (!ALIGN_EPI) { if (wr == 0) PG8_BAR; }
    PG8_BAR;
    if constexpr (Epi::AFTER_DRAIN) { E.fused(acc, cur, wr, wc, fr, fq, lds, wid, lane); S.done(cur); }
#undef PG8_SA
#undef PG8_SB
#undef PG8_STAGE
#undef PG8_LDA
#undef PG8_LDB
#undef PG8_MMA
#undef PG8_WAIT_V
#undef PG8_WAIT_L
#undef PG8_BAR
#undef PG8_SCHED
}
}

constexpr int NWAVES = 8;
constexpr int BATCH = 8, SEQ = 8192, D = 1024, T = BATCH * SEQ;
constexpr int IN_TOTAL = 10768, NP1 = 7936;
constexpr int NSLOT = 2 * T + 4096;
constexpr int NPH = 18;
#ifndef MK_N_LAUNCHES
#define MK_N_LAUNCHES 1
#endif
constexpr int N_LAUNCHES = MK_N_LAUNCHES;
static_assert(N_LAUNCHES == 1 || N_LAUNCHES == NPH, "MK_N_LAUNCHES is 1 or NPH");
constexpr int DNU = 73728;

constexpr size_t MiB = 1u << 20;
constexpr size_t WS_CTL = 0, CTL_ZERO_BYTES = 1 * MiB;
constexpr size_t WS_BTP1 = 1 * MiB;
constexpr size_t WS_BTZ = 17 * MiB, WS_BTGA = 19 * MiB, WS_BTGB = 21 * MiB, WS_BTB = 23 * MiB, WS_BTOUT = 25 * MiB, WS_BTPG = 27 * MiB;
constexpr size_t WS_BTA = 29 * MiB;
constexpr size_t WS_BTPLE = 30 * MiB;
constexpr size_t WS_BTGU = 31 * MiB;
constexpr size_t WS_BTDN = 47 * MiB;
constexpr size_t WS_QA = 56 * MiB;
constexpr size_t WS_DNP = 56 * MiB;
constexpr size_t WS_G1 = 56 * MiB, WS_G2 = 184 * MiB;
constexpr size_t WS_H3 = 56 * MiB;
constexpr size_t WS_H2 = 184 * MiB;
constexpr size_t WS_PB = 184 * MiB;
constexpr size_t WS_E1 = 216 * MiB;
constexpr size_t WS_HX = 312 * MiB;
constexpr size_t WS_ACT = 576 * MiB;
constexpr size_t WS_Y = 642 * MiB;
constexpr size_t WS_QB = 632 * MiB;
constexpr size_t WS_ON = 632 * MiB;
constexpr size_t WS_OA = 760 * MiB;
constexpr size_t WS_HR = 824 * MiB;
constexpr size_t WS_BG = 1016 * MiB;
constexpr size_t WS_TOK = 1020 * MiB;
constexpr size_t WS_SLOT = 1021 * MiB;
constexpr size_t WS_CW = 1021 * MiB + 512 * 1024;
constexpr size_t WS_DLB = 1022 * MiB + 256 * 1024;
constexpr size_t WS_END = 1024 * MiB;
static_assert(WS_Y + (size_t)NSLOT * 2048 <= WS_BG && WS_HX + (size_t)NSLOT * 2048 <= WS_ACT && WS_ACT + (size_t)NSLOT * 512 <= WS_Y && WS_HR + (size_t)T * 2048 <= WS_BG && WS_CW + (size_t)NSLOT * 4 <= WS_DLB, "d_ws map");
constexpr size_t DO_H = 0, DO_OG = 0, DO_LSE = 192 * MiB;
constexpr int CW_BAR = 4096;
constexpr int CW_CNT = 16384;
constexpr int CW_CUR = 16384 + 64;
constexpr int RING_OFF = 0, RING_BYTES = 131072;
constexpr int LDS_BYTES = 147456;
constexpr int MISC_OFF = LDS_BYTES - 256;

#define GAS __attribute__((address_space(1)))
#define LAS __attribute__((address_space(3)))
typedef unsigned short bf16;
typedef unsigned v4u __attribute__((ext_vector_type(4)));
typedef unsigned v2u __attribute__((ext_vector_type(2)));
typedef float f32x4 __attribute__((ext_vector_type(4)));
typedef float f32x16 __attribute__((ext_vector_type(16)));
typedef short bf16x8 __attribute__((ext_vector_type(8)));
typedef short s16x4 __attribute__((ext_vector_type(4)));
typedef GAS unsigned gu32;
#define RLX_AGENT __ATOMIC_RELAXED, __HIP_MEMORY_SCOPE_AGENT
using pg8::cvt_pk_bf16; using pg8::bflo; using pg8::bfhi; using pg8::pack8; using pg8::unpack8; using pg8::sigm;
__device__ __forceinline__ float bf2f(unsigned short b) { return __uint_as_float(((unsigned)b) << 16); }
__device__ __forceinline__ unsigned short f2bf(float f) { return (unsigned short)(cvt_pk_bf16(f, 0.f) & 0xffffu); }
__device__ __forceinline__ int crow(int r, int hi) { return (r & 3) + 8 * (r >> 2) + 4 * hi; }
__device__ __forceinline__ float wave_sum(float v) {
#pragma unroll
    for (int o = 1; o < 64; o <<= 1) v += __shfl_xor(v, o);
    return v;
}
__device__ __forceinline__ s16x4 ldtr(const LAS unsigned char* p) { return __builtin_bit_cast(s16x4, __builtin_amdgcn_ds_read_tr16_b64_v4i16((LAS s16x4*)p)); }
#define MFMA32(a, b, c) __builtin_amdgcn_mfma_f32_32x32x16_bf16((a), (b), (c), 0, 0, 0)

#define XB_TMO      128
#define XB_XCNT(j)  (256  + 64 * (j))
#define XB_XSUB(j)  (1280 + 64 * (j))
#define XB_XGEN(j)  (2304 + 64 * (j))
#define XB_TOP      3328
#define XB_TOPGEN   3392
#define XCD_BAR_WORDS 3456
#define XB_SPIN_CAP (1u << 18)

__device__ __forceinline__ unsigned xb_ld(unsigned* p)              { return __hip_atomic_load(p, __ATOMIC_RELAXED, __HIP_MEMORY_SCOPE_AGENT); }
__device__ __forceinline__ unsigned xb_add(unsigned* p, unsigned v) { return __hip_atomic_fetch_add(p, v, __ATOMIC_RELAXED, __HIP_MEMORY_SCOPE_AGENT); }
__device__ __forceinline__ unsigned xb_xcc_id() { return (unsigned)__builtin_amdgcn_s_getreg((3 << 11) | 20) & 0xFu; }
#define XB_SPIN(cond, bar) do { unsigned _sp = 0; while (cond) { __builtin_amdgcn_s_sleep(1); \
    if ((++_sp & 255u) == 0u) { if (xb_ld(&(bar)[XB_TMO])) break; if (_sp > XB_SPIN_CAP) { atomicAdd(&(bar)[XB_TMO], 1u); break; } } } } while (0)

struct XcdBarrier {
    unsigned* bar; unsigned x;
    volatile LAS unsigned* st;
};

__device__ __forceinline__ XcdBarrier xcd_barrier_post(unsigned* bar, volatile LAS unsigned* st) {
    XcdBarrier b; b.bar = bar; b.x = xb_xcc_id(); b.st = st;
    if (threadIdx.x == 0) (void)xb_add(&bar[XB_XCNT(b.x)], 1u);
    return b;
}
__device__ __forceinline__ void xcd_barrier_complete(unsigned* bar, unsigned x, unsigned& nloc, unsigned& nx) {
    const unsigned G = gridDim.x * gridDim.y * gridDim.z;
    unsigned sum, cnt, mine, sp = 0u;
    for (;;) {
        sum = 0u; cnt = 0u; mine = 0u;
#pragma unroll
        for (unsigned j = 0; j < 16; ++j) { const unsigned c = xb_ld(&bar[XB_XCNT(j)]); sum += c; cnt += (c > 0u) ? 1u : 0u; mine = (j == x) ? c : mine; }
        if (sum == G) break;
        __builtin_amdgcn_s_sleep(1);
        if ((++sp & 255u) == 0u) { if (xb_ld(&bar[XB_TMO])) break; if (sp > XB_SPIN_CAP) { atomicAdd(&bar[XB_TMO], 1u); break; } }
    }
    nloc = mine > 0u ? mine : 1u; nx = cnt > 0u ? cnt : 1u;
}

__device__ __forceinline__ void xcd_barrier(const XcdBarrier& b) {
    asm volatile("s_waitcnt vmcnt(0)" ::: "memory");
    __syncthreads();
    if (threadIdx.x == 0) {
        unsigned* bar = b.bar;
        __builtin_amdgcn_s_waitcnt(0);
        unsigned nloc = b.st[0], nx = b.st[1];
        if (nloc == 0u) { xcd_barrier_complete(bar, b.x, nloc, nx); b.st[0] = nloc; b.st[1] = nx; }
        const unsigned old = xb_add(&bar[XB_XSUB(b.x)], 1u);
        const unsigned gen = old / nloc;
        if (old + 1u == (gen + 1u) * nloc) {
            __builtin_amdgcn_fence(__ATOMIC_RELEASE, "agent");
            asm volatile("s_waitcnt vmcnt(0)" ::: "memory");
            const unsigned og = xb_add(&bar[XB_TOP], 1u);
            const unsigned tg = og / nx;
            if (og + 1u == (tg + 1u) * nx) xb_add(&bar[XB_TOPGEN], 1u);
            else XB_SPIN(xb_ld(&bar[XB_TOPGEN]) == tg, bar);
            __builtin_amdgcn_fence(__ATOMIC_ACQUIRE, "agent");
            xb_add(&bar[XB_XGEN(b.x)], 1u);
            asm volatile("s_waitcnt vmcnt(0)" ::: "memory");
        } else {
            XB_SPIN(xb_ld(&bar[XB_XGEN(b.x)]) == gen, bar);
            __builtin_amdgcn_fence(__ATOMIC_ACQUIRE, "agent");
            asm volatile("s_waitcnt vmcnt(0)" ::: "memory");
        }
    }
    __syncthreads();
}

__device__ __forceinline__ void p0_tr_item(const float* W, int ld, int K, int scol, bf16* WT, int drow, int k0, LAS float* scr, int lane) {
#pragma unroll 8
    for (int i = 0; i < 32; ++i) { const int kk = 2 * i + (lane >> 5); scr[kk * 33 + (lane & 31)] = W[(size_t)(k0 + kk) * ld + scol + (lane & 31)]; }
    asm volatile("s_waitcnt lgkmcnt(0)" ::: "memory");
    const int c = lane & 7;
#pragma unroll
    for (int j = 0; j < 4; ++j) { const int n = (lane >> 3) + 8 * j; const LAS float* s = scr + (8 * c) * 33 + n;
        v4u o; o.x = cvt_pk_bf16(s[0 * 33], s[1 * 33]); o.y = cvt_pk_bf16(s[2 * 33], s[3 * 33]); o.z = cvt_pk_bf16(s[4 * 33], s[5 * 33]); o.w = cvt_pk_bf16(s[6 * 33], s[7 * 33]);
        *(GAS v4u*)(WT + (size_t)(drow + n) * K + k0 + 8 * c) = o; }
    asm volatile("s_waitcnt lgkmcnt(0)" ::: "memory");
}
__device__ __forceinline__ void rms_row_to_bf16(const float* xrow, const float* gain, bf16* orow, int lane) {
    const GAS f32x4* xr = (const GAS f32x4*)xrow + lane; const GAS f32x4* gr = (const GAS f32x4*)gain + lane;
    f32x4 v[4]; float s = 0.f;
#pragma unroll
    for (int j = 0; j < 4; ++j) { v[j] = xr[64 * j]; s += (v[j].x * v[j].x + v[j].y * v[j].y) + (v[j].z * v[j].z + v[j].w * v[j].w); }
    const float rs = rsqrtf(wave_sum(s) * (1.f / D) + 1e-6f);
    GAS v2u* o8 = (GAS v2u*)orow + lane;
#pragma unroll
    for (int j = 0; j < 4; ++j) { const f32x4 g = gr[64 * j]; v2u w; w.x = cvt_pk_bf16(v[j].x * rs * g.x, v[j].y * rs * g.y); w.y = cvt_pk_bf16(v[j].z * rs * g.z, v[j].w * rs * g.w); o8[64 * j] = w; }
}

struct Ptrs {
    const float* in[24]; float* out; unsigned char* ws;
};

__device__ __forceinline__ void p0_prologue(const Ptrs& P, LAS unsigned char* lds, int G, int c, int wave, int lane) {
    LAS float* scr = (LAS float*)(lds + wave * 16384);
    const int gw = c * NWAVES + wave, NGW = G * NWAVES;
    const float* w_in = P.in[3];
    bf16* BTP1 = (bf16*)(P.ws + WS_BTP1);
    constexpr int I_QK = 16 * 96, I_VB = 16 * 144, I_BA = 16, I_Z = 16 * 32, I_A = 8 * 32, I_SQ = 16 * 32, I_PLE = 4 * 32, I_EG = 16 * 16 * 8, I_ED = 16 * 4 * 32;
    constexpr int NITEMS = I_QK + I_VB + I_BA + 3 * I_Z + I_A + 3 * I_SQ + I_PLE + 2 * I_EG + I_ED;
    for (int it = gw; it < NITEMS; it += NGW) {
        int r = it;
        if (r < I_QK) { const int kb = r / 96, nb = r % 96, n0 = 32 * nb, pn = n0 >> 8, w = n0 & 255, wc = w >> 6, bj = (w >> 5) & 1;
            p0_tr_item(w_in, IN_TOTAL, D, n0, BTP1, 256 * pn + 128 * bj + 32 * wc, 64 * kb, scr, lane); continue; } r -= I_QK;
        if (r < I_VB) { const int kb = r / 144, nb = r % 144, n0 = 3072 + 32 * nb; p0_tr_item(w_in, IN_TOTAL, D, n0, BTP1, n0, 64 * kb, scr, lane); continue; } r -= I_VB;
        if (r < I_BA) { p0_tr_item(w_in, IN_TOTAL, D, 8704, BTP1, 7680, 64 * r, scr, lane); continue; } r -= I_BA;
        if (r < I_Z) { const int kb = r / 32, nb = r % 32; p0_tr_item(w_in, IN_TOTAL, D, 7680 + 32 * nb, (bf16*)(P.ws + WS_BTZ), 32 * nb, 64 * kb, scr, lane); continue; } r -= I_Z;
        if (r < I_Z) { const int kb = r / 32, nb = r % 32; p0_tr_item(w_in, IN_TOTAL, D, 8720 + 32 * nb, (bf16*)(P.ws + WS_BTGA), 32 * nb, 64 * kb, scr, lane); continue; } r -= I_Z;
        if (r < I_Z) { const int kb = r / 32, nb = r % 32; p0_tr_item(w_in, IN_TOTAL, D, 9744 + 32 * nb, (bf16*)(P.ws + WS_BTGB), 32 * nb, 64 * kb, scr, lane); continue; } r -= I_Z;
        if (r < I_A) { const int kb = r / 32, nb = r % 32; p0_tr_item(P.in[10], D, 512, 32 * nb, (bf16*)(P.ws + WS_BTA), 32 * nb, 64 * kb, scr, lane); continue; } r -= I_A;
        if (r < I_SQ) { const int kb = r / 32, nb = r % 32; p0_tr_item(P.in[11], D, D, 32 * nb, (bf16*)(P.ws + WS_BTB), 32 * nb, 64 * kb, scr, lane); continue; } r -= I_SQ;
        if (r < I_SQ) { const int kb = r / 32, nb = r % 32; p0_tr_item(P.in[12], D, D, 32 * nb, (bf16*)(P.ws + WS_BTOUT), 32 * nb, 64 * kb, scr, lane); continue; } r -= I_SQ;
        if (r < I_SQ) { const int kb = r / 32, nb = r % 32; p0_tr_item(P.in[23], D, D, 32 * nb, (bf16*)(P.ws + WS_BTPG), 32 * nb, 64 * kb, scr, lane); continue; } r -= I_SQ;
        if (r < I_PLE) { const int kb = r / 32, nb = r % 32; p0_tr_item(P.in[22], D, 256, 32 * nb, (bf16*)(P.ws + WS_BTPLE), 32 * nb, 64 * kb, scr, lane); continue; } r -= I_PLE;
        if (r < I_EG) { const int e = r / 128, q = r % 128, kb = q / 8, nb = q % 8, f0 = 32 * nb;
            p0_tr_item(P.in[18] + (size_t)e * 1024 * 256, 256, D, f0, (bf16*)(P.ws + WS_BTGU) + (size_t)e * 512 * 1024, 256 * (f0 >> 7) + (f0 & 127), 64 * kb, scr, lane); continue; } r -= I_EG;
        if (r < I_EG) { const int e = r / 128, q = r % 128, kb = q / 8, nb = q % 8, f0 = 32 * nb;
            p0_tr_item(P.in[19] + (size_t)e * 1024 * 256, 256, D, f0, (bf16*)(P.ws + WS_BTGU) + (size_t)e * 512 * 1024, 256 * (f0 >> 7) + 128 + (f0 & 127), 64 * kb, scr, lane); continue; } r -= I_EG;
        { const int e = r / 128, q = r % 128, kb = q / 32, nb = q % 32;
            p0_tr_item(P.in[20] + (size_t)e * 256 * 1024, D, 256, 32 * nb, (bf16*)(P.ws + WS_BTDN) + (size_t)e * 1024 * 256, 32 * nb, 64 * kb, scr, lane); }
    }
    { GAS v4u* z = (GAS v4u*)(BTP1 + (size_t)7712 * D); const int nz = 224 * D / 8; for (int i = gw * 64 + lane; i < nz; i += NGW * 64) z[i] = (v4u){0u, 0u, 0u, 0u}; }
    bf16* H = (bf16*)((unsigned char*)P.out + DO_H);
    for (int m = gw; m < T; m += NGW) rms_row_to_bf16(P.in[0] + (size_t)m * D, P.in[2], H + (size_t)m * D, lane);
}

__device__ __forceinline__ void attn_phase(LAS unsigned char* lds, const bf16* QA, bf16* OG, float* LSE, int G, int c) {
    int tid_ = threadIdx.x; asm volatile("" : "+v"(tid_));
    const int tid = tid_, lane = tid & 63, wid = __builtin_amdgcn_readfirstlane(tid >> 6), l32 = lane & 31, hi = lane >> 5;
    LAS unsigned char* KS = lds; LAS unsigned char* VS = lds + 55296;
    for (int u = c; u < 6144; u += G) {
        const int b = u / 768; int rem = u % 768; int g, h, r, pr;
        if (rem < 256) { g = 0; h = rem >> 5; r = 0; pr = rem & 31; }
        else if (rem < 512) { rem -= 256; g = 1; h = rem >> 5; r = (rem & 31) >> 3; pr = rem & 7; }
        else { rem -= 512; g = 2; h = rem >> 5; r = (rem & 31) >> 1; pr = rem & 1; }
        const int dil = 1 << (2 * g);
        const size_t rowb = (size_t)b * SEQ;
        const bf16* Qg = QA + g * 512 + h * 64;
        __syncthreads();
#pragma unroll
        for (int k = 0; k < 6; ++k) {
            const int ci = tid + 512 * k, j = ci >> 3, ch = ci & 7, sidx = 256 * pr - 128 + j;
            v4u kv = (v4u){0u, 0u, 0u, 0u}, vv = (v4u){0u, 0u, 0u, 0u};
            if (sidx >= 0) { const bf16* p = Qg + (rowb + (size_t)(sidx * dil + r)) * pg8::QAP + ch * 8; kv = *(const GAS v4u*)(p + 1536); vv = *(const GAS v4u*)(p + 3072); }
            *(LAS v4u*)(KS + j * 144 + ch * 16) = kv; *(LAS v4u*)(VS + j * 144 + ch * 16) = vv;
        }
        const int qi = 32 * wid + l32; const size_t mq = rowb + (size_t)((256 * pr + qi) * dil + r);
        bf16x8 qf[4];
#pragma unroll
        for (int ks = 0; ks < 4; ++ks) qf[ks] = *(const GAS bf16x8*)(Qg + mq * pg8::QAP + 16 * ks + 8 * hi);
        __syncthreads();
        f32x16 sc[5];
#pragma unroll
        for (int kb = 0; kb < 5; ++kb) {
            const int jb = 32 * wid + 32 * kb; f32x16 a = {};
#pragma unroll
            for (int ks = 0; ks < 4; ++ks) { const bf16x8 kf = *(const LAS bf16x8*)(KS + (jb + l32) * 144 + (16 * ks + 8 * hi) * 2); a = MFMA32(kf, qf[ks], a); }
            sc[kb] = a;
        }
        const float NEG = -1e30f;
#pragma unroll
        for (int rr = 0; rr < 16; ++rr) { const int cc = crow(rr, hi); if (cc < l32) sc[0][rr] = NEG; if (cc > l32) sc[4][rr] = NEG; }
        if (pr == 0) {
#pragma unroll
            for (int kb = 0; kb < 4; ++kb) if (wid + kb < 4) {
#pragma unroll
                for (int rr = 0; rr < 16; ++rr) sc[kb][rr] = NEG; }
        }
        float mx = NEG;
#pragma unroll
        for (int kb = 0; kb < 5; ++kb)
#pragma unroll
            for (int rr = 0; rr < 16; ++rr) mx = fmaxf(mx, sc[kb][rr]);
        mx = fmaxf(mx, __shfl_xor(mx, 32));
        float l = 0.f;
#pragma unroll
        for (int kb = 0; kb < 5; ++kb)
#pragma unroll
            for (int rr = 0; rr < 16; ++rr) { const float p = __builtin_amdgcn_exp2f(sc[kb][rr] - mx); sc[kb][rr] = p; l += p; }
        l += __shfl_xor(l, 32);
        f32x16 o[2]; o[0] = f32x16{}; o[1] = f32x16{};
        const int traddr = ((lane & 15) >> 2) * 144 + (16 * ((lane >> 4) & 1) + 4 * (lane & 3)) * 2;
#pragma unroll
        for (int kb = 0; kb < 5; ++kb)
#pragma unroll
            for (int ks2 = 0; ks2 < 2; ++ks2) {
                v4u pw; pw.x = cvt_pk_bf16(sc[kb][8 * ks2 + 0], sc[kb][8 * ks2 + 1]); pw.y = cvt_pk_bf16(sc[kb][8 * ks2 + 2], sc[kb][8 * ks2 + 3]);
                pw.z = cvt_pk_bf16(sc[kb][8 * ks2 + 4], sc[kb][8 * ks2 + 5]); pw.w = cvt_pk_bf16(sc[kb][8 * ks2 + 6], sc[kb][8 * ks2 + 7]);
                const bf16x8 pf = __builtin_bit_cast(bf16x8, pw);
                const int kv0 = 32 * wid + 32 * kb + 16 * ks2 + 4 * hi;
#pragma unroll
                for (int db = 0; db < 2; ++db) {
                    const LAS unsigned char* vp = VS + kv0 * 144 + traddr + db * 64;
                    const s16x4 lo = ldtr(vp), h4 = ldtr(vp + 8 * 144);
                    const bf16x8 vf = (bf16x8){lo[0], lo[1], lo[2], lo[3], h4[0], h4[1], h4[2], h4[3]};
                    o[db] = MFMA32(vf, pf, o[db]);
                }
            }
        const float inv = 1.0f / l;
        bf16* orow = OG + mq * 1536 + g * 512 + h * 64;
#pragma unroll
        for (int db = 0; db < 2; ++db)
#pragma unroll
            for (int rq = 0; rq < 4; ++rq) { v2u w; w.x = cvt_pk_bf16(o[db][4 * rq] * inv, o[db][4 * rq + 1] * inv); w.y = cvt_pk_bf16(o[db][4 * rq + 2] * inv, o[db][4 * rq + 3] * inv);
                *(GAS v2u*)(orow + 32 * db + 8 * rq + 4 * hi) = w; }
        if (hi == 0) LSE[mq * 24 + g * 8 + h] = mx + __builtin_amdgcn_logf(l);
    }
}

constexpr int PREP_RAW_PITCH = 784;
__device__ __forceinline__ void prep_issue_raw(const bf16* QB, int u, int tid, v4u (&pf)[7]) {
    const int bh = u >> 7, n = u & 127, b = bh >> 3, h = bh & 7;
#pragma unroll
    for (int k = 0; k < 7; ++k) { const int q = tid + 512 * k, rr = q / 48, cc = q % 48, tt = 64 * n - 3 + rr;
        v4u v = (v4u){0u, 0u, 0u, 0u};
        if (q < 67 * 48 && tt >= 0) v = *(const GAS v4u*)(QB + ((size_t)b * SEQ + tt) * pg8::QBP + (cc >> 4) * 1024 + h * 128 + (cc & 15) * 8);
        pf[k] = v; }
}
__device__ __forceinline__ void prep_phase(LAS unsigned char* lds, const bf16* QB, const float* BG, const float* conv_w, unsigned char* DNP, float* DLB, int G, int c) {
    const int tid0 = threadIdx.x, wid = __builtin_amdgcn_readfirstlane(tid0 >> 6);
    LAS unsigned char* QS = lds; LAS unsigned char* KS = lds + 17408; LAS unsigned char* VS = lds + 34816;
    LAS float* AS = (LAS float*)(lds + 52224); LAS unsigned char* TS = lds + 69632; LAS unsigned char* AB = lds + 78848; LAS unsigned char* DT = lds + 88064;
    LAS float* gcT = (LAS float*)(lds + 104768); LAS float* btT = (LAS float*)(lds + 105024); LAS float* cwT = (LAS float*)(lds + 105280);
    LAS unsigned char* RAW = lds + 52224;
    v4u pf[7];
    if (c < 8192) prep_issue_raw(QB, c, tid0, pf);
    for (int u = c; u < 8192; u += G) {
        int tid = tid0; asm volatile("" : "+v"(tid));
        const int lane = tid & 63, l32 = lane & 31, hi = lane >> 5;
        const int bh = u >> 7, n = u & 127, b = bh >> 3, h = bh & 7; const size_t m0 = (size_t)b * SEQ + 64 * n;
        unsigned char* rec = DNP + (size_t)u * DNU;
        __syncthreads();
#pragma unroll
        for (int k = 0; k < 7; ++k) { const int q = tid + 512 * k; if (q < 67 * 48) *(LAS v4u*)(RAW + (q / 48) * PREP_RAW_PITCH + (q % 48) * 16) = pf[k]; }
        if (wid == 0) {
            float gv = BG[(m0 + lane) * 16 + 8 + h]; const float bv = BG[(m0 + lane) * 16 + h];
#pragma unroll
            for (int o = 1; o < 64; o <<= 1) { const float t = __shfl_up(gv, o); if (lane >= o) gv += t; }
            gcT[lane] = gv; btT[lane] = bv; if (lane == 63) DLB[u] = __expf(gv);
        }
        if (tid >= 64 && tid < 64 + 384) { const int t = tid - 64;
#pragma unroll
            for (int j = 0; j < 4; ++j) cwT[j * 384 + t] = conv_w[j * 3072 + (t >> 7) * 1024 + h * 128 + (t & 127)]; }
        __syncthreads();
        if (u + G < 8192) prep_issue_raw(QB, u + G, tid, pf);
#pragma unroll 2
        for (int it = 0; it < 6; ++it) {
            const int item = tid + 512 * it, ten = item >> 10, i = (item & 1023) >> 4, cg = item & 15;
            f32x4 y0 = {0.f, 0.f, 0.f, 0.f}, y1 = {0.f, 0.f, 0.f, 0.f};
#pragma unroll
            for (int j = 0; j < 4; ++j) { const v4u raw = *(const LAS v4u*)(RAW + (i + j) * PREP_RAW_PITCH + (ten * 16 + cg) * 16); f32x4 a, bb; unpack8(raw, a, bb);
                const f32x4 w0 = *(const LAS f32x4*)(cwT + j * 384 + ten * 128 + cg * 8), w1 = *(const LAS f32x4*)(cwT + j * 384 + ten * 128 + cg * 8 + 4); y0 += a * w0; y1 += bb * w1; }
#pragma unroll
            for (int e = 0; e < 4; ++e) { y0[e] = y0[e] * sigm(y0[e]); y1[e] = y1[e] * sigm(y1[e]); }
            float scl;
            if (ten < 2) { float ss = (y0[0] * y0[0] + y0[1] * y0[1]) + (y0[2] * y0[2] + y0[3] * y0[3]) + (y1[0] * y1[0] + y1[1] * y1[1]) + (y1[2] * y1[2] + y1[3] * y1[3]);
                ss += __shfl_xor(ss, 1); ss += __shfl_xor(ss, 2); ss += __shfl_xor(ss, 4); ss += __shfl_xor(ss, 8);
                scl = rsqrtf(ss + 1e-6f) * (ten == 0 ? 0.08838834764831845f : 1.0f); }
            else scl = btT[i];
            LAS unsigned char* dst = (ten == 0 ? QS : (ten == 1 ? KS : VS)) + i * 272 + cg * 16;
            *(LAS v4u*)dst = pack8(y0 * scl, y1 * scl);
        }
        __syncthreads();
        if (wid < 6) {
            const int kind = wid / 3, pi = wid % 3, ib = pi ? 1 : 0, jb = (pi == 2) ? 1 : 0;
            f32x16 a = {};
            if (kind == 0) {
#pragma unroll
                for (int ks = 0; ks < 8; ++ks) { const bf16x8 af = *(const LAS bf16x8*)(KS + (32 * ib + l32) * 272 + (16 * ks + 8 * hi) * 2), bf = *(const LAS bf16x8*)(KS + (32 * jb + l32) * 272 + (16 * ks + 8 * hi) * 2); a = MFMA32(af, bf, a); }
                const int j = 32 * jb + l32; const float gj = gcT[j];
#pragma unroll
                for (int rr = 0; rr < 16; ++rr) { const int i = 32 * ib + crow(rr, hi); const float v = (j < i) ? btT[i] * a[rr] * __expf(gcT[i] - gj) : 0.f; AS[i * 68 + j] = v; *(LAS unsigned short*)(AB + i * 144 + j * 2) = f2bf(v); }
            } else {
#pragma unroll
                for (int ks = 0; ks < 8; ++ks) { const bf16x8 af = *(const LAS bf16x8*)(KS + (32 * jb + l32) * 272 + (16 * ks + 8 * hi) * 2), bf = *(const LAS bf16x8*)(QS + (32 * ib + l32) * 272 + (16 * ks + 8 * hi) * 2); a = MFMA32(af, bf, a); }
                const int i = 32 * ib + l32; const float gi = gcT[i];
#pragma unroll
                for (int rr = 0; rr < 16; ++rr) { const int j = 32 * jb + crow(rr, hi); a[rr] = (j <= i) ? a[rr] * __expf(gi - gcT[j]) : 0.f; }
#pragma unroll
                for (int ks2 = 0; ks2 < 2; ++ks2) { v4u w; w.x = cvt_pk_bf16(a[8 * ks2], a[8 * ks2 + 1]); w.y = cvt_pk_bf16(a[8 * ks2 + 2], a[8 * ks2 + 3]); w.z = cvt_pk_bf16(a[8 * ks2 + 4], a[8 * ks2 + 5]); w.w = cvt_pk_bf16(a[8 * ks2 + 6], a[8 * ks2 + 7]);
                    *(GAS v4u*)(rec + 49152 + ((ib * 4 + 2 * jb + ks2) * 64 + lane) * 16) = w; }
            }
        }
        __syncthreads();
        if (wid == 0) {
            const int blk = lane >> 4, cc = lane & 15; const float fcc = (float)cc;
            float x[16];
#pragma unroll
            for (int i = 0; i < 16; ++i) {
                float a0 = fmaxf(0.f, 1.f - fabsf(fcc - (float)i)), a1 = 0.f;
#pragma unroll
                for (int j4 = 0; j4 < (i + 3) / 4; ++j4) { const f32x4 av = *(const LAS f32x4*)(AS + (16 * blk + i) * 68 + 16 * blk + 4 * j4);
                    if (4 * j4 + 0 < i) a0 -= av[0] * x[4 * j4 + 0]; if (4 * j4 + 1 < i) a1 -= av[1] * x[4 * j4 + 1];
                    if (4 * j4 + 2 < i) a0 -= av[2] * x[4 * j4 + 2]; if (4 * j4 + 3 < i) a1 -= av[3] * x[4 * j4 + 3]; }
                x[i] = a0 + a1;
            }
            {
                unsigned xp[8];
#pragma unroll
                for (int q = 0; q < 8; ++q) xp[q] = cvt_pk_bf16(x[2 * q], x[2 * q + 1]);
#pragma unroll
                for (int q = 0; q < 8; ++q) { v4u w = (v4u){0u, 0u, 0u, 0u};
                    if ((q >> 1) == blk) { if (q & 1) w = (v4u){xp[4], xp[5], xp[6], xp[7]}; else w = (v4u){xp[0], xp[1], xp[2], xp[3]}; }
                    *(LAS v4u*)(DT + lane * 144 + q * 16) = w; }
#pragma unroll
                for (int m = 0; m < 64; ++m) { const int i = m & 15; float v = 0.f;
                    if ((m >> 4) == blk) v = x[i];
                    *(LAS unsigned short*)(TS + m * 144 + lane * 2) = f2bf(v); }
            }
            f32x16 Dp[2];
#pragma unroll
            for (int p = 0; p < 2; ++p) {
                bf16x8 af = *(const LAS bf16x8*)(AB + (32 * p + l32) * 144 + (32 * p + 8 * hi) * 2); if (l32 < 16) af = (bf16x8){0, 0, 0, 0, 0, 0, 0, 0};
                const bf16x8 bfr = *(const LAS bf16x8*)(DT + (32 * p + l32) * 144 + (32 * p + 8 * hi) * 2);
                f32x16 Y = {}; Y = MFMA32(af, bfr, Y);
                v4u yw; yw.x = cvt_pk_bf16(Y[8], Y[9]); yw.y = cvt_pk_bf16(Y[10], Y[11]); yw.z = cvt_pk_bf16(Y[12], Y[13]); yw.w = cvt_pk_bf16(Y[14], Y[15]);
                const v2u d0 = *(const LAS v2u*)(TS + (32 * p + l32) * 144 + (32 * p + 16 + 4 * hi) * 2), d1 = *(const LAS v2u*)(TS + (32 * p + l32) * 144 + (32 * p + 24 + 4 * hi) * 2);
                const v4u dw = (v4u){d0.x, d0.y, d1.x, d1.y};
                f32x16 Z = {}; Z = MFMA32(__builtin_bit_cast(bf16x8, dw), __builtin_bit_cast(bf16x8, yw), Z);
#pragma unroll
                for (int rq = 0; rq < 4; ++rq) { const v2u g = *(const LAS v2u*)(DT + (32 * p + l32) * 144 + (32 * p + 8 * rq + 4 * hi) * 2);
                    Z[4 * rq + 0] = bflo(g.x) - Z[4 * rq + 0]; Z[4 * rq + 1] = bfhi(g.x) - Z[4 * rq + 1]; Z[4 * rq + 2] = bflo(g.y) - Z[4 * rq + 2]; Z[4 * rq + 3] = bfhi(g.y) - Z[4 * rq + 3]; }
                Dp[p] = Z;
#pragma unroll
                for (int r = 0; r < 16; ++r) *(LAS unsigned short*)(TS + (32 * p + crow(r, hi)) * 144 + (32 * p + l32) * 2) = f2bf(Z[r]);
            }
            {
                f32x16 Y = {};
#pragma unroll
                for (int ks = 0; ks < 2; ++ks) {
                    const v2u a0 = *(const LAS v2u*)(AB + (32 + l32) * 144 + (16 * ks + 4 * hi) * 2), a1 = *(const LAS v2u*)(AB + (32 + l32) * 144 + (16 * ks + 8 + 4 * hi) * 2);
                    const v4u aw = (v4u){a0.x, a0.y, a1.x, a1.y};
                    v4u bw; bw.x = cvt_pk_bf16(Dp[0][8 * ks + 0], Dp[0][8 * ks + 1]); bw.y = cvt_pk_bf16(Dp[0][8 * ks + 2], Dp[0][8 * ks + 3]); bw.z = cvt_pk_bf16(Dp[0][8 * ks + 4], Dp[0][8 * ks + 5]); bw.w = cvt_pk_bf16(Dp[0][8 * ks + 6], Dp[0][8 * ks + 7]);
                    Y = MFMA32(__builtin_bit_cast(bf16x8, aw), __builtin_bit_cast(bf16x8, bw), Y);
                }
                f32x16 L = {};
#pragma unroll
                for (int ks = 0; ks < 2; ++ks) {
                    const v2u a0 = *(const LAS v2u*)(TS + (32 + l32) * 144 + (32 + 16 * ks + 4 * hi) * 2), a1 = *(const LAS v2u*)(TS + (32 + l32) * 144 + (32 + 16 * ks + 8 + 4 * hi) * 2);
                    const v4u aw = (v4u){a0.x, a0.y, a1.x, a1.y};
                    v4u bw; bw.x = cvt_pk_bf16(Y[8 * ks + 0], Y[8 * ks + 1]); bw.y = cvt_pk_bf16(Y[8 * ks + 2], Y[8 * ks + 3]); bw.z = cvt_pk_bf16(Y[8 * ks + 4], Y[8 * ks + 5]); bw.w = cvt_pk_bf16(Y[8 * ks + 6], Y[8 * ks + 7]);
                    L = MFMA32(__builtin_bit_cast(bf16x8, aw), __builtin_bit_cast(bf16x8, bw), L);
                }
#pragma unroll
                for (int r = 0; r < 16; ++r) *(LAS unsigned short*)(TS + (32 + crow(r, hi)) * 144 + l32 * 2) = f2bf(-L[r]);
            }
        } else {
            const float glast = gcT[63];
            for (int f = wid - 1; f < 32; f += 7) {
                if (f < 16) { const int ib = f >> 3, ks = f & 7, i = 32 * ib + l32; const float eg = __expf(gcT[i]);
                    const v2u lo = *(const LAS v2u*)(QS + i * 272 + (16 * ks + 4 * hi) * 2), h2 = *(const LAS v2u*)(QS + i * 272 + (16 * ks + 8 + 4 * hi) * 2);
                    v4u w; w.x = cvt_pk_bf16(bflo(lo.x) * eg, bfhi(lo.x) * eg); w.y = cvt_pk_bf16(bflo(lo.y) * eg, bfhi(lo.y) * eg); w.z = cvt_pk_bf16(bflo(h2.x) * eg, bfhi(h2.x) * eg); w.w = cvt_pk_bf16(bflo(h2.y) * eg, bfhi(h2.y) * eg);
                    *(GAS v4u*)(rec + 16384 + ((ib * 8 + ks) * 64 + lane) * 16) = w;
                } else { const int dkb = (f - 16) >> 2, ksj = (f - 16) & 3, dk = 32 * dkb + l32; float v[8];
#pragma unroll
                    for (int jj = 0; jj < 8; ++jj) { const int j = 16 * ksj + 4 * hi + (jj & 3) + 8 * (jj >> 2); v[jj] = bf2f(*(const LAS unsigned short*)(KS + j * 272 + dk * 2)) * __expf(glast - gcT[j]); }
                    v4u w; w.x = cvt_pk_bf16(v[0], v[1]); w.y = cvt_pk_bf16(v[2], v[3]); w.z = cvt_pk_bf16(v[4], v[5]); w.w = cvt_pk_bf16(v[6], v[7]);
                    *(GAS v4u*)(rec + 32768 + ((dkb * 4 + ksj) * 64 + lane) * 16) = w; }
            }
        }
        __syncthreads();
        {
            const int eb = wid & 3, ib = wid >> 2; f32x16 a = {};
            for (int ks = 0; ks < (ib ? 4 : 2); ++ks) {
                const bf16x8 tf = *(const LAS bf16x8*)(TS + (32 * ib + l32) * 144 + (16 * ks + 8 * hi) * 2);
                bf16x8 vf;
#pragma unroll
                for (int jj = 0; jj < 8; ++jj) vf[jj] = (short)*(const LAS unsigned short*)(VS + (16 * ks + 8 * hi + jj) * 272 + (32 * eb + l32) * 2);
                a = MFMA32(tf, vf, a);
#ifdef DBG_PREPCHK
                { bool b0 = false, b1 = false; for (int jj = 0; jj < 8; ++jj) { if ((((unsigned short)tf[jj]) & 0x7f80u) == 0x7f80u) b0 = true; if ((((unsigned short)vf[jj]) & 0x7f80u) == 0x7f80u) b1 = true; }
                  if (b0 || b1) atomicAnd(DBGW, ~1u); }
#endif
            }
#ifdef DBG_PREPCHK
            { bool b2 = false; for (int r = 0; r < 16; ++r) if (!(a[r] - a[r] == 0.f)) b2 = true; if (b2) atomicAnd(DBGW, ~4u); }
#endif
            v4u w0, w1; w0.x = cvt_pk_bf16(a[0], a[1]); w0.y = cvt_pk_bf16(a[2], a[3]); w0.z = cvt_pk_bf16(a[4], a[5]); w0.w = cvt_pk_bf16(a[6], a[7]);
            w1.x = cvt_pk_bf16(a[8], a[9]); w1.y = cvt_pk_bf16(a[10], a[11]); w1.z = cvt_pk_bf16(a[12], a[13]); w1.w = cvt_pk_bf16(a[14], a[15]);
            GAS v4u* up = (GAS v4u*)(rec + 57344 + ((eb * 2 + ib) * 64 + lane) * 32); up[0] = w0; up[1] = w1;
#ifdef DBG_PREPCHK
            { bool bb = false; const unsigned ww[8] = {w0.x, w0.y, w0.z, w0.w, w1.x, w1.y, w1.z, w1.w}; for (int k = 0; k < 8; ++k) if ((ww[k] & 0x7f80u) == 0x7f80u || (ww[k] & 0x7f800000u) == 0x7f800000u) bb = true;
              if (bb) atomicAnd(DBGW, ~2u); if (u == 5 && tid == 0) atomicAnd(DBGW, ~8u); }
#endif
        }
        __syncthreads();
        { const int i = tid >> 3, c8 = tid & 7; const float s = btT[i] * __expf(gcT[i]);
#pragma unroll
            for (int q = 0; q < 2; ++q) { const v4u kw = *(const LAS v4u*)(KS + i * 272 + c8 * 32 + q * 16); f32x4 a, bb; unpack8(kw, a, bb); *(LAS v4u*)(VS + i * 272 + c8 * 32 + q * 16) = pack8(a * s, bb * s); } }
        __syncthreads();
        {
            const int dkb = wid & 3, ib = wid >> 2; f32x16 a = {};
            for (int ks = 0; ks < (ib ? 4 : 2); ++ks) {
                bf16x8 kf;
#pragma unroll
                for (int jj = 0; jj < 8; ++jj) kf[jj] = (short)*(const LAS unsigned short*)(VS + (16 * ks + 8 * hi + jj) * 272 + (32 * dkb + l32) * 2);
                const bf16x8 tf = *(const LAS bf16x8*)(TS + (32 * ib + l32) * 144 + (16 * ks + 8 * hi) * 2);
                a = MFMA32(kf, tf, a);
#ifdef DBG_PREPCHK
                { bool b3 = false; for (int jj = 0; jj < 8; ++jj) if ((((unsigned short)kf[jj]) & 0x7f80u) == 0x7f80u) b3 = true; if (b3) atomicAnd(DBGW, ~1u); }
#endif
            }
#ifdef DBG_PREPCHK
            { bool b4 = false; for (int r = 0; r < 16; ++r) if (!(a[r] - a[r] == 0.f)) b4 = true; if (b4) atomicAnd(DBGW, ~16u); }
#endif
#pragma unroll
            for (int ks2 = 0; ks2 < 2; ++ks2) { v4u w; w.x = cvt_pk_bf16(a[8 * ks2], a[8 * ks2 + 1]); w.y = cvt_pk_bf16(a[8 * ks2 + 2], a[8 * ks2 + 3]); w.z = cvt_pk_bf16(a[8 * ks2 + 4], a[8 * ks2 + 5]); w.w = cvt_pk_bf16(a[8 * ks2 + 6], a[8 * ks2 + 7]);
                *(GAS v4u*)(rec + ((ib * 8 + 2 * dkb + ks2) * 64 + lane) * 16) = w; }
        }
    }
}

__device__ __forceinline__ void scan_chain(LAS unsigned char* lds, const unsigned char* DNP, const float* DLB, bf16* ON, const float* dn_gain, int bh) {
    int tid_ = threadIdx.x; asm volatile("" : "+v"(tid_));
    const int tid = tid_, lane = tid & 63, wid = __builtin_amdgcn_readfirstlane(tid >> 6), l32 = lane & 31, hi = lane >> 5;
    LAS unsigned char* OT = lds + 114688; LAS float* GT = (LAS float*)(lds + 132096);
    const int b = bh >> 3, h = bh & 7; const size_t u0 = (size_t)bh * 128;
    __syncthreads();
    if (tid < 128) GT[tid] = dn_gain[tid];
    const int lt = tid - 256;
    if (wid >= 4) { const GAS v4u* src = (const GAS v4u*)(DNP + u0 * DNU);
#pragma unroll
        for (int k = 0; k < 14; ++k) *(LAS v4u*)(lds + (lt + 256 * k) * 16) = src[lt + 256 * k]; }
    f32x16 S[4]; S[0] = f32x16{}; S[1] = f32x16{}; S[2] = f32x16{}; S[3] = f32x16{};
    __syncthreads();
#pragma unroll 1
    for (int n = 0; n < 128; ++n) {
        const LAS unsigned char* Pb = lds + (n & 1) * 57344;
        f32x16 O0 = {}, O1 = {};
        if (wid < 4) {
            v4u uc[4]; float dl;
            { const GAS v4u* up = (const GAS v4u*)(DNP + (u0 + n) * DNU + 57344 + (wid * 2 * 64 + lane) * 32);
              uc[0] = up[0]; uc[1] = up[1]; uc[2] = up[128]; uc[3] = up[129]; dl = DLB[u0 + n]; }
            bf16x8 vb[4];
            {
                f32x16 W0 = {}, W1 = {};
#pragma unroll
                for (int ks = 0; ks < 8; ++ks) {
                    const int dkb = ks >> 1, o8 = 8 * (ks & 1);
                    v4u sw; sw.x = cvt_pk_bf16(S[dkb][o8 + 0], S[dkb][o8 + 1]); sw.y = cvt_pk_bf16(S[dkb][o8 + 2], S[dkb][o8 + 3]); sw.z = cvt_pk_bf16(S[dkb][o8 + 4], S[dkb][o8 + 5]); sw.w = cvt_pk_bf16(S[dkb][o8 + 6], S[dkb][o8 + 7]);
                    const bf16x8 sb = __builtin_bit_cast(bf16x8, sw);
                    const bf16x8 w0 = *(const LAS bf16x8*)(Pb + ((0 * 8 + ks) * 64 + lane) * 16), w1 = *(const LAS bf16x8*)(Pb + ((1 * 8 + ks) * 64 + lane) * 16);
                    W0 = MFMA32(w0, sb, W0); W1 = MFMA32(w1, sb, W1);
                    __builtin_amdgcn_sched_barrier(0);
                }
                float v[16];
#pragma unroll
                for (int q = 0; q < 2; ++q) { const v4u w = uc[q];
                    v[8 * q + 0] = bflo(w.x); v[8 * q + 1] = bfhi(w.x); v[8 * q + 2] = bflo(w.y); v[8 * q + 3] = bfhi(w.y); v[8 * q + 4] = bflo(w.z); v[8 * q + 5] = bfhi(w.z); v[8 * q + 6] = bflo(w.w); v[8 * q + 7] = bfhi(w.w); }
#pragma unroll
                for (int r = 0; r < 16; ++r) v[r] -= W0[r];
#pragma unroll
                for (int ks2 = 0; ks2 < 2; ++ks2) { v4u w; w.x = cvt_pk_bf16(v[8 * ks2], v[8 * ks2 + 1]); w.y = cvt_pk_bf16(v[8 * ks2 + 2], v[8 * ks2 + 3]); w.z = cvt_pk_bf16(v[8 * ks2 + 4], v[8 * ks2 + 5]); w.w = cvt_pk_bf16(v[8 * ks2 + 6], v[8 * ks2 + 7]); vb[ks2] = __builtin_bit_cast(bf16x8, w); }
#pragma unroll
                for (int q = 0; q < 2; ++q) { const v4u w = uc[2 + q];
                    v[8 * q + 0] = bflo(w.x); v[8 * q + 1] = bfhi(w.x); v[8 * q + 2] = bflo(w.y); v[8 * q + 3] = bfhi(w.y); v[8 * q + 4] = bflo(w.z); v[8 * q + 5] = bfhi(w.z); v[8 * q + 6] = bflo(w.w); v[8 * q + 7] = bfhi(w.w); }
#pragma unroll
                for (int r = 0; r < 16; ++r) v[r] -= W1[r];
#pragma unroll
                for (int ks2 = 0; ks2 < 2; ++ks2) { v4u w; w.x = cvt_pk_bf16(v[8 * ks2], v[8 * ks2 + 1]); w.y = cvt_pk_bf16(v[8 * ks2 + 2], v[8 * ks2 + 3]); w.z = cvt_pk_bf16(v[8 * ks2 + 4], v[8 * ks2 + 5]); w.w = cvt_pk_bf16(v[8 * ks2 + 6], v[8 * ks2 + 7]); vb[2 + ks2] = __builtin_bit_cast(bf16x8, w); }
            }
            __builtin_amdgcn_sched_barrier(0);
#pragma unroll
            for (int ks = 0; ks < 8; ++ks) {
                const int dkb = ks >> 1, o8 = 8 * (ks & 1);
                v4u sw; sw.x = cvt_pk_bf16(S[dkb][o8 + 0], S[dkb][o8 + 1]); sw.y = cvt_pk_bf16(S[dkb][o8 + 2], S[dkb][o8 + 3]); sw.z = cvt_pk_bf16(S[dkb][o8 + 4], S[dkb][o8 + 5]); sw.w = cvt_pk_bf16(S[dkb][o8 + 6], S[dkb][o8 + 7]);
                const bf16x8 sb = __builtin_bit_cast(bf16x8, sw);
                const bf16x8 q0 = *(const LAS bf16x8*)(Pb + 16384 + ((0 * 8 + ks) * 64 + lane) * 16), q1 = *(const LAS bf16x8*)(Pb + 16384 + ((1 * 8 + ks) * 64 + lane) * 16);
                O0 = MFMA32(q0, sb, O0); O1 = MFMA32(q1, sb, O1);
                __builtin_amdgcn_sched_barrier(0);
            }
#pragma unroll
            for (int ksj = 0; ksj < 2; ++ksj) { const bf16x8 af = *(const LAS bf16x8*)(Pb + 49152 + ((0 * 4 + ksj) * 64 + lane) * 16); O0 = MFMA32(af, vb[ksj], O0); }
#pragma unroll
            for (int ksj = 0; ksj < 4; ++ksj) { const bf16x8 af = *(const LAS bf16x8*)(Pb + 49152 + ((1 * 4 + ksj) * 64 + lane) * 16); O1 = MFMA32(af, vb[ksj], O1); }
#pragma unroll
            for (int dkb = 0; dkb < 4; ++dkb) {
#pragma unroll
                for (int r = 0; r < 16; ++r) S[dkb][r] *= dl;
#pragma unroll
                for (int ksj = 0; ksj < 4; ++ksj) { const bf16x8 kf = *(const LAS bf16x8*)(Pb + 32768 + ((dkb * 4 + ksj) * 64 + lane) * 16); S[dkb] = MFMA32(kf, vb[ksj], S[dkb]); }
            }
        } else {
            if (n > 0) {
                const int i = lt >> 2, qd = lt & 3; f32x4 v[8]; float ss = 0.f;
#pragma unroll
                for (int k = 0; k < 4; ++k) { const v4u w = *(const LAS v4u*)(OT + i * 272 + qd * 64 + k * 16); unpack8(w, v[2 * k], v[2 * k + 1]); }
#pragma unroll
                for (int k = 0; k < 8; ++k) ss += (v[k][0] * v[k][0] + v[k][1] * v[k][1]) + (v[k][2] * v[k][2] + v[k][3] * v[k][3]);
                ss += __shfl_xor(ss, 1); ss += __shfl_xor(ss, 2);
                const float rs = rsqrtf(ss * (1.0f / 128.0f) + 1e-6f);
                bf16* dst = ON + ((size_t)b * SEQ + 64 * (n - 1) + i) * 1024 + h * 128 + qd * 32;
#pragma unroll
                for (int k = 0; k < 4; ++k) { const f32x4 g0 = *(const LAS f32x4*)(GT + qd * 32 + 8 * k), g1 = *(const LAS f32x4*)(GT + qd * 32 + 8 * k + 4); *(GAS v4u*)(dst + 8 * k) = pack8(v[2 * k] * rs * g0, v[2 * k + 1] * rs * g1); }
            }
            if (n + 1 < 128) { const GAS v4u* src = (const GAS v4u*)(DNP + (u0 + n + 1) * DNU); LAS unsigned char* Pn = lds + ((n + 1) & 1) * 57344;
#pragma unroll
                for (int k = 0; k < 14; ++k) *(LAS v4u*)(Pn + (lt + 256 * k) * 16) = src[lt + 256 * k]; }
        }
        __syncthreads();
        if (wid < 4) {
#pragma unroll
            for (int r = 0; r < 16; ++r) { *(LAS unsigned short*)(OT + (crow(r, hi)) * 272 + (32 * wid + l32) * 2) = f2bf(O0[r]); *(LAS unsigned short*)(OT + (32 + crow(r, hi)) * 272 + (32 * wid + l32) * 2) = f2bf(O1[r]); }
        }
        __syncthreads();
    }
    if (wid >= 4) {
        const int i = lt >> 2, qd = lt & 3; f32x4 v[8]; float ss = 0.f;
#pragma unroll
        for (int k = 0; k < 4; ++k) { const v4u w = *(const LAS v4u*)(OT + i * 272 + qd * 64 + k * 16); unpack8(w, v[2 * k], v[2 * k + 1]); }
#pragma unroll
        for (int k = 0; k < 8; ++k) ss += (v[k][0] * v[k][0] + v[k][1] * v[k][1]) + (v[k][2] * v[k][2] + v[k][3] * v[k][3]);
        ss += __shfl_xor(ss, 1); ss += __shfl_xor(ss, 2);
        const float rs = rsqrtf(ss * (1.0f / 128.0f) + 1e-6f);
        bf16* dst = ON + ((size_t)b * SEQ + 64 * 127 + i) * 1024 + h * 128 + qd * 32;
#pragma unroll
        for (int k = 0; k < 4; ++k) { const f32x4 g0 = *(const LAS f32x4*)(GT + qd * 32 + 8 * k), g1 = *(const LAS f32x4*)(GT + qd * 32 + 8 * k + 4); *(GAS v4u*)(dst + 8 * k) = pack8(v[2 * k] * rs * g0, v[2 * k + 1] * rs * g1); }
    }
}
__device__ __forceinline__ void combine_rows(const Ptrs& P, int first, int stride, int lane) {
    const bf16* OG = (const bf16*)((const unsigned char*)P.out + DO_OG); const float* LSE = (const float*)((const unsigned char*)P.out + DO_LSE);
    bf16* OA = (bf16*)(P.ws + WS_OA); bf16* HR = (bf16*)(P.ws + WS_HR);
    for (int m = first; m < T; m += stride) {
        const int hd = lane >> 3; const float l0 = LSE[(size_t)m * 24 + hd], l1 = LSE[(size_t)m * 24 + 8 + hd], l2 = LSE[(size_t)m * 24 + 16 + hd];
        const float mx = fmaxf(l0, fmaxf(l1, l2)); float w0 = __builtin_amdgcn_exp2f(l0 - mx), w1 = __builtin_amdgcn_exp2f(l1 - mx), w2 = __builtin_amdgcn_exp2f(l2 - mx);
        const float inv = 1.0f / (w0 + w1 + w2); w0 *= inv; w1 *= inv; w2 *= inv;
        const bf16* og = OG + (size_t)m * 1536 + lane * 8;
        f32x4 a0, b0, a1, b1, a2, b2; unpack8(*(const GAS v4u*)og, a0, b0); unpack8(*(const GAS v4u*)(og + 512), a1, b1); unpack8(*(const GAS v4u*)(og + 1024), a2, b2);
        *(GAS v4u*)(OA + (size_t)m * 512 + lane * 8) = pack8(a0 * w0 + a1 * w1 + a2 * w2, b0 * w0 + b1 * w1 + b2 * w2);
        rms_row_to_bf16(P.in[0] + (size_t)m * D, P.in[2], HR + (size_t)m * D, lane);
    }
}

__device__ __forceinline__ void router_phase(const Ptrs& P, LAS unsigned char* lds, int G, int c, int wave, int lane) {
    LAS float* WrT = (LAS float*)lds;
    const float* x1 = P.out; bf16* H2 = (bf16*)(P.ws + WS_H2); int4* TOK = (int4*)(P.ws + WS_TOK); unsigned* cnt = (unsigned*)(P.ws + WS_CTL) + CW_CNT;
    __syncthreads();
    for (int i = threadIdx.x; i < 1024 * 4; i += 512) { const int k = i >> 2, cc = i & 3; WrT[cc * 1024 + k] = P.in[14][i]; }
    for (int i = threadIdx.x; i < 1024 * 16; i += 512) { const int k = i >> 4, cc = i & 15; WrT[(4 + cc) * 1024 + k] = P.in[16][i]; }
    __syncthreads();
    const GAS f32x4* gr = (const GAS f32x4*)P.in[13] + lane; f32x4 gn[4];
#pragma unroll
    for (int j = 0; j < 4; ++j) gn[j] = gr[64 * j];
    float bias[20];
#pragma unroll
    for (int q = 0; q < 4; ++q) bias[q] = P.in[15][q];
#pragma unroll
    for (int q = 0; q < 16; ++q) bias[4 + q] = P.in[17][q];
    unsigned mycnt = 0;
    const int gw = c * NWAVES + wave, NGW = G * NWAVES;
    for (int m = gw; m < T; m += NGW) {
        asm volatile("" ::: "memory");
        const GAS f32x4* xr = (const GAS f32x4*)(x1 + (size_t)m * D) + lane; f32x4 v[4]; float s = 0.f;
#pragma unroll
        for (int j = 0; j < 4; ++j) { v[j] = xr[64 * j]; s += (v[j].x * v[j].x + v[j].y * v[j].y) + (v[j].z * v[j].z + v[j].w * v[j].w); }
        const float rs = rsqrtf(wave_sum(s) * (1.f / D) + 1e-6f);
        GAS v2u* o8 = (GAS v2u*)(H2 + (size_t)m * D) + lane;
#pragma unroll
        for (int j = 0; j < 4; ++j) { v[j] = v[j] * rs * gn[j]; v2u w; w.x = cvt_pk_bf16(v[j].x, v[j].y); w.y = cvt_pk_bf16(v[j].z, v[j].w); o8[64 * j] = w; }
        float lg[20];
#pragma unroll
        for (int q = 0; q < 20; ++q) { float a = 0.f;
#pragma unroll
            for (int j = 0; j < 4; ++j) { const f32x4 w = *(const LAS f32x4*)(WrT + q * 1024 + 4 * lane + 256 * j); a += (v[j].x * w.x + v[j].y * w.y) + (v[j].z * w.z + v[j].w * w.w); }
            lg[q] = wave_sum(a) + bias[q]; }
        int gi = 0; float gm = lg[0];
#pragma unroll
        for (int q = 1; q < 4; ++q) if (lg[q] > gm) { gm = lg[q]; gi = q; }
        float gs = 0.f;
#pragma unroll
        for (int q = 0; q < 4; ++q) gs += __expf(lg[q] - gm);
        const float pg = 1.0f / gs;
        float sl[4];
#pragma unroll
        for (int q = 0; q < 4; ++q) sl[q] = gi == 0 ? lg[4 + q] : (gi == 1 ? lg[8 + q] : (gi == 2 ? lg[12 + q] : lg[16 + q]));
        int i0 = 0; float m0 = sl[0];
#pragma unroll
        for (int q = 1; q < 4; ++q) if (sl[q] > m0) { m0 = sl[q]; i0 = q; }
        int i1 = -1; float m1 = -3.0e38f;
#pragma unroll
        for (int q = 0; q < 4; ++q) if (q != i0 && sl[q] > m1) { m1 = sl[q]; i1 = q; }
        const float e1 = __expf(m1 - m0); const float w0 = 1.0f / (1.0f + e1), w1 = e1 * w0;
        const int ex0 = 4 * gi + i0, ex1 = 4 * gi + i1;
        if (lane == 0) TOK[m] = make_int4(ex0, ex1, __float_as_int(pg * w0), __float_as_int(pg * w1));
        mycnt += (lane == ex0 ? 1u : 0u) + (lane == ex1 ? 1u : 0u);
    }
    if (lane < 16 && mycnt) atomicAdd(&cnt[lane], mycnt);
}

__device__ __forceinline__ void place_phase(const Ptrs& P, int G, int c, int wave, int lane) {
    const bf16* H2 = (const bf16*)(P.ws + WS_H2); bf16* HX = (bf16*)(P.ws + WS_HX); const int4* TOK = (const int4*)(P.ws + WS_TOK); int2* SLOT = (int2*)(P.ws + WS_SLOT); float* CWv = (float*)(P.ws + WS_CW);
    const unsigned* cnt = (const unsigned*)(P.ws + WS_CTL) + CW_CNT; unsigned* cur = (unsigned*)(P.ws + WS_CTL) + CW_CUR;
    int sbase = 0; { int acc = 0; for (int e = 0; e < 16; ++e) { if (e == lane) sbase = acc; acc += (int)((cnt[e] + 255u) >> 8) * 256; } }
    const int gw = c * NWAVES + wave, NGW = G * NWAVES;
    for (int bt = gw; bt < T / 64; bt += NGW) {
        const int m = bt * 64 + lane; const int4 tk = TOK[m];
        int p0 = 0, p1 = 0;
#pragma unroll 1
        for (int e = 0; e < 16; ++e) {
            const unsigned long long k0 = __ballot(tk.x == e), k1 = __ballot(tk.y == e);
            const int n0 = __popcll(k0), n1 = __popcll(k1);
            unsigned base = 0; if (lane == 0 && (n0 + n1)) base = atomicAdd(&cur[e], (unsigned)(n0 + n1));
            base = __shfl(base, 0); const int sb = __shfl(sbase, e);
            const unsigned long long lt = (1ull << lane) - 1ull;
            if (tk.x == e) p0 = sb + (int)base + __popcll(k0 & lt);
            if (tk.y == e) p1 = sb + (int)base + n0 + __popcll(k1 & lt);
        }
        SLOT[m] = make_int2(p0, p1); CWv[p0] = __int_as_float(tk.z); CWv[p1] = __int_as_float(tk.w);
#pragma unroll 1
        for (int k = 0; k < 64; ++k) {
            const int q0 = __shfl(p0, k), q1 = __shfl(p1, k); const size_t mk = (size_t)bt * 64 + k;
            const GAS v4u* src = (const GAS v4u*)(H2 + mk * D) + lane; const v4u a = src[0], bq = src[64];
            GAS v4u* d0 = (GAS v4u*)(HX + (size_t)q0 * D) + lane; GAS v4u* d1 = (GAS v4u*)(HX + (size_t)q1 * D) + lane;
            d0[0] = a; d0[64] = bq; d1[0] = a; d1[64] = bq;
        }
    }
}

__device__ __forceinline__ void ple_norm_phase(const Ptrs& P, int G, int c, int wave, int lane) {
    float* xo = P.out; const bf16* Y = (const bf16*)(P.ws + WS_Y); const int2* SLOT = (const int2*)(P.ws + WS_SLOT); bf16* H3 = (bf16*)(P.ws + WS_H3); bf16* PB = (bf16*)(P.ws + WS_PB);
    const GAS f32x4* gr = (const GAS f32x4*)P.in[21] + lane; f32x4 gn[4];
#pragma unroll
    for (int j = 0; j < 4; ++j) gn[j] = gr[64 * j];
    const int gw = c * NWAVES + wave, NGW = G * NWAVES;
    for (int m = gw; m < T; m += NGW) {
        const int2 sl = SLOT[m];
        GAS f32x4* xr = (GAS f32x4*)(xo + (size_t)m * D) + lane; const GAS v2u* y0 = (const GAS v2u*)(Y + (size_t)sl.x * D) + lane; const GAS v2u* y1 = (const GAS v2u*)(Y + (size_t)sl.y * D) + lane;
        f32x4 v[4]; float s = 0.f;
#pragma unroll
        for (int j = 0; j < 4; ++j) { const v2u a = y0[64 * j], bq = y1[64 * j]; v[j] = xr[64 * j];
            v[j].x += bflo(a.x) + bflo(bq.x); v[j].y += bfhi(a.x) + bfhi(bq.x); v[j].z += bflo(a.y) + bflo(bq.y); v[j].w += bfhi(a.y) + bfhi(bq.y);
            xr[64 * j] = v[j]; s += (v[j].x * v[j].x + v[j].y * v[j].y) + (v[j].z * v[j].z + v[j].w * v[j].w); }
        const float rs = rsqrtf(wave_sum(s) * (1.f / D) + 1e-6f);
        GAS v2u* o8 = (GAS v2u*)(H3 + (size_t)m * D) + lane;
#pragma unroll
        for (int j = 0; j < 4; ++j) { v2u w; w.x = cvt_pk_bf16(v[j].x * rs * gn[j].x, v[j].y * rs * gn[j].y); w.y = cvt_pk_bf16(v[j].z * rs * gn[j].z, v[j].w * rs * gn[j].w); o8[64 * j] = w; }
        const f32x4 pv = *((const GAS f32x4*)(P.in[1] + (size_t)m * 256) + lane); v2u pw; pw.x = cvt_pk_bf16(pv.x, pv.y); pw.y = cvt_pk_bf16(pv.z, pv.w);
        *((GAS v2u*)(PB + (size_t)m * 256) + lane) = pw;
    }
}

struct Args { Ptrs p; int ph_lo, ph_hi; };
__global__ void __launch_bounds__(NWAVES * 64, 2) fwd_kernel(Args args) {
    extern __shared__ __attribute__((aligned(16))) unsigned char lds_raw[];
    LAS unsigned char* lds = (LAS unsigned char*)lds_raw;
    volatile LAS unsigned* MISC = (volatile LAS unsigned*)(lds + MISC_OFF);
    const int tid = threadIdx.x, lane = tid & 63, wave = __builtin_amdgcn_readfirstlane(tid >> 6);
    const int G = gridDim.x, c = blockIdx.x;
    const Ptrs& P = args.p;
    unsigned char* ws = P.ws;
    gu32* ctl = (gu32*)(ws + WS_CTL);
    for (int u = tid; u < 64; u += NWAVES * 64) MISC[u] = 0u;
    __syncthreads();
    XcdBarrier bar; bar.bar = (unsigned*)ctl + CW_BAR; bar.x = 0; bar.st = nullptr;
    if (N_LAUNCHES == 1) bar = xcd_barrier_post((unsigned*)ctl + CW_BAR, MISC + 8);
    const int lo = args.ph_lo, hi = args.ph_hi;
#ifndef PH_MASK
#define PH_MASK 0x3ffff
#endif
#define IN(k) (((PH_MASK >> (k)) & 1) && lo <= (k) && (k) < hi)
#define SEAM(k) do { if (IN(k) && IN((k) + 1)) xcd_barrier(bar); } while (0)

    if (IN(0)) { p0_prologue(P, lds, G, c, wave, lane); } SEAM(0);

    if (IN(1)) {
        pg8::StaticOrder S; S.init((const unsigned char*)P.out + DO_H, ws + WS_BTP1, T, NP1, D, G, c);
        pg8::EpiP1 E{(bf16*)(ws + WS_QA), (bf16*)(ws + WS_QB), (float*)(ws + WS_BG), P.in[4], P.in[5], P.in[7], P.in[8]};
        pg8::gemm_phase<pg8::EpiP1, pg8::StaticOrder, true, true>(lds + RING_OFF, D, S, E);
    } SEAM(1);

    if (IN(2)) { attn_phase(lds, (const bf16*)(ws + WS_QA), (bf16*)((unsigned char*)P.out + DO_OG), (float*)((unsigned char*)P.out + DO_LSE), G, c); } SEAM(2);

    if (IN(3)) { prep_phase(lds, (const bf16*)(ws + WS_QB), (const float*)(ws + WS_BG), P.in[6], ws + WS_DNP, (float*)(ws + WS_DLB), G, c); } SEAM(3);

    if (IN(4)) {
        const int nscan = G > 64 ? 64 : G;
        if (c < nscan) { for (int bh = c; bh < 64; bh += nscan) scan_chain(lds, ws + WS_DNP, (const float*)(ws + WS_DLB), (bf16*)(ws + WS_ON), P.in[9], bh); }
        if (G > 64) { if (c >= 64) combine_rows(P, (c - 64) * NWAVES + wave, (G - 64) * NWAVES, lane); }
        else combine_rows(P, c * NWAVES + wave, G * NWAVES, lane);
    } SEAM(4);

    if (IN(5)) { pg8::StaticOrder S; S.init(ws + WS_HR, ws + WS_BTZ, T, D, D, G, c); pg8::EpiSiluMul E{(bf16*)(ws + WS_ON)};
        pg8::gemm_phase<pg8::EpiSiluMul, pg8::StaticOrder, true, true>(lds + RING_OFF, D, S, E); } SEAM(5);
    if (IN(6)) { pg8::StaticOrder S; S.init(ws + WS_HR, ws + WS_BTGA, T, D, D, G, c); pg8::EpiBf16<1> E{(bf16*)(ws + WS_G1), D};
        pg8::gemm_phase<pg8::EpiBf16<1>, pg8::StaticOrder, true, true>(lds + RING_OFF, D, S, E); } SEAM(6);
    if (IN(7)) { pg8::StaticOrder S; S.init(ws + WS_HR, ws + WS_BTGB, T, D, D, G, c); pg8::EpiBf16<1> E{(bf16*)(ws + WS_G2), D};
        pg8::gemm_phase<pg8::EpiBf16<1>, pg8::StaticOrder, true, true>(lds + RING_OFF, D, S, E); } SEAM(7);
    if (IN(8)) { pg8::StaticOrder S; S.init(ws + WS_OA, ws + WS_BTA, T, D, 512, G, c); pg8::EpiGateMul<false> E{(const bf16*)(ws + WS_G1), (bf16*)(ws + WS_G1)};
        pg8::gemm_phase<pg8::EpiGateMul<false>, pg8::StaticOrder, true, true>(lds + RING_OFF, 512, S, E); } SEAM(8);
    if (IN(9)) { pg8::StaticOrder S; S.init(ws + WS_ON, ws + WS_BTB, T, D, D, G, c); pg8::EpiGateMul<true> E{(const bf16*)(ws + WS_G2), (bf16*)(ws + WS_G1)};
        pg8::gemm_phase<pg8::EpiGateMul<true>, pg8::StaticOrder, true, true>(lds + RING_OFF, D, S, E); } SEAM(9);
    if (IN(10)) { pg8::StaticOrder S; S.init(ws + WS_G1, ws + WS_BTOUT, T, D, D, G, c); pg8::EpiResF32 E{P.in[0], P.out};
        pg8::gemm_phase<pg8::EpiResF32, pg8::StaticOrder, true, true>(lds + RING_OFF, D, S, E); } SEAM(10);
    if (IN(11)) { router_phase(P, lds, G, c, wave, lane); } SEAM(11);
    if (IN(12)) { place_phase(P, G, c, wave, lane); } SEAM(12);
    if (IN(13)) { pg8::ExpertOrder S; S.init(ws + WS_HX, ws + WS_BTGU, (const unsigned*)ctl + CW_CNT, 512, D, G, c); pg8::EpiGU E{(bf16*)(ws + WS_ACT), (const float*)(ws + WS_CW)};
        pg8::gemm_phase<pg8::EpiGU, pg8::ExpertOrder, true, true>(lds + RING_OFF, D, S, E); } SEAM(13);
    if (IN(14)) { pg8::ExpertOrder S; S.init(ws + WS_ACT, ws + WS_BTDN, (const unsigned*)ctl + CW_CNT, D, 256, G, c); pg8::EpiBf16<0> E{(bf16*)(ws + WS_Y), D};
        pg8::gemm_phase<pg8::EpiBf16<0>, pg8::ExpertOrder, true, true>(lds + RING_OFF, 256, S, E); } SEAM(14);
    if (IN(15)) { ple_norm_phase(P, G, c, wave, lane); } SEAM(15);
    if (IN(16)) { pg8::StaticOrder S; S.init(ws + WS_PB, ws + WS_BTPLE, T, D, 256, G, c); pg8::EpiBf16<0> E{(bf16*)(ws + WS_E1), D};
        pg8::gemm_phase<pg8::EpiBf16<0>, pg8::StaticOrder, true, true>(lds + RING_OFF, 256, S, E); } SEAM(16);
    if (IN(17)) { pg8::StaticOrder S; S.init(ws + WS_H3, ws + WS_BTPG, T, D, D, G, c); pg8::EpiPleOut E{(const bf16*)(ws + WS_E1), P.out};
        pg8::gemm_phase<pg8::EpiPleOut, pg8::StaticOrder, true, true>(lds + RING_OFF, D, S, E); }
#undef IN
#undef SEAM
}

#ifndef DBG_LAST
#define DBG_LAST (NPH - 1)
#endif
__global__ void dbg_sanitize(float* out, size_t n) {
    for (size_t i = (size_t)blockIdx.x * blockDim.x + threadIdx.x; i < n; i += (size_t)gridDim.x * blockDim.x) { const float v = out[i]; if (!(v - v == 0.f)) out[i] = 0.f; }
}
__global__ void dbg_copy(const float* x, float* out, size_t n) {
    for (size_t i = (size_t)blockIdx.x * blockDim.x + threadIdx.x; i < n; i += (size_t)gridDim.x * blockDim.x) out[i] = x[i];
}
#ifdef DBG_CHECK
__global__ void dbg_check(const void* p, size_t nbytes, int is_f32, unsigned id, unsigned* word) {
    const size_t n16 = nbytes / 16; const uint4* q = (const uint4*)p; bool bad = false;
    for (size_t i = (size_t)blockIdx.x * blockDim.x + threadIdx.x; i < n16; i += (size_t)gridDim.x * blockDim.x) { const uint4 v = q[i]; const unsigned w[4] = {v.x, v.y, v.z, v.w};
        for (int k = 0; k < 4; ++k) { if (is_f32) { if ((w[k] & 0x7f800000u) == 0x7f800000u) bad = true; } else { if ((w[k] & 0x7f80u) == 0x7f80u || (w[k] & 0x7f800000u) == 0x7f800000u) bad = true; } } }
    if (bad) atomicMin(word, id);
}
__global__ void dbg_check_dnp(const unsigned char* p, unsigned id, unsigned* word) {
    bool bad = false;
    for (size_t i = (size_t)blockIdx.x * blockDim.x + threadIdx.x; i < (size_t)8192 * (DNU / 16); i += (size_t)gridDim.x * blockDim.x) { const size_t rec = i / (DNU / 16), o = (i % (DNU / 16)) * 16;
        if (o >= 49152 + 2048 && o < 49152 + 4096) continue;
        const uint4 v = *(const uint4*)(p + rec * DNU + o); const unsigned w[4] = {v.x, v.y, v.z, v.w};
        for (int k = 0; k < 4; ++k) if ((w[k] & 0x7f80u) == 0x7f80u || (w[k] & 0x7f800000u) == 0x7f800000u) { const unsigned part = o < 16384 ? 0u : (o < 32768 ? 1u : (o < 49152 ? 2u : (o < 57344 ? 3u : 4u))); atomicAnd(word, ~(1u << part)); } }
    (void)bad;
}
__global__ void dbg_check_tmax(const unsigned char* p, unsigned* word) {
    for (size_t r = (size_t)blockIdx.x * blockDim.x + threadIdx.x; r < 8192; r += (size_t)gridDim.x * blockDim.x) { const float* d = (const float*)(p + r * DNU + 49152 + 2048);
        unsigned bits = 0; if (d[0] > 1e3f) bits |= 1u; if (d[2] != 0.f) bits |= 2u; if (d[1] > 1.5f) bits |= 4u; if (d[1] > 100.f) bits |= 8u; if (d[3] != 0.f) bits |= 16u;
        if (bits) atomicAnd(word, ~bits); }
}
__global__ void dbg_final(const float* x, float* out, const unsigned* word) {
    unsigned id = *word;
#ifdef DBG_BITS
    id = (~id) & 31u; if (id == 0) id = 0xffffffffu;
#endif
    const size_t nz = id == 0xffffffffu ? 0 : (size_t)id * (T / 32) * D; const size_t n = (size_t)T * D;
    for (size_t i = (size_t)blockIdx.x * blockDim.x + threadIdx.x; i < n; i += (size_t)gridDim.x * blockDim.x) out[i] = i < nz ? 0.f : x[i];
}
#endif
extern "C" void kernel_launch(void* const* d_in, const int* in_sizes, int n_in, void* d_out, int out_size, void* d_ws, size_t ws_size, hipStream_t stream) {
    static int grid = 0;
    if (grid == 0) {
        if (n_in != 24 || out_size != T * D || ws_size < WS_END) { fprintf(stderr, "kernel_launch: unexpected shapes (n_in %d, out %d, ws %zu)\n", n_in, out_size, ws_size); grid = -1; return; }
        int dev = 0, cus = 0;
        if (hipGetDevice(&dev) != hipSuccess || hipDeviceGetAttribute(&cus, hipDeviceAttributeMultiprocessorCount, dev) != hipSuccess) { grid = -1; return; }
        if (hipFuncSetAttribute((const void*)fwd_kernel, hipFuncAttributeMaxDynamicSharedMemorySize, LDS_BYTES) != hipSuccess) { grid = -1; return; }
        int per_cu = 0;
        if (hipOccupancyMaxActiveBlocksPerMultiprocessor(&per_cu, (const void*)fwd_kernel, NWAVES * 64, LDS_BYTES) != hipSuccess || per_cu < 1) { fprintf(stderr, "kernel_launch: occupancy query says %d\n", per_cu); }
        (void)hipGetLastError();
        grid = cus;
    }
    if (grid < 0) return;
    if (hipMemsetAsync((char*)d_ws + WS_CTL, 0, CTL_ZERO_BYTES, stream) != hipSuccess) return;
    Args a{};
    for (int i = 0; i < 24; ++i) a.p.in[i] = (const float*)d_in[i];
    a.p.out = (float*)d_out; a.p.ws = (unsigned char*)d_ws;
    if (N_LAUNCHES == 1) { a.ph_lo = 0; a.ph_hi = NPH; hipLaunchKernelGGL(fwd_kernel, dim3(grid), dim3(NWAVES * 64), LDS_BYTES, stream, a); }
    else for (int li = 0; li <= DBG_LAST; ++li) { a.ph_lo = li; a.ph_hi = li + 1; hipLaunchKernelGGL(fwd_kernel, dim3(grid), dim3(NWAVES * 64), LDS_BYTES, stream, a);
#ifdef DUP_PH
        if (li == DUP_PH) hipLaunchKernelGGL(fwd_kernel, dim3(grid), dim3(NWAVES * 64), LDS_BYTES, stream, a);
#endif
#ifdef DBG_CHECK
        unsigned char* W = (unsigned char*)d_ws; unsigned char* O = (unsigned char*)d_out; unsigned* word = (unsigned*)(W + 1022 * MiB + 512 * 1024);
        if (li == 0) hipMemsetAsync(word, 0xFF, 4, stream);
#define CHK(p, nb, f32, id) hipLaunchKernelGGL(dbg_check, dim3(1024), dim3(256), 0, stream, (const void*)(p), (size_t)(nb), f32, (unsigned)(id), word)
        if (li == 0) { CHK(O + DO_H, (size_t)T * D * 2, 0, 1); CHK(W + WS_BTP1, (size_t)NP1 * D * 2, 0, 2); CHK(W + WS_BTZ, 38 * MiB, 0, 3); }
        if (li == 1) { CHK(W + WS_QA, (size_t)T * 4608 * 2, 0, 4); CHK(W + WS_QB, (size_t)T * 3072 * 2, 0, 5); CHK(W + WS_BG, (size_t)T * 16 * 4, 1, 6); }
        if (li == 2) { CHK(O + DO_OG, (size_t)T * 1536 * 2, 0, 7); CHK(O + DO_LSE, (size_t)T * 24 * 4, 1, 8); }
#if defined(DBG_PREPCHK)
        if (li == 3) {
#elif defined(DBG_TMAX)
        if (li == 3) { hipLaunchKernelGGL(dbg_check_tmax, dim3(32), dim3(256), 0, stream, W + WS_DNP, word);
#else
        if (li == 3) { hipLaunchKernelGGL(dbg_check_dnp, dim3(1024), dim3(256), 0, stream, W + WS_DNP, 9u, word);
#endif
        CHK(W + WS_DLB, 8192 * 4, 1, 14); }
        if (li == 4) { CHK(W + WS_ON, (size_t)T * D * 2, 0, 11); CHK(W + WS_OA, (size_t)T * 512 * 2, 0, 12); CHK(W + WS_HR, (size_t)T * D * 2, 0, 13); }
        if (li == 5) CHK(W + WS_ON, (size_t)T * D * 2, 0, 14);
        if (li == 6) CHK(W + WS_G1, (size_t)T * D * 2, 0, 15);
        if (li == 7) CHK(W + WS_G2, (size_t)T * D * 2, 0, 16);
        if (li == 8) CHK(W + WS_G1, (size_t)T * D * 2, 0, 17);
        if (li == 9) CHK(W + WS_G1, (size_t)T * D * 2, 0, 18);
        if (li == 10) CHK(O, (size_t)T * D * 4, 1, 19);
        if (li == 11) { CHK(W + WS_H2, (size_t)T * D * 2, 0, 20); CHK(W + WS_TOK, (size_t)T * 16, 1, 21); }
        if (li == 15) { CHK(O, (size_t)T * D * 4, 1, 25); CHK(W + WS_H3, (size_t)T * D * 2, 0, 26); }
        if (li == 16) CHK(W + WS_E1, (size_t)T * D * 2, 0, 27);
        if (li == 17) CHK(O, (size_t)T * D * 4, 1, 28);
        if (li == DBG_LAST) hipLaunchKernelGGL(dbg_final, dim3(2048), dim3(256), 0, stream, (const float*)d_in[0], (float*)d_out, (const unsigned*)word);
#endif
    }
#ifdef DBG_COPYX
    hipLaunchKernelGGL(dbg_copy, dim3(2048), dim3(256), 0, stream, (const float*)d_in[0], (float*)d_out, (size_t)out_size);
#endif
#ifdef DBG_SANITIZE
    hipLaunchKernelGGL(dbg_sanitize, dim3(2048), dim3(256), 0, stream, (float*)d_out, (size_t)out_size);
#endif
}
```

```cpp
#define MK_N_LAUNCHES 1
#include <hip/hip_runtime.h>
#include <cstdio>
#include <cstdint>
namespace pg8 {
#define PG8_LAS __attribute__((address_space(3)))
typedef unsigned short bf16_t;
typedef short bf16x8 __attribute__((ext_vector_type(8)));
typedef float f32x4 __attribute__((ext_vector_type(4)));
typedef unsigned u32x4 __attribute__((ext_vector_type(4)));
typedef unsigned u32x2 __attribute__((ext_vector_type(2)));
constexpr int BM = 256, BK = 64, HALF = 128, HTB = HALF * BK * 2  , STAGE_BYTES = 8 * HTB, NXCD = 8, WGM = 8;

__host__ __device__ __forceinline__ int lds_byte(int r, int c) { const int st = (r >> 4) * 2 + (c >> 5), rr = r & 15, cc = c & 31, ob = rr * 64 + cc * 2; return st * 1024 + (ob ^ (((ob >> 9) & 1) << 5)); }
__host__ __device__ __forceinline__ void stage_rc(int b, int& R, int& C) { const int st = b / 1024, sb = b % 1024, swz = sb ^ (((sb >> 9) & 1) << 5); R = (st >> 1) * 16 + swz / 64; C = (st & 1) * 32 + (swz % 64) / 2; }
__host__ __device__ __forceinline__ int perm32(int rho) { const int n = rho >> 4, i = rho & 15; return 8 * (i >> 2) + 4 * n + (i & 3); }

struct Unit { int pm, pn; const char* a; const char* b; };

struct StaticOrder {
    static constexpr bool GATHER = false; static constexpr int MAXU = 0;
    __device__ __forceinline__ int row_of(const Unit&, int) const { return 0; }
    const char* A; const char* Bt; size_t tstep; int nM, nN, nwg, G, c;
    __device__ __forceinline__ void init(const void* A_, const void* Bt_, int M, int N, int K, int G_, int c_) { A = (const char*)A_; Bt = (const char*)Bt_; tstep = (size_t)BM * K * 2; nM = M / BM; nN = N / BM; nwg = nM * nN; G = G_; c = c_; }
    __device__ __forceinline__ bool next(int i, Unit& u) const {
        const long L = (long)i * G + c; if (L >= nwg) return false;
        int wgid = (int)L; { const int q = nwg / NXCD, r = nwg % NXCD, xcd = wgid % NXCD, off = wgid / NXCD; wgid = (xcd < r ? xcd * (q + 1) : r * (q + 1) + (xcd - r) * q) + off; }
        const int nig = WGM * nN, gid = wgid / nig, fm = gid * WGM, gsz = (nM - fm) < WGM ? (nM - fm) : WGM;
        u.pm = fm + ((wgid % nig) % gsz); u.pn = (wgid % nig) / gsz; u.a = A + (size_t)u.pm * tstep; u.b = Bt + (size_t)u.pn * tstep; return true;
    }
    __device__ __forceinline__ const char* a_ptr(const Unit& u) const { return u.a; }
    __device__ __forceinline__ const char* b_ptr(const Unit& u) const { return u.b; }
    __device__ __forceinline__ void a_ready(const Unit&) const {}
    __device__ __forceinline__ void done(const Unit&) const {}
};
template <bool GATHER_> struct ExpertOrder {
    static constexpr bool GATHER = GATHER_; static constexpr int MAXU = 14;
    const int* rows;
    __device__ __forceinline__ int row_of(const Unit& u, int r) const { return rows[u.pm * BM + r]; }
    const char* A; const char* Bt; const unsigned* cnt; size_t tstep, bstride; int nN, G, c;
    __device__ __forceinline__ void init(const void* A_, const void* Bt_, const unsigned* cnt_, int N, int K, int G_, int c_) { A = (const char*)A_; Bt = (const char*)Bt_; cnt = cnt_; tstep = (size_t)BM * K * 2; bstride = (size_t)N * K * 2; nN = N / BM; G = G_; c = c_; }
    __device__ __forceinline__ bool next(int i, Unit& u) const {
        const long L = (long)i * G + c; const int rt = (int)(L / nN), pn = (int)(L % nN);
        int acc = 0, found = -1;
        for (int e = 0; e < 16; ++e) { const int te = (int)((cnt[e] + 255u) >> 8); if (found < 0 && rt < acc + te) found = e; acc += te; }
        if (found < 0) return false;
        u.pm = rt; u.pn = pn; u.a = GATHER ? A : A + (size_t)rt * tstep; u.b = Bt + (size_t)found * bstride + (size_t)pn * tstep; return true;
    }
    __device__ __forceinline__ const char* a_ptr(const Unit& u) const { return u.a; }
    __device__ __forceinline__ const char* b_ptr(const Unit& u) const { return u.b; }
    __device__ __forceinline__ void a_ready(const Unit&) const {}
    __device__ __forceinline__ void done(const Unit&) const {}
};

typedef float f32x2_t __attribute__((ext_vector_type(2))); typedef __bf16 bf16x2_t __attribute__((ext_vector_type(2)));
__device__ __forceinline__ unsigned cvt_pk_bf16(float lo, float hi) { const f32x2_t v = {lo, hi}; const bf16x2_t b = __builtin_convertvector(v, bf16x2_t); return __builtin_bit_cast(unsigned, b); }
__device__ __forceinline__ float bflo(unsigned w) { return __uint_as_float(w << 16); }
__device__ __forceinline__ float bfhi(unsigned w) { return __uint_as_float(w & 0xffff0000u); }
__device__ __forceinline__ float sigm(float x) { return 1.0f / (1.0f + __expf(-x)); }
__device__ __forceinline__ u32x4 pack8(const f32x4 a, const f32x4 b) { u32x4 w; w.x = cvt_pk_bf16(a[0], a[1]); w.y = cvt_pk_bf16(a[2], a[3]); w.z = cvt_pk_bf16(b[0], b[1]); w.w = cvt_pk_bf16(b[2], b[3]); return w; }
__device__ __forceinline__ void unpack8(const u32x4 w, f32x4& a, f32x4& b) { a = (f32x4){bflo(w.x), bfhi(w.x), bflo(w.y), bfhi(w.y)}; b = (f32x4){bflo(w.z), bfhi(w.z), bflo(w.w), bfhi(w.w)}; }

constexpr float QSCALE = 0.125f * 1.4426950408889634f;
constexpr float EPSN = 1e-6f;
constexpr int QAP = 4608, QBP = 3072;

struct EpiP1 {
    static constexpr bool PERM = true, AFTER_DRAIN = false;
    bf16_t* QA; bf16_t* QB; float* BG; const float* qn; const float* kn; const float* a_log; const float* dt_bias;
    __device__ __forceinline__ void operator()(const f32x4 (&acc)[2][2][4][2], const Unit& u, int wr, int wc, int fr, int fq) const {
        const int row0 = u.pm * BM + wr * 64 + fr;
        if (u.pn < 12) {
            const float* gn = (u.pn < 6) ? qn : kn; const float sc = (u.pn < 6) ? QSCALE : 1.0f;
            f32x4 gv[2][2];
#pragma unroll
            for (int bj = 0; bj < 2; ++bj)
#pragma unroll
                for (int n = 0; n < 2; ++n) gv[bj][n] = *(const f32x4*)(gn + 32 * bj + 8 * fq + 4 * n) * sc;
#pragma unroll
            for (int ai = 0; ai < 2; ++ai)
#pragma unroll
                for (int m = 0; m < 4; ++m) {
                    float ss = 0.f;
#pragma unroll
                    for (int bj = 0; bj < 2; ++bj)
#pragma unroll
                        for (int n = 0; n < 2; ++n) { const f32x4 x = acc[ai][bj][m][n]; ss += (x[0] * x[0] + x[1] * x[1]) + (x[2] * x[2] + x[3] * x[3]); }
                    ss += __shfl_xor(ss, 16); ss += __shfl_xor(ss, 32);
                    const float rs = rsqrtf(ss * (1.0f / 64.0f) + EPSN);
                    bf16_t* rowp = QA + (size_t)(row0 + ai * HALF + m * 16) * QAP + u.pn * BM + wc * 64 + 8 * fq;
#pragma unroll
                    for (int bj = 0; bj < 2; ++bj) { const f32x4 v0 = acc[ai][bj][m][0] * rs * gv[bj][0], v1 = acc[ai][bj][m][1] * rs * gv[bj][1]; *(u32x4*)(rowp + bj * 32) = pack8(v0, v1); }
                }
        } else if (u.pn < 30) {
            bf16_t* const base = (u.pn < 18) ? QA + u.pn * BM : QB + (u.pn - 18) * BM; const int pitch = (u.pn < 18) ? QAP : QBP;
#pragma unroll
            for (int ai = 0; ai < 2; ++ai)
#pragma unroll
                for (int m = 0; m < 4; ++m) { bf16_t* rowp = base + (size_t)(row0 + ai * HALF + m * 16) * pitch + wc * 32 + 8 * fq;
#pragma unroll
                    for (int bj = 0; bj < 2; ++bj) *(u32x4*)(rowp + bj * HALF) = pack8(acc[ai][bj][m][0], acc[ai][bj][m][1]); }
        } else {
            if (wc == 0 && fq < 2) {
                f32x4 al[2], db[2];
#pragma unroll
                for (int n = 0; n < 2; ++n) { al[n] = *(const f32x4*)(a_log + 4 * n); db[n] = *(const f32x4*)(dt_bias + 4 * n); }
#pragma unroll
                for (int ai = 0; ai < 2; ++ai)
#pragma unroll
                    for (int m = 0; m < 4; ++m) { float* rowp = BG + (size_t)(row0 + ai * HALF + m * 16) * 16 + 8 * fq;
#pragma unroll
                        for (int n = 0; n < 2; ++n) { const f32x4 x = acc[ai][0][m][n]; f32x4 o;
#pragma unroll
                            for (int e = 0; e < 4; ++e) { if (fq == 0) o[e] = sigm(x[e]); else { const float z = x[e] + db[n][e]; const float sp = z > 20.f ? z : log1pf(__expf(z)); o[e] = -__expf(al[n][e]) * sp; } }
                            *(f32x4*)(rowp + 4 * n) = o; } }
            }
        }
    }
};
struct EpiSiluMul {
    static constexpr bool PERM = true, AFTER_DRAIN = false;
    bf16_t* O;
    __device__ __forceinline__ void operator()(const f32x4 (&acc)[2][2][4][2], const Unit& u, int wr, int wc, int fr, int fq) const {
        const int row0 = u.pm * BM + wr * 64 + fr;
#pragma unroll
        for (int ai = 0; ai < 2; ++ai)
#pragma unroll
            for (int m = 0; m < 4; ++m) { bf16_t* rowp = O + (size_t)(row0 + ai * HALF + m * 16) * 1024 + u.pn * BM + wc * 32 + 8 * fq;
#pragma unroll
                for (int bj = 0; bj < 2; ++bj) { const u32x4 w = *(const u32x4*)(rowp + bj * HALF); f32x4 a, b; unpack8(w, a, b); f32x4 z0 = acc[ai][bj][m][0], z1 = acc[ai][bj][m][1];
#pragma unroll
                    for (int e = 0; e < 4; ++e) { a[e] *= z0[e] * sigm(z0[e]); b[e] *= z1[e] * sigm(z1[e]); }
                    *(u32x4*)(rowp + bj * HALF) = pack8(a, b); } }
    }
};
struct EpiZG {
    static constexpr bool PERM = true, AFTER_DRAIN = false;
    bf16_t* ON; bf16_t* G1; bf16_t* G2;
    __device__ __forceinline__ void operator()(const f32x4 (&acc)[2][2][4][2], const Unit& u, int wr, int wc, int fr, int fq) const {
        const int row0 = u.pm * BM + wr * 64 + fr; const int t = u.pn >> 2;
        const long dG1 = (const char*)G1 - (const char*)ON, dG2 = (const char*)G2 - (const char*)ON;
        bf16_t* const O = (bf16_t*)((char*)ON + (t == 1 ? dG1 : 0) + (t == 2 ? dG2 : 0));
#pragma unroll
        for (int ai = 0; ai < 2; ++ai)
#pragma unroll
            for (int m = 0; m < 4; ++m) { bf16_t* rowp = O + (size_t)(row0 + ai * HALF + m * 16) * 1024 + (u.pn & 3) * BM + wc * 32 + 8 * fq;
#pragma unroll
                for (int bj = 0; bj < 2; ++bj) { f32x4 a = acc[ai][bj][m][0], b = acc[ai][bj][m][1];
                    if (t == 0) { const u32x4 w = *(const u32x4*)(rowp + bj * HALF); f32x4 oa, ob; unpack8(w, oa, ob);
#pragma unroll
                        for (int e = 0; e < 4; ++e) { a[e] = oa[e] * a[e] * sigm(a[e]); b[e] = ob[e] * b[e] * sigm(b[e]); } }
                    else {
#pragma unroll
                        for (int e = 0; e < 4; ++e) { a[e] = sigm(a[e]); b[e] = sigm(b[e]); } }
                    *(u32x4*)(rowp + bj * HALF) = pack8(a, b); } }
    }
};
template <int MODE> struct EpiBf16 {
    static constexpr bool PERM = true, AFTER_DRAIN = false;
    bf16_t* O; int ldc;
    __device__ __forceinline__ void operator()(const f32x4 (&acc)[2][2][4][2], const Unit& u, int wr, int wc, int fr, int fq) const {
        const int row0 = u.pm * BM + wr * 64 + fr;
#pragma unroll
        for (int ai = 0; ai < 2; ++ai)
#pragma unroll
            for (int m = 0; m < 4; ++m) { bf16_t* rowp = O + (size_t)(row0 + ai * HALF + m * 16) * ldc + u.pn * BM + wc * 32 + 8 * fq;
#pragma unroll
                for (int bj = 0; bj < 2; ++bj) { f32x4 a = acc[ai][bj][m][0], b = acc[ai][bj][m][1];
                    if (MODE == 1) {
#pragma unroll
                        for (int e = 0; e < 4; ++e) { a[e] = sigm(a[e]); b[e] = sigm(b[e]); } }
                    *(u32x4*)(rowp + bj * HALF) = pack8(a, b); } }
    }
};
template <bool ADD> struct EpiGateMul {
    static constexpr bool PERM = true, AFTER_DRAIN = false;
    const bf16_t* Gt; bf16_t* Mo;
    __device__ __forceinline__ void operator()(const f32x4 (&acc)[2][2][4][2], const Unit& u, int wr, int wc, int fr, int fq) const {
        const int row0 = u.pm * BM + wr * 64 + fr;
#pragma unroll
        for (int ai = 0; ai < 2; ++ai)
#pragma unroll
            for (int m = 0; m < 4; ++m) { const size_t off = (size_t)(row0 + ai * HALF + m * 16) * 1024 + u.pn * BM + wc * 32 + 8 * fq;
#pragma unroll
                for (int bj = 0; bj < 2; ++bj) { const u32x4 gw = *(const u32x4*)(Gt + off + bj * HALF); f32x4 ga, gb; unpack8(gw, ga, gb);
                    f32x4 a = ga * acc[ai][bj][m][0], b = gb * acc[ai][bj][m][1];
                    if (ADD) { const u32x4 mw = *(const u32x4*)(Mo + off + bj * HALF); f32x4 ma, mb; unpack8(mw, ma, mb); a += ma; b += mb; }
                    *(u32x4*)(Mo + off + bj * HALF) = pack8(a, b); } }
    }
};
struct EpiResF32 {
    static constexpr bool PERM = false, AFTER_DRAIN = false;
    const float* base; float* out;
    __device__ __forceinline__ void operator()(const f32x4 (&acc)[2][2][4][2], const Unit& u, int wr, int wc, int fr, int fq) const {
        const int row0 = u.pm * BM + wr * 64 + fr, col0 = u.pn * BM + wc * 32 + 4 * fq;
#pragma unroll
        for (int ai = 0; ai < 2; ++ai)
#pragma unroll
            for (int m = 0; m < 4; ++m) { const size_t off = (size_t)(row0 + ai * HALF + m * 16) * 1024 + col0;
#pragma unroll
                for (int bj = 0; bj < 2; ++bj)
#pragma unroll
                    for (int n = 0; n < 2; ++n) { const f32x4 bs = *(const f32x4*)(base + off + bj * HALF + n * 16); *(f32x4*)(out + off + bj * HALF + n * 16) = bs + acc[ai][bj][m][n]; }
                asm volatile("" ::: "memory"); }
    }
};
struct EpiPleOut {
    static constexpr bool PERM = false, AFTER_DRAIN = false;
    const bf16_t* E1; float* out;
    __device__ __forceinline__ void operator()(const f32x4 (&acc)[2][2][4][2], const Unit& u, int wr, int wc, int fr, int fq) const {
        const int row0 = u.pm * BM + wr * 64 + fr, col0 = u.pn * BM + wc * 32 + 4 * fq;
#pragma unroll
        for (int ai = 0; ai < 2; ++ai)
#pragma unroll
            for (int m = 0; m < 4; ++m) { const size_t off = (size_t)(row0 + ai * HALF + m * 16) * 1024 + col0;
#pragma unroll
                for (int bj = 0; bj < 2; ++bj)
#pragma unroll
                    for (int n = 0; n < 2; ++n) { const size_t o2 = off + bj * HALF + n * 16; const f32x4 bs = *(const f32x4*)(out + o2); const u32x2 ew = *(const u32x2*)(E1 + o2);
                        const f32x4 ev = (f32x4){bflo(ew.x), bfhi(ew.x), bflo(ew.y), bfhi(ew.y)}; const f32x4 a = acc[ai][bj][m][n]; f32x4 r;
#pragma unroll
                        for (int e = 0; e < 4; ++e) r[e] = bs[e] + sigm(a[e]) * ev[e];
                        *(f32x4*)(out + o2) = r; }
                asm volatile("" ::: "memory"); }
    }
};
struct EpiGU {
    static constexpr bool PERM = true, AFTER_DRAIN = false;
    bf16_t* ACT; const float* CW;
    __device__ __forceinline__ void operator()(const f32x4 (&acc)[2][2][4][2], const Unit& u, int wr, int wc, int fr, int fq) const {
        const int row0 = u.pm * BM + wr * 64 + fr;
#pragma unroll
        for (int ai = 0; ai < 2; ++ai)
#pragma unroll
            for (int m = 0; m < 4; ++m) { const int row = row0 + ai * HALF + m * 16; const float cw = CW[row];
                f32x4 a, b; const f32x4 g0 = acc[ai][0][m][0], g1 = acc[ai][0][m][1], u0 = acc[ai][1][m][0], u1 = acc[ai][1][m][1];
#pragma unroll
                for (int e = 0; e < 4; ++e) { a[e] = g0[e] * sigm(g0[e]) * u0[e] * cw; b[e] = g1[e] * sigm(g1[e]) * u1[e] * cw; }
                *(u32x4*)(ACT + (size_t)row * 256 + u.pn * HALF + wc * 32 + 8 * fq) = pack8(a, b); }
    }
};

template <class Epi, class Sched, bool ALIGN_EPI = false, bool SP2 = false>
__device__ __forceinline__ void gemm_phase(PG8_LAS unsigned char* lds, const int KK, const Sched& S, const Epi& E) {
    int tid_ = threadIdx.x; asm volatile("" : "+v"(tid_));
    const int tid = tid_, wid = __builtin_amdgcn_readfirstlane(tid >> 6), lane = tid & 63, wr = wid >> 2, wc = wid & 3, fr = lane & 15, fq = lane >> 4;
    int K_ = KK; asm volatile("" : "+s"(K_));
    const int K = K_, nt = K / BK;
    unsigned vA[2][2], vN[2][2], voffB[2]; int stR[2], stC[2];
#pragma unroll
    for (int i = 0; i < 2; ++i) { int R, C; stage_rc(tid * 16 + i * 8192, R, C); const int Rb = Epi::PERM ? ((R & ~31) + perm32(R & 31)) : R; stR[i] = R; stC[i] = C;
        voffB[i] = (unsigned)(Rb * K + C) * 2u;
#pragma unroll
        for (int h = 0; h < 2; ++h) { vA[h][i] = (unsigned)((h * HALF + R) * K + C) * 2u; vN[h][i] = vA[h][i]; } }
    const size_t kstep = (size_t)(BK * 2);
    const size_t hstep = (size_t)HALF * K * 2;
    const size_t tstep = 2 * hstep;
    const unsigned ldsw = (unsigned)wid * 1024u;
    const int aoff = lds_byte(wr * 64 + fr, fq * 8), boff = lds_byte(wc * 32 + fr, fq * 8);
#define PG8_SA(b, h) (((b) * 2 + (h)) * HTB)
#define PG8_SB(b, h) ((4 + (b) * 2 + (h)) * HTB)
#define PG8_STAGE(bufoff, gbase, voff) do { _Pragma("unroll") for (int _i = 0; _i < 2; ++_i) \
        __builtin_amdgcn_global_load_lds((const unsigned*)((const char*)(gbase) + (voff)[_i]), (PG8_LAS unsigned*)(lds + (bufoff) + ldsw + _i * 8192), 16, 0, 0); } while (0)
#define PG8_LDA(dst, b, h) do { _Pragma("unroll") for (int m = 0; m < 4; ++m) _Pragma("unroll") for (int k = 0; k < 2; ++k) dst[m][k] = *(const PG8_LAS bf16x8*)(lds + PG8_SA(b, h) + aoff + m * 2048 + k * 1024); } while (0)
#define PG8_LDB(dst, b, h) do { _Pragma("unroll") for (int n = 0; n < 2; ++n) _Pragma("unroll") for (int k = 0; k < 2; ++k) dst[n][k] = *(const PG8_LAS bf16x8*)(lds + PG8_SB(b, h) + boff + n * 2048 + k * 1024); } while (0)
#define PG8_MMA(ai, bj, At, Bt) do { __builtin_amdgcn_s_setprio(1); _Pragma("unroll") for (int m = 0; m < 4; ++m) _Pragma("unroll") for (int n = 0; n < 2; ++n) _Pragma("unroll") for (int k = 0; k < 2; ++k) \
        acc[ai][bj][m][n] = __builtin_amdgcn_mfma_f32_16x16x32_bf16(Bt[n][k], At[m][k], acc[ai][bj][m][n], 0, 0, 0); __builtin_amdgcn_s_setprio(0); } while (0)
#define PG8_WAIT_V(n) asm volatile("s_waitcnt vmcnt(" #n ")" ::: "memory")
#define PG8_WAIT_L(n) asm volatile("s_waitcnt lgkmcnt(" #n ")" ::: "memory")
#define PG8_BAR __builtin_amdgcn_s_barrier()
#define PG8_SCHED __builtin_amdgcn_sched_barrier(0)
    Unit cur, nxt; int ui = 0;
    if (!S.next(0, cur)) return;
    f32x4 acc[2][2][4][2];
#pragma unroll
    for (int a = 0; a < 2; ++a)
#pragma unroll
        for (int b = 0; b < 2; ++b)
#pragma unroll
            for (int m = 0; m < 4; ++m)
#pragma unroll
                for (int n = 0; n < 2; ++n) acc[a][b][m][n] = (f32x4){0.f, 0.f, 0.f, 0.f};
    bf16x8 At[4][2], B0[2][2], B1[2][2];
    const char* cA = S.a_ptr(cur); const char* cB = S.b_ptr(cur);
    if constexpr (Sched::GATHER) {
        PG8_LAS int* rid = (PG8_LAS int*)(lds + STAGE_BYTES);
        { Unit t_; for (int i = 0; i < Sched::MAXU && S.next(i, t_); ++i) if (tid < 256) rid[i * 256 + tid] = S.row_of(t_, tid); }
        asm volatile("s_waitcnt vmcnt(0) lgkmcnt(0)" ::: "memory"); PG8_BAR; asm volatile("" ::: "memory");
#pragma unroll
        for (int i = 0; i < 2; ++i)
#pragma unroll
            for (int h = 0; h < 2; ++h) vA[h][i] = (unsigned)(rid[h * HALF + stR[i]] * K + stC[i]) * 2u;
    }
    S.a_ready(cur);
    if constexpr (SP2) {
        PG8_STAGE(PG8_SB(0, 0), cB, voffB); PG8_STAGE(PG8_SB(0, 1), cB + hstep, voffB); PG8_STAGE(PG8_SA(0, 0), cA, vA[0]); PG8_STAGE(PG8_SA(0, 1), cA, vA[1]);
        if (wr == 1) PG8_BAR;
        PG8_WAIT_V(2); PG8_BAR;
        PG8_STAGE(PG8_SB(1, 0), cB + kstep, voffB); PG8_STAGE(PG8_SA(1, 0), cA + kstep, vA[0]); PG8_STAGE(PG8_SB(1, 1), cB + hstep + kstep, voffB);
        PG8_WAIT_V(6); PG8_BAR;
    } else {
        PG8_STAGE(PG8_SB(0, 0), cB, voffB); PG8_STAGE(PG8_SA(0, 0), cA, vA[0]); PG8_STAGE(PG8_SB(0, 1), cB + hstep, voffB); PG8_STAGE(PG8_SA(0, 1), cA, vA[1]);
        if (wr == 1) PG8_BAR;
        PG8_WAIT_V(4); PG8_BAR;
        PG8_STAGE(PG8_SB(1, 0), cB + kstep, voffB); PG8_STAGE(PG8_SA(1, 0), cA + kstep, vA[0]); PG8_STAGE(PG8_SB(1, 1), cB + hstep + kstep, voffB);
        PG8_WAIT_V(6); PG8_BAR;
    }
    for (;;) {
        const bool has_next = S.next(ui + 1, nxt);
        const char* nA = has_next ? S.a_ptr(nxt) : cA; const char* nB = has_next ? S.b_ptr(nxt) : cB;
        if constexpr (Sched::GATHER) { const PG8_LAS int* rid = (const PG8_LAS int*)(lds + STAGE_BYTES) + (has_next ? (ui + 1) : ui) * 256;
#pragma unroll
            for (int i = 0; i < 2; ++i)
#pragma unroll
                for (int h = 0; h < 2; ++h) vN[h][i] = (unsigned)(rid[h * HALF + stR[i]] * K + stC[i]) * 2u; }
        for (int t = 0; t < nt; t += 2) {
            const bool last = (t == nt - 2);
            const char* a1 = cA + (size_t)(t + 1) * kstep;
            const char* a2 = last ? nA : cA + (size_t)(t + 2) * kstep; const char* b2 = last ? nB : cB + (size_t)(t + 2) * kstep;
            const char* a3 = a2 + kstep; const char* b3 = b2 + kstep;
            unsigned vS[2][2];
#pragma unroll
            for (int i = 0; i < 2; ++i) { vS[0][i] = (Sched::GATHER && last) ? vN[0][i] : vA[0][i]; vS[1][i] = (Sched::GATHER && last) ? vN[1][i] : vA[1][i]; }
            if (last && has_next) S.a_ready(nxt);
            if constexpr (SP2) {
            PG8_LDB(B0, 0, 0); PG8_LDB(B1, 0, 1); PG8_SCHED; PG8_LDA(At, 0, 0); PG8_STAGE(PG8_SA(1, 1), a1, vA[1]);
            PG8_WAIT_V(8); PG8_WAIT_L(0); PG8_BAR; PG8_MMA(0, 0, At, B0); PG8_MMA(0, 1, At, B1); PG8_BAR; PG8_SCHED;
            PG8_LDA(At, 0, 1); PG8_STAGE(PG8_SB(0, 0), b2, voffB); PG8_STAGE(PG8_SB(0, 1), b2 + hstep, voffB); PG8_STAGE(PG8_SA(0, 0), a2, vS[0]);
            PG8_WAIT_V(8); PG8_WAIT_L(0); PG8_BAR; PG8_MMA(1, 0, At, B0); PG8_MMA(1, 1, At, B1); PG8_BAR; PG8_SCHED;
            PG8_LDB(B0, 1, 0); PG8_LDB(B1, 1, 1); PG8_SCHED; PG8_LDA(At, 1, 0); PG8_STAGE(PG8_SA(0, 1), a2, vS[1]);
            PG8_WAIT_V(8); PG8_WAIT_L(0); PG8_BAR; PG8_MMA(0, 0, At, B0); PG8_MMA(0, 1, At, B1); PG8_BAR; PG8_SCHED;
            PG8_LDA(At, 1, 1); PG8_STAGE(PG8_SB(1, 0), b3, voffB); PG8_STAGE(PG8_SB(1, 1), b3 + hstep, voffB); PG8_STAGE(PG8_SA(1, 0), a3, vS[0]);
            PG8_WAIT_V(8); PG8_WAIT_L(0); PG8_BAR; PG8_MMA(1, 0, At, B0); PG8_MMA(1, 1, At, B1); PG8_BAR; PG8_SCHED;
            } else {
            PG8_LDB(B0, 0, 0); PG8_SCHED; PG8_LDA(At, 0, 0); PG8_STAGE(PG8_SA(1, 1), a1, vA[1]);
            PG8_WAIT_L(8); PG8_BAR; PG8_WAIT_L(0); PG8_MMA(0, 0, At, B0); PG8_BAR; PG8_SCHED;
            PG8_LDB(B1, 0, 1); PG8_STAGE(PG8_SB(0, 0), b2, voffB);
            PG8_BAR; PG8_WAIT_L(0); PG8_MMA(0, 1, At, B1); PG8_BAR;
            PG8_LDA(At, 0, 1); PG8_STAGE(PG8_SA(0, 0), a2, vS[0]);
            PG8_BAR; PG8_WAIT_L(0); PG8_MMA(1, 0, At, B0); PG8_BAR; PG8_SCHED;
            PG8_STAGE(PG8_SB(0, 1), b2 + hstep, voffB);
            PG8_WAIT_V(6); PG8_BAR; PG8_MMA(1, 1, At, B1); PG8_BAR;
            PG8_LDB(B0, 1, 0); PG8_SCHED; PG8_LDA(At, 1, 0); PG8_STAGE(PG8_SA(0, 1), a2, vS[1]);
            PG8_WAIT_L(8); PG8_BAR; PG8_WAIT_L(0); PG8_MMA(0, 0, At, B0); PG8_BAR; PG8_SCHED;
            PG8_LDB(B1, 1, 1); PG8_STAGE(PG8_SB(1, 0), b3, voffB);
            PG8_BAR; PG8_WAIT_L(0); PG8_MMA(0, 1, At, B1); PG8_BAR;
            PG8_LDA(At, 1, 1); PG8_STAGE(PG8_SA(1, 0), a3, vS[0]);
            PG8_BAR; PG8_WAIT_L(0); PG8_MMA(1, 0, At, B0); PG8_BAR; PG8_SCHED;
            PG8_STAGE(PG8_SB(1, 1), b3 + hstep, voffB);
            PG8_WAIT_V(6); PG8_BAR; PG8_MMA(1, 1, At, B1); PG8_BAR;
            }
        }
        if constexpr (ALIGN_EPI) { if (wr == 0) PG8_BAR; }
        if constexpr (!Epi::AFTER_DRAIN) { E(acc, cur, wr, wc, fr, fq); S.done(cur); }
        if (!has_next) break;
#pragma unroll
        for (int a = 0; a < 2; ++a)
#pragma unroll
            for (int b = 0; b < 2; ++b)
#pragma unroll
                for (int m = 0; m < 4; ++m)
#pragma unroll
                    for (int n = 0; n < 2; ++n) acc[a][b][m][n] = (f32x4){0.f, 0.f, 0.f, 0.f};
        cur = nxt; cA = nA; cB = nB; ++ui;
        if constexpr (Sched::GATHER) {
#pragma unroll
            for (int i = 0; i < 2; ++i) { vA[0][i] = vN[0][i]; vA[1][i] = vN[1][i]; } }
        if constexpr (ALIGN_EPI) { if (wr == 1) PG8_BAR; }
    }
    PG8_WAIT_V(0);
    if constexpr (!ALIGN_EPI) { if (wr == 0) PG8_BAR; }
    PG8_BAR;
    if constexpr (Epi::AFTER_DRAIN) { E.fused(acc, cur, wr, wc, fr, fq, lds, wid, lane); S.done(cur); }
#undef PG8_SA
#undef PG8_SB
#undef PG8_STAGE
#undef PG8_LDA
#undef PG8_LDB
#undef PG8_MMA
#undef PG8_WAIT_V
#undef PG8_WAIT_L
#undef PG8_BAR
#undef PG8_SCHED
}
}

constexpr int NWAVES = 8;
constexpr int BATCH = 8, SEQ = 8192, D = 1024, T = BATCH * SEQ;
constexpr int IN_TOTAL = 10768, NP1 = 7936;
constexpr int NSLOT = 2 * T + 4096;
constexpr int NPH = 18;
#ifndef MK_N_LAUNCHES
#define MK_N_LAUNCHES 1
#endif
constexpr int N_LAUNCHES = MK_N_LAUNCHES;
static_assert(N_LAUNCHES == 1 || N_LAUNCHES == NPH, "MK_N_LAUNCHES is 1 or NPH");
constexpr int DNU = 73728;

constexpr size_t MiB = 1u << 20;
constexpr size_t WS_CTL = 0, CTL_ZERO_BYTES = 1 * MiB;
constexpr size_t WS_ROWS = 131072;
constexpr size_t WS_BTP1 = 1 * MiB;
constexpr size_t WS_BTZ = 17 * MiB, WS_BTGA = 19 * MiB, WS_BTGB = 21 * MiB, WS_BTB = 23 * MiB, WS_BTOUT = 25 * MiB, WS_BTPG = 27 * MiB;
constexpr size_t WS_BTA = 29 * MiB;
constexpr size_t WS_BTPLE = 30 * MiB;
constexpr size_t WS_BTGU = 31 * MiB;
constexpr size_t WS_BTDN = 47 * MiB;
constexpr size_t WS_QA = 56 * MiB;
constexpr size_t WS_DNP = 56 * MiB;
constexpr size_t WS_G1 = 56 * MiB, WS_G2 = 184 * MiB;
constexpr size_t WS_H3 = 56 * MiB;
constexpr size_t WS_H2 = 184 * MiB;
constexpr size_t WS_PB = 184 * MiB;
constexpr size_t WS_E1 = 216 * MiB;
constexpr size_t WS_HX = 312 * MiB;
constexpr size_t WS_ACT = 576 * MiB;
constexpr size_t WS_Y = 642 * MiB;
constexpr size_t WS_QB = 632 * MiB;
constexpr size_t WS_ON = 632 * MiB;
constexpr size_t WS_OA = 760 * MiB;
constexpr size_t WS_HR = 824 * MiB;
constexpr size_t WS_BG = 1016 * MiB;
constexpr size_t WS_TOK = 1020 * MiB;
constexpr size_t WS_SLOT = 1021 * MiB;
constexpr size_t WS_CW = 1021 * MiB + 512 * 1024;
constexpr size_t WS_DLB = 1022 * MiB + 256 * 1024;
constexpr size_t WS_END = 1024 * MiB;
static_assert(WS_ROWS + (size_t)NSLOT * 4 <= CTL_ZERO_BYTES && WS_Y + (size_t)NSLOT * 2048 <= WS_BG && WS_HX + (size_t)NSLOT * 2048 <= WS_ACT && WS_ACT + (size_t)NSLOT * 512 <= WS_Y && WS_HR + (size_t)T * 2048 <= WS_BG && WS_CW + (size_t)NSLOT * 4 <= WS_DLB, "d_ws map");
constexpr size_t DO_H = 0, DO_OG = 0, DO_LSE = 192 * MiB;
constexpr int CW_BAR = 4096;
constexpr int CW_CNT = 16384;
constexpr int CW_CUR = 16384 + 64;
constexpr int RING_OFF = 0, RING_BYTES = 131072;
constexpr int LDS_BYTES = 147456;
constexpr int MISC_OFF = LDS_BYTES - 256;

#define GAS __attribute__((address_space(1)))
#define LAS __attribute__((address_space(3)))
typedef unsigned short bf16;
typedef unsigned v4u __attribute__((ext_vector_type(4)));
typedef unsigned v2u __attribute__((ext_vector_type(2)));
typedef float f32x4 __attribute__((ext_vector_type(4)));
typedef float f32x16 __attribute__((ext_vector_type(16)));
typedef short bf16x8 __attribute__((ext_vector_type(8)));
typedef short s16x4 __attribute__((ext_vector_type(4)));
typedef GAS unsigned gu32;
#define RLX_AGENT __ATOMIC_RELAXED, __HIP_MEMORY_SCOPE_AGENT
using pg8::cvt_pk_bf16; using pg8::bflo; using pg8::bfhi; using pg8::pack8; using pg8::unpack8; using pg8::sigm;
__device__ __forceinline__ float bf2f(unsigned short b) { return __uint_as_float(((unsigned)b) << 16); }
__device__ __forceinline__ unsigned short f2bf(float f) { return (unsigned short)(cvt_pk_bf16(f, 0.f) & 0xffffu); }
__device__ __forceinline__ int crow(int r, int hi) { return (r & 3) + 8 * (r >> 2) + 4 * hi; }
template <int CTRL> __device__ __forceinline__ float dpp_mov(float v) { return __builtin_bit_cast(float, __builtin_amdgcn_update_dpp(0, __builtin_bit_cast(int, v), CTRL, 0xF, 0xF, true)); }
__device__ __forceinline__ float wave_sum(float v) {
    v += dpp_mov<0xB1>(v); v += dpp_mov<0x4E>(v); v += dpp_mov<0x141>(v); v += dpp_mov<0x140>(v);
    const int iv = __builtin_bit_cast(int, v);
    const float r0 = __builtin_bit_cast(float, __builtin_amdgcn_readlane(iv, 0)), r1 = __builtin_bit_cast(float, __builtin_amdgcn_readlane(iv, 16)), r2 = __builtin_bit_cast(float, __builtin_amdgcn_readlane(iv, 32)), r3 = __builtin_bit_cast(float, __builtin_amdgcn_readlane(iv, 48));
    return (r0 + r1) + (r2 + r3);
}
__device__ __forceinline__ s16x4 ldtr(const LAS unsigned char* p) { return __builtin_bit_cast(s16x4, __builtin_amdgcn_ds_read_tr16_b64_v4i16((LAS s16x4*)p)); }
#define MFMA32(a, b, c) __builtin_amdgcn_mfma_f32_32x32x16_bf16((a), (b), (c), 0, 0, 0)

#define XB_TMO      128
#define XB_XCNT(j)  (256  + 64 * (j))
#define XB_XSUB(j)  (1280 + 64 * (j))
#define XB_XGEN(j)  (2304 + 64 * (j))
#define XB_TOP      3328
#define XB_TOPGEN   3392
#define XCD_BAR_WORDS 3456
#define XB_SPIN_CAP (1u << 18)

__device__ __forceinline__ unsigned xb_ld(unsigned* p)              { return __hip_atomic_load(p, __ATOMIC_RELAXED, __HIP_MEMORY_SCOPE_AGENT); }
__device__ __forceinline__ unsigned xb_add(unsigned* p, unsigned v) { return __hip_atomic_fetch_add(p, v, __ATOMIC_RELAXED, __HIP_MEMORY_SCOPE_AGENT); }
__device__ __forceinline__ unsigned xb_xcc_id() { return (unsigned)__builtin_amdgcn_s_getreg((3 << 11) | 20) & 0xFu; }
#define XB_SPIN(cond, bar) do { unsigned _sp = 0; while (cond) { __builtin_amdgcn_s_sleep(1); \
    if ((++_sp & 255u) == 0u) { if (xb_ld(&(bar)[XB_TMO])) break; if (_sp > XB_SPIN_CAP) { atomicAdd(&(bar)[XB_TMO], 1u); break; } } } } while (0)

struct XcdBarrier {
    unsigned* bar; unsigned x;
    volatile LAS unsigned* st;
};

__device__ __forceinline__ XcdBarrier xcd_barrier_post(unsigned* bar, volatile LAS unsigned* st) {
    XcdBarrier b; b.bar = bar; b.x = xb_xcc_id(); b.st = st;
    if (threadIdx.x == 0) (void)xb_add(&bar[XB_XCNT(b.x)], 1u);
    return b;
}
__device__ __forceinline__ void xcd_barrier_complete(unsigned* bar, unsigned x, unsigned& nloc, unsigned& nx) {
    const unsigned G = gridDim.x * gridDim.y * gridDim.z;
    unsigned sum, cnt, mine, sp = 0u;
    for (;;) {
        sum = 0u; cnt = 0u; mine = 0u;
#pragma unroll
        for (unsigned j = 0; j < 16; ++j) { const unsigned c = xb_ld(&bar[XB_XCNT(j)]); sum += c; cnt += (c > 0u) ? 1u : 0u; mine = (j == x) ? c : mine; }
        if (sum == G) break;
        __builtin_amdgcn_s_sleep(1);
        if ((++sp & 255u) == 0u) { if (xb_ld(&bar[XB_TMO])) break; if (sp > XB_SPIN_CAP) { atomicAdd(&bar[XB_TMO], 1u); break; } }
    }
    nloc = mine > 0u ? mine : 1u; nx = cnt > 0u ? cnt : 1u;
}

__device__ __forceinline__ void xcd_barrier(const XcdBarrier& b) {
    asm volatile("s_waitcnt vmcnt(0)" ::: "memory");
    __syncthreads();
    if (threadIdx.x == 0) {
        unsigned* bar = b.bar;
        __builtin_amdgcn_s_waitcnt(0);
        unsigned nloc = b.st[0], nx = b.st[1];
        if (nloc == 0u) { xcd_barrier_complete(bar, b.x, nloc, nx); b.st[0] = nloc; b.st[1] = nx; }
        const unsigned old = xb_add(&bar[XB_XSUB(b.x)], 1u);
        const unsigned gen = old / nloc;
        if (old + 1u == (gen + 1u) * nloc) {
            __builtin_amdgcn_fence(__ATOMIC_RELEASE, "agent");
            asm volatile("s_waitcnt vmcnt(0)" ::: "memory");
            const unsigned og = xb_add(&bar[XB_TOP], 1u);
            const unsigned tg = og / nx;
            if (og + 1u == (tg + 1u) * nx) xb_add(&bar[XB_TOPGEN], 1u);
            else XB_SPIN(xb_ld(&bar[XB_TOPGEN]) == tg, bar);
            __builtin_amdgcn_fence(__ATOMIC_ACQUIRE, "agent");
            xb_add(&bar[XB_XGEN(b.x)], 1u);
            asm volatile("s_waitcnt vmcnt(0)" ::: "memory");
        } else {
            XB_SPIN(xb_ld(&bar[XB_XGEN(b.x)]) == gen, bar);
            __builtin_amdgcn_fence(__ATOMIC_ACQUIRE, "agent");
            asm volatile("s_waitcnt vmcnt(0)" ::: "memory");
        }
    }
    __syncthreads();
}

__device__ __forceinline__ void p0_tr_item(const float* W, int ld, int K, int scol, bf16* WT, int drow, int k0, LAS float* scr, int lane) {
#pragma unroll 8
    for (int i = 0; i < 32; ++i) { const int kk = 2 * i + (lane >> 5); scr[kk * 33 + (lane & 31)] = W[(size_t)(k0 + kk) * ld + scol + (lane & 31)]; }
    asm volatile("s_waitcnt lgkmcnt(0)" ::: "memory");
    const int c = lane & 7;
#pragma unroll
    for (int j = 0; j < 4; ++j) { const int n = (lane >> 3) + 8 * j; const LAS float* s = scr + (8 * c) * 33 + n;
        v4u o; o.x = cvt_pk_bf16(s[0 * 33], s[1 * 33]); o.y = cvt_pk_bf16(s[2 * 33], s[3 * 33]); o.z = cvt_pk_bf16(s[4 * 33], s[5 * 33]); o.w = cvt_pk_bf16(s[6 * 33], s[7 * 33]);
        *(GAS v4u*)(WT + (size_t)(drow + n) * K + k0 + 8 * c) = o; }
    asm volatile("s_waitcnt lgkmcnt(0)" ::: "memory");
}
__device__ __forceinline__ void rms_row_to_bf16(const float* xrow, const float* gain, bf16* orow, int lane) {
    const GAS f32x4* xr = (const GAS f32x4*)xrow + lane; const GAS f32x4* gr = (const GAS f32x4*)gain + lane;
    f32x4 v[4]; float s = 0.f;
#pragma unroll
    for (int j = 0; j < 4; ++j) { v[j] = xr[64 * j]; s += (v[j].x * v[j].x + v[j].y * v[j].y) + (v[j].z * v[j].z + v[j].w * v[j].w); }
    const float rs = rsqrtf(wave_sum(s) * (1.f / D) + 1e-6f);
    GAS v2u* o8 = (GAS v2u*)orow + lane;
#pragma unroll
    for (int j = 0; j < 4; ++j) { const f32x4 g = gr[64 * j]; v2u w; w.x = cvt_pk_bf16(v[j].x * rs * g.x, v[j].y * rs * g.y); w.y = cvt_pk_bf16(v[j].z * rs * g.z, v[j].w * rs * g.w); o8[64 * j] = w; }
}

__device__ __forceinline__ void rms_rows_to_bf16(const float* X, const float* gain, bf16* O, int first, int stride, int lane) {
    const GAS f32x4* gr = (const GAS f32x4*)gain + lane; f32x4 g[4];
#pragma unroll
    for (int j = 0; j < 4; ++j) g[j] = gr[64 * j];
    f32x4 nx[4];
    if (first < T) { const GAS f32x4* xr = (const GAS f32x4*)(X + (size_t)first * D) + lane;
#pragma unroll
        for (int j = 0; j < 4; ++j) nx[j] = xr[64 * j]; }
    for (int m = first; m < T; m += stride) {
        f32x4 v[4]; float s = 0.f;
#pragma unroll
        for (int j = 0; j < 4; ++j) v[j] = nx[j];
        if (m + stride < T) { const GAS f32x4* xr = (const GAS f32x4*)(X + (size_t)(m + stride) * D) + lane;
#pragma unroll
            for (int j = 0; j < 4; ++j) nx[j] = xr[64 * j]; }
#pragma unroll
        for (int j = 0; j < 4; ++j) s += (v[j].x * v[j].x + v[j].y * v[j].y) + (v[j].z * v[j].z + v[j].w * v[j].w);
        const float rs = rsqrtf(wave_sum(s) * (1.f / D) + 1e-6f);
        GAS v2u* o8 = (GAS v2u*)(O + (size_t)m * D) + lane;
#pragma unroll
        for (int j = 0; j < 4; ++j) { v2u w; w.x = cvt_pk_bf16(v[j].x * rs * g[j].x, v[j].y * rs * g[j].y); w.y = cvt_pk_bf16(v[j].z * rs * g[j].z, v[j].w * rs * g[j].w); o8[64 * j] = w; }
    }
}

struct Ptrs {
    const float* in[24]; float* out; unsigned char* ws;
};

__device__ __forceinline__ void p0_prologue(const Ptrs& P, LAS unsigned char* lds, int G, int c, int wave, int lane) {
    LAS float* scr = (LAS float*)(lds + wave * 16384);
    const int gw = c * NWAVES + wave, NGW = G * NWAVES;
    const float* w_in = P.in[3];
    bf16* BTP1 = (bf16*)(P.ws + WS_BTP1);
    constexpr int I_QK = 16 * 96, I_VB = 16 * 144, I_BA = 16, I_Z = 16 * 32, I_A = 8 * 32, I_SQ = 16 * 32, I_PLE = 4 * 32, I_EG = 16 * 16 * 8, I_ED = 16 * 4 * 32;
    constexpr int NITEMS = I_QK + I_VB + I_BA + 3 * I_Z + I_A + 3 * I_SQ + I_PLE + 2 * I_EG + I_ED;
    for (int it = gw; it < NITEMS; it += NGW) {
        int r = it;
        if (r < I_QK) { const int kb = r / 96, nb = r % 96, n0 = 32 * nb, pn = n0 >> 8, w = n0 & 255, wc = w >> 6, bj = (w >> 5) & 1;
            p0_tr_item(w_in, IN_TOTAL, D, n0, BTP1, 256 * pn + 128 * bj + 32 * wc, 64 * kb, scr, lane); continue; } r -= I_QK;
        if (r < I_VB) { const int kb = r / 144, nb = r % 144, n0 = 3072 + 32 * nb; p0_tr_item(w_in, IN_TOTAL, D, n0, BTP1, n0, 64 * kb, scr, lane); continue; } r -= I_VB;
        if (r < I_BA) { p0_tr_item(w_in, IN_TOTAL, D, 8704, BTP1, 7680, 64 * r, scr, lane); continue; } r -= I_BA;
        if (r < I_Z) { const int kb = r / 32, nb = r % 32; p0_tr_item(w_in, IN_TOTAL, D, 7680 + 32 * nb, (bf16*)(P.ws + WS_BTZ), 32 * nb, 64 * kb, scr, lane); continue; } r -= I_Z;
        if (r < I_Z) { const int kb = r / 32, nb = r % 32; p0_tr_item(w_in, IN_TOTAL, D, 8720 + 32 * nb, (bf16*)(P.ws + WS_BTGA), 32 * nb, 64 * kb, scr, lane); continue; } r -= I_Z;
        if (r < I_Z) { const int kb = r / 32, nb = r % 32; p0_tr_item(w_in, IN_TOTAL, D, 9744 + 32 * nb, (bf16*)(P.ws + WS_BTGB), 32 * nb, 64 * kb, scr, lane); continue; } r -= I_Z;
        if (r < I_A) { const int kb = r / 32, nb = r % 32; p0_tr_item(P.in[10], D, 512, 32 * nb, (bf16*)(P.ws + WS_BTA), 32 * nb, 64 * kb, scr, lane); continue; } r -= I_A;
        if (r < I_SQ) { const int kb = r / 32, nb = r % 32; p0_tr_item(P.in[11], D, D, 32 * nb, (bf16*)(P.ws + WS_BTB), 32 * nb, 64 * kb, scr, lane); continue; } r -= I_SQ;
        if (r < I_SQ) { const int kb = r / 32, nb = r % 32; p0_tr_item(P.in[12], D, D, 32 * nb, (bf16*)(P.ws + WS_BTOUT), 32 * nb, 64 * kb, scr, lane); continue; } r -= I_SQ;
        if (r < I_SQ) { const int kb = r / 32, nb = r % 32; p0_tr_item(P.in[23], D, D, 32 * nb, (bf16*)(P.ws + WS_BTPG), 32 * nb, 64 * kb, scr, lane); continue; } r -= I_SQ;
        if (r < I_PLE) { const int kb = r / 32, nb = r % 32; p0_tr_item(P.in[22], D, 256, 32 * nb, (bf16*)(P.ws + WS_BTPLE), 32 * nb, 64 * kb, scr, lane); continue; } r -= I_PLE;
        if (r < I_EG) { const int e = r / 128, q = r % 128, kb = q / 8, nb = q % 8, f0 = 32 * nb;
            p0_tr_item(P.in[18] + (size_t)e * 1024 * 256, 256, D, f0, (bf16*)(P.ws + WS_BTGU) + (size_t)e * 512 * 1024, 256 * (f0 >> 7) + (f0 & 127), 64 * kb, scr, lane); continue; } r -= I_EG;
        if (r < I_EG) { const int e = r / 128, q = r % 128, kb = q / 8, nb = q % 8, f0 = 32 * nb;
            p0_tr_item(P.in[19] + (size_t)e * 1024 * 256, 256, D, f0, (bf16*)(P.ws + WS_BTGU) + (size_t)e * 512 * 1024, 256 * (f0 >> 7) + 128 + (f0 & 127), 64 * kb, scr, lane); continue; } r -= I_EG;
        { const int e = r / 128, q = r % 128, kb = q / 32, nb = q % 32;
            p0_tr_item(P.in[20] + (size_t)e * 256 * 1024, D, 256, 32 * nb, (bf16*)(P.ws + WS_BTDN) + (size_t)e * 1024 * 256, 32 * nb, 64 * kb, scr, lane); }
    }
    { GAS v4u* z = (GAS v4u*)(BTP1 + (size_t)7712 * D); const int nz = 224 * D / 8; for (int i = gw * 64 + lane; i < nz; i += NGW * 64) z[i] = (v4u){0u, 0u, 0u, 0u}; }
    bf16* H = (bf16*)((unsigned char*)P.out + DO_H);
    rms_rows_to_bf16(P.in[0], P.in[2], H, gw, NGW, lane);
}

__device__ __forceinline__ void attn_phase(LAS unsigned char* lds, const bf16* QA, bf16* OG, float* LSE, int G, int c) {
    int tid_ = threadIdx.x; asm volatile("" : "+v"(tid_));
    const int tid = tid_, lane = tid & 63, wid = __builtin_amdgcn_readfirstlane(tid >> 6), l32 = lane & 31, hi = lane >> 5;
    LAS unsigned char* KS = lds; LAS unsigned char* VS = lds + 55296;
    for (int u = c; u < 6144; u += G) {
        const int b = u / 768; int rem = u % 768; int g, h, r, pr;
        if (rem < 256) { g = 0; h = rem >> 5; r = 0; pr = rem & 31; }
        else if (rem < 512) { rem -= 256; g = 1; h = rem >> 5; r = (rem & 31) >> 3; pr = rem & 7; }
        else { rem -= 512; g = 2; h = rem >> 5; r = (rem & 31) >> 1; pr = rem & 1; }
        const int dil = 1 << (2 * g);
        const size_t rowb = (size_t)b * SEQ;
        const bf16* Qg = QA + g * 512 + h * 64;
        __syncthreads();
#pragma unroll
        for (int k = 0; k < 6; ++k) {
            const int ci = tid + 512 * k, j = ci >> 3, ch = ci & 7, sidx = 256 * pr - 128 + j;
            v4u kv = (v4u){0u, 0u, 0u, 0u}, vv = (v4u){0u, 0u, 0u, 0u};
            if (sidx >= 0) { const bf16* p = Qg + (rowb + (size_t)(sidx * dil + r)) * pg8::QAP + ch * 8; kv = *(const GAS v4u*)(p + 1536); vv = *(const GAS v4u*)(p + 3072); }
            *(LAS v4u*)(KS + j * 144 + ch * 16) = kv; *(LAS v4u*)(VS + j * 144 + ch * 16) = vv;
        }
        const int qi = 32 * wid + l32; const size_t mq = rowb + (size_t)((256 * pr + qi) * dil + r);
        bf16x8 qf[4];
#pragma unroll
        for (int ks = 0; ks < 4; ++ks) qf[ks] = *(const GAS bf16x8*)(Qg + mq * pg8::QAP + 16 * ks + 8 * hi);
        __syncthreads();
        f32x16 sc[5];
#pragma unroll
        for (int kb = 0; kb < 5; ++kb) {
            const int jb = 32 * wid + 32 * kb; f32x16 a = {};
#pragma unroll
            for (int ks = 0; ks < 4; ++ks) { const bf16x8 kf = *(const LAS bf16x8*)(KS + (jb + l32) * 144 + (16 * ks + 8 * hi) * 2); a = MFMA32(kf, qf[ks], a); }
            sc[kb] = a;
        }
        const float NEG = -1e30f;
#pragma unroll
        for (int rr = 0; rr < 16; ++rr) { const int cc = crow(rr, hi); if (cc < l32) sc[0][rr] = NEG; if (cc > l32) sc[4][rr] = NEG; }
        if (pr == 0) {
#pragma unroll
            for (int kb = 0; kb < 4; ++kb) if (wid + kb < 4) {
#pragma unroll
                for (int rr = 0; rr < 16; ++rr) sc[kb][rr] = NEG; }
        }
        float mx = NEG;
#pragma unroll
        for (int kb = 0; kb < 5; ++kb)
#pragma unroll
            for (int rr = 0; rr < 16; ++rr) mx = fmaxf(mx, sc[kb][rr]);
        mx = fmaxf(mx, __shfl_xor(mx, 32));
        float l = 0.f;
#pragma unroll
        for (int kb = 0; kb < 5; ++kb)
#pragma unroll
            for (int rr = 0; rr < 16; ++rr) { const float p = __builtin_amdgcn_exp2f(sc[kb][rr] - mx); sc[kb][rr] = p; l += p; }
        l += __shfl_xor(l, 32);
        f32x16 o[2]; o[0] = f32x16{}; o[1] = f32x16{};
        const int traddr = ((lane & 15) >> 2) * 144 + (16 * ((lane >> 4) & 1) + 4 * (lane & 3)) * 2;
#pragma unroll
        for (int kb = 0; kb < 5; ++kb)
#pragma unroll
            for (int ks2 = 0; ks2 < 2; ++ks2) {
                v4u pw; pw.x = cvt_pk_bf16(sc[kb][8 * ks2 + 0], sc[kb][8 * ks2 + 1]); pw.y = cvt_pk_bf16(sc[kb][8 * ks2 + 2], sc[kb][8 * ks2 + 3]);
                pw.z = cvt_pk_bf16(sc[kb][8 * ks2 + 4], sc[kb][8 * ks2 + 5]); pw.w = cvt_pk_bf16(sc[kb][8 * ks2 + 6], sc[kb][8 * ks2 + 7]);
                const bf16x8 pf = __builtin_bit_cast(bf16x8, pw);
                const int kv0 = 32 * wid + 32 * kb + 16 * ks2 + 4 * hi;
#pragma unroll
                for (int db = 0; db < 2; ++db) {
                    const LAS unsigned char* vp = VS + kv0 * 144 + traddr + db * 64;
                    const s16x4 lo = ldtr(vp), h4 = ldtr(vp + 8 * 144);
                    const bf16x8 vf = (bf16x8){lo[0], lo[1], lo[2], lo[3], h4[0], h4[1], h4[2], h4[3]};
                    o[db] = MFMA32(vf, pf, o[db]);
                }
            }
        const float inv = 1.0f / l;
        bf16* orow = OG + mq * 1536 + g * 512 + h * 64;
#pragma unroll
        for (int db = 0; db < 2; ++db)
#pragma unroll
            for (int rq = 0; rq < 4; ++rq) { v2u w; w.x = cvt_pk_bf16(o[db][4 * rq] * inv, o[db][4 * rq + 1] * inv); w.y = cvt_pk_bf16(o[db][4 * rq + 2] * inv, o[db][4 * rq + 3] * inv);
                *(GAS v2u*)(orow + 32 * db + 8 * rq + 4 * hi) = w; }
        if (hi == 0) LSE[mq * 24 + g * 8 + h] = mx + __builtin_amdgcn_logf(l);
    }
}

constexpr int PREP_RAW_PITCH = 784;
__device__ __forceinline__ void prep_issue_raw(const bf16* QB, int u, int tid, v4u (&pf)[7]) {
    const int bh = u >> 7, n = u & 127, b = bh >> 3, h = bh & 7;
#pragma unroll
    for (int k = 0; k < 7; ++k) { const int q = tid + 512 * k, rr = q / 48, cc = q % 48, tt = 64 * n - 3 + rr;
        v4u v = (v4u){0u, 0u, 0u, 0u};
        if (q < 67 * 48 && tt >= 0) v = *(const GAS v4u*)(QB + ((size_t)b * SEQ + tt) * pg8::QBP + (cc >> 4) * 1024 + h * 128 + (cc & 15) * 8);
        pf[k] = v; }
}
__device__ __forceinline__ void prep_phase(LAS unsigned char* lds, const bf16* QB, const float* BG, const float* conv_w, unsigned char* DNP, float* DLB, int G, int c) {
    const int tid0 = threadIdx.x, wid = __builtin_amdgcn_readfirstlane(tid0 >> 6);
    LAS unsigned char* QS = lds; LAS unsigned char* KS = lds + 17408; LAS unsigned char* VS = lds + 34816;
    LAS float* AS = (LAS float*)(lds + 52224); LAS unsigned char* TS = lds + 69632; LAS unsigned char* AB = lds + 78848; LAS unsigned char* DT = lds + 88064;
    LAS float* gcT = (LAS float*)(lds + 104768); LAS float* btT = (LAS float*)(lds + 105024); LAS float* cwT = (LAS float*)(lds + 105280);
    LAS unsigned char* RAW = lds + 52224;
    v4u pf[7];
    if (c < 8192) prep_issue_raw(QB, c, tid0, pf);
    for (int u = c; u < 8192; u += G) {
        int tid = tid0; asm volatile("" : "+v"(tid));
        const int lane = tid & 63, l32 = lane & 31, hi = lane >> 5;
        const int bh = u >> 7, n = u & 127, b = bh >> 3, h = bh & 7; const size_t m0 = (size_t)b * SEQ + 64 * n;
        unsigned char* rec = DNP + (size_t)u * DNU;
        __syncthreads();
#pragma unroll
        for (int k = 0; k < 7; ++k) { const int q = tid + 512 * k; if (q < 67 * 48) *(LAS v4u*)(RAW + (q / 48) * PREP_RAW_PITCH + (q % 48) * 16) = pf[k]; }
        if (wid == 0) {
            float gv = BG[(m0 + lane) * 16 + 8 + h]; const float bv = BG[(m0 + lane) * 16 + h];
#pragma unroll
            for (int o = 1; o < 64; o <<= 1) { const float t = __shfl_up(gv, o); if (lane >= o) gv += t; }
            gcT[lane] = gv; btT[lane] = bv; if (lane == 63) DLB[u] = __expf(gv);
        }
        if (tid >= 64 && tid < 64 + 384) { const int t = tid - 64;
#pragma unroll
            for (int j = 0; j < 4; ++j) cwT[j * 384 + t] = conv_w[j * 3072 + (t >> 7) * 1024 + h * 128 + (t & 127)]; }
        __syncthreads();
        if (u + G < 8192) prep_issue_raw(QB, u + G, tid, pf);
#pragma unroll 2
        for (int it = 0; it < 6; ++it) {
            const int item = tid + 512 * it, ten = item >> 10, i = (item & 1023) >> 4, cg = item & 15;
            f32x4 y0 = {0.f, 0.f, 0.f, 0.f}, y1 = {0.f, 0.f, 0.f, 0.f};
#pragma unroll
            for (int j = 0; j < 4; ++j) { const v4u raw = *(const LAS v4u*)(RAW + (i + j) * PREP_RAW_PITCH + (ten * 16 + cg) * 16); f32x4 a, bb; unpack8(raw, a, bb);
                const f32x4 w0 = *(const LAS f32x4*)(cwT + j * 384 + ten * 128 + cg * 8), w1 = *(const LAS f32x4*)(cwT + j * 384 + ten * 128 + cg * 8 + 4); y0 += a * w0; y1 += bb * w1; }
#pragma unroll
            for (int e = 0; e < 4; ++e) { y0[e] = y0[e] * sigm(y0[e]); y1[e] = y1[e] * sigm(y1[e]); }
            float scl;
            if (ten < 2) { float ss = (y0[0] * y0[0] + y0[1] * y0[1]) + (y0[2] * y0[2] + y0[3] * y0[3]) + (y1[0] * y1[0] + y1[1] * y1[1]) + (y1[2] * y1[2] + y1[3] * y1[3]);
                ss += __shfl_xor(ss, 1); ss += __shfl_xor(ss, 2); ss += __shfl_xor(ss, 4); ss += __shfl_xor(ss, 8);
                scl = rsqrtf(ss + 1e-6f) * (ten == 0 ? 0.08838834764831845f : 1.0f); }
            else scl = btT[i];
            LAS unsigned char* dst = (ten == 0 ? QS : (ten == 1 ? KS : VS)) + i * 272 + cg * 16;
            *(LAS v4u*)dst = pack8(y0 * scl, y1 * scl);
        }
        __syncthreads();
        if (wid < 6) {
            const int kind = wid / 3, pi = wid % 3, ib = pi ? 1 : 0, jb = (pi == 2) ? 1 : 0;
            f32x16 a = {};
            if (kind == 0) {
#pragma unroll
                for (int ks = 0; ks < 8; ++ks) { const bf16x8 af = *(const LAS bf16x8*)(KS + (32 * ib + l32) * 272 + (16 * ks + 8 * hi) * 2), bf = *(const LAS bf16x8*)(KS + (32 * jb + l32) * 272 + (16 * ks + 8 * hi) * 2); a = MFMA32(af, bf, a); }
                const int j = 32 * jb + l32; const float gj = gcT[j];
#pragma unroll
                for (int rr = 0; rr < 16; ++rr) { const int i = 32 * ib + crow(rr, hi); const float v = (j < i) ? btT[i] * a[rr] * __expf(gcT[i] - gj) : 0.f; AS[i * 68 + j] = v; *(LAS unsigned short*)(AB + i * 144 + j * 2) = f2bf(v); }
            } else {
#pragma unroll
                for (int ks = 0; ks < 8; ++ks) { const bf16x8 af = *(const LAS bf16x8*)(KS + (32 * jb + l32) * 272 + (16 * ks + 8 * hi) * 2), bf = *(const LAS bf16x8*)(QS + (32 * ib + l32) * 272 + (16 * ks + 8 * hi) * 2); a = MFMA32(af, bf, a); }
                const int i = 32 * ib + l32; const float gi = gcT[i];
#pragma unroll
                for (int rr = 0; rr < 16; ++rr) { const int j = 32 * jb + crow(rr, hi); a[rr] = (j <= i) ? a[rr] * __expf(gi - gcT[j]) : 0.f; }
#pragma unroll
                for (int ks2 = 0; ks2 < 2; ++ks2) { v4u w; w.x = cvt_pk_bf16(a[8 * ks2], a[8 * ks2 + 1]); w.y = cvt_pk_bf16(a[8 * ks2 + 2], a[8 * ks2 + 3]); w.z = cvt_pk_bf16(a[8 * ks2 + 4], a[8 * ks2 + 5]); w.w = cvt_pk_bf16(a[8 * ks2 + 6], a[8 * ks2 + 7]);
                    *(GAS v4u*)(rec + 49152 + ((ib * 4 + 2 * jb + ks2) * 64 + lane) * 16) = w; }
            }
        }
        __syncthreads();
        if (wid == 0) {
            const int blk = lane >> 4, cc = lane & 15; const float fcc = (float)cc;
            float x[16];
#pragma unroll
            for (int i = 0; i < 16; ++i) {
                float a0 = fmaxf(0.f, 1.f - fabsf(fcc - (float)i)), a1 = 0.f;
#pragma unroll
                for (int j4 = 0; j4 < (i + 3) / 4; ++j4) { const f32x4 av = *(const LAS f32x4*)(AS + (16 * blk + i) * 68 + 16 * blk + 4 * j4);
                    if (4 * j4 + 0 < i) a0 -= av[0] * x[4 * j4 + 0]; if (4 * j4 + 1 < i) a1 -= av[1] * x[4 * j4 + 1];
                    if (4 * j4 + 2 < i) a0 -= av[2] * x[4 * j4 + 2]; if (4 * j4 + 3 < i) a1 -= av[3] * x[4 * j4 + 3]; }
                x[i] = a0 + a1;
            }
            {
                unsigned xp[8];
#pragma unroll
                for (int q = 0; q < 8; ++q) xp[q] = cvt_pk_bf16(x[2 * q], x[2 * q + 1]);
#pragma unroll
                for (int q = 0; q < 8; ++q) { v4u w = (v4u){0u, 0u, 0u, 0u};
                    if ((q >> 1) == blk) { if (q & 1) w = (v4u){xp[4], xp[5], xp[6], xp[7]}; else w = (v4u){xp[0], xp[1], xp[2], xp[3]}; }
                    *(LAS v4u*)(DT + lane * 144 + q * 16) = w; }
#pragma unroll
                for (int m = 0; m < 64; ++m) { const int i = m & 15; float v = 0.f;
                    if ((m >> 4) == blk) v = x[i];
                    *(LAS unsigned short*)(TS + m * 144 + lane * 2) = f2bf(v); }
            }
            f32x16 Dp[2];
#pragma unroll
            for (int p = 0; p < 2; ++p) {
                bf16x8 af = *(const LAS bf16x8*)(AB + (32 * p + l32) * 144 + (32 * p + 8 * hi) * 2); if (l32 < 16) af = (bf16x8){0, 0, 0, 0, 0, 0, 0, 0};
                const bf16x8 bfr = *(const LAS bf16x8*)(DT + (32 * p + l32) * 144 + (32 * p + 8 * hi) * 2);
                f32x16 Y = {}; Y = MFMA32(af, bfr, Y);
                v4u yw; yw.x = cvt_pk_bf16(Y[8], Y[9]); yw.y = cvt_pk_bf16(Y[10], Y[11]); yw.z = cvt_pk_bf16(Y[12], Y[13]); yw.w = cvt_pk_bf16(Y[14], Y[15]);
                const v2u d0 = *(const LAS v2u*)(TS + (32 * p + l32) * 144 + (32 * p + 16 + 4 * hi) * 2), d1 = *(const LAS v2u*)(TS + (32 * p + l32) * 144 + (32 * p + 24 + 4 * hi) * 2);
                const v4u dw = (v4u){d0.x, d0.y, d1.x, d1.y};
                f32x16 Z = {}; Z = MFMA32(__builtin_bit_cast(bf16x8, dw), __builtin_bit_cast(bf16x8, yw), Z);
#pragma unroll
                for (int rq = 0; rq < 4; ++rq) { const v2u g = *(const LAS v2u*)(DT + (32 * p + l32) * 144 + (32 * p + 8 * rq + 4 * hi) * 2);
                    Z[4 * rq + 0] = bflo(g.x) - Z[4 * rq + 0]; Z[4 * rq + 1] = bfhi(g.x) - Z[4 * rq + 1]; Z[4 * rq + 2] = bflo(g.y) - Z[4 * rq + 2]; Z[4 * rq + 3] = bfhi(g.y) - Z[4 * rq + 3]; }
                Dp[p] = Z;
#pragma unroll
                for (int r = 0; r < 16; ++r) *(LAS unsigned short*)(TS + (32 * p + crow(r, hi)) * 144 + (32 * p + l32) * 2) = f2bf(Z[r]);
            }
            {
                f32x16 Y = {};
#pragma unroll
                for (int ks = 0; ks < 2; ++ks) {
                    const v2u a0 = *(const LAS v2u*)(AB + (32 + l32) * 144 + (16 * ks + 4 * hi) * 2), a1 = *(const LAS v2u*)(AB + (32 + l32) * 144 + (16 * ks + 8 + 4 * hi) * 2);
                    const v4u aw = (v4u){a0.x, a0.y, a1.x, a1.y};
                    v4u bw; bw.x = cvt_pk_bf16(Dp[0][8 * ks + 0], Dp[0][8 * ks + 1]); bw.y = cvt_pk_bf16(Dp[0][8 * ks + 2], Dp[0][8 * ks + 3]); bw.z = cvt_pk_bf16(Dp[0][8 * ks + 4], Dp[0][8 * ks + 5]); bw.w = cvt_pk_bf16(Dp[0][8 * ks + 6], Dp[0][8 * ks + 7]);
                    Y = MFMA32(__builtin_bit_cast(bf16x8, aw), __builtin_bit_cast(bf16x8, bw), Y);
                }
                f32x16 L = {};
#pragma unroll
                for (int ks = 0; ks < 2; ++ks) {
                    const v2u a0 = *(const LAS v2u*)(TS + (32 + l32) * 144 + (32 + 16 * ks + 4 * hi) * 2), a1 = *(const LAS v2u*)(TS + (32 + l32) * 144 + (32 + 16 * ks + 8 + 4 * hi) * 2);
                    const v4u aw = (v4u){a0.x, a0.y, a1.x, a1.y};
                    v4u bw; bw.x = cvt_pk_bf16(Y[8 * ks + 0], Y[8 * ks + 1]); bw.y = cvt_pk_bf16(Y[8 * ks + 2], Y[8 * ks + 3]); bw.z = cvt_pk_bf16(Y[8 * ks + 4], Y[8 * ks + 5]); bw.w = cvt_pk_bf16(Y[8 * ks + 6], Y[8 * ks + 7]);
                    L = MFMA32(__builtin_bit_cast(bf16x8, aw), __builtin_bit_cast(bf16x8, bw), L);
                }
#pragma unroll
                for (int r = 0; r < 16; ++r) *(LAS unsigned short*)(TS + (32 + crow(r, hi)) * 144 + l32 * 2) = f2bf(-L[r]);
            }
        } else {
            const float glast = gcT[63];
            for (int f = wid - 1; f < 32; f += 7) {
                if (f < 16) { const int ib = f >> 3, ks = f & 7, i = 32 * ib + l32; const float eg = __expf(gcT[i]);
                    const v2u lo = *(const LAS v2u*)(QS + i * 272 + (16 * ks + 4 * hi) * 2), h2 = *(const LAS v2u*)(QS + i * 272 + (16 * ks + 8 + 4 * hi) * 2);
                    v4u w; w.x = cvt_pk_bf16(bflo(lo.x) * eg, bfhi(lo.x) * eg); w.y = cvt_pk_bf16(bflo(lo.y) * eg, bfhi(lo.y) * eg); w.z = cvt_pk_bf16(bflo(h2.x) * eg, bfhi(h2.x) * eg); w.w = cvt_pk_bf16(bflo(h2.y) * eg, bfhi(h2.y) * eg);
                    *(GAS v4u*)(rec + 16384 + ((ib * 8 + ks) * 64 + lane) * 16) = w;
                } else { const int dkb = (f - 16) >> 2, ksj = (f - 16) & 3, dk = 32 * dkb + l32; float v[8];
#pragma unroll
                    for (int jj = 0; jj < 8; ++jj) { const int j = 16 * ksj + 4 * hi + (jj & 3) + 8 * (jj >> 2); v[jj] = bf2f(*(const LAS unsigned short*)(KS + j * 272 + dk * 2)) * __expf(glast - gcT[j]); }
                    v4u w; w.x = cvt_pk_bf16(v[0], v[1]); w.y = cvt_pk_bf16(v[2], v[3]); w.z = cvt_pk_bf16(v[4], v[5]); w.w = cvt_pk_bf16(v[6], v[7]);
                    *(GAS v4u*)(rec + 32768 + ((dkb * 4 + ksj) * 64 + lane) * 16) = w; }
            }
        }
        __syncthreads();
        {
            const int eb = wid & 3, ib = wid >> 2; f32x16 a = {};
            for (int ks = 0; ks < (ib ? 4 : 2); ++ks) {
                const bf16x8 tf = *(const LAS bf16x8*)(TS + (32 * ib + l32) * 144 + (16 * ks + 8 * hi) * 2);
                bf16x8 vf;
#pragma unroll
                for (int jj = 0; jj < 8; ++jj) vf[jj] = (short)*(const LAS unsigned short*)(VS + (16 * ks + 8 * hi + jj) * 272 + (32 * eb + l32) * 2);
                a = MFMA32(tf, vf, a);
#ifdef DBG_PREPCHK
                { bool b0 = false, b1 = false; for (int jj = 0; jj < 8; ++jj) { if ((((unsigned short)tf[jj]) & 0x7f80u) == 0x7f80u) b0 = true; if ((((unsigned short)vf[jj]) & 0x7f80u) == 0x7f80u) b1 = true; }
                  if (b0 || b1) atomicAnd(DBGW, ~1u); }
#endif
            }
#ifdef DBG_PREPCHK
            { bool b2 = false; for (int r = 0; r < 16; ++r) if (!(a[r] - a[r] == 0.f)) b2 = true; if (b2) atomicAnd(DBGW, ~4u); }
#endif
            v4u w0, w1; w0.x = cvt_pk_bf16(a[0], a[1]); w0.y = cvt_pk_bf16(a[2], a[3]); w0.z = cvt_pk_bf16(a[4], a[5]); w0.w = cvt_pk_bf16(a[6], a[7]);
            w1.x = cvt_pk_bf16(a[8], a[9]); w1.y = cvt_pk_bf16(a[10], a[11]); w1.z = cvt_pk_bf16(a[12], a[13]); w1.w = cvt_pk_bf16(a[14], a[15]);
            GAS v4u* up = (GAS v4u*)(rec + 57344 + ((eb * 2 + ib) * 64 + lane) * 32); up[0] = w0; up[1] = w1;
#ifdef DBG_PREPCHK
            { bool bb = false; const unsigned ww[8] = {w0.x, w0.y, w0.z, w0.w, w1.x, w1.y, w1.z, w1.w}; for (int k = 0; k < 8; ++k) if ((ww[k] & 0x7f80u) == 0x7f80u || (ww[k] & 0x7f800000u) == 0x7f800000u) bb = true;
              if (bb) atomicAnd(DBGW, ~2u); if (u == 5 && tid == 0) atomicAnd(DBGW, ~8u); }
#endif
        }
        __syncthreads();
        { const int i = tid >> 3, c8 = tid & 7; const float s = btT[i] * __expf(gcT[i]);
#pragma unroll
            for (int q = 0; q < 2; ++q) { const v4u kw = *(const LAS v4u*)(KS + i * 272 + c8 * 32 + q * 16); f32x4 a, bb; unpack8(kw, a, bb); *(LAS v4u*)(VS + i * 272 + c8 * 32 + q * 16) = pack8(a * s, bb * s); } }
        __syncthreads();
        {
            const int dkb = wid & 3, ib = wid >> 2; f32x16 a = {};
            for (int ks = 0; ks < (ib ? 4 : 2); ++ks) {
                bf16x8 kf;
#pragma unroll
                for (int jj = 0; jj < 8; ++jj) kf[jj] = (short)*(const LAS unsigned short*)(VS + (16 * ks + 8 * hi + jj) * 272 + (32 * dkb + l32) * 2);
                const bf16x8 tf = *(const LAS bf16x8*)(TS + (32 * ib + l32) * 144 + (16 * ks + 8 * hi) * 2);
                a = MFMA32(kf, tf, a);
#ifdef DBG_PREPCHK
                { bool b3 = false; for (int jj = 0; jj < 8; ++jj) if ((((unsigned short)kf[jj]) & 0x7f80u) == 0x7f80u) b3 = true; if (b3) atomicAnd(DBGW, ~1u); }
#endif
            }
#ifdef DBG_PREPCHK
            { bool b4 = false; for (int r = 0; r < 16; ++r) if (!(a[r] - a[r] == 0.f)) b4 = true; if (b4) atomicAnd(DBGW, ~16u); }
#endif
#pragma unroll
            for (int ks2 = 0; ks2 < 2; ++ks2) { v4u w; w.x = cvt_pk_bf16(a[8 * ks2], a[8 * ks2 + 1]); w.y = cvt_pk_bf16(a[8 * ks2 + 2], a[8 * ks2 + 3]); w.z = cvt_pk_bf16(a[8 * ks2 + 4], a[8 * ks2 + 5]); w.w = cvt_pk_bf16(a[8 * ks2 + 6], a[8 * ks2 + 7]);
                *(GAS v4u*)(rec + ((ib * 8 + 2 * dkb + ks2) * 64 + lane) * 16) = w; }
        }
    }
}

__device__ __forceinline__ void scan_chain(LAS unsigned char* lds, const unsigned char* DNP, const float* DLB, bf16* ON, const float* dn_gain, int bh) {
    int tid_ = threadIdx.x; asm volatile("" : "+v"(tid_));
    const int tid = tid_, lane = tid & 63, wid = __builtin_amdgcn_readfirstlane(tid >> 6), l32 = lane & 31, hi = lane >> 5;
    LAS unsigned char* OT = lds + 114688; LAS float* GT = (LAS float*)(lds + 132096);
    const int b = bh >> 3, h = bh & 7; const size_t u0 = (size_t)bh * 128;
    __syncthreads();
    if (tid < 128) GT[tid] = dn_gain[tid];
    const int lt = tid - 256;
    if (wid >= 4) { const GAS v4u* src = (const GAS v4u*)(DNP + u0 * DNU);
#pragma unroll
        for (int k = 0; k < 14; ++k) *(LAS v4u*)(lds + (lt + 256 * k) * 16) = src[lt + 256 * k]; }
    f32x16 S[4]; S[0] = f32x16{}; S[1] = f32x16{}; S[2] = f32x16{}; S[3] = f32x16{};
    v4u un[4] = {}; float dln = 0.f;
    if (wid < 4) { const GAS v4u* up = (const GAS v4u*)(DNP + u0 * DNU + 57344 + (wid * 2 * 64 + lane) * 32);
        un[0] = up[0]; un[1] = up[1]; un[2] = up[128]; un[3] = up[129]; dln = DLB[u0]; }
    __syncthreads();
#pragma unroll 1
    for (int n = 0; n < 128; ++n) {
        const LAS unsigned char* Pb = lds + (n & 1) * 57344;
        f32x16 O0 = {}, O1 = {};
        if (wid < 4) {
            const v4u uc[4] = {un[0], un[1], un[2], un[3]}; const float dl = dln;
            if (n + 1 < 128) { const GAS v4u* up = (const GAS v4u*)(DNP + (u0 + n + 1) * DNU + 57344 + (wid * 2 * 64 + lane) * 32);
              un[0] = up[0]; un[1] = up[1]; un[2] = up[128]; un[3] = up[129]; dln = DLB[u0 + n + 1]; }
            bf16x8 vb[4];
            {
                f32x16 W0 = {}, W1 = {};
#pragma unroll
                for (int ks = 0; ks < 8; ++ks) {
                    const int dkb = ks >> 1, o8 = 8 * (ks & 1);
                    v4u sw; sw.x = cvt_pk_bf16(S[dkb][o8 + 0], S[dkb][o8 + 1]); sw.y = cvt_pk_bf16(S[dkb][o8 + 2], S[dkb][o8 + 3]); sw.z = cvt_pk_bf16(S[dkb][o8 + 4], S[dkb][o8 + 5]); sw.w = cvt_pk_bf16(S[dkb][o8 + 6], S[dkb][o8 + 7]);
                    const bf16x8 sb = __builtin_bit_cast(bf16x8, sw);
                    const bf16x8 w0 = *(const LAS bf16x8*)(Pb + ((0 * 8 + ks) * 64 + lane) * 16), w1 = *(const LAS bf16x8*)(Pb + ((1 * 8 + ks) * 64 + lane) * 16);
                    W0 = MFMA32(w0, sb, W0); W1 = MFMA32(w1, sb, W1);
                    __builtin_amdgcn_sched_barrier(0);
                }
                float v[16];
#pragma unroll
                for (int q = 0; q < 2; ++q) { const v4u w = uc[q];
                    v[8 * q + 0] = bflo(w.x); v[8 * q + 1] = bfhi(w.x); v[8 * q + 2] = bflo(w.y); v[8 * q + 3] = bfhi(w.y); v[8 * q + 4] = bflo(w.z); v[8 * q + 5] = bfhi(w.z); v[8 * q + 6] = bflo(w.w); v[8 * q + 7] = bfhi(w.w); }
#pragma unroll
                for (int r = 0; r < 16; ++r) v[r] -= W0[r];
#pragma unroll
                for (int ks2 = 0; ks2 < 2; ++ks2) { v4u w; w.x = cvt_pk_bf16(v[8 * ks2], v[8 * ks2 + 1]); w.y = cvt_pk_bf16(v[8 * ks2 + 2], v[8 * ks2 + 3]); w.z = cvt_pk_bf16(v[8 * ks2 + 4], v[8 * ks2 + 5]); w.w = cvt_pk_bf16(v[8 * ks2 + 6], v[8 * ks2 + 7]); vb[ks2] = __builtin_bit_cast(bf16x8, w); }
#pragma unroll
                for (int q = 0; q < 2; ++q) { const v4u w = uc[2 + q];
                    v[8 * q + 0] = bflo(w.x); v[8 * q + 1] = bfhi(w.x); v[8 * q + 2] = bflo(w.y); v[8 * q + 3] = bfhi(w.y); v[8 * q + 4] = bflo(w.z); v[8 * q + 5] = bfhi(w.z); v[8 * q + 6] = bflo(w.w); v[8 * q + 7] = bfhi(w.w); }
#pragma unroll
                for (int r = 0; r < 16; ++r) v[r] -= W1[r];
#pragma unroll
                for (int ks2 = 0; ks2 < 2; ++ks2) { v4u w; w.x = cvt_pk_bf16(v[8 * ks2], v[8 * ks2 + 1]); w.y = cvt_pk_bf16(v[8 * ks2 + 2], v[8 * ks2 + 3]); w.z = cvt_pk_bf16(v[8 * ks2 + 4], v[8 * ks2 + 5]); w.w = cvt_pk_bf16(v[8 * ks2 + 6], v[8 * ks2 + 7]); vb[2 + ks2] = __builtin_bit_cast(bf16x8, w); }
            }
            __builtin_amdgcn_sched_barrier(0);
#pragma unroll
            for (int ks = 0; ks < 8; ++ks) {
                const int dkb = ks >> 1, o8 = 8 * (ks & 1);
                v4u sw; sw.x = cvt_pk_bf16(S[dkb][o8 + 0], S[dkb][o8 + 1]); sw.y = cvt_pk_bf16(S[dkb][o8 + 2], S[dkb][o8 + 3]); sw.z = cvt_pk_bf16(S[dkb][o8 + 4], S[dkb][o8 + 5]); sw.w = cvt_pk_bf16(S[dkb][o8 + 6], S[dkb][o8 + 7]);
                const bf16x8 sb = __builtin_bit_cast(bf16x8, sw);
                const bf16x8 q0 = *(const LAS bf16x8*)(Pb + 16384 + ((0 * 8 + ks) * 64 + lane) * 16), q1 = *(const LAS bf16x8*)(Pb + 16384 + ((1 * 8 + ks) * 64 + lane) * 16);
                O0 = MFMA32(q0, sb, O0); O1 = MFMA32(q1, sb, O1);
                __builtin_amdgcn_sched_barrier(0);
            }
#pragma unroll
            for (int ksj = 0; ksj < 2; ++ksj) { const bf16x8 af = *(const LAS bf16x8*)(Pb + 49152 + ((0 * 4 + ksj) * 64 + lane) * 16); O0 = MFMA32(af, vb[ksj], O0); }
#pragma unroll
            for (int ksj = 0; ksj < 4; ++ksj) { const bf16x8 af = *(const LAS bf16x8*)(Pb + 49152 + ((1 * 4 + ksj) * 64 + lane) * 16); O1 = MFMA32(af, vb[ksj], O1); }
#pragma unroll
            for (int dkb = 0; dkb < 4; ++dkb) {
#pragma unroll
                for (int r = 0; r < 16; ++r) S[dkb][r] *= dl;
#pragma unroll
                for (int ksj = 0; ksj < 4; ++ksj) { const bf16x8 kf = *(const LAS bf16x8*)(Pb + 32768 + ((dkb * 4 + ksj) * 64 + lane) * 16); S[dkb] = MFMA32(kf, vb[ksj], S[dkb]); }
            }
        } else {
            if (n > 0) {
                const int i = lt >> 2, qd = lt & 3; f32x4 v[8]; float ss = 0.f;
#pragma unroll
                for (int k = 0; k < 4; ++k) { const v4u w = *(const LAS v4u*)(OT + i * 272 + qd * 64 + k * 16); unpack8(w, v[2 * k], v[2 * k + 1]); }
#pragma unroll
                for (int k = 0; k < 8; ++k) ss += (v[k][0] * v[k][0] + v[k][1] * v[k][1]) + (v[k][2] * v[k][2] + v[k][3] * v[k][3]);
                ss += __shfl_xor(ss, 1); ss += __shfl_xor(ss, 2);
                const float rs = rsqrtf(ss * (1.0f / 128.0f) + 1e-6f);
                bf16* dst = ON + ((size_t)b * SEQ + 64 * (n - 1) + i) * 1024 + h * 128 + qd * 32;
#pragma unroll
                for (int k = 0; k < 4; ++k) { const f32x4 g0 = *(const LAS f32x4*)(GT + qd * 32 + 8 * k), g1 = *(const LAS f32x4*)(GT + qd * 32 + 8 * k + 4); *(GAS v4u*)(dst + 8 * k) = pack8(v[2 * k] * rs * g0, v[2 * k + 1] * rs * g1); }
            }
            if (n + 1 < 128) { const GAS v4u* src = (const GAS v4u*)(DNP + (u0 + n + 1) * DNU); LAS unsigned char* Pn = lds + ((n + 1) & 1) * 57344;
#pragma unroll
                for (int k = 0; k < 14; ++k) *(LAS v4u*)(Pn + (lt + 256 * k) * 16) = src[lt + 256 * k]; }
        }
        __syncthreads();
        if (wid < 4) {
#pragma unroll
            for (int r = 0; r < 16; ++r) { *(LAS unsigned short*)(OT + (crow(r, hi)) * 272 + (32 * wid + l32) * 2) = f2bf(O0[r]); *(LAS unsigned short*)(OT + (32 + crow(r, hi)) * 272 + (32 * wid + l32) * 2) = f2bf(O1[r]); }
        }
        __syncthreads();
    }
    if (wid >= 4) {
        const int i = lt >> 2, qd = lt & 3; f32x4 v[8]; float ss = 0.f;
#pragma unroll
        for (int k = 0; k < 4; ++k) { const v4u w = *(const LAS v4u*)(OT + i * 272 + qd * 64 + k * 16); unpack8(w, v[2 * k], v[2 * k + 1]); }
#pragma unroll
        for (int k = 0; k < 8; ++k) ss += (v[k][0] * v[k][0] + v[k][1] * v[k][1]) + (v[k][2] * v[k][2] + v[k][3] * v[k][3]);
        ss += __shfl_xor(ss, 1); ss += __shfl_xor(ss, 2);
        const float rs = rsqrtf(ss * (1.0f / 128.0f) + 1e-6f);
        bf16* dst = ON + ((size_t)b * SEQ + 64 * 127 + i) * 1024 + h * 128 + qd * 32;
#pragma unroll
        for (int k = 0; k < 4; ++k) { const f32x4 g0 = *(const LAS f32x4*)(GT + qd * 32 + 8 * k), g1 = *(const LAS f32x4*)(GT + qd * 32 + 8 * k + 4); *(GAS v4u*)(dst + 8 * k) = pack8(v[2 * k] * rs * g0, v[2 * k + 1] * rs * g1); }
    }
}
__device__ __forceinline__ void combine_rows(const Ptrs& P, int first, int stride, int lane) {
    const bf16* OG = (const bf16*)((const unsigned char*)P.out + DO_OG); const float* LSE = (const float*)((const unsigned char*)P.out + DO_LSE);
    bf16* OA = (bf16*)(P.ws + WS_OA); bf16* HR = (bf16*)(P.ws + WS_HR);
    for (int m = first; m < T; m += stride) {
        const int hd = lane >> 3; const float l0 = LSE[(size_t)m * 24 + hd], l1 = LSE[(size_t)m * 24 + 8 + hd], l2 = LSE[(size_t)m * 24 + 16 + hd];
        const float mx = fmaxf(l0, fmaxf(l1, l2)); float w0 = __builtin_amdgcn_exp2f(l0 - mx), w1 = __builtin_amdgcn_exp2f(l1 - mx), w2 = __builtin_amdgcn_exp2f(l2 - mx);
        const float inv = 1.0f / (w0 + w1 + w2); w0 *= inv; w1 *= inv; w2 *= inv;
        const bf16* og = OG + (size_t)m * 1536 + lane * 8;
        f32x4 a0, b0, a1, b1, a2, b2; unpack8(*(const GAS v4u*)og, a0, b0); unpack8(*(const GAS v4u*)(og + 512), a1, b1); unpack8(*(const GAS v4u*)(og + 1024), a2, b2);
        *(GAS v4u*)(OA + (size_t)m * 512 + lane * 8) = pack8(a0 * w0 + a1 * w1 + a2 * w2, b0 * w0 + b1 * w1 + b2 * w2);
    }
    rms_rows_to_bf16(P.in[0], P.in[2], HR, first, stride, lane);
}

__device__ __forceinline__ void router_phase(const Ptrs& P, LAS unsigned char* lds, int G, int c, int wave, int lane) {
    LAS float* WrT = (LAS float*)lds; LAS unsigned* bcnt = (LAS unsigned*)(lds + 81920);
    const float* x1 = P.out; bf16* H2 = (bf16*)(P.ws + WS_H2); int4* TOK = (int4*)(P.ws + WS_TOK); unsigned* cnt = (unsigned*)(P.ws + WS_CTL) + CW_CNT;
    __syncthreads();
    for (int i = threadIdx.x; i < 1024 * 4; i += 512) { const int k = i >> 2, cc = i & 3; WrT[cc * 1024 + k] = P.in[14][i]; }
    for (int i = threadIdx.x; i < 1024 * 16; i += 512) { const int k = i >> 4, cc = i & 15; WrT[(4 + cc) * 1024 + k] = P.in[16][i]; }
    if (threadIdx.x < 16) bcnt[threadIdx.x] = 0u;
    __syncthreads();
    const GAS f32x4* gr = (const GAS f32x4*)P.in[13] + lane; f32x4 gn[4];
#pragma unroll
    for (int j = 0; j < 4; ++j) gn[j] = gr[64 * j];
    float bias[20];
#pragma unroll
    for (int q = 0; q < 4; ++q) bias[q] = P.in[15][q];
#pragma unroll
    for (int q = 0; q < 16; ++q) bias[4 + q] = P.in[17][q];
    unsigned mycnt = 0;
    const int gw = c * NWAVES + wave, NGW = G * NWAVES;
    f32x4 nx[4];
    if (gw < T) { const GAS f32x4* xr = (const GAS f32x4*)(x1 + (size_t)gw * D) + lane;
#pragma unroll
        for (int j = 0; j < 4; ++j) nx[j] = xr[64 * j]; }
    for (int m = gw; m < T; m += NGW) {
        asm volatile("" ::: "memory");
        f32x4 v[4]; float s = 0.f;
#pragma unroll
        for (int j = 0; j < 4; ++j) v[j] = nx[j];
        if (m + NGW < T) { const GAS f32x4* xr = (const GAS f32x4*)(x1 + (size_t)(m + NGW) * D) + lane;
#pragma unroll
            for (int j = 0; j < 4; ++j) nx[j] = xr[64 * j]; }
#pragma unroll
        for (int j = 0; j < 4; ++j) s += (v[j].x * v[j].x + v[j].y * v[j].y) + (v[j].z * v[j].z + v[j].w * v[j].w);
        const float rs = rsqrtf(wave_sum(s) * (1.f / D) + 1e-6f);
        GAS v2u* o8 = (GAS v2u*)(H2 + (size_t)m * D) + lane;
#pragma unroll
        for (int j = 0; j < 4; ++j) { v[j] = v[j] * rs * gn[j]; v2u w; w.x = cvt_pk_bf16(v[j].x, v[j].y); w.y = cvt_pk_bf16(v[j].z, v[j].w); o8[64 * j] = w; }
        float lg[20];
#pragma unroll
        for (int q = 0; q < 20; ++q) { float a = 0.f;
#pragma unroll
            for (int j = 0; j < 4; ++j) { const f32x4 w = *(const LAS f32x4*)(WrT + q * 1024 + 4 * lane + 256 * j); a += (v[j].x * w.x + v[j].y * w.y) + (v[j].z * w.z + v[j].w * w.w); }
            lg[q] = wave_sum(a) + bias[q]; }
        int gi = 0; float gm = lg[0];
#pragma unroll
        for (int q = 1; q < 4; ++q) if (lg[q] > gm) { gm = lg[q]; gi = q; }
        float gs = 0.f;
#pragma unroll
        for (int q = 0; q < 4; ++q) gs += __expf(lg[q] - gm);
        const float pg = 1.0f / gs;
        float sl[4];
#pragma unroll
        for (int q = 0; q < 4; ++q) sl[q] = gi == 0 ? lg[4 + q] : (gi == 1 ? lg[8 + q] : (gi == 2 ? lg[12 + q] : lg[16 + q]));
        int i0 = 0; float m0 = sl[0];
#pragma unroll
        for (int q = 1; q < 4; ++q) if (sl[q] > m0) { m0 = sl[q]; i0 = q; }
        int i1 = -1; float m1 = -3.0e38f;
#pragma unroll
        for (int q = 0; q < 4; ++q) if (q != i0 && sl[q] > m1) { m1 = sl[q]; i1 = q; }
        const float e1 = __expf(m1 - m0); const float w0 = 1.0f / (1.0f + e1), w1 = e1 * w0;
        const int ex0 = 4 * gi + i0, ex1 = 4 * gi + i1;
        if (lane == 0) TOK[m] = make_int4(ex0, ex1, __float_as_int(pg * w0), __float_as_int(pg * w1));
        mycnt += (lane == ex0 ? 1u : 0u) + (lane == ex1 ? 1u : 0u);
    }
    if (lane < 16 && mycnt) atomicAdd((unsigned*)&bcnt[lane], mycnt);
    __syncthreads();
    if (threadIdx.x < 16 && bcnt[threadIdx.x]) atomicAdd(&cnt[threadIdx.x], bcnt[threadIdx.x]);
}

__device__ __forceinline__ void place_phase(const Ptrs& P, LAS unsigned char* lds, int G, int c, int wave, int lane) {
    int* ROWS = (int*)(P.ws + WS_ROWS); const int4* TOK = (const int4*)(P.ws + WS_TOK); int2* SLOT = (int2*)(P.ws + WS_SLOT); float* CWv = (float*)(P.ws + WS_CW);
    const unsigned* cnt = (const unsigned*)(P.ws + WS_CTL) + CW_CNT; unsigned* cur = (unsigned*)(P.ws + WS_CTL) + CW_CUR;
    LAS unsigned* wc = (LAS unsigned*)lds;
    LAS unsigned* bb = (LAS unsigned*)(lds + 1024);
    for (int g = c; g < T / 512; g += G) {
        const int m = g * 512 + wave * 64 + lane; const int4 tk = TOK[m];
        __syncthreads();
        unsigned long long k0s = 0, k1s = 0;
#pragma unroll 1
        for (int e = 0; e < 16; ++e) { const unsigned long long k0 = __ballot(tk.x == e), k1 = __ballot(tk.y == e);
            if (tk.x == e) k0s = k0; if (tk.y == e) k1s = k1;
            if (lane == 0) { wc[(wave * 16 + e) * 2] = (unsigned)__popcll(k0); wc[(wave * 16 + e) * 2 + 1] = (unsigned)__popcll(k1); } }
        __syncthreads();
        if (threadIdx.x < 16) { const int e = threadIdx.x; unsigned tot = 0; for (int w = 0; w < 8; ++w) tot += wc[(w * 16 + e) * 2] + wc[(w * 16 + e) * 2 + 1];
            unsigned sb = 0; for (int q = 0; q < e; ++q) sb += ((cnt[q] + 255u) >> 8) * 256u;
            bb[e] = sb + (tot ? atomicAdd(&cur[e], tot) : 0u); }
        __syncthreads();
        unsigned o0 = bb[tk.x], o1 = bb[tk.y];
        for (int w = 0; w < wave; ++w) { o0 += wc[(w * 16 + tk.x) * 2] + wc[(w * 16 + tk.x) * 2 + 1]; o1 += wc[(w * 16 + tk.y) * 2] + wc[(w * 16 + tk.y) * 2 + 1]; }
        const unsigned long long lt = (1ull << lane) - 1ull;
        const int p0 = (int)(o0 + (unsigned)__popcll(k0s & lt));
        const int p1 = (int)(o1 + wc[(wave * 16 + tk.y) * 2] + (unsigned)__popcll(k1s & lt));
        SLOT[m] = make_int2(p0, p1); CWv[p0] = __int_as_float(tk.z); CWv[p1] = __int_as_float(tk.w); ROWS[p0] = m; ROWS[p1] = m;
    }
}

__device__ __forceinline__ void ple_norm_phase(const Ptrs& P, int G, int c, int wave, int lane) {
    float* xo = P.out; const bf16* Y = (const bf16*)(P.ws + WS_Y); const int2* SLOT = (const int2*)(P.ws + WS_SLOT); bf16* H3 = (bf16*)(P.ws + WS_H3); bf16* PB = (bf16*)(P.ws + WS_PB);
    const GAS f32x4* gr = (const GAS f32x4*)P.in[21] + lane; f32x4 gn[4];
#pragma unroll
    for (int j = 0; j < 4; ++j) gn[j] = gr[64 * j];
    const int gw = c * NWAVES + wave, NGW = G * NWAVES;
    f32x4 nx[4], npv; v2u ny0[4], ny1[4]; int2 sl2 = make_int2(0, 0);
    if (gw < T) { const int2 sl = SLOT[gw];
        const GAS f32x4* xr = (const GAS f32x4*)(xo + (size_t)gw * D) + lane; const GAS v2u* y0 = (const GAS v2u*)(Y + (size_t)sl.x * D) + lane; const GAS v2u* y1 = (const GAS v2u*)(Y + (size_t)sl.y * D) + lane;
#pragma unroll
        for (int j = 0; j < 4; ++j) { nx[j] = xr[64 * j]; ny0[j] = y0[64 * j]; ny1[j] = y1[64 * j]; }
        npv = *((const GAS f32x4*)(P.in[1] + (size_t)gw * 256) + lane);
        if (gw + NGW < T) sl2 = SLOT[gw + NGW]; }
    for (int m = gw; m < T; m += NGW) {
        f32x4 v[4]; v2u a[4], bq[4]; const f32x4 pv = npv; float s = 0.f;
#pragma unroll
        for (int j = 0; j < 4; ++j) { v[j] = nx[j]; a[j] = ny0[j]; bq[j] = ny1[j]; }
        if (m + NGW < T) { const int mn = m + NGW; const int2 sl = sl2;
            const GAS f32x4* xr = (const GAS f32x4*)(xo + (size_t)mn * D) + lane; const GAS v2u* y0 = (const GAS v2u*)(Y + (size_t)sl.x * D) + lane; const GAS v2u* y1 = (const GAS v2u*)(Y + (size_t)sl.y * D) + lane;
#pragma unroll
            for (int j = 0; j < 4; ++j) { nx[j] = xr[64 * j]; ny0[j] = y0[64 * j]; ny1[j] = y1[64 * j]; }
            npv = *((const GAS f32x4*)(P.in[1] + (size_t)mn * 256) + lane);
            if (mn + NGW < T) sl2 = SLOT[mn + NGW]; }
        GAS f32x4* xw = (GAS f32x4*)(xo + (size_t)m * D) + lane;
#pragma unroll
        for (int j = 0; j < 4; ++j) {
            v[j].x += bflo(a[j].x) + bflo(bq[j].x); v[j].y += bfhi(a[j].x) + bfhi(bq[j].x); v[j].z += bflo(a[j].y) + bflo(bq[j].y); v[j].w += bfhi(a[j].y) + bfhi(bq[j].y);
            xw[64 * j] = v[j]; s += (v[j].x * v[j].x + v[j].y * v[j].y) + (v[j].z * v[j].z + v[j].w * v[j].w); }
        const float rs = rsqrtf(wave_sum(s) * (1.f / D) + 1e-6f);
        GAS v2u* o8 = (GAS v2u*)(H3 + (size_t)m * D) + lane;
#pragma unroll
        for (int j = 0; j < 4; ++j) { v2u w; w.x = cvt_pk_bf16(v[j].x * rs * gn[j].x, v[j].y * rs * gn[j].y); w.y = cvt_pk_bf16(v[j].z * rs * gn[j].z, v[j].w * rs * gn[j].w); o8[64 * j] = w; }
        v2u pw; pw.x = cvt_pk_bf16(pv.x, pv.y); pw.y = cvt_pk_bf16(pv.z, pv.w);
        *((GAS v2u*)(PB + (size_t)m * 256) + lane) = pw;
    }
}

struct Args { Ptrs p; int ph_lo, ph_hi; };
__global__ void __launch_bounds__(NWAVES * 64, 2) fwd_kernel(Args args) {
    extern __shared__ __attribute__((aligned(16))) unsigned char lds_raw[];
    LAS unsigned char* lds = (LAS unsigned char*)lds_raw;
    volatile LAS unsigned* MISC = (volatile LAS unsigned*)(lds + MISC_OFF);
    const int tid = threadIdx.x, lane = tid & 63, wave = __builtin_amdgcn_readfirstlane(tid >> 6);
    const int G = gridDim.x, c = blockIdx.x;
    const Ptrs& P = args.p;
    unsigned char* ws = P.ws;
    gu32* ctl = (gu32*)(ws + WS_CTL);
    for (int u = tid; u < 64; u += NWAVES * 64) MISC[u] = 0u;
    __syncthreads();
    XcdBarrier bar; bar.bar = (unsigned*)ctl + CW_BAR; bar.x = 0; bar.st = nullptr;
    if (N_LAUNCHES == 1) bar = xcd_barrier_post((unsigned*)ctl + CW_BAR, MISC + 8);
    const int lo = args.ph_lo, hi = args.ph_hi;
#ifndef PH_MASK
#define PH_MASK 0x3ffff
#endif
#define IN(k) (((PH_MASK >> (k)) & 1) && lo <= (k) && (k) < hi)
#define SEAM(k) do { if (IN(k) && IN((k) + 1)) xcd_barrier(bar); } while (0)

    if (IN(0)) { p0_prologue(P, lds, G, c, wave, lane); } SEAM(0);

    if (IN(1)) {
        pg8::StaticOrder S; S.init((const unsigned char*)P.out + DO_H, ws + WS_BTP1, T, NP1, D, G, c);
        pg8::EpiP1 E{(bf16*)(ws + WS_QA), (bf16*)(ws + WS_QB), (float*)(ws + WS_BG), P.in[4], P.in[5], P.in[7], P.in[8]};
        pg8::gemm_phase<pg8::EpiP1, pg8::StaticOrder, true, true>(lds + RING_OFF, D, S, E);
    } SEAM(1);

    if (IN(2)) { attn_phase(lds, (const bf16*)(ws + WS_QA), (bf16*)((unsigned char*)P.out + DO_OG), (float*)((unsigned char*)P.out + DO_LSE), G, c); } SEAM(2);

    if (IN(3)) { prep_phase(lds, (const bf16*)(ws + WS_QB), (const float*)(ws + WS_BG), P.in[6], ws + WS_DNP, (float*)(ws + WS_DLB), G, c); } SEAM(3);

    if (IN(4)) {
        const int nscan = G > 64 ? 64 : G;
        if (c < nscan) { for (int bh = c; bh < 64; bh += nscan) scan_chain(lds, ws + WS_DNP, (const float*)(ws + WS_DLB), (bf16*)(ws + WS_ON), P.in[9], bh); }
        if (G > 64) { if (c >= 64) combine_rows(P, (c - 64) * NWAVES + wave, (G - 64) * NWAVES, lane); }
        else combine_rows(P, c * NWAVES + wave, G * NWAVES, lane);
    } SEAM(4);

    if (IN(5)) { pg8::StaticOrder S; S.init(ws + WS_HR, ws + WS_BTZ, T, 3072, D, G, c); pg8::EpiZG E{(bf16*)(ws + WS_ON), (bf16*)(ws + WS_G1), (bf16*)(ws + WS_G2)};
        pg8::gemm_phase<pg8::EpiZG, pg8::StaticOrder, true, true>(lds + RING_OFF, D, S, E); } SEAM(5);
    if (IN(8)) { pg8::StaticOrder S; S.init(ws + WS_OA, ws + WS_BTA, T, D, 512, G, c); pg8::EpiGateMul<false> E{(const bf16*)(ws + WS_G1), (bf16*)(ws + WS_G1)};
        pg8::gemm_phase<pg8::EpiGateMul<false>, pg8::StaticOrder, true, true>(lds + RING_OFF, 512, S, E); } SEAM(8);
    if (IN(9)) { pg8::StaticOrder S; S.init(ws + WS_ON, ws + WS_BTB, T, D, D, G, c); pg8::EpiGateMul<true> E{(const bf16*)(ws + WS_G2), (bf16*)(ws + WS_G1)};
        pg8::gemm_phase<pg8::EpiGateMul<true>, pg8::StaticOrder, true, true>(lds + RING_OFF, D, S, E); } SEAM(9);
    if (IN(10)) { pg8::StaticOrder S; S.init(ws + WS_G1, ws + WS_BTOUT, T, D, D, G, c); pg8::EpiResF32 E{P.in[0], P.out};
        pg8::gemm_phase<pg8::EpiResF32, pg8::StaticOrder, true, true>(lds + RING_OFF, D, S, E); } SEAM(10);
    if (IN(11)) { router_phase(P, lds, G, c, wave, lane); } SEAM(11);
    if (IN(12)) { place_phase(P, lds, G, c, wave, lane); } SEAM(12);
    if (IN(13)) { pg8::ExpertOrder<true> S; S.init(ws + WS_H2, ws + WS_BTGU, (const unsigned*)ctl + CW_CNT, 512, D, G, c); S.rows = (const int*)(ws + WS_ROWS); pg8::EpiGU E{(bf16*)(ws + WS_ACT), (const float*)(ws + WS_CW)};
        pg8::gemm_phase<pg8::EpiGU, pg8::ExpertOrder<true>, true, true>(lds + RING_OFF, D, S, E); } SEAM(13);
    if (IN(14)) { pg8::ExpertOrder<false> S; S.init(ws + WS_ACT, ws + WS_BTDN, (const unsigned*)ctl + CW_CNT, D, 256, G, c); S.rows = nullptr; pg8::EpiBf16<0> E{(bf16*)(ws + WS_Y), D};
        pg8::gemm_phase<pg8::EpiBf16<0>, pg8::ExpertOrder<false>, true, true>(lds + RING_OFF, 256, S, E); } SEAM(14);
    if (IN(15)) { ple_norm_phase(P, G, c, wave, lane); } SEAM(15);
    if (IN(16)) { pg8::StaticOrder S; S.init(ws + WS_PB, ws + WS_BTPLE, T, D, 256, G, c); pg8::EpiBf16<0> E{(bf16*)(ws + WS_E1), D};
        pg8::gemm_phase<pg8::EpiBf16<0>, pg8::StaticOrder, true, true>(lds + RING_OFF, 256, S, E); } SEAM(16);
    if (IN(17)) { pg8::StaticOrder S; S.init(ws + WS_H3, ws + WS_BTPG, T, D, D, G, c); pg8::EpiPleOut E{(const bf16*)(ws + WS_E1), P.out};
        pg8::gemm_phase<pg8::EpiPleOut, pg8::StaticOrder, true, true>(lds + RING_OFF, D, S, E); }
#undef IN
#undef SEAM
}

#ifndef DBG_LAST
#define DBG_LAST (NPH - 1)
#endif
__global__ void dbg_sanitize(float* out, size_t n) {
    for (size_t i = (size_t)blockIdx.x * blockDim.x + threadIdx.x; i < n; i += (size_t)gridDim.x * blockDim.x) { const float v = out[i]; if (!(v - v == 0.f)) out[i] = 0.f; }
}
__global__ void dbg_copy(const float* x, float* out, size_t n) {
    for (size_t i = (size_t)blockIdx.x * blockDim.x + threadIdx.x; i < n; i += (size_t)gridDim.x * blockDim.x) out[i] = x[i];
}
#ifdef DBG_CHECK
__global__ void dbg_check(const void* p, size_t nbytes, int is_f32, unsigned id, unsigned* word) {
    const size_t n16 = nbytes / 16; const uint4* q = (const uint4*)p; bool bad = false;
    for (size_t i = (size_t)blockIdx.x * blockDim.x + threadIdx.x; i < n16; i += (size_t)gridDim.x * blockDim.x) { const uint4 v = q[i]; const unsigned w[4] = {v.x, v.y, v.z, v.w};
        for (int k = 0; k < 4; ++k) { if (is_f32) { if ((w[k] & 0x7f800000u) == 0x7f800000u) bad = true; } else { if ((w[k] & 0x7f80u) == 0x7f80u || (w[k] & 0x7f800000u) == 0x7f800000u) bad = true; } } }
    if (bad) atomicMin(word, id);
}
__global__ void dbg_check_dnp(const unsigned char* p, unsigned id, unsigned* word) {
    bool bad = false;
    for (size_t i = (size_t)blockIdx.x * blockDim.x + threadIdx.x; i < (size_t)8192 * (DNU / 16); i += (size_t)gridDim.x * blockDim.x) { const size_t rec = i / (DNU / 16), o = (i % (DNU / 16)) * 16;
        if (o >= 49152 + 2048 && o < 49152 + 4096) continue;
        const uint4 v = *(const uint4*)(p + rec * DNU + o); const unsigned w[4] = {v.x, v.y, v.z, v.w};
        for (int k = 0; k < 4; ++k) if ((w[k] & 0x7f80u) == 0x7f80u || (w[k] & 0x7f800000u) == 0x7f800000u) { const unsigned part = o < 16384 ? 0u : (o < 32768 ? 1u : (o < 49152 ? 2u : (o < 57344 ? 3u : 4u))); atomicAnd(word, ~(1u << part)); } }
    (void)bad;
}
__global__ void dbg_check_tmax(const unsigned char* p, unsigned* word) {
    for (size_t r = (size_t)blockIdx.x * blockDim.x + threadIdx.x; r < 8192; r += (size_t)gridDim.x * blockDim.x) { const float* d = (const float*)(p + r * DNU + 49152 + 2048);
        unsigned bits = 0; if (d[0] > 1e3f) bits |= 1u; if (d[2] != 0.f) bits |= 2u; if (d[1] > 1.5f) bits |= 4u; if (d[1] > 100.f) bits |= 8u; if (d[3] != 0.f) bits |= 16u;
        if (bits) atomicAnd(word, ~bits); }
}
__global__ void dbg_final(const float* x, float* out, const unsigned* word) {
    unsigned id = *word;
#ifdef DBG_BITS
    id = (~id) & 31u; if (id == 0) id = 0xffffffffu;
#endif
    const size_t nz = id == 0xffffffffu ? 0 : (size_t)id * (T / 32) * D; const size_t n = (size_t)T * D;
    for (size_t i = (size_t)blockIdx.x * blockDim.x + threadIdx.x; i < n; i += (size_t)gridDim.x * blockDim.x) out[i] = i < nz ? 0.f : x[i];
}
#endif
extern "C" void kernel_launch(void* const* d_in, const int* in_sizes, int n_in, void* d_out, int out_size, void* d_ws, size_t ws_size, hipStream_t stream) {
    static int grid = 0;
    if (grid == 0) {
        if (n_in != 24 || out_size != T * D || ws_size < WS_END) { fprintf(stderr, "kernel_launch: unexpected shapes (n_in %d, out %d, ws %zu)\n", n_in, out_size, ws_size); grid = -1; return; }
        int dev = 0, cus = 0;
        if (hipGetDevice(&dev) != hipSuccess || hipDeviceGetAttribute(&cus, hipDeviceAttributeMultiprocessorCount, dev) != hipSuccess) { grid = -1; return; }
        if (hipFuncSetAttribute((const void*)fwd_kernel, hipFuncAttributeMaxDynamicSharedMemorySize, LDS_BYTES) != hipSuccess) { grid = -1; return; }
        int per_cu = 0;
        if (hipOccupancyMaxActiveBlocksPerMultiprocessor(&per_cu, (const void*)fwd_kernel, NWAVES * 64, LDS_BYTES) != hipSuccess || per_cu < 1) { fprintf(stderr, "kernel_launch: occupancy query says %d\n", per_cu); }
        (void)hipGetLastError();
        grid = cus;
    }
    if (grid < 0) return;
    if (hipMemsetAsync((char*)d_ws + WS_CTL, 0, CTL_ZERO_BYTES, stream) != hipSuccess) return;
    Args a{};
    for (int i = 0; i < 24; ++i) a.p.in[i] = (const float*)d_in[i];
    a.p.out = (float*)d_out; a.p.ws = (unsigned char*)d_ws;
    if (N_LAUNCHES == 1) { a.ph_lo = 0; a.ph_hi = NPH; hipLaunchKernelGGL(fwd_kernel, dim3(grid), dim3(NWAVES * 64), LDS_BYTES, stream, a); }
    else for (int li = 0; li <= DBG_LAST; ++li) { a.ph_lo = li; a.ph_hi = li + 1; hipLaunchKernelGGL(fwd_kernel, dim3(grid), dim3(NWAVES * 64), LDS_BYTES, stream, a);
#ifdef DUP_PH
        if (li == DUP_PH) { if (li == 11 || li == 12) hipMemsetAsync((char*)d_ws + WS_CTL + CW_CNT * 4 + (li == 12 ? 256 : 0), 0, 64, stream); }
        if (li == DUP_PH) hipLaunchKernelGGL(fwd_kernel, dim3(grid), dim3(NWAVES * 64), LDS_BYTES, stream, a);
#endif
#ifdef DBG_CHECK
        unsigned char* W = (unsigned char*)d_ws; unsigned char* O = (unsigned char*)d_out; unsigned* word = (unsigned*)(W + 1022 * MiB + 512 * 1024);
        if (li == 0) hipMemsetAsync(word, 0xFF, 4, stream);
#define CHK(p, nb, f32, id) hipLaunchKernelGGL(dbg_check, dim3(1024), dim3(256), 0, stream, (const void*)(p), (size_t)(nb), f32, (unsigned)(id), word)
        if (li == 0) { CHK(O + DO_H, (size_t)T * D * 2, 0, 1); CHK(W + WS_BTP1, (size_t)NP1 * D * 2, 0, 2); CHK(W + WS_BTZ, 38 * MiB, 0, 3); }
        if (li == 1) { CHK(W + WS_QA, (size_t)T * 4608 * 2, 0, 4); CHK(W + WS_QB, (size_t)T * 3072 * 2, 0, 5); CHK(W + WS_BG, (size_t)T * 16 * 4, 1, 6); }
        if (li == 2) { CHK(O + DO_OG, (size_t)T * 1536 * 2, 0, 7); CHK(O + DO_LSE, (size_t)T * 24 * 4, 1, 8); }
#if defined(DBG_PREPCHK)
        if (li == 3) {
#elif defined(DBG_TMAX)
        if (li == 3) { hipLaunchKernelGGL(dbg_check_tmax, dim3(32), dim3(256), 0, stream, W + WS_DNP, word);
#else
        if (li == 3) { hipLaunchKernelGGL(dbg_check_dnp, dim3(1024), dim3(256), 0, stream, W + WS_DNP, 9u, word);
#endif
        CHK(W + WS_DLB, 8192 * 4, 1, 14); }
        if (li == 4) { CHK(W + WS_ON, (size_t)T * D * 2, 0, 11); CHK(W + WS_OA, (size_t)T * 512 * 2, 0, 12); CHK(W + WS_HR, (size_t)T * D * 2, 0, 13); }
        if (li == 5) CHK(W + WS_ON, (size_t)T * D * 2, 0, 14);
        if (li == 6) CHK(W + WS_G1, (size_t)T * D * 2, 0, 15);
        if (li == 7) CHK(W + WS_G2, (size_t)T * D * 2, 0, 16);
        if (li == 8) CHK(W + WS_G1, (size_t)T * D * 2, 0, 17);
        if (li == 9) CHK(W + WS_G1, (size_t)T * D * 2, 0, 18);
        if (li == 10) CHK(O, (size_t)T * D * 4, 1, 19);
        if (li == 11) { CHK(W + WS_H2, (size_t)T * D * 2, 0, 20); CHK(W + WS_TOK, (size_t)T * 16, 1, 21); }
        if (li == 15) { CHK(O, (size_t)T * D * 4, 1, 25); CHK(W + WS_H3, (size_t)T * D * 2, 0, 26); }
        if (li == 16) CHK(W + WS_E1, (size_t)T * D * 2, 0, 27);
        if (li == 17) CHK(O, (size_t)T * D * 4, 1, 28);
        if (li == DBG_LAST) hipLaunchKernelGGL(dbg_final, dim3(2048), dim3(256), 0, stream, (const float*)d_in[0], (float*)d_out, (const unsigned*)word);
#endif
    }
#ifdef DBG_COPYX
    hipLaunchKernelGGL(dbg_copy, dim3(2048), dim3(256), 0, stream, (const float*)d_in[0], (float*)d_out, (size_t)out_size);
#endif
#ifdef DBG_SANITIZE
    hipLaunchKernelGGL(dbg_sanitize, dim3(2048), dim3(256), 0, stream, (float*)d_out, (size_t)out_size);
#endif
}
```

```cpp
#ifndef MK_N_LAUNCHES
#define MK_N_LAUNCHES 1
#endif
#define P1_FP8 1
#define MORE_FP8 1
#define D10_BF16 1
#define X_BF16 1
#define STAGGER_P1 2
#define P1_NT 1
#include <hip/hip_runtime.h>
#include <cstdio>
#include <cstdint>
namespace pg8 {
#define PG8_LAS __attribute__((address_space(3)))
typedef unsigned short bf16_t;
typedef short bf16x8 __attribute__((ext_vector_type(8)));
typedef float f32x4 __attribute__((ext_vector_type(4)));
typedef unsigned u32x4 __attribute__((ext_vector_type(4)));
typedef unsigned u32x2 __attribute__((ext_vector_type(2)));
constexpr int BM = 256, BK = 64, HALF = 128, HTB = HALF * BK * 2  , STAGE_BYTES = 8 * HTB, NXCD = 8, WGM = 8;

constexpr int FP8_SCALE_A = 127 - 2, FP8_SCALE_B = 127 - 6;
__host__ __device__ __forceinline__ int lds_byte(int r, int c) { const int st = (r >> 4) * 2 + (c >> 5), rr = r & 15, cc = c & 31, ob = rr * 64 + cc * 2; return st * 1024 + (ob ^ (((ob >> 9) & 1) << 5)); }
__host__ __device__ __forceinline__ void stage_rc(int b, int& R, int& C) { const int st = b / 1024, sb = b % 1024, swz = sb ^ (((sb >> 9) & 1) << 5); R = (st >> 1) * 16 + swz / 64; C = (st & 1) * 32 + (swz % 64) / 2; }
__host__ __device__ __forceinline__ int perm32(int rho) { const int n = rho >> 4, i = rho & 15; return 8 * (i >> 2) + 4 * n + (i & 3); }

struct Unit { int pm, pn; const char* a; const char* b; };

struct StaticOrder {
    static constexpr bool GATHER = false; static constexpr int MAXU = 0;
    __device__ __forceinline__ int row_of(const Unit&, int) const { return 0; }
    const char* A; const char* Bt; size_t tstep; int nM, nN, nwg, G, c, cap;
    __device__ __forceinline__ void init(const void* A_, const void* Bt_, int M, int N, int K, int G_, int c_) { A = (const char*)A_; Bt = (const char*)Bt_; tstep = (size_t)BM * K * 2; nM = M / BM; nN = N / BM; nwg = nM * nN; G = G_; c = c_; cap = 0x7fffffff; }
    __device__ __forceinline__ bool next(int i, Unit& u) const {
        const long L = (long)i * G + c; if (L >= nwg || i >= cap) return false;
        int wgid = (int)L; { const int q = nwg / NXCD, r = nwg % NXCD, xcd = wgid % NXCD, off = wgid / NXCD; wgid = (xcd < r ? xcd * (q + 1) : r * (q + 1) + (xcd - r) * q) + off; }
        const int nig = WGM * nN, gid = wgid / nig, fm = gid * WGM, gsz = (nM - fm) < WGM ? (nM - fm) : WGM;
        u.pm = fm + ((wgid % nig) % gsz); u.pn = (wgid % nig) / gsz; u.a = A + (size_t)u.pm * tstep; u.b = Bt + (size_t)u.pn * tstep; return true;
    }
    __device__ __forceinline__ const char* a_ptr(const Unit& u) const { return u.a; }
    __device__ __forceinline__ const char* b_ptr(const Unit& u) const { return u.b; }
    __device__ __forceinline__ void a_ready(const Unit&) const {}
    __device__ __forceinline__ void done(const Unit&) const {}
};
template <bool GATHER_> struct ExpertOrder {
    static constexpr bool GATHER = GATHER_; static constexpr int MAXU = 14;
    const int* rows;
    __device__ __forceinline__ int row_of(const Unit& u, int r) const { return rows[u.pm * BM + r]; }
    const char* A; const char* Bt; const unsigned* cnt; size_t tstep, bstride; int nN, G, c;
    __device__ __forceinline__ void init(const void* A_, const void* Bt_, const unsigned* cnt_, int N, int K, int G_, int c_) { A = (const char*)A_; Bt = (const char*)Bt_; cnt = cnt_; tstep = (size_t)BM * K * 2; bstride = (size_t)N * K * 2; nN = N / BM; G = G_; c = c_; }
    __device__ __forceinline__ bool next(int i, Unit& u) const {
        const long L = (long)i * G + c; const int rt = (int)(L / nN), pn = (int)(L % nN);
        int acc = 0, found = -1;
        for (int e = 0; e < 16; ++e) { const int te = (int)((cnt[e] + 255u) >> 8); if (found < 0 && rt < acc + te) found = e; acc += te; }
        if (found < 0) return false;
        u.pm = rt; u.pn = pn; u.a = GATHER ? A : A + (size_t)rt * tstep; u.b = Bt + (size_t)found * bstride + (size_t)pn * tstep; return true;
    }
    __device__ __forceinline__ const char* a_ptr(const Unit& u) const { return u.a; }
    __device__ __forceinline__ const char* b_ptr(const Unit& u) const { return u.b; }
    __device__ __forceinline__ void a_ready(const Unit&) const {}
    __device__ __forceinline__ void done(const Unit&) const {}
};

typedef float f32x2_t __attribute__((ext_vector_type(2))); typedef __bf16 bf16x2_t __attribute__((ext_vector_type(2)));
__device__ __forceinline__ unsigned cvt_pk_bf16(float lo, float hi) { const f32x2_t v = {lo, hi}; const bf16x2_t b = __builtin_convertvector(v, bf16x2_t); return __builtin_bit_cast(unsigned, b); }
__device__ __forceinline__ float bflo(unsigned w) { return __uint_as_float(w << 16); }
__device__ __forceinline__ float bfhi(unsigned w) { return __uint_as_float(w & 0xffff0000u); }
__device__ __forceinline__ float sigm(float x) { return __builtin_amdgcn_rcpf(1.0f + __expf(-x)); }
__device__ __forceinline__ u32x4 pack8(const f32x4 a, const f32x4 b) { u32x4 w; w.x = cvt_pk_bf16(a[0], a[1]); w.y = cvt_pk_bf16(a[2], a[3]); w.z = cvt_pk_bf16(b[0], b[1]); w.w = cvt_pk_bf16(b[2], b[3]); return w; }
__device__ __forceinline__ int xq_src(int lane) { return (((lane & 3) << 4) + (lane >> 2)) << 2; }
__device__ __forceinline__ u32x4 xq(const int bp, const u32x4 w) { u32x4 o; o.x = (unsigned)__builtin_amdgcn_ds_bpermute(bp, (int)w.x); o.y = (unsigned)__builtin_amdgcn_ds_bpermute(bp, (int)w.y); o.z = (unsigned)__builtin_amdgcn_ds_bpermute(bp, (int)w.z); o.w = (unsigned)__builtin_amdgcn_ds_bpermute(bp, (int)w.w); return o; }
__device__ __forceinline__ f32x4 xqf(const int bp, const f32x4 v) { return __builtin_bit_cast(f32x4, xq(bp, __builtin_bit_cast(u32x4, v))); }
__device__ __forceinline__ void unpack8(const u32x4 w, f32x4& a, f32x4& b) { a = (f32x4){bflo(w.x), bfhi(w.x), bflo(w.y), bfhi(w.y)}; b = (f32x4){bflo(w.z), bfhi(w.z), bflo(w.w), bfhi(w.w)}; }

__device__ __forceinline__ u32x2 pack8_u8(const f32x4 a, const f32x4 b) { unsigned w0 = 0u, w1 = 0u;
    w0 = __builtin_amdgcn_cvt_pk_u8_f32(__builtin_rintf(a[0] * 255.f), 0, w0); w0 = __builtin_amdgcn_cvt_pk_u8_f32(__builtin_rintf(a[1] * 255.f), 1, w0); w0 = __builtin_amdgcn_cvt_pk_u8_f32(__builtin_rintf(a[2] * 255.f), 2, w0); w0 = __builtin_amdgcn_cvt_pk_u8_f32(__builtin_rintf(a[3] * 255.f), 3, w0);
    w1 = __builtin_amdgcn_cvt_pk_u8_f32(__builtin_rintf(b[0] * 255.f), 0, w1); w1 = __builtin_amdgcn_cvt_pk_u8_f32(__builtin_rintf(b[1] * 255.f), 1, w1); w1 = __builtin_amdgcn_cvt_pk_u8_f32(__builtin_rintf(b[2] * 255.f), 2, w1); w1 = __builtin_amdgcn_cvt_pk_u8_f32(__builtin_rintf(b[3] * 255.f), 3, w1);
    return (u32x2){w0, w1}; }
__device__ __forceinline__ void unpack8_u8(const u32x2 w, f32x4& a, f32x4& b) { const float s = 1.0f / 255.f;
    a = (f32x4){(float)(w.x & 0xffu), (float)((w.x >> 8) & 0xffu), (float)((w.x >> 16) & 0xffu), (float)(w.x >> 24)} * s; b = (f32x4){(float)(w.y & 0xffu), (float)((w.y >> 8) & 0xffu), (float)((w.y >> 16) & 0xffu), (float)(w.y >> 24)} * s; }
constexpr float QSCALE = 0.125f * 1.4426950408889634f;
constexpr float EPSN = 1e-6f;
constexpr int TOK_ROWS = 65536;
constexpr int QAP = 4608, QBP = 3072;

#ifdef P1_NT
#define P1_STORE(p, v) __builtin_nontemporal_store((v), (p))
#else
#define P1_STORE(p, v) (*(p) = (v))
#endif
struct EpiP1 {
    static constexpr bool PERM = true, AFTER_DRAIN = false;
    bf16_t* QA; bf16_t* QB; float* BG; const float* qn; const float* kn; const float* a_log; const float* dt_bias;
    __device__ __forceinline__ void operator()(const f32x4 (&acc)[2][2][4][2], const Unit& u, int wr, int wc, int fr, int fq) const {
        const int row0 = u.pm * BM + wr * 64 + fr;
        const int lane_ = 16 * fq + fr, r2 = lane_ >> 2, q2 = lane_ & 3, bp = xq_src(lane_), row0t = u.pm * BM + wr * 64 + r2;
        if (u.pn < 12) {
            const float* gn = (u.pn < 6) ? qn : kn; const float sc = (u.pn < 6) ? QSCALE : 1.0f;
            f32x4 gv[2][2];
#pragma unroll
            for (int bj = 0; bj < 2; ++bj)
#pragma unroll
                for (int n = 0; n < 2; ++n) gv[bj][n] = *(const f32x4*)(gn + 32 * bj + 8 * fq + 4 * n) * sc;
#pragma unroll
            for (int ai = 0; ai < 2; ++ai)
#pragma unroll
                for (int m = 0; m < 4; ++m) {
                    float ss = 0.f;
#pragma unroll
                    for (int bj = 0; bj < 2; ++bj)
#pragma unroll
                        for (int n = 0; n < 2; ++n) { const f32x4 x = acc[ai][bj][m][n]; ss += (x[0] * x[0] + x[1] * x[1]) + (x[2] * x[2] + x[3] * x[3]); }
                    ss += __shfl_xor(ss, 16); ss += __shfl_xor(ss, 32);
                    const float rs = rsqrtf(ss * (1.0f / 64.0f) + EPSN);
                    bf16_t* rowp = QA + ((size_t)(u.pn * 4 + wc) * TOK_ROWS + (size_t)(row0t + ai * HALF + m * 16)) * 64 + 8 * q2;
#pragma unroll
                    for (int bj = 0; bj < 2; ++bj) { const f32x4 v0 = acc[ai][bj][m][0] * rs * gv[bj][0], v1 = acc[ai][bj][m][1] * rs * gv[bj][1]; P1_STORE((u32x4*)(rowp + bj * 32), xq(bp, pack8(v0, v1))); }
                }
        } else if (u.pn < 30) {
#pragma unroll
            for (int ai = 0; ai < 2; ++ai)
#pragma unroll
                for (int m = 0; m < 4; ++m) { const size_t row = (size_t)(row0t + ai * HALF + m * 16);
#pragma unroll
                    for (int bj = 0; bj < 2; ++bj) { bf16_t* p = (u.pn < 18) ? QA + ((size_t)(u.pn * 4 + 2 * bj + (wc >> 1)) * TOK_ROWS + row) * 64 + 32 * (wc & 1) + 8 * q2
                                                                         : QB + ((size_t)((u.pn - 18) * 2 + bj) * TOK_ROWS + row) * 128 + 32 * wc + 8 * q2;
                        P1_STORE((u32x4*)p, xq(bp, pack8(acc[ai][bj][m][0], acc[ai][bj][m][1]))); } }
        } else {
            if (wc == 0 && fq < 2) {
                f32x4 al[2], db[2];
#pragma unroll
                for (int n = 0; n < 2; ++n) { al[n] = *(const f32x4*)(a_log + 4 * n); db[n] = *(const f32x4*)(dt_bias + 4 * n); }
#pragma unroll
                for (int ai = 0; ai < 2; ++ai)
#pragma unroll
                    for (int m = 0; m < 4; ++m) { float* rowp = BG + (size_t)(row0 + ai * HALF + m * 16) * 16 + 8 * fq;
#pragma unroll
                        for (int n = 0; n < 2; ++n) { const f32x4 x = acc[ai][0][m][n]; f32x4 o;
#pragma unroll
                            for (int e = 0; e < 4; ++e) { if (fq == 0) o[e] = sigm(x[e]); else { const float z = x[e] + db[n][e]; const float sp = z > 20.f ? z : log1pf(__expf(z)); o[e] = -__expf(al[n][e]) * sp; } }
                            *(f32x4*)(rowp + 4 * n) = o; } }
            }
        }
    }
};
struct EpiSiluMul {
    static constexpr bool PERM = true, AFTER_DRAIN = false;
    bf16_t* O;
    __device__ __forceinline__ void operator()(const f32x4 (&acc)[2][2][4][2], const Unit& u, int wr, int wc, int fr, int fq) const {
        const int lane_ = 16 * fq + fr, r2 = lane_ >> 2, q2 = lane_ & 3, bp = xq_src(lane_), row0t = u.pm * BM + wr * 64 + r2;
        bf16_t* const base = O + (size_t)row0t * 1024 + u.pn * BM + wc * 32 + 8 * q2;
        u32x4 ld[4][2][2];
#define SM_LOAD(q_) do { _Pragma("unroll") for (int mm = 0; mm < 2; ++mm) _Pragma("unroll") for (int bj = 0; bj < 2; ++bj) \
            ld[q_][mm][bj] = *(const u32x4*)(base + (size_t)(((q_) >> 1) * HALF + (2 * ((q_) & 1) + mm) * 16) * 1024 + bj * HALF); } while (0)
        SM_LOAD(0);
#pragma unroll
        for (int q = 0; q < 4; ++q) {
            if (q == 0) SM_LOAD(1); if (q == 1) SM_LOAD(2); if (q == 2) SM_LOAD(3);
            const int ai = q >> 1;
#pragma unroll
            for (int mm = 0; mm < 2; ++mm) { const int m = 2 * (q & 1) + mm; bf16_t* rowp = base + (size_t)(ai * HALF + m * 16) * 1024;
#pragma unroll
                for (int bj = 0; bj < 2; ++bj) { f32x4 a, b; unpack8(ld[q][mm][bj], a, b); const f32x4 z0 = xqf(bp, acc[ai][bj][m][0]), z1 = xqf(bp, acc[ai][bj][m][1]);
#pragma unroll
                    for (int e = 0; e < 4; ++e) { a[e] *= z0[e] * sigm(z0[e]); b[e] *= z1[e] * sigm(z1[e]); }
                    *(u32x4*)(rowp + bj * HALF) = pack8(a, b); } }
            asm volatile("" ::: "memory");
        }
#undef SM_LOAD
    }
};
struct EpiZG {
    static constexpr bool PERM = true, AFTER_DRAIN = false;
    bf16_t* ON; bf16_t* G1; bf16_t* G2;
    __device__ __forceinline__ void operator()(const f32x4 (&acc)[2][2][4][2], const Unit& u, int wr, int wc, int fr, int fq) const {
        const int row0 = u.pm * BM + wr * 64 + fr; const int t = u.pn >> 2;
        const long dG1 = (const char*)G1 - (const char*)ON, dG2 = (const char*)G2 - (const char*)ON;
        bf16_t* const O = (bf16_t*)((char*)ON + (t == 1 ? dG1 : 0) + (t == 2 ? dG2 : 0));
#pragma unroll
        for (int ai = 0; ai < 2; ++ai)
#pragma unroll
            for (int m = 0; m < 4; ++m) { bf16_t* rowp = O + (size_t)(row0 + ai * HALF + m * 16) * 1024 + (u.pn & 3) * BM + wc * 32 + 8 * fq;
#pragma unroll
                for (int bj = 0; bj < 2; ++bj) { f32x4 a = acc[ai][bj][m][0], b = acc[ai][bj][m][1];
                    if (t == 0) { const u32x4 w = *(const u32x4*)(rowp + bj * HALF); f32x4 oa, ob; unpack8(w, oa, ob);
#pragma unroll
                        for (int e = 0; e < 4; ++e) { a[e] = oa[e] * a[e] * sigm(a[e]); b[e] = ob[e] * b[e] * sigm(b[e]); } }
                    else {
#pragma unroll
                        for (int e = 0; e < 4; ++e) { a[e] = sigm(a[e]); b[e] = sigm(b[e]); } }
                    *(u32x4*)(rowp + bj * HALF) = pack8(a, b); } }
    }
};
struct EpiG12 {
    static constexpr bool PERM = true, AFTER_DRAIN = false;
    unsigned char* G1; unsigned char* G2;
    __device__ __forceinline__ void operator()(const f32x4 (&acc)[2][2][4][2], const Unit& u, int wr, int wc, int fr, int fq) const {
        const int lane_ = 16 * fq + fr, r2 = lane_ >> 2, q2 = lane_ & 3, bp = xq_src(lane_), row0t = u.pm * BM + wr * 64 + r2;
        const long dG2 = G2 - G1;
        unsigned char* const O = G1 + ((u.pn >> 2) ? dG2 : 0);
#pragma unroll
        for (int ai = 0; ai < 2; ++ai)
#pragma unroll
            for (int m = 0; m < 4; ++m) { unsigned char* rowp = O + (size_t)(row0t + ai * HALF + m * 16) * 1024 + (u.pn & 3) * BM + wc * 32 + 8 * q2;
#pragma unroll
                for (int bj = 0; bj < 2; ++bj) { f32x4 a = acc[ai][bj][m][0], b = acc[ai][bj][m][1];
#pragma unroll
                    for (int e = 0; e < 4; ++e) { a[e] = sigm(a[e]); b[e] = sigm(b[e]); }
                    const u32x2 w = pack8_u8(a, b);
                    *(u32x2*)(rowp + bj * HALF) = (u32x2){(unsigned)__builtin_amdgcn_ds_bpermute(bp, (int)w.x), (unsigned)__builtin_amdgcn_ds_bpermute(bp, (int)w.y)}; } }
    }
};
template <int MODE> struct EpiBf16 {
    static constexpr bool PERM = true, AFTER_DRAIN = false;
    bf16_t* O; int ldc; int skip;
    __device__ __forceinline__ void operator()(const f32x4 (&acc)[2][2][4][2], const Unit& u, int wr, int wc, int fr, int fq) const {
        const int lane_ = 16 * fq + fr, r2 = lane_ >> 2, q2 = lane_ & 3, bp = xq_src(lane_), row0t = u.pm * BM + wr * 64 + r2;
#pragma unroll
        for (int ai = 0; ai < 2; ++ai)
#pragma unroll
            for (int m = 0; m < 4; ++m) { bf16_t* rowp = O + (size_t)(row0t + ai * HALF + m * 16) * ldc + u.pn * BM + wc * 32 + 8 * q2;
#pragma unroll
                for (int bj = 0; bj < 2; ++bj) { f32x4 a = acc[ai][bj][m][0], b = acc[ai][bj][m][1];
                    if (MODE == 1) {
#pragma unroll
                        for (int e = 0; e < 4; ++e) { a[e] = sigm(a[e]); b[e] = sigm(b[e]); } }
                    if (!skip) *(u32x4*)(rowp + bj * HALF) = xq(bp, pack8(a, b)); } }
    }
};
struct EpiF8 {
    static constexpr bool PERM = true, AFTER_DRAIN = false;
    unsigned char* O; int ldc; float sc;
    __device__ __forceinline__ void operator()(const f32x4 (&acc)[2][2][4][2], const Unit& u, int wr, int wc, int fr, int fq) const {
        const int lane_ = 16 * fq + fr, r2 = lane_ >> 2, q2 = lane_ & 3, bp = xq_src(lane_), row0t = u.pm * BM + wr * 64 + r2;
#pragma unroll
        for (int ai = 0; ai < 2; ++ai)
#pragma unroll
            for (int m = 0; m < 4; ++m) { unsigned char* rowp = O + (size_t)(row0t + ai * HALF + m * 16) * ldc + u.pn * BM + wc * 32 + 8 * q2;
#pragma unroll
                for (int bj = 0; bj < 2; ++bj) { const f32x4 a = acc[ai][bj][m][0] * sc, b = acc[ai][bj][m][1] * sc;
                    int w0 = __builtin_amdgcn_cvt_pk_fp8_f32(a[0], a[1], 0, false); w0 = __builtin_amdgcn_cvt_pk_fp8_f32(a[2], a[3], w0, true);
                    int w1 = __builtin_amdgcn_cvt_pk_fp8_f32(b[0], b[1], 0, false); w1 = __builtin_amdgcn_cvt_pk_fp8_f32(b[2], b[3], w1, true);
                    *(u32x2*)(rowp + bj * HALF) = (u32x2){(unsigned)__builtin_amdgcn_ds_bpermute(bp, w0), (unsigned)__builtin_amdgcn_ds_bpermute(bp, w1)}; } }
    }
};
template <bool ADD> struct EpiGateMul {
    static constexpr bool PERM = true, AFTER_DRAIN = false;
    const unsigned char* Gt; const bf16_t* Mi; bf16_t* Mo;
    __device__ __forceinline__ void operator()(const f32x4 (&acc)[2][2][4][2], const Unit& u, int wr, int wc, int fr, int fq) const {
        const int lane_ = 16 * fq + fr, r2 = lane_ >> 2, q2 = lane_ & 3, bp = xq_src(lane_), row0t = u.pm * BM + wr * 64 + r2;
        const size_t off0 = (size_t)row0t * 1024 + u.pn * BM + wc * 32 + 8 * q2;
        u32x2 lg[4][2][2]; u32x4 lm[4][2][2];
#define GM_LOAD(q_) do { _Pragma("unroll") for (int mm = 0; mm < 2; ++mm) _Pragma("unroll") for (int bj = 0; bj < 2; ++bj) { const size_t off = off0 + (size_t)(((q_) >> 1) * HALF + (2 * ((q_) & 1) + mm) * 16) * 1024 + bj * HALF; \
            lg[q_][mm][bj] = *(const u32x2*)(Gt + off); if (ADD) lm[q_][mm][bj] = *(const u32x4*)(Mi + off); } } while (0)
        GM_LOAD(0);
#pragma unroll
        for (int q = 0; q < 4; ++q) {
            if (q == 0) GM_LOAD(1); if (q == 1) GM_LOAD(2); if (q == 2) GM_LOAD(3);
            const int ai = q >> 1;
#pragma unroll
            for (int mm = 0; mm < 2; ++mm) { const int m = 2 * (q & 1) + mm; const size_t off = off0 + (size_t)(ai * HALF + m * 16) * 1024;
#pragma unroll
                for (int bj = 0; bj < 2; ++bj) { f32x4 ga, gb; unpack8_u8(lg[q][mm][bj], ga, gb);
                    f32x4 a = ga * xqf(bp, acc[ai][bj][m][0]), b = gb * xqf(bp, acc[ai][bj][m][1]);
                    if (ADD) { f32x4 ma, mb; unpack8(lm[q][mm][bj], ma, mb); a += ma; b += mb; }
                    *(u32x4*)(Mo + off + bj * HALF) = pack8(a, b); } }
            asm volatile("" ::: "memory");
        }
#undef GM_LOAD
    }
};
struct EpiResF32 {
    static constexpr bool PERM = false, AFTER_DRAIN = false;
    const float* base; float* out; int flags;
    __device__ __forceinline__ void operator()(const f32x4 (&acc)[2][2][4][2], const Unit& u, int wr, int wc, int fr, int fq) const {
        const int row0 = u.pm * BM + wr * 64 + fr, col0 = u.pn * BM + wc * 32 + 4 * fq;
#pragma unroll
        for (int ai = 0; ai < 2; ++ai) {
            f32x4 bs[4][2][2];
#pragma unroll
            for (int m = 0; m < 4; ++m)
#pragma unroll
                for (int bj = 0; bj < 2; ++bj)
#pragma unroll
                    for (int n = 0; n < 2; ++n) bs[m][bj][n] = (flags & 2) ? (f32x4){0.f, 0.f, 0.f, 0.f} : *(const f32x4*)(base + (size_t)(row0 + ai * HALF + m * 16) * 1024 + col0 + bj * HALF + n * 16);
#pragma unroll
            for (int m = 0; m < 4; ++m)
#pragma unroll
                for (int bj = 0; bj < 2; ++bj)
#pragma unroll
                    for (int n = 0; n < 2; ++n) { const f32x4 r_ = bs[m][bj][n] + acc[ai][bj][m][n]; if (!(flags & 1) || r_[0] == 12345.678f) *(f32x4*)(out + (size_t)(row0 + ai * HALF + m * 16) * 1024 + col0 + bj * HALF + n * 16) = r_; }
            asm volatile("" ::: "memory");
        }
    }
};
struct EpiPleOut {
    static constexpr bool PERM = false, AFTER_DRAIN = false;
    const bf16_t* E1; const bf16_t* X2; float* out;
    __device__ __forceinline__ void operator()(const f32x4 (&acc)[2][2][4][2], const Unit& u, int wr, int wc, int fr, int fq) const {
        const int lane_ = 16 * fq + fr, r2 = lane_ >> 2, q2 = lane_ & 3, bp = xq_src(lane_), row0t = u.pm * BM + wr * 64 + r2;
        const int col0 = u.pn * BM + wc * 32 + 4 * q2;
#pragma unroll
        for (int ai = 0; ai < 2; ++ai)
#pragma unroll
            for (int mh = 0; mh < 2; ++mh) {
                u32x2 xw[2][2][2], ew[2][2][2];
#pragma unroll
                for (int mm = 0; mm < 2; ++mm)
#pragma unroll
                    for (int bj = 0; bj < 2; ++bj)
#pragma unroll
                        for (int n = 0; n < 2; ++n) { const size_t o2 = (size_t)(row0t + ai * HALF + (2 * mh + mm) * 16) * 1024 + col0 + bj * HALF + n * 16; xw[mm][bj][n] = *(const u32x2*)(X2 + o2); ew[mm][bj][n] = *(const u32x2*)(E1 + o2); }
#pragma unroll
                for (int mm = 0; mm < 2; ++mm)
#pragma unroll
                    for (int bj = 0; bj < 2; ++bj)
#pragma unroll
                        for (int n = 0; n < 2; ++n) { const size_t o2 = (size_t)(row0t + ai * HALF + (2 * mh + mm) * 16) * 1024 + col0 + bj * HALF + n * 16; const u32x2 w = ew[mm][bj][n], xq_ = xw[mm][bj][n];
                            const f32x4 ev = (f32x4){bflo(w.x), bfhi(w.x), bflo(w.y), bfhi(w.y)}, xv = (f32x4){bflo(xq_.x), bfhi(xq_.x), bflo(xq_.y), bfhi(xq_.y)}; const f32x4 a = xqf(bp, acc[ai][bj][2 * mh + mm][n]); f32x4 r;
#pragma unroll
                            for (int e = 0; e < 4; ++e) r[e] = xv[e] + sigm(a[e]) * ev[e];
                            __builtin_nontemporal_store(r, (f32x4*)(out + o2)); }
                asm volatile("" ::: "memory");
            }
    }
};
struct EpiGU {
    static constexpr bool PERM = true, AFTER_DRAIN = false;
    bf16_t* ACT; const float* CW;
    __device__ __forceinline__ void operator()(const f32x4 (&acc)[2][2][4][2], const Unit& u, int wr, int wc, int fr, int fq) const {
        const int row0 = u.pm * BM + wr * 64 + fr;
        const int lane_ = 16 * fq + fr, r2 = lane_ >> 2, q2 = lane_ & 3, bp = xq_src(lane_), row0t = u.pm * BM + wr * 64 + r2;
#pragma unroll
        for (int ai = 0; ai < 2; ++ai)
#pragma unroll
            for (int m = 0; m < 4; ++m) { const int row = row0 + ai * HALF + m * 16; const float cw = CW[row];
                f32x4 a, b; const f32x4 g0 = acc[ai][0][m][0], g1 = acc[ai][0][m][1], u0 = acc[ai][1][m][0], u1 = acc[ai][1][m][1];
#pragma unroll
                for (int e = 0; e < 4; ++e) { a[e] = g0[e] * sigm(g0[e]) * u0[e] * cw; b[e] = g1[e] * sigm(g1[e]) * u1[e] * cw;
#ifdef FP8_EMU2
                    { const int w_ = __builtin_amdgcn_cvt_pk_fp8_f32(a[e] * 32.f, b[e] * 32.f, 0, false); a[e] = __builtin_amdgcn_cvt_f32_fp8(w_, 0) * (1.f / 32.f); b[e] = __builtin_amdgcn_cvt_f32_fp8(w_, 1) * (1.f / 32.f); }
#endif
                }
                *(u32x4*)(ACT + (size_t)(row0t + ai * HALF + m * 16) * 256 + u.pn * HALF + wc * 32 + 8 * q2) = xq(bp, pack8(a, b)); }
    }
};

template <class Epi, class Sched, bool ALIGN_EPI = false, bool SP2 = false, bool FP8 = false>
__device__ __forceinline__ void gemm_phase(PG8_LAS unsigned char* lds, const int KK, const Sched& S, const Epi& E) {
    int tid_ = threadIdx.x; asm volatile("" : "+v"(tid_));
    const int tid = tid_, wid = __builtin_amdgcn_readfirstlane(tid >> 6), lane = tid & 63, wr = wid >> 2, wc = wid & 3, fr = lane & 15, fq = lane >> 4;
    int K_ = KK; asm volatile("" : "+s"(K_));
    const int K = K_, nt = K / BK;
    unsigned vA[2][2], vN[2][2], voffB[2]; int stR[2], stC[2];
#pragma unroll
    for (int i = 0; i < 2; ++i) { int R, C; stage_rc(tid * 16 + i * 8192, R, C); const int Rb = Epi::PERM ? ((R & ~31) + perm32(R & 31)) : R; stR[i] = R; stC[i] = C;
        voffB[i] = (unsigned)(Rb * K + C) * 2u;
#pragma unroll
        for (int h = 0; h < 2; ++h) { vA[h][i] = (unsigned)((h * HALF + R) * K + C) * 2u; if constexpr (Sched::GATHER) vN[h][i] = vA[h][i]; } }
    const size_t kstep = (size_t)(BK * 2);
    const size_t hstep = (size_t)HALF * K * 2;
    const size_t tstep = 2 * hstep;
    const unsigned ldsw = (unsigned)wid * 1024u;
    const int aoff = lds_byte(wr * 64 + fr, fq * 8), boff = lds_byte(wc * 32 + fr, fq * 8);
#define PG8_SA(b, h) (((b) * 2 + (h)) * HTB)
#define PG8_SB(b, h) ((4 + (b) * 2 + (h)) * HTB)
#define PG8_STAGE(bufoff, gbase, voff) do { _Pragma("unroll") for (int _i = 0; _i < 2; ++_i) \
        __builtin_amdgcn_global_load_lds((const unsigned*)((const char*)(gbase) + (voff)[_i]), (PG8_LAS unsigned*)(lds + (bufoff) + ldsw + _i * 8192), 16, 0, 0); } while (0)
    typedef int v8i_ __attribute__((ext_vector_type(8))); typedef int v4i_ __attribute__((ext_vector_type(4)));
#define PG8_LDA(dst, b, h) do { if constexpr (FP8) { _Pragma("unroll") for (int m = 0; m < 4; ++m) { const v4i_ lo_ = *(const PG8_LAS v4i_*)(lds + PG8_SA(b, h) + aoff + m * 2048), hi_ = *(const PG8_LAS v4i_*)(lds + PG8_SA(b, h) + aoff + m * 2048 + 1024); dst##8[m] = __builtin_shufflevector(lo_, hi_, 0, 1, 2, 3, 4, 5, 6, 7); } } \
        else { _Pragma("unroll") for (int m = 0; m < 4; ++m) _Pragma("unroll") for (int k = 0; k < 2; ++k) dst[m][k] = *(const PG8_LAS bf16x8*)(lds + PG8_SA(b, h) + aoff + m * 2048 + k * 1024); } } while (0)
#define PG8_LDB(dst, b, h) do { if constexpr (FP8) { _Pragma("unroll") for (int n = 0; n < 2; ++n) { const v4i_ lo_ = *(const PG8_LAS v4i_*)(lds + PG8_SB(b, h) + boff + n * 2048), hi_ = *(const PG8_LAS v4i_*)(lds + PG8_SB(b, h) + boff + n * 2048 + 1024); dst##8[n] = __builtin_shufflevector(lo_, hi_, 0, 1, 2, 3, 4, 5, 6, 7); } } \
        else { _Pragma("unroll") for (int n = 0; n < 2; ++n) _Pragma("unroll") for (int k = 0; k < 2; ++k) dst[n][k] = *(const PG8_LAS bf16x8*)(lds + PG8_SB(b, h) + boff + n * 2048 + k * 1024); } } while (0)
#define PG8_MMA(ai, bj, At, Bt) do { __builtin_amdgcn_s_setprio(1); \
        if constexpr (FP8) { _Pragma("unroll") for (int m = 0; m < 4; ++m) _Pragma("unroll") for (int n = 0; n < 2; ++n) \
            asm volatile("v_mfma_scale_f32_16x16x128_f8f6f4 %0, %1, %2, %0, %3, %4 op_sel_hi:[0,0,0]" : "+v"(acc[ai][bj][m][n]) : "v"(Bt##8[n]), "v"(At##8[m]), "v"(f8sb), "v"(f8sa)); } \
        else { _Pragma("unroll") for (int m = 0; m < 4; ++m) _Pragma("unroll") for (int n = 0; n < 2; ++n) _Pragma("unroll") for (int k = 0; k < 2; ++k) \
            acc[ai][bj][m][n] = __builtin_amdgcn_mfma_f32_16x16x32_bf16(Bt[n][k], At[m][k], acc[ai][bj][m][n], 0, 0, 0); } \
        __builtin_amdgcn_s_setprio(0); } while (0)
#define PG8_WAIT_V(n) asm volatile("s_waitcnt vmcnt(" #n ")" ::: "memory")
#define PG8_WAIT_L(n) asm volatile("s_waitcnt lgkmcnt(" #n ")" ::: "memory")
#define PG8_BAR __builtin_amdgcn_s_barrier()
#define PG8_SCHED __builtin_amdgcn_sched_barrier(0)
    Unit cur, nxt; int ui = 0;
    if (!S.next(0, cur)) return;
    f32x4 acc[2][2][4][2];
#pragma unroll
    for (int a = 0; a < 2; ++a)
#pragma unroll
        for (int b = 0; b < 2; ++b)
#pragma unroll
            for (int m = 0; m < 4; ++m)
#pragma unroll
                for (int n = 0; n < 2; ++n) acc[a][b][m][n] = (f32x4){0.f, 0.f, 0.f, 0.f};
    const int f8sa = FP8_SCALE_A, f8sb = FP8_SCALE_B;
    bf16x8 At[4][2], B0[2][2], B1[2][2]; v8i_ At8[4], B08[2], B18[2];
    const char* cA = S.a_ptr(cur); const char* cB = S.b_ptr(cur);
    if constexpr (Sched::GATHER) {
        PG8_LAS int* rid = (PG8_LAS int*)(lds + STAGE_BYTES);
        { Unit t_; for (int i = 0; i < Sched::MAXU && S.next(i, t_); ++i) if (tid < 256) rid[i * 256 + tid] = S.row_of(t_, tid); }
        asm volatile("s_waitcnt vmcnt(0) lgkmcnt(0)" ::: "memory"); PG8_BAR; asm volatile("" ::: "memory");
#pragma unroll
        for (int i = 0; i < 2; ++i)
#pragma unroll
            for (int h = 0; h < 2; ++h) vA[h][i] = (unsigned)(rid[h * HALF + stR[i]] * K + stC[i]) * 2u;
    }
    S.a_ready(cur);
    if constexpr (SP2) {
        PG8_STAGE(PG8_SB(0, 0), cB, voffB); PG8_STAGE(PG8_SB(0, 1), cB + hstep, voffB); PG8_STAGE(PG8_SA(0, 0), cA, vA[0]); PG8_STAGE(PG8_SA(0, 1), cA, vA[1]);
        if (wr == 1) PG8_BAR;
        PG8_WAIT_V(2); PG8_BAR;
        PG8_STAGE(PG8_SB(1, 0), cB + kstep, voffB); PG8_STAGE(PG8_SA(1, 0), cA + kstep, vA[0]); PG8_STAGE(PG8_SB(1, 1), cB + hstep + kstep, voffB);
        PG8_WAIT_V(6); PG8_BAR;
    } else {
        PG8_STAGE(PG8_SB(0, 0), cB, voffB); PG8_STAGE(PG8_SA(0, 0), cA, vA[0]); PG8_STAGE(PG8_SB(0, 1), cB + hstep, voffB); PG8_STAGE(PG8_SA(0, 1), cA, vA[1]);
        if (wr == 1) PG8_BAR;
        PG8_WAIT_V(4); PG8_BAR;
        PG8_STAGE(PG8_SB(1, 0), cB + kstep, voffB); PG8_STAGE(PG8_SA(1, 0), cA + kstep, vA[0]); PG8_STAGE(PG8_SB(1, 1), cB + hstep + kstep, voffB);
        PG8_WAIT_V(6); PG8_BAR;
    }
    for (;;) {
        const bool has_next = S.next(ui + 1, nxt);
        const char* nA = has_next ? S.a_ptr(nxt) : cA; const char* nB = has_next ? S.b_ptr(nxt) : cB;
        if constexpr (Sched::GATHER) { const PG8_LAS int* rid = (const PG8_LAS int*)(lds + STAGE_BYTES) + (has_next ? (ui + 1) : ui) * 256;
#pragma unroll
            for (int i = 0; i < 2; ++i)
#pragma unroll
                for (int h = 0; h < 2; ++h) vN[h][i] = (unsigned)(rid[h * HALF + stR[i]] * K + stC[i]) * 2u; }
        for (int t = 0; t < nt; t += 2) {
            const bool last = (t == nt - 2);
            const char* a1 = cA + (size_t)(t + 1) * kstep;
            const char* a2 = last ? nA : cA + (size_t)(t + 2) * kstep; const char* b2 = last ? nB : cB + (size_t)(t + 2) * kstep;
            const char* a3 = a2 + kstep; const char* b3 = b2 + kstep;
            unsigned vS[2][2];
#pragma unroll
            for (int i = 0; i < 2; ++i) { if constexpr (Sched::GATHER) { vS[0][i] = last ? vN[0][i] : vA[0][i]; vS[1][i] = last ? vN[1][i] : vA[1][i]; } else { vS[0][i] = vA[0][i]; vS[1][i] = vA[1][i]; } }
            if (last && has_next) S.a_ready(nxt);
            if constexpr (SP2) {
            PG8_LDB(B0, 0, 0); PG8_LDB(B1, 0, 1); PG8_SCHED; PG8_LDA(At, 0, 0); PG8_STAGE(PG8_SA(1, 1), a1, vA[1]);
            PG8_WAIT_V(8); PG8_WAIT_L(0); PG8_BAR; PG8_MMA(0, 0, At, B0); PG8_MMA(0, 1, At, B1); PG8_BAR; PG8_SCHED;
            PG8_LDA(At, 0, 1); PG8_STAGE(PG8_SB(0, 0), b2, voffB); PG8_STAGE(PG8_SB(0, 1), b2 + hstep, voffB); PG8_STAGE(PG8_SA(0, 0), a2, vS[0]);
            PG8_WAIT_V(8); PG8_WAIT_L(0); PG8_BAR; PG8_MMA(1, 0, At, B0); PG8_MMA(1, 1, At, B1); PG8_BAR; PG8_SCHED;
            PG8_LDB(B0, 1, 0); PG8_LDB(B1, 1, 1); PG8_SCHED; PG8_LDA(At, 1, 0); PG8_STAGE(PG8_SA(0, 1), a2, vS[1]);
            PG8_WAIT_V(8); PG8_WAIT_L(0); PG8_BAR; PG8_MMA(0, 0, At, B0); PG8_MMA(0, 1, At, B1); PG8_BAR; PG8_SCHED;
            PG8_LDA(At, 1, 1); PG8_STAGE(PG8_SB(1, 0), b3, voffB); PG8_STAGE(PG8_SB(1, 1), b3 + hstep, voffB); PG8_STAGE(PG8_SA(1, 0), a3, vS[0]);
            PG8_WAIT_V(8); PG8_WAIT_L(0); PG8_BAR; PG8_MMA(1, 0, At, B0); PG8_MMA(1, 1, At, B1); PG8_BAR; PG8_SCHED;
            } else {
            PG8_LDB(B0, 0, 0); PG8_SCHED; PG8_LDA(At, 0, 0); PG8_STAGE(PG8_SA(1, 1), a1, vA[1]);
            PG8_WAIT_L(8); PG8_BAR; PG8_WAIT_L(0); PG8_MMA(0, 0, At, B0); PG8_BAR; PG8_SCHED;
            PG8_LDB(B1, 0, 1); PG8_STAGE(PG8_SB(0, 0), b2, voffB);
            PG8_BAR; PG8_WAIT_L(0); PG8_MMA(0, 1, At, B1); PG8_BAR;
            PG8_LDA(At, 0, 1); PG8_STAGE(PG8_SA(0, 0), a2, vS[0]);
            PG8_BAR; PG8_WAIT_L(0); PG8_MMA(1, 0, At, B0); PG8_BAR; PG8_SCHED;
            PG8_STAGE(PG8_SB(0, 1), b2 + hstep, voffB);
            PG8_WAIT_V(6); PG8_BAR; PG8_MMA(1, 1, At, B1); PG8_BAR;
            PG8_LDB(B0, 1, 0); PG8_SCHED; PG8_LDA(At, 1, 0); PG8_STAGE(PG8_SA(0, 1), a2, vS[1]);
            PG8_WAIT_L(8); PG8_BAR; PG8_WAIT_L(0); PG8_MMA(0, 0, At, B0); PG8_BAR; PG8_SCHED;
            PG8_LDB(B1, 1, 1); PG8_STAGE(PG8_SB(1, 0), b3, voffB);
            PG8_BAR; PG8_WAIT_L(0); PG8_MMA(0, 1, At, B1); PG8_BAR;
            PG8_LDA(At, 1, 1); PG8_STAGE(PG8_SA(1, 0), a3, vS[0]);
            PG8_BAR; PG8_WAIT_L(0); PG8_MMA(1, 0, At, B0); PG8_BAR; PG8_SCHED;
            PG8_STAGE(PG8_SB(1, 1), b3 + hstep, voffB);
            PG8_WAIT_V(6); PG8_BAR; PG8_MMA(1, 1, At, B1); PG8_BAR;
            }
        }
        if constexpr (FP8) asm volatile("s_nop 15\n\ts_nop 15\n\ts_nop 15" ::: "memory");
        if constexpr (ALIGN_EPI) { if (wr == 0) PG8_BAR; }
        if constexpr (!Epi::AFTER_DRAIN) { E(acc, cur, wr, wc, fr, fq); S.done(cur); }
        if (!has_next) break;
#pragma unroll
        for (int a = 0; a < 2; ++a)
#pragma unroll
            for (int b = 0; b < 2; ++b)
#pragma unroll
                for (int m = 0; m < 4; ++m)
#pragma unroll
                    for (int n = 0; n < 2; ++n) acc[a][b][m][n] = (f32x4){0.f, 0.f, 0.f, 0.f};
        cur = nxt; cA = nA; cB = nB; ++ui;
        if constexpr (Sched::GATHER) {
#pragma unroll
            for (int i = 0; i < 2; ++i) { vA[0][i] = vN[0][i]; vA[1][i] = vN[1][i]; } }
        if constexpr (ALIGN_EPI) { if (wr == 1) PG8_BAR; }
    }
    PG8_WAIT_V(0);
    if constexpr (!ALIGN_EPI) { if (wr == 0) PG8_BAR; }
    PG8_BAR;
    if constexpr (Epi::AFTER_DRAIN) { E.fused(acc, cur, wr, wc, fr, fq, lds, wid, lane); S.done(cur); }
#undef PG8_SA
#undef PG8_SB
#undef PG8_STAGE
#undef PG8_LDA
#undef PG8_LDB
#undef PG8_MMA
#undef PG8_WAIT_V
#undef PG8_WAIT_L
#undef PG8_BAR
#undef PG8_SCHED
}
}

constexpr int NWAVES = 8;
constexpr int BATCH = 8, SEQ = 8192, D = 1024, T = BATCH * SEQ;
constexpr int IN_TOTAL = 10768, NP1 = 7936;
constexpr int NSLOT = 2 * T + 4096;
constexpr int NPH = 18;
#ifndef MK_N_LAUNCHES
#define MK_N_LAUNCHES 1
#endif
constexpr int N_LAUNCHES = MK_N_LAUNCHES;
static_assert(N_LAUNCHES == 1 || N_LAUNCHES == NPH, "MK_N_LAUNCHES is 1 or NPH");
constexpr int DNU = 73728;

constexpr size_t MiB = 1u << 20;
constexpr size_t WS_CTL = 0, CTL_ZERO_BYTES = 1 * MiB;
constexpr size_t WS_ROWS = 131072;
constexpr size_t WS_BTP1 = 1 * MiB;
constexpr size_t WS_BTZ = 17 * MiB, WS_BTGA = 19 * MiB, WS_BTGB = 21 * MiB, WS_BTB = 23 * MiB, WS_BTOUT = 25 * MiB, WS_BTPG = 27 * MiB;
constexpr size_t WS_BTA = 29 * MiB;
constexpr size_t WS_BTPLE = 30 * MiB;
constexpr size_t WS_BTGU = 31 * MiB;
constexpr size_t WS_BTDN = 47 * MiB;
constexpr size_t WS_QA = 56 * MiB;
constexpr size_t WS_DNP = 56 * MiB;
constexpr size_t WS_M = 56 * MiB;
constexpr size_t WS_H3 = 56 * MiB;
constexpr size_t WS_H2 = 184 * MiB;
constexpr size_t WS_PB = 184 * MiB;
constexpr size_t WS_E1 = 216 * MiB;
constexpr size_t WS_D10 = 312 * MiB;
constexpr size_t WS_HX = 312 * MiB;
constexpr size_t WS_ACT = 576 * MiB;
constexpr size_t WS_Y = 642 * MiB;
constexpr size_t WS_QB = 632 * MiB;
constexpr size_t WS_ON = 632 * MiB;
constexpr size_t WS_OA = 760 * MiB;
constexpr size_t WS_HR8 = 952 * MiB;
constexpr size_t WS_X1 = 824 * MiB;
constexpr size_t WS_HR = 824 * MiB;
constexpr size_t WS_BG = 1016 * MiB;
constexpr size_t WS_TOK = 1020 * MiB;
constexpr size_t WS_SLOT = 1021 * MiB;
constexpr size_t WS_CW = 1021 * MiB + 512 * 1024;
constexpr size_t WS_DLB = 1022 * MiB + 256 * 1024;
constexpr size_t WS_END = 1024 * MiB;
static_assert(WS_ROWS + (size_t)NSLOT * 4 <= CTL_ZERO_BYTES && WS_Y + (size_t)NSLOT * 2048 <= WS_BG && WS_HX + (size_t)NSLOT * 2048 <= WS_ACT && WS_ACT + (size_t)NSLOT * 512 <= WS_Y && WS_HR + (size_t)T * 2048 <= WS_BG && WS_CW + (size_t)NSLOT * 4 <= WS_DLB, "d_ws map");
constexpr size_t DO_H = 0, DO_OG = 0, DO_LSE = 192 * MiB, DO_G1 = 0, DO_G2 = 64 * MiB, DO_M1 = 128 * MiB;
constexpr int CW_BAR = 4096;
constexpr int CW_CNT = 16384;
constexpr int CW_CUR = 16384 + 64;
constexpr int CW_SUB2 = 16384 + 320;
constexpr int CW_SUB = 16384 + 256;
constexpr int RING_OFF = 0, RING_BYTES = 131072;
constexpr int LDS_BYTES = 147456;
constexpr int MISC_OFF = LDS_BYTES - 256;

#define GAS __attribute__((address_space(1)))
#define LAS __attribute__((address_space(3)))
typedef unsigned short bf16;
typedef unsigned v4u __attribute__((ext_vector_type(4)));
typedef unsigned v2u __attribute__((ext_vector_type(2)));
typedef float f32x4 __attribute__((ext_vector_type(4)));
typedef float f32x16 __attribute__((ext_vector_type(16)));
typedef short bf16x8 __attribute__((ext_vector_type(8)));
typedef short s16x4 __attribute__((ext_vector_type(4)));
typedef GAS unsigned gu32;
#define RLX_AGENT __ATOMIC_RELAXED, __HIP_MEMORY_SCOPE_AGENT
using pg8::cvt_pk_bf16; using pg8::bflo; using pg8::bfhi; using pg8::pack8; using pg8::unpack8; using pg8::sigm;
__device__ __forceinline__ float bf2f(unsigned short b) { return __uint_as_float(((unsigned)b) << 16); }
__device__ __forceinline__ unsigned short f2bf(float f) { return (unsigned short)(cvt_pk_bf16(f, 0.f) & 0xffffu); }
__device__ __forceinline__ int crow(int r, int hi) { return (r & 3) + 8 * (r >> 2) + 4 * hi; }
template <int CTRL> __device__ __forceinline__ float dpp_mov(float v) { return __builtin_bit_cast(float, __builtin_amdgcn_update_dpp(0, __builtin_bit_cast(int, v), CTRL, 0xF, 0xF, true)); }
__device__ __forceinline__ float wave_sum(float v) {
    v += dpp_mov<0xB1>(v); v += dpp_mov<0x4E>(v); v += dpp_mov<0x141>(v); v += dpp_mov<0x140>(v);
    const int iv = __builtin_bit_cast(int, v);
    const float r0 = __builtin_bit_cast(float, __builtin_amdgcn_readlane(iv, 0)), r1 = __builtin_bit_cast(float, __builtin_amdgcn_readlane(iv, 16)), r2 = __builtin_bit_cast(float, __builtin_amdgcn_readlane(iv, 32)), r3 = __builtin_bit_cast(float, __builtin_amdgcn_readlane(iv, 48));
    return (r0 + r1) + (r2 + r3);
}
__device__ __forceinline__ s16x4 ldtr(const LAS unsigned char* p) { return __builtin_bit_cast(s16x4, __builtin_amdgcn_ds_read_tr16_b64_v4i16((LAS s16x4*)p)); }
#define MFMA32(a, b, c) __builtin_amdgcn_mfma_f32_32x32x16_bf16((a), (b), (c), 0, 0, 0)

#define XB_TMO      128
#define XB_XCNT(j)  (256  + 64 * (j))
#define XB_XSUB(j)  (1280 + 64 * (j))
#define XB_XGEN(j)  (2304 + 64 * (j))
#define XB_TOP      3328
#define XB_TOPGEN   3392
#define XCD_BAR_WORDS 3456
#define XB_SPIN_CAP (1u << 18)

__device__ __forceinline__ unsigned xb_ld(unsigned* p)              { return __hip_atomic_load(p, __ATOMIC_RELAXED, __HIP_MEMORY_SCOPE_AGENT); }
__device__ __forceinline__ unsigned xb_add(unsigned* p, unsigned v) { return __hip_atomic_fetch_add(p, v, __ATOMIC_RELAXED, __HIP_MEMORY_SCOPE_AGENT); }
__device__ __forceinline__ unsigned xb_xcc_id() { return (unsigned)__builtin_amdgcn_s_getreg((3 << 11) | 20) & 0xFu; }
#define XB_SPIN(cond, bar) do { unsigned _sp = 0; while (cond) { __builtin_amdgcn_s_sleep(1); \
    if ((++_sp & 255u) == 0u) { if (xb_ld(&(bar)[XB_TMO])) break; if (_sp > XB_SPIN_CAP) { atomicAdd(&(bar)[XB_TMO], 1u); break; } } } } while (0)

struct XcdBarrier {
    unsigned* bar; unsigned x;
    volatile LAS unsigned* st;
};

__device__ __forceinline__ XcdBarrier xcd_barrier_post(unsigned* bar, volatile LAS unsigned* st) {
    XcdBarrier b; b.bar = bar; b.x = xb_xcc_id(); b.st = st;
    if (threadIdx.x == 0) (void)xb_add(&bar[XB_XCNT(b.x)], 1u);
    return b;
}
__device__ __forceinline__ void xcd_barrier_complete(unsigned* bar, unsigned x, unsigned& nloc, unsigned& nx) {
    const unsigned G = gridDim.x * gridDim.y * gridDim.z;
    unsigned sum, cnt, mine, sp = 0u;
    for (;;) {
        sum = 0u; cnt = 0u; mine = 0u;
#pragma unroll
        for (unsigned j = 0; j < 16; ++j) { const unsigned c = xb_ld(&bar[XB_XCNT(j)]); sum += c; cnt += (c > 0u) ? 1u : 0u; mine = (j == x) ? c : mine; }
        if (sum == G) break;
        __builtin_amdgcn_s_sleep(1);
        if ((++sp & 255u) == 0u) { if (xb_ld(&bar[XB_TMO])) break; if (sp > XB_SPIN_CAP) { atomicAdd(&bar[XB_TMO], 1u); break; } }
    }
    nloc = mine > 0u ? mine : 1u; nx = cnt > 0u ? cnt : 1u;
}

__device__ __forceinline__ void xcd_barrier(const XcdBarrier& b) {
    asm volatile("s_waitcnt vmcnt(0)" ::: "memory");
    __syncthreads();
    if (threadIdx.x == 0) {
        unsigned* bar = b.bar;
        __builtin_amdgcn_s_waitcnt(0);
        unsigned nloc = b.st[0], nx = b.st[1];
        if (nloc == 0u) { xcd_barrier_complete(bar, b.x, nloc, nx); b.st[0] = nloc; b.st[1] = nx; }
        const unsigned old = xb_add(&bar[XB_XSUB(b.x)], 1u);
        const unsigned gen = old / nloc;
        if (old + 1u == (gen + 1u) * nloc) {
            __builtin_amdgcn_fence(__ATOMIC_RELEASE, "agent");
            asm volatile("s_waitcnt vmcnt(0)" ::: "memory");
            const unsigned og = xb_add(&bar[XB_TOP], 1u);
            const unsigned tg = og / nx;
            if (og + 1u == (tg + 1u) * nx) xb_add(&bar[XB_TOPGEN], 1u);
            else XB_SPIN(xb_ld(&bar[XB_TOPGEN]) == tg, bar);
            __builtin_amdgcn_fence(__ATOMIC_ACQUIRE, "agent");
            xb_add(&bar[XB_XGEN(b.x)], 1u);
            asm volatile("s_waitcnt vmcnt(0)" ::: "memory");
        } else {
            XB_SPIN(xb_ld(&bar[XB_XGEN(b.x)]) == gen, bar);
            __builtin_amdgcn_fence(__ATOMIC_ACQUIRE, "agent");
            asm volatile("s_waitcnt vmcnt(0)" ::: "memory");
        }
    }
    __syncthreads();
}

#ifdef FP8_EMU2
#define EMU2(x) (x)
#else
#define EMU2(x) 0.f
#endif
#ifndef FP8_EMU_W
#define FP8_EMU_W 0.f
#endif
#ifndef FP8_EMU_H
#define FP8_EMU_H 0.f
#endif
__device__ __forceinline__ float fp8_rt(float v, float sc) { const int w = __builtin_amdgcn_cvt_pk_fp8_f32(v * sc, 0.f, 0, false); return __builtin_amdgcn_cvt_f32_fp8(w, 0) / sc; }
__device__ __forceinline__ void p0_tr_item(const float* W, int ld, int K, int scol, bf16* WT, int drow, int k0, LAS float* scr, int lane, float emu = 0.f) {
#pragma unroll 8
    for (int i = 0; i < 32; ++i) { const int kk = 2 * i + (lane >> 5); float wv = W[(size_t)(k0 + kk) * ld + scol + (lane & 31)]; if (emu != 0.f) wv = fp8_rt(wv, emu); scr[kk * 33 + (lane & 31)] = wv; }
    asm volatile("s_waitcnt lgkmcnt(0)" ::: "memory");
    const int c = lane & 7;
#pragma unroll
    for (int j = 0; j < 4; ++j) { const int n = (lane >> 3) + 8 * j; const LAS float* s = scr + (8 * c) * 33 + n;
        v4u o; o.x = cvt_pk_bf16(s[0 * 33], s[1 * 33]); o.y = cvt_pk_bf16(s[2 * 33], s[3 * 33]); o.z = cvt_pk_bf16(s[4 * 33], s[5 * 33]); o.w = cvt_pk_bf16(s[6 * 33], s[7 * 33]);
        *(GAS v4u*)(WT + (size_t)(drow + n) * K + k0 + 8 * c) = o; }
    asm volatile("s_waitcnt lgkmcnt(0)" ::: "memory");
}
__device__ __forceinline__ void p0_tr_item_f8(const float* W, int ld, int K, int scol, unsigned char* WT, int drow, int k0, LAS float* scr, int lane, float sc) {
#pragma unroll 8
    for (int i = 0; i < 32; ++i) { const int kk = 2 * i + (lane >> 5); scr[kk * 33 + (lane & 31)] = W[(size_t)(k0 + kk) * ld + scol + (lane & 31)] * sc; }
    asm volatile("s_waitcnt lgkmcnt(0)" ::: "memory");
    const int c = lane & 7;
#pragma unroll
    for (int j = 0; j < 4; ++j) { const int n = (lane >> 3) + 8 * j; const LAS float* s = scr + (8 * c) * 33 + n;
        int w0 = __builtin_amdgcn_cvt_pk_fp8_f32(s[0 * 33], s[1 * 33], 0, false); w0 = __builtin_amdgcn_cvt_pk_fp8_f32(s[2 * 33], s[3 * 33], w0, true);
        int w1 = __builtin_amdgcn_cvt_pk_fp8_f32(s[4 * 33], s[5 * 33], 0, false); w1 = __builtin_amdgcn_cvt_pk_fp8_f32(s[6 * 33], s[7 * 33], w1, true);
        *(GAS v2u*)(WT + (size_t)(drow + n) * K + k0 + 8 * c) = (v2u){(unsigned)w0, (unsigned)w1}; }
    asm volatile("s_waitcnt lgkmcnt(0)" ::: "memory");
}
__device__ __forceinline__ void rms_rows_to_f8(const float* X, const float* gain, unsigned char* O, int first, int stride, int lane, float sc) {
    const GAS f32x4* gr = (const GAS f32x4*)gain + lane; f32x4 g[4];
#pragma unroll
    for (int j = 0; j < 4; ++j) g[j] = gr[64 * j] * sc;
    auto load_row = [&](f32x4 (&n)[4], const int m) { const GAS f32x4* xr = (const GAS f32x4*)(X + (size_t)m * D) + lane;
#pragma unroll
        for (int j = 0; j < 4; ++j) n[j] = xr[64 * j]; };
    auto proc_row = [&](const f32x4 (&v)[4], const int m) { float s = 0.f;
#pragma unroll
        for (int j = 0; j < 4; ++j) s += (v[j].x * v[j].x + v[j].y * v[j].y) + (v[j].z * v[j].z + v[j].w * v[j].w);
        const float rs = rsqrtf(wave_sum(s) * (1.f / D) + 1e-6f);
        GAS unsigned* o4 = (GAS unsigned*)(O + (size_t)m * D) + lane;
#pragma unroll
        for (int j = 0; j < 4; ++j) { int w = __builtin_amdgcn_cvt_pk_fp8_f32(v[j].x * rs * g[j].x, v[j].y * rs * g[j].y, 0, false); w = __builtin_amdgcn_cvt_pk_fp8_f32(v[j].z * rs * g[j].z, v[j].w * rs * g[j].w, w, true); o4[64 * j] = (unsigned)w; } };
    f32x4 nA[4], nB[4];
    if (first < T) load_row(nA, first);
    if (first + stride < T) load_row(nB, first + stride);
    for (int m = first; m < T; m += 2 * stride) {
        { f32x4 v[4];
#pragma unroll
          for (int j = 0; j < 4; ++j) v[j] = nA[j];
          if (m + 2 * stride < T) load_row(nA, m + 2 * stride);
          proc_row(v, m); }
        if (m + stride < T) { f32x4 v[4];
#pragma unroll
          for (int j = 0; j < 4; ++j) v[j] = nB[j];
          if (m + 3 * stride < T) load_row(nB, m + 3 * stride);
          proc_row(v, m + stride); }
    }
}
__device__ __forceinline__ void rms_rows_to_both(const float* X, const float* gain, bf16* O, unsigned char* O8, int first, int stride, int lane, float sc) {
    const GAS f32x4* gr = (const GAS f32x4*)gain + lane; f32x4 g[4];
#pragma unroll
    for (int j = 0; j < 4; ++j) g[j] = gr[64 * j];
    auto load_row = [&](f32x4 (&n)[4], const int m) { const GAS f32x4* xr = (const GAS f32x4*)(X + (size_t)m * D) + lane;
#pragma unroll
        for (int j = 0; j < 4; ++j) n[j] = xr[64 * j]; };
    auto proc_row = [&](const f32x4 (&v)[4], const int m) { float s = 0.f;
#pragma unroll
        for (int j = 0; j < 4; ++j) s += (v[j].x * v[j].x + v[j].y * v[j].y) + (v[j].z * v[j].z + v[j].w * v[j].w);
        const float rs = rsqrtf(wave_sum(s) * (1.f / D) + 1e-6f);
        GAS v2u* o8 = (GAS v2u*)(O + (size_t)m * D) + lane; GAS unsigned* o4 = (GAS unsigned*)(O8 + (size_t)m * D) + lane;
#pragma unroll
        for (int j = 0; j < 4; ++j) { const f32x4 q_ = v[j] * rs * g[j]; v2u w; w.x = cvt_pk_bf16(q_.x, q_.y); w.y = cvt_pk_bf16(q_.z, q_.w); o8[64 * j] = w;
            int w8 = __builtin_amdgcn_cvt_pk_fp8_f32(q_.x * sc, q_.y * sc, 0, false); w8 = __builtin_amdgcn_cvt_pk_fp8_f32(q_.z * sc, q_.w * sc, w8, true); o4[64 * j] = (unsigned)w8; } };
    f32x4 nA[4], nB[4];
    if (first < T) load_row(nA, first);
    if (first + stride < T) load_row(nB, first + stride);
    for (int m = first; m < T; m += 2 * stride) {
        { f32x4 v[4];
#pragma unroll
          for (int j = 0; j < 4; ++j) v[j] = nA[j];
          if (m + 2 * stride < T) load_row(nA, m + 2 * stride);
          proc_row(v, m); }
        if (m + stride < T) { f32x4 v[4];
#pragma unroll
          for (int j = 0; j < 4; ++j) v[j] = nB[j];
          if (m + 3 * stride < T) load_row(nB, m + 3 * stride);
          proc_row(v, m + stride); }
    }
}
__device__ __forceinline__ void rms_row_to_bf16(const float* xrow, const float* gain, bf16* orow, int lane) {
    const GAS f32x4* xr = (const GAS f32x4*)xrow + lane; const GAS f32x4* gr = (const GAS f32x4*)gain + lane;
    f32x4 v[4]; float s = 0.f;
#pragma unroll
    for (int j = 0; j < 4; ++j) { v[j] = xr[64 * j]; s += (v[j].x * v[j].x + v[j].y * v[j].y) + (v[j].z * v[j].z + v[j].w * v[j].w); }
    const float rs = rsqrtf(wave_sum(s) * (1.f / D) + 1e-6f);
    GAS v2u* o8 = (GAS v2u*)orow + lane;
#pragma unroll
    for (int j = 0; j < 4; ++j) { const f32x4 g = gr[64 * j]; v2u w; w.x = cvt_pk_bf16(v[j].x * rs * g.x, v[j].y * rs * g.y); w.y = cvt_pk_bf16(v[j].z * rs * g.z, v[j].w * rs * g.w); o8[64 * j] = w; }
}

__device__ __forceinline__ void rms_rows_to_bf16(const float* X, const float* gain, bf16* O, int first, int stride, int lane, float emu = 0.f) {
    const GAS f32x4* gr = (const GAS f32x4*)gain + lane; f32x4 g[4];
#pragma unroll
    for (int j = 0; j < 4; ++j) g[j] = gr[64 * j];
    f32x4 nx[4];
    if (first < T) { const GAS f32x4* xr = (const GAS f32x4*)(X + (size_t)first * D) + lane;
#pragma unroll
        for (int j = 0; j < 4; ++j) nx[j] = xr[64 * j]; }
    for (int m = first; m < T; m += stride) {
        f32x4 v[4]; float s = 0.f;
#pragma unroll
        for (int j = 0; j < 4; ++j) v[j] = nx[j];
        if (m + stride < T) { const GAS f32x4* xr = (const GAS f32x4*)(X + (size_t)(m + stride) * D) + lane;
#pragma unroll
            for (int j = 0; j < 4; ++j) nx[j] = xr[64 * j]; }
#pragma unroll
        for (int j = 0; j < 4; ++j) s += (v[j].x * v[j].x + v[j].y * v[j].y) + (v[j].z * v[j].z + v[j].w * v[j].w);
        const float rs = rsqrtf(wave_sum(s) * (1.f / D) + 1e-6f);
        GAS v2u* o8 = (GAS v2u*)(O + (size_t)m * D) + lane;
#pragma unroll
        for (int j = 0; j < 4; ++j) { float a0 = v[j].x * rs * g[j].x, a1 = v[j].y * rs * g[j].y, a2 = v[j].z * rs * g[j].z, a3 = v[j].w * rs * g[j].w;
            if (emu != 0.f) { a0 = fp8_rt(a0, emu); a1 = fp8_rt(a1, emu); a2 = fp8_rt(a2, emu); a3 = fp8_rt(a3, emu); }
            v2u w; w.x = cvt_pk_bf16(a0, a1); w.y = cvt_pk_bf16(a2, a3); o8[64 * j] = w; }
    }
}

struct Ptrs {
    const float* in[24]; float* out; unsigned char* ws;
};

__device__ __forceinline__ void p0_prologue(const Ptrs& P, LAS unsigned char* lds, int G, int c, int wave, int lane) {
    LAS float* scr = (LAS float*)(lds + wave * 16384);
    const int gw = c * NWAVES + wave, NGW = G * NWAVES;
    const float* w_in = P.in[3];
    bf16* BTP1 = (bf16*)(P.ws + WS_BTP1);
#ifdef P1_FP8
#define P1_TR(scol, drow, k0) p0_tr_item_f8(w_in, IN_TOTAL, D, (scol), (unsigned char*)BTP1, (drow), (k0), scr, lane, 64.0f)
#else
#define P1_TR(scol, drow, k0) p0_tr_item(w_in, IN_TOTAL, D, (scol), BTP1, (drow), (k0), scr, lane, FP8_EMU_W)
#endif
    constexpr int I_QK = 16 * 96, I_VB = 16 * 144, I_BA = 16, I_Z = 16 * 32, I_A = 8 * 32, I_SQ = 16 * 32, I_PLE = 4 * 32, I_EG = 16 * 16 * 8, I_ED = 16 * 4 * 32;
    constexpr int NITEMS = I_QK + I_VB + I_BA + 3 * I_Z + I_A + 3 * I_SQ + I_PLE + 2 * I_EG + I_ED;
    for (int it = gw; it < NITEMS; it += NGW) {
        int r = it;
        if (r < I_QK) { const int kb = r / 96, nb = r % 96, n0 = 32 * nb, pn = n0 >> 8, w = n0 & 255, wc = w >> 6, bj = (w >> 5) & 1;
            P1_TR(n0, 256 * pn + 128 * bj + 32 * wc, 64 * kb); continue; } r -= I_QK;
        if (r < I_VB) { const int kb = r / 144, nb = r % 144, n0 = 3072 + 32 * nb; P1_TR(n0, n0, 64 * kb); continue; } r -= I_VB;
        if (r < I_BA) { P1_TR(8704, 7680, 64 * r); continue; } r -= I_BA;
        if (r < I_Z) { const int kb = r / 32, nb = r % 32; p0_tr_item(w_in, IN_TOTAL, D, 7680 + 32 * nb, (bf16*)(P.ws + WS_BTZ), 32 * nb, 64 * kb, scr, lane); continue; } r -= I_Z;
#ifdef MORE_FP8
        if (r < I_Z) { const int kb = r / 32, nb = r % 32; p0_tr_item_f8(w_in, IN_TOTAL, D, 8720 + 32 * nb, (unsigned char*)(P.ws + WS_BTGA), 32 * nb, 64 * kb, scr, lane, 64.0f); continue; } r -= I_Z;
#else
        if (r < I_Z) { const int kb = r / 32, nb = r % 32; p0_tr_item(w_in, IN_TOTAL, D, 8720 + 32 * nb, (bf16*)(P.ws + WS_BTGA), 32 * nb, 64 * kb, scr, lane); continue; } r -= I_Z;
#endif
#ifdef MORE_FP8
        if (r < I_Z) { const int kb = r / 32, nb = r % 32; p0_tr_item_f8(w_in, IN_TOTAL, D, 9744 + 32 * nb, (unsigned char*)(P.ws + WS_BTGA) + (size_t)1024 * D, 32 * nb, 64 * kb, scr, lane, 64.0f); continue; } r -= I_Z;
#else
        if (r < I_Z) { const int kb = r / 32, nb = r % 32; p0_tr_item(w_in, IN_TOTAL, D, 9744 + 32 * nb, (bf16*)(P.ws + WS_BTGB), 32 * nb, 64 * kb, scr, lane); continue; } r -= I_Z;
#endif
        if (r < I_A) { const int kb = r / 32, nb = r % 32; p0_tr_item(P.in[10], D, 512, 32 * nb, (bf16*)(P.ws + WS_BTA), 32 * nb, 64 * kb, scr, lane); continue; } r -= I_A;
        if (r < I_SQ) { const int kb = r / 32, nb = r % 32; p0_tr_item(P.in[11], D, D, 32 * nb, (bf16*)(P.ws + WS_BTB), 32 * nb, 64 * kb, scr, lane); continue; } r -= I_SQ;
        if (r < I_SQ) { const int kb = r / 32, nb = r % 32; p0_tr_item(P.in[12], D, D, 32 * nb, (bf16*)(P.ws + WS_BTOUT), 32 * nb, 64 * kb, scr, lane); continue; } r -= I_SQ;
#ifdef MORE_FP8
        if (r < I_SQ) { const int kb = r / 32, nb = r % 32; p0_tr_item_f8(P.in[23], D, D, 32 * nb, (unsigned char*)(P.ws + WS_BTPG), 32 * nb, 64 * kb, scr, lane, 64.0f); continue; } r -= I_SQ;
#else
        if (r < I_SQ) { const int kb = r / 32, nb = r % 32; p0_tr_item(P.in[23], D, D, 32 * nb, (bf16*)(P.ws + WS_BTPG), 32 * nb, 64 * kb, scr, lane, EMU2(64.f)); continue; } r -= I_SQ;
#endif
        if (r < I_PLE) { const int kb = r / 32, nb = r % 32; p0_tr_item(P.in[22], D, 256, 32 * nb, (bf16*)(P.ws + WS_BTPLE), 32 * nb, 64 * kb, scr, lane); continue; } r -= I_PLE;
#ifdef MORE_FP8
        if (r < I_EG) { const int e = r / 128, q = r % 128, kb = q / 8, nb = q % 8, f0 = 32 * nb;
            p0_tr_item_f8(P.in[18] + (size_t)e * 1024 * 256, 256, D, f0, (unsigned char*)(P.ws + WS_BTGU) + (size_t)e * 512 * 1024, 256 * (f0 >> 7) + (f0 & 127), 64 * kb, scr, lane, 64.0f); continue; } r -= I_EG;
        if (r < I_EG) { const int e = r / 128, q = r % 128, kb = q / 8, nb = q % 8, f0 = 32 * nb;
            p0_tr_item_f8(P.in[19] + (size_t)e * 1024 * 256, 256, D, f0, (unsigned char*)(P.ws + WS_BTGU) + (size_t)e * 512 * 1024, 256 * (f0 >> 7) + 128 + (f0 & 127), 64 * kb, scr, lane, 64.0f); continue; } r -= I_EG;
#else
        if (r < I_EG) { const int e = r / 128, q = r % 128, kb = q / 8, nb = q % 8, f0 = 32 * nb;
            p0_tr_item(P.in[18] + (size_t)e * 1024 * 256, 256, D, f0, (bf16*)(P.ws + WS_BTGU) + (size_t)e * 512 * 1024, 256 * (f0 >> 7) + (f0 & 127), 64 * kb, scr, lane, EMU2(64.f)); continue; } r -= I_EG;
        if (r < I_EG) { const int e = r / 128, q = r % 128, kb = q / 8, nb = q % 8, f0 = 32 * nb;
            p0_tr_item(P.in[19] + (size_t)e * 1024 * 256, 256, D, f0, (bf16*)(P.ws + WS_BTGU) + (size_t)e * 512 * 1024, 256 * (f0 >> 7) + 128 + (f0 & 127), 64 * kb, scr, lane, EMU2(64.f)); continue; } r -= I_EG;
#endif
        { const int e = r / 128, q = r % 128, kb = q / 32, nb = q % 32;
            p0_tr_item(P.in[20] + (size_t)e * 256 * 1024, D, 256, 32 * nb, (bf16*)(P.ws + WS_BTDN) + (size_t)e * 1024 * 256, 32 * nb, 64 * kb, scr, lane, EMU2(32.f)); }
    }
#ifdef P1_FP8
    { GAS v4u* z = (GAS v4u*)((unsigned char*)BTP1 + (size_t)7712 * D); const int nz = 224 * D / 16; for (int i = gw * 64 + lane; i < nz; i += NGW * 64) z[i] = (v4u){0u, 0u, 0u, 0u}; }
#else
    { GAS v4u* z = (GAS v4u*)(BTP1 + (size_t)7712 * D); const int nz = 224 * D / 8; for (int i = gw * 64 + lane; i < nz; i += NGW * 64) z[i] = (v4u){0u, 0u, 0u, 0u}; }
#endif
    bf16* H = (bf16*)((unsigned char*)P.out + DO_H);
#ifdef P1_FP8
    rms_rows_to_f8(P.in[0], P.in[2], (unsigned char*)H, gw, NGW, lane, 4.0f);
#else
    rms_rows_to_bf16(P.in[0], P.in[2], H, gw, NGW, lane, FP8_EMU_H);
#endif
}

struct AttnU { int b, g, h, r, pr, dil; };
__device__ __forceinline__ AttnU attn_decode(int u) {
    AttnU a; a.b = u / 768; int rem = u % 768;
    if (rem < 256) { a.g = 0; a.h = rem >> 5; a.r = 0; a.pr = rem & 31; }
    else if (rem < 512) { rem -= 256; a.g = 1; a.h = rem >> 5; a.r = (rem & 31) >> 3; a.pr = rem & 7; }
    else { rem -= 512; a.g = 2; a.h = rem >> 5; a.r = (rem & 31) >> 1; a.pr = rem & 1; }
    a.dil = 1 << (2 * a.g); return a;
}
__device__ __forceinline__ void attn_issue(const bf16* QA, int u, bool cont, int tid, int wid, int l32, int hi, v4u (&pk)[6], v4u (&pv)[6], bf16x8 (&pq)[4]) {
    const AttnU a = attn_decode(u); const size_t rowb = (size_t)a.b * SEQ; const bf16* Qg = QA + (size_t)(a.g * 8 + a.h) * T * 64;
#pragma unroll
    for (int k = 0; k < 6; ++k) {
        const int ci = tid + 512 * k, j = (ci >> 3) + (cont ? 128 : 0), ch = ci & 7, sidx = 256 * a.pr - 128 + j;
        v4u kv = (v4u){0u, 0u, 0u, 0u}, vv = (v4u){0u, 0u, 0u, 0u};
        if (sidx >= 0 && !(cont && k >= 4)) { const bf16* p = Qg + (rowb + (size_t)(sidx * a.dil + a.r)) * 64 + ch * 8; kv = *(const GAS v4u*)(p + (size_t)24 * T * 64); vv = *(const GAS v4u*)(p + (size_t)48 * T * 64); }
        pk[k] = kv; pv[k] = vv;
    }
    const int qi = 32 * wid + l32; const size_t mq = rowb + (size_t)((256 * a.pr + qi) * a.dil + a.r);
#pragma unroll
    for (int ks = 0; ks < 4; ++ks) pq[ks] = *(const GAS bf16x8*)(Qg + mq * 64 + 16 * ks + 8 * hi);
}
__device__ __forceinline__ bool attn_continues(int uprev, int u) {
    const AttnU a = attn_decode(uprev), b = attn_decode(u); return a.b == b.b && a.g == b.g && a.h == b.h && a.r == b.r && b.pr == a.pr + 1;
}
__device__ __forceinline__ void attn_phase(LAS unsigned char* lds, const bf16* QA, bf16* OG, float* LSE, int G, int c, int flags) {
    int tid_ = threadIdx.x; asm volatile("" : "+v"(tid_));
    const int tid = tid_, lane = tid & 63, wid = __builtin_amdgcn_readfirstlane(tid >> 6), l32 = lane & 31, hi = lane >> 5;
    LAS unsigned char* KS = lds; LAS unsigned char* VS = lds + 55296;
    v4u pk[6], pv[6]; bf16x8 pq[4];
    const int upb = 6144 / G, ubeg = c * upb, uend = ubeg + upb;
    if (ubeg < uend) attn_issue(QA, ubeg, false, tid, wid, l32, hi, pk, pv, pq);
    int base = 0; bool cont = false;
    for (int u = ubeg; u < uend; ++u) {
        const AttnU au = attn_decode(u); const int g = au.g, h = au.h, pr = au.pr;
        const size_t rowb = (size_t)au.b * SEQ;
        if (cont) base = (base + 2) % 3; else base = 0;
        __syncthreads();
#pragma unroll
        for (int k = 0; k < 6; ++k) { const int ci = tid + 512 * k, j = (ci >> 3) + (cont ? 128 : 0), ch = ci & 7;
            if (!(cont && k >= 4)) { const int prow = ((base + (j >> 7)) % 3) * 128 + (j & 127); *(LAS v4u*)(KS + prow * 144 + ch * 16) = pk[k]; *(LAS v4u*)(VS + prow * 144 + ch * 16) = pv[k]; } }
        const int qi = 32 * wid + l32; const size_t mq = rowb + (size_t)((256 * pr + qi) * au.dil + au.r);
        bf16x8 qf[4];
#pragma unroll
        for (int ks = 0; ks < 4; ++ks) qf[ks] = pq[ks];
        __syncthreads();
        const bool cont_next = (u + 1 < uend) && attn_continues(u, u + 1);
        if (u + 1 < uend && !(flags & 256)) attn_issue(QA, u + 1, cont_next, tid, wid, l32, hi, pk, pv, pq);
        if (flags & 128) { cont = cont_next; continue; }
        int prow5[5];
#pragma unroll
        for (int kb = 0; kb < 5; ++kb) { const int jb = 32 * wid + 32 * kb; prow5[kb] = ((base + (jb >> 7)) % 3) * 128 + (jb & 127); }
        f32x16 sc[5];
#pragma unroll
        for (int kb = 0; kb < 5; ++kb) {
            f32x16 a = {};
#pragma unroll
            for (int ks = 0; ks < 4; ++ks) { const bf16x8 kf = *(const LAS bf16x8*)(KS + (prow5[kb] + l32) * 144 + (16 * ks + 8 * hi) * 2); a = MFMA32(kf, qf[ks], a); }
            sc[kb] = a;
        }
        const float NEG = -1e30f;
#pragma unroll
        for (int rr = 0; rr < 16; ++rr) { const int cc = crow(rr, hi); if (cc < l32) sc[0][rr] = NEG; if (cc > l32) sc[4][rr] = NEG; }
        if (pr == 0) {
#pragma unroll
            for (int kb = 0; kb < 4; ++kb) if (wid + kb < 4) {
#pragma unroll
                for (int rr = 0; rr < 16; ++rr) sc[kb][rr] = NEG; }
        }
        float mx = NEG;
#pragma unroll
        for (int kb = 0; kb < 5; ++kb)
#pragma unroll
            for (int rr = 0; rr < 16; ++rr) mx = fmaxf(mx, sc[kb][rr]);
        mx = fmaxf(mx, __shfl_xor(mx, 32));
        float l = 0.f;
#pragma unroll
        for (int kb = 0; kb < 5; ++kb)
#pragma unroll
            for (int rr = 0; rr < 16; ++rr) { const float p = __builtin_amdgcn_exp2f(sc[kb][rr] - mx); sc[kb][rr] = p; l += p; }
        l += __shfl_xor(l, 32);
        f32x16 o[2]; o[0] = f32x16{}; o[1] = f32x16{};
        const int traddr = ((lane & 15) >> 2) * 144 + (16 * ((lane >> 4) & 1) + 4 * (lane & 3)) * 2;
#pragma unroll
        for (int kb = 0; kb < 5; ++kb)
#pragma unroll
            for (int ks2 = 0; ks2 < 2; ++ks2) {
                v4u pw; pw.x = cvt_pk_bf16(sc[kb][8 * ks2 + 0], sc[kb][8 * ks2 + 1]); pw.y = cvt_pk_bf16(sc[kb][8 * ks2 + 2], sc[kb][8 * ks2 + 3]);
                pw.z = cvt_pk_bf16(sc[kb][8 * ks2 + 4], sc[kb][8 * ks2 + 5]); pw.w = cvt_pk_bf16(sc[kb][8 * ks2 + 6], sc[kb][8 * ks2 + 7]);
                const bf16x8 pf = __builtin_bit_cast(bf16x8, pw);
                const int kv0 = prow5[kb] + 16 * ks2 + 4 * hi;
#pragma unroll
                for (int db = 0; db < 2; ++db) {
                    const LAS unsigned char* vp = VS + kv0 * 144 + traddr + db * 64;
                    const s16x4 lo = ldtr(vp), h4 = ldtr(vp + 8 * 144);
                    const bf16x8 vf = (bf16x8){lo[0], lo[1], lo[2], lo[3], h4[0], h4[1], h4[2], h4[3]};
                    o[db] = MFMA32(vf, pf, o[db]);
                }
            }
        const float inv = 1.0f / l;
        LAS unsigned char* stg = lds + 110592 + wid * 4096;
#pragma unroll
        for (int db = 0; db < 2; ++db)
#pragma unroll
            for (int rq = 0; rq < 4; ++rq) { v2u w; w.x = cvt_pk_bf16(o[db][4 * rq] * inv, o[db][4 * rq + 1] * inv); w.y = cvt_pk_bf16(o[db][4 * rq + 2] * inv, o[db][4 * rq + 3] * inv);
                *(LAS v2u*)(stg + l32 * 128 + (((4 * db + rq) ^ (l32 & 7)) * 16) + hi * 8) = w; }
        {
            const int rr = lane >> 3, cch = lane & 7;
#pragma unroll
            for (int i = 0; i < 4; ++i) { const int row = rr + 8 * i; const v4u w = *(const LAS v4u*)(stg + row * 128 + ((cch ^ (row & 7)) * 16));
                const int qrow = 32 * wid + row; const size_t mrow = rowb + (size_t)((256 * pr + qrow) * au.dil + au.r);
                *(GAS v4u*)(OG + mrow * 1536 + g * 512 + h * 64 + cch * 8) = w; }
        }
        if (hi == 0) LSE[mq * 24 + g * 8 + h] = mx + __builtin_amdgcn_logf(l);
        cont = cont_next;
    }
}

constexpr int PREP_RAW_PITCH = 784;
__device__ __forceinline__ void prep_issue_raw(const bf16* QB, int u, int tid, v4u (&pf)[7]) {
    const int bh = u >> 7, n = u & 127, b = bh >> 3, h = bh & 7;
#pragma unroll
    for (int k = 0; k < 7; ++k) { const int q = tid + 512 * k, rr = q / 48, cc = q % 48, tt = 64 * n - 3 + rr;
        v4u v = (v4u){0u, 0u, 0u, 0u};
        if (q < 67 * 48 && tt >= 0) v = *(const GAS v4u*)(QB + ((size_t)((cc >> 4) * 8 + h) * T + (size_t)b * SEQ + tt) * 128 + (cc & 15) * 8);
        pf[k] = v; }
}
__device__ __forceinline__ void prep_phase(LAS unsigned char* lds, const bf16* QB, const float* BG, const float* conv_w, unsigned char* DNP, float* DLB, int G, int c, int flags) {
    const int tid0 = threadIdx.x, wid = __builtin_amdgcn_readfirstlane(tid0 >> 6);
    LAS unsigned char* QS = lds; LAS unsigned char* KS = lds + 17408; LAS unsigned char* VS = lds + 34816;
    LAS float* AS = (LAS float*)(lds + 52224); LAS unsigned char* TS = lds + 69632; LAS unsigned char* AB = lds + 78848; LAS unsigned char* DT = lds + 88064;
    LAS float* gcT = (LAS float*)(lds + 104768); LAS float* btT = (LAS float*)(lds + 105024); LAS float* cwT = (LAS float*)(lds + 105280);
    LAS unsigned char* RAW = lds + 52224;
    LAS float* egT = (LAS float*)(lds + 128832);
    LAS unsigned char* KB = lds + 111424;
    v4u pf[7];
    const int upb = 8192 / G, ubeg = c * upb, uend = ubeg + upb;
    float gnx = 0.f, bnx = 0.f;
    if (ubeg < uend) { prep_issue_raw(QB, ubeg, tid0, pf);
        if (wid == 0) { const int bh0 = ubeg >> 7, n0 = ubeg & 127; const size_t mm = (size_t)(bh0 >> 3) * SEQ + 64 * n0 + (tid0 & 63); gnx = BG[mm * 16 + 8 + (bh0 & 7)]; bnx = BG[mm * 16 + (bh0 & 7)]; } }
    { const int h0 = (ubeg >> 7) & 7; __syncthreads();
      if (tid0 < 384) {
#pragma unroll
        for (int j = 0; j < 4; ++j) cwT[j * 384 + tid0] = conv_w[j * 3072 + (tid0 >> 7) * 1024 + h0 * 128 + (tid0 & 127)]; } }
    for (int u = ubeg; u < uend; ++u) {
        int tid = tid0; asm volatile("" : "+v"(tid));
        const int lane = tid & 63, l32 = lane & 31, hi = lane >> 5;
        const int bh = u >> 7, n = u & 127, b = bh >> 3, h = bh & 7; const size_t m0 = (size_t)b * SEQ + 64 * n;
        unsigned char* rec = DNP + (size_t)u * DNU;
        __syncthreads();
#pragma unroll
        for (int k = 0; k < 7; ++k) { const int q = tid + 512 * k; if (q < 67 * 48) *(LAS v4u*)(RAW + (q / 48) * PREP_RAW_PITCH + (q % 48) * 16) = pf[k]; }
        if (wid == 0) {
            float gv = gnx; const float bv = bnx;
            gv += dpp_mov<0x111>(gv); gv += dpp_mov<0x112>(gv); gv += dpp_mov<0x114>(gv); gv += dpp_mov<0x118>(gv);
            { const int iv = __builtin_bit_cast(int, gv);
              const float r0 = __builtin_bit_cast(float, __builtin_amdgcn_readlane(iv, 15)), r1 = __builtin_bit_cast(float, __builtin_amdgcn_readlane(iv, 31)), r2 = __builtin_bit_cast(float, __builtin_amdgcn_readlane(iv, 47));
              gv += (lane >= 16 ? r0 : 0.f) + (lane >= 32 ? r1 : 0.f) + (lane >= 48 ? r2 : 0.f); }
            const float glast_ = __builtin_bit_cast(float, __builtin_amdgcn_readlane(__builtin_bit_cast(int, gv), 63));
            gcT[lane] = gv; btT[lane] = bv; egT[lane] = __expf(glast_ - gv); if (lane == 63) DLB[u] = __expf(gv);
        }
        __syncthreads();
        if (u + 1 < uend) { prep_issue_raw(QB, u + 1, tid, pf);
            if (wid == 0) { gnx = BG[(m0 + 64 + lane) * 16 + 8 + h]; bnx = BG[(m0 + 64 + lane) * 16 + h]; } }
        if (tid < 384 && !(flags & 512)) {
            const int cg = tid & 15, rg = (tid >> 4) & 7, ten = tid >> 7;
            f32x4 w0[4], w1[4];
#pragma unroll
            for (int j = 0; j < 4; ++j) { w0[j] = *(const LAS f32x4*)(cwT + j * 384 + ten * 128 + cg * 8); w1[j] = *(const LAS f32x4*)(cwT + j * 384 + ten * 128 + cg * 8 + 4); }
            const LAS unsigned char* rp = RAW + (rg * 8) * PREP_RAW_PITCH + (ten * 16 + cg) * 16;
            f32x4 wa[4], wb[4];
#pragma unroll
            for (int j = 0; j < 3; ++j) unpack8(*(const LAS v4u*)(rp + j * PREP_RAW_PITCH), wa[j], wb[j]);
            LAS unsigned char* dstb = (ten == 0 ? QS : (ten == 1 ? KS : VS)) + (rg * 8) * 272 + cg * 16;
#pragma unroll
            for (int ii = 0; ii < 8; ++ii) {
                unpack8(*(const LAS v4u*)(rp + (ii + 3) * PREP_RAW_PITCH), wa[(ii + 3) & 3], wb[(ii + 3) & 3]);
                f32x4 y0 = {0.f, 0.f, 0.f, 0.f}, y1 = {0.f, 0.f, 0.f, 0.f};
#pragma unroll
                for (int j = 0; j < 4; ++j) { y0 += wa[(ii + j) & 3] * w0[j]; y1 += wb[(ii + j) & 3] * w1[j]; }
#pragma unroll
                for (int e = 0; e < 4; ++e) { y0[e] = y0[e] * sigm(y0[e]); y1[e] = y1[e] * sigm(y1[e]); }
                float scl;
                if (ten < 2) { float ss = (y0[0] * y0[0] + y0[1] * y0[1]) + (y0[2] * y0[2] + y0[3] * y0[3]) + (y1[0] * y1[0] + y1[1] * y1[1]) + (y1[2] * y1[2] + y1[3] * y1[3]);
                    ss += dpp_mov<0xB1>(ss); ss += dpp_mov<0x4E>(ss); ss += dpp_mov<0x141>(ss); ss += dpp_mov<0x140>(ss);
                    scl = rsqrtf(ss + 1e-6f) * (ten == 0 ? 0.08838834764831845f : 1.0f); }
                else scl = btT[rg * 8 + ii];
                *(LAS v4u*)(dstb + ii * 272) = pack8(y0 * scl, y1 * scl);
                if (ten == 1) { const float s2 = scl * btT[rg * 8 + ii] * __expf(gcT[rg * 8 + ii]); *(LAS v4u*)(KB + (rg * 8 + ii) * 272 + cg * 16) = pack8(y0 * s2, y1 * s2); }
            }
        }
        __syncthreads();
        if (wid < 6 && !(flags & 8)) {
            const int kind = wid / 3, pi = wid % 3, ib = pi ? 1 : 0, jb = (pi == 2) ? 1 : 0;
            f32x16 a = {};
            if (kind == 0) {
#pragma unroll
                for (int ks = 0; ks < 8; ++ks) { const bf16x8 af = *(const LAS bf16x8*)(KS + (32 * ib + l32) * 272 + (16 * ks + 8 * hi) * 2), bf = *(const LAS bf16x8*)(KS + (32 * jb + l32) * 272 + (16 * ks + 8 * hi) * 2); a = MFMA32(af, bf, a); }
                const int j = 32 * jb + l32; const float gj = gcT[j];
#pragma unroll
                for (int rr = 0; rr < 16; ++rr) { const int i = 32 * ib + crow(rr, hi); const float v = (j < i) ? btT[i] * a[rr] * __expf(gcT[i] - gj) : 0.f; AS[i * 68 + j] = v; *(LAS unsigned short*)(AB + i * 144 + j * 2) = f2bf(v); }
            } else {
#pragma unroll
                for (int ks = 0; ks < 8; ++ks) { const bf16x8 af = *(const LAS bf16x8*)(KS + (32 * jb + l32) * 272 + (16 * ks + 8 * hi) * 2), bf = *(const LAS bf16x8*)(QS + (32 * ib + l32) * 272 + (16 * ks + 8 * hi) * 2); a = MFMA32(af, bf, a); }
                const int i = 32 * ib + l32; const float gi = gcT[i];
#pragma unroll
                for (int rr = 0; rr < 16; ++rr) { const int j = 32 * jb + crow(rr, hi); a[rr] = (j <= i) ? a[rr] * __expf(gi - gcT[j]) : 0.f; }
#pragma unroll
                for (int ks2 = 0; ks2 < 2; ++ks2) { v4u w; w.x = cvt_pk_bf16(a[8 * ks2], a[8 * ks2 + 1]); w.y = cvt_pk_bf16(a[8 * ks2 + 2], a[8 * ks2 + 3]); w.z = cvt_pk_bf16(a[8 * ks2 + 4], a[8 * ks2 + 5]); w.w = cvt_pk_bf16(a[8 * ks2 + 6], a[8 * ks2 + 7]);
                    __builtin_nontemporal_store(w, (GAS v4u*)(rec + 49152 + ((ib * 4 + 2 * jb + ks2) * 64 + lane) * 16)); }
            }
        }
        __syncthreads();
        if (wid == 0) { if (!(flags & 2)) {
            const int blk = lane >> 4, cc = lane & 15; const float fcc = (float)cc;
            float x[16];
#pragma unroll
            for (int i = 0; i < 16; ++i) {
                float a0 = fmaxf(0.f, 1.f - fabsf(fcc - (float)i)), a1 = 0.f;
#pragma unroll
                for (int j4 = 0; j4 < (i + 3) / 4; ++j4) { const f32x4 av = *(const LAS f32x4*)(AS + (16 * blk + i) * 68 + 16 * blk + 4 * j4);
                    if (4 * j4 + 0 < i) a0 -= av[0] * x[4 * j4 + 0]; if (4 * j4 + 1 < i) a1 -= av[1] * x[4 * j4 + 1];
                    if (4 * j4 + 2 < i) a0 -= av[2] * x[4 * j4 + 2]; if (4 * j4 + 3 < i) a1 -= av[3] * x[4 * j4 + 3]; }
                x[i] = a0 + a1;
            }
            {
                unsigned xp[8];
#pragma unroll
                for (int q = 0; q < 8; ++q) xp[q] = cvt_pk_bf16(x[2 * q], x[2 * q + 1]);
#pragma unroll
                for (int q = 0; q < 8; ++q) { v4u w = (v4u){0u, 0u, 0u, 0u};
                    if ((q >> 1) == blk) { if (q & 1) w = (v4u){xp[4], xp[5], xp[6], xp[7]}; else w = (v4u){xp[0], xp[1], xp[2], xp[3]}; }
                    *(LAS v4u*)(DT + lane * 144 + q * 16) = w; }
#pragma unroll
                for (int m = 0; m < 64; ++m) { const int i = m & 15; float v = 0.f;
                    if ((m >> 4) == blk) v = x[i];
                    *(LAS unsigned short*)(TS + m * 144 + lane * 2) = f2bf(v); }
            }
            f32x16 Dp[2];
#pragma unroll
            for (int p = 0; p < 2; ++p) {
                bf16x8 af = *(const LAS bf16x8*)(AB + (32 * p + l32) * 144 + (32 * p + 8 * hi) * 2); if (l32 < 16) af = (bf16x8){0, 0, 0, 0, 0, 0, 0, 0};
                const bf16x8 bfr = *(const LAS bf16x8*)(DT + (32 * p + l32) * 144 + (32 * p + 8 * hi) * 2);
                f32x16 Y = {}; Y = MFMA32(af, bfr, Y);
                v4u yw; yw.x = cvt_pk_bf16(Y[8], Y[9]); yw.y = cvt_pk_bf16(Y[10], Y[11]); yw.z = cvt_pk_bf16(Y[12], Y[13]); yw.w = cvt_pk_bf16(Y[14], Y[15]);
                const v2u d0 = *(const LAS v2u*)(TS + (32 * p + l32) * 144 + (32 * p + 16 + 4 * hi) * 2), d1 = *(const LAS v2u*)(TS + (32 * p + l32) * 144 + (32 * p + 24 + 4 * hi) * 2);
                const v4u dw = (v4u){d0.x, d0.y, d1.x, d1.y};
                f32x16 Z = {}; Z = MFMA32(__builtin_bit_cast(bf16x8, dw), __builtin_bit_cast(bf16x8, yw), Z);
#pragma unroll
                for (int rq = 0; rq < 4; ++rq) { const v2u g = *(const LAS v2u*)(DT + (32 * p + l32) * 144 + (32 * p + 8 * rq + 4 * hi) * 2);
                    Z[4 * rq + 0] = bflo(g.x) - Z[4 * rq + 0]; Z[4 * rq + 1] = bfhi(g.x) - Z[4 * rq + 1]; Z[4 * rq + 2] = bflo(g.y) - Z[4 * rq + 2]; Z[4 * rq + 3] = bfhi(g.y) - Z[4 * rq + 3]; }
                Dp[p] = Z;
#pragma unroll
                for (int r = 0; r < 16; ++r) *(LAS unsigned short*)(TS + (32 * p + crow(r, hi)) * 144 + (32 * p + l32) * 2) = f2bf(Z[r]);
            }
            {
                f32x16 Y = {};
#pragma unroll
                for (int ks = 0; ks < 2; ++ks) {
                    const v2u a0 = *(const LAS v2u*)(AB + (32 + l32) * 144 + (16 * ks + 4 * hi) * 2), a1 = *(const LAS v2u*)(AB + (32 + l32) * 144 + (16 * ks + 8 + 4 * hi) * 2);
                    const v4u aw = (v4u){a0.x, a0.y, a1.x, a1.y};
                    v4u bw; bw.x = cvt_pk_bf16(Dp[0][8 * ks + 0], Dp[0][8 * ks + 1]); bw.y = cvt_pk_bf16(Dp[0][8 * ks + 2], Dp[0][8 * ks + 3]); bw.z = cvt_pk_bf16(Dp[0][8 * ks + 4], Dp[0][8 * ks + 5]); bw.w = cvt_pk_bf16(Dp[0][8 * ks + 6], Dp[0][8 * ks + 7]);
                    Y = MFMA32(__builtin_bit_cast(bf16x8, aw), __builtin_bit_cast(bf16x8, bw), Y);
                }
                f32x16 L = {};
#pragma unroll
                for (int ks = 0; ks < 2; ++ks) {
                    const v2u a0 = *(const LAS v2u*)(TS + (32 + l32) * 144 + (32 + 16 * ks + 4 * hi) * 2), a1 = *(const LAS v2u*)(TS + (32 + l32) * 144 + (32 + 16 * ks + 8 + 4 * hi) * 2);
                    const v4u aw = (v4u){a0.x, a0.y, a1.x, a1.y};
                    v4u bw; bw.x = cvt_pk_bf16(Y[8 * ks + 0], Y[8 * ks + 1]); bw.y = cvt_pk_bf16(Y[8 * ks + 2], Y[8 * ks + 3]); bw.z = cvt_pk_bf16(Y[8 * ks + 4], Y[8 * ks + 5]); bw.w = cvt_pk_bf16(Y[8 * ks + 6], Y[8 * ks + 7]);
                    L = MFMA32(__builtin_bit_cast(bf16x8, aw), __builtin_bit_cast(bf16x8, bw), L);
                }
#pragma unroll
                for (int r = 0; r < 16; ++r) *(LAS unsigned short*)(TS + (32 + crow(r, hi)) * 144 + l32 * 2) = f2bf(-L[r]);
            }
        } } else if (!(flags & 1024)) {
            const float glast = gcT[63];
            for (int f = wid - 1; f < 32; f += 7) {
                if (f < 16) { const int ib = f >> 3, ks = f & 7, i = 32 * ib + l32; const float eg = __expf(gcT[i]);
                    const v2u lo = *(const LAS v2u*)(QS + i * 272 + (16 * ks + 4 * hi) * 2), h2 = *(const LAS v2u*)(QS + i * 272 + (16 * ks + 8 + 4 * hi) * 2);
                    v4u w; w.x = cvt_pk_bf16(bflo(lo.x) * eg, bfhi(lo.x) * eg); w.y = cvt_pk_bf16(bflo(lo.y) * eg, bfhi(lo.y) * eg); w.z = cvt_pk_bf16(bflo(h2.x) * eg, bfhi(h2.x) * eg); w.w = cvt_pk_bf16(bflo(h2.y) * eg, bfhi(h2.y) * eg);
                    __builtin_nontemporal_store(w, (GAS v4u*)(rec + 16384 + ((ib * 8 + ks) * 64 + lane) * 16));
                } else { const int dkb = (f - 16) >> 2, ksj = (f - 16) & 3, dk = 32 * dkb + l32; float v[8];
#pragma unroll
                    for (int jj = 0; jj < 8; ++jj) { const int j = 16 * ksj + 4 * hi + (jj & 3) + 8 * (jj >> 2); v[jj] = bf2f(*(const LAS unsigned short*)(KS + j * 272 + dk * 2)) * egT[j]; }
                    v4u w; w.x = cvt_pk_bf16(v[0], v[1]); w.y = cvt_pk_bf16(v[2], v[3]); w.z = cvt_pk_bf16(v[4], v[5]); w.w = cvt_pk_bf16(v[6], v[7]);
                    __builtin_nontemporal_store(w, (GAS v4u*)(rec + 32768 + ((dkb * 4 + ksj) * 64 + lane) * 16)); }
            }
        }
        __syncthreads();
        if (!(flags & 4)) {
            const int eb = wid & 3, ib = wid >> 2; f32x16 a = {};
            for (int ks = 0; ks < (ib ? 4 : 2); ++ks) {
                const bf16x8 tf = *(const LAS bf16x8*)(TS + (32 * ib + l32) * 144 + (16 * ks + 8 * hi) * 2);
                bf16x8 vf;
#pragma unroll
                for (int jj = 0; jj < 8; ++jj) vf[jj] = (short)*(const LAS unsigned short*)(VS + (16 * ks + 8 * hi + jj) * 272 + (32 * eb + l32) * 2);
                a = MFMA32(tf, vf, a);
#ifdef DBG_PREPCHK
                { bool b0 = false, b1 = false; for (int jj = 0; jj < 8; ++jj) { if ((((unsigned short)tf[jj]) & 0x7f80u) == 0x7f80u) b0 = true; if ((((unsigned short)vf[jj]) & 0x7f80u) == 0x7f80u) b1 = true; }
                  if (b0 || b1) atomicAnd(DBGW, ~1u); }
#endif
            }
#ifdef DBG_PREPCHK
            { bool b2 = false; for (int r = 0; r < 16; ++r) if (!(a[r] - a[r] == 0.f)) b2 = true; if (b2) atomicAnd(DBGW, ~4u); }
#endif
            v4u w0, w1; w0.x = cvt_pk_bf16(a[0], a[1]); w0.y = cvt_pk_bf16(a[2], a[3]); w0.z = cvt_pk_bf16(a[4], a[5]); w0.w = cvt_pk_bf16(a[6], a[7]);
            w1.x = cvt_pk_bf16(a[8], a[9]); w1.y = cvt_pk_bf16(a[10], a[11]); w1.z = cvt_pk_bf16(a[12], a[13]); w1.w = cvt_pk_bf16(a[14], a[15]);
            GAS v4u* up = (GAS v4u*)(rec + 57344 + ((eb * 2 + ib) * 64 + lane) * 32); __builtin_nontemporal_store(w0, up); __builtin_nontemporal_store(w1, up + 1);
#ifdef DBG_PREPCHK
            { bool bb = false; const unsigned ww[8] = {w0.x, w0.y, w0.z, w0.w, w1.x, w1.y, w1.z, w1.w}; for (int k = 0; k < 8; ++k) if ((ww[k] & 0x7f80u) == 0x7f80u || (ww[k] & 0x7f800000u) == 0x7f800000u) bb = true;
              if (bb) atomicAnd(DBGW, ~2u); if (u == 5 && tid == 0) atomicAnd(DBGW, ~8u); }
#endif
        }
        if (!(flags & 4)) {
            const int dkb = wid & 3, ib = wid >> 2; f32x16 a = {};
            for (int ks = 0; ks < (ib ? 4 : 2); ++ks) {
                bf16x8 kf;
#pragma unroll
                for (int jj = 0; jj < 8; ++jj) kf[jj] = (short)*(const LAS unsigned short*)(KB + (16 * ks + 8 * hi + jj) * 272 + (32 * dkb + l32) * 2);
                const bf16x8 tf = *(const LAS bf16x8*)(TS + (32 * ib + l32) * 144 + (16 * ks + 8 * hi) * 2);
                a = MFMA32(kf, tf, a);
#ifdef DBG_PREPCHK
                { bool b3 = false; for (int jj = 0; jj < 8; ++jj) if ((((unsigned short)kf[jj]) & 0x7f80u) == 0x7f80u) b3 = true; if (b3) atomicAnd(DBGW, ~1u); }
#endif
            }
#ifdef DBG_PREPCHK
            { bool b4 = false; for (int r = 0; r < 16; ++r) if (!(a[r] - a[r] == 0.f)) b4 = true; if (b4) atomicAnd(DBGW, ~16u); }
#endif
#pragma unroll
            for (int ks2 = 0; ks2 < 2; ++ks2) { v4u w; w.x = cvt_pk_bf16(a[8 * ks2], a[8 * ks2 + 1]); w.y = cvt_pk_bf16(a[8 * ks2 + 2], a[8 * ks2 + 3]); w.z = cvt_pk_bf16(a[8 * ks2 + 4], a[8 * ks2 + 5]); w.w = cvt_pk_bf16(a[8 * ks2 + 6], a[8 * ks2 + 7]);
                __builtin_nontemporal_store(w, (GAS v4u*)(rec + ((ib * 8 + 2 * dkb + ks2) * 64 + lane) * 16)); }
        }
    }
}

__device__ __forceinline__ void scan_chain(LAS unsigned char* lds, const unsigned char* DNP, const float* DLB, bf16* ON, const float* dn_gain, int bh) {
    int tid_ = threadIdx.x; asm volatile("" : "+v"(tid_));
    const int tid = tid_, lane = tid & 63, wid = __builtin_amdgcn_readfirstlane(tid >> 6), l32 = lane & 31, hi = lane >> 5;
    LAS unsigned char* OT = lds + 114688; LAS float* GT = (LAS float*)(lds + 132096);
    const int b = bh >> 3, h = bh & 7; const size_t u0 = (size_t)bh * 128;
    __syncthreads();
    if (tid < 128) GT[tid] = dn_gain[tid];
    const int lt = tid - 256;
#define SCAN_DMA(recp, dstoff) do { _Pragma("unroll") for (int k_ = 0; k_ < 7; ++k_) { const int p_ = wid * 7 + k_; \
        __builtin_amdgcn_global_load_lds((const unsigned*)((recp) + p_ * 1024 + lane * 16), (LAS unsigned*)(lds + (dstoff) + p_ * 1024), 16, 0, 0); } } while (0)
    SCAN_DMA(DNP + u0 * DNU, 0);
    f32x16 S[4]; S[0] = f32x16{}; S[1] = f32x16{}; S[2] = f32x16{}; S[3] = f32x16{};
    v4u un[4] = {}; float dln = 0.f;
    if (wid < 4) { const GAS v4u* up = (const GAS v4u*)(DNP + u0 * DNU + 57344 + (wid * 2 * 64 + lane) * 32);
        un[0] = up[0]; un[1] = up[1]; un[2] = up[128]; un[3] = up[129]; dln = DLB[u0]; }
    asm volatile("s_waitcnt vmcnt(0)" ::: "memory");
    __syncthreads();
#pragma unroll 1
    for (int n = 0; n < 128; ++n) {
        const LAS unsigned char* Pb = lds + (n & 1) * 57344;
        f32x16 O0 = {}, O1 = {};
        if (n + 1 < 128) SCAN_DMA(DNP + (u0 + n + 1) * DNU, ((n + 1) & 1) * 57344);
        if (wid < 4) {
            const v4u uc[4] = {un[0], un[1], un[2], un[3]}; const float dl = dln;
            if (n + 1 < 128) { const GAS v4u* up = (const GAS v4u*)(DNP + (u0 + n + 1) * DNU + 57344 + (wid * 2 * 64 + lane) * 32);
              un[0] = up[0]; un[1] = up[1]; un[2] = up[128]; un[3] = up[129]; dln = DLB[u0 + n + 1]; }
            bf16x8 vb[4];
#define SC_W(ib, ks) (*(const LAS bf16x8*)(Pb + (((ib) * 8 + (ks)) * 64 + lane) * 16))
#define SC_Q(ib, ks) (*(const LAS bf16x8*)(Pb + 16384 + (((ib) * 8 + (ks)) * 64 + lane) * 16))
#define SC_K(dkb, ksj) (*(const LAS bf16x8*)(Pb + 32768 + (((dkb) * 4 + (ksj)) * 64 + lane) * 16))
#define SC_A(ib, ksj) (*(const LAS bf16x8*)(Pb + 49152 + (((ib) * 4 + (ksj)) * 64 + lane) * 16))
            {
                f32x16 W0 = {}, W1 = {};
                bf16x8 fw0 = SC_W(0, 0), fw1 = SC_W(1, 0), fq0 = SC_Q(0, 0), fq1 = SC_Q(1, 0);
#pragma unroll
                for (int ks = 0; ks < 8; ++ks) {
                    const bf16x8 cw0 = fw0, cw1 = fw1, cq0 = fq0, cq1 = fq1;
                    if (ks < 7) { fw0 = SC_W(0, ks + 1); fw1 = SC_W(1, ks + 1); fq0 = SC_Q(0, ks + 1); fq1 = SC_Q(1, ks + 1); }
                    const int dkb = ks >> 1, o8 = 8 * (ks & 1);
                    v4u sw; sw.x = cvt_pk_bf16(S[dkb][o8 + 0], S[dkb][o8 + 1]); sw.y = cvt_pk_bf16(S[dkb][o8 + 2], S[dkb][o8 + 3]); sw.z = cvt_pk_bf16(S[dkb][o8 + 4], S[dkb][o8 + 5]); sw.w = cvt_pk_bf16(S[dkb][o8 + 6], S[dkb][o8 + 7]);
                    const bf16x8 sb = __builtin_bit_cast(bf16x8, sw);
                    W0 = MFMA32(cw0, sb, W0); W1 = MFMA32(cw1, sb, W1); O0 = MFMA32(cq0, sb, O0); O1 = MFMA32(cq1, sb, O1);
                    __builtin_amdgcn_sched_barrier(0);
                }
                float v[16];
#pragma unroll
                for (int q = 0; q < 2; ++q) { const v4u w = uc[q];
                    v[8 * q + 0] = bflo(w.x); v[8 * q + 1] = bfhi(w.x); v[8 * q + 2] = bflo(w.y); v[8 * q + 3] = bfhi(w.y); v[8 * q + 4] = bflo(w.z); v[8 * q + 5] = bfhi(w.z); v[8 * q + 6] = bflo(w.w); v[8 * q + 7] = bfhi(w.w); }
#pragma unroll
                for (int r = 0; r < 16; ++r) v[r] -= W0[r];
#pragma unroll
                for (int ks2 = 0; ks2 < 2; ++ks2) { v4u w; w.x = cvt_pk_bf16(v[8 * ks2], v[8 * ks2 + 1]); w.y = cvt_pk_bf16(v[8 * ks2 + 2], v[8 * ks2 + 3]); w.z = cvt_pk_bf16(v[8 * ks2 + 4], v[8 * ks2 + 5]); w.w = cvt_pk_bf16(v[8 * ks2 + 6], v[8 * ks2 + 7]); vb[ks2] = __builtin_bit_cast(bf16x8, w); }
#pragma unroll
                for (int q = 0; q < 2; ++q) { const v4u w = uc[2 + q];
                    v[8 * q + 0] = bflo(w.x); v[8 * q + 1] = bfhi(w.x); v[8 * q + 2] = bflo(w.y); v[8 * q + 3] = bfhi(w.y); v[8 * q + 4] = bflo(w.z); v[8 * q + 5] = bfhi(w.z); v[8 * q + 6] = bflo(w.w); v[8 * q + 7] = bfhi(w.w); }
#pragma unroll
                for (int r = 0; r < 16; ++r) v[r] -= W1[r];
#pragma unroll
                for (int ks2 = 0; ks2 < 2; ++ks2) { v4u w; w.x = cvt_pk_bf16(v[8 * ks2], v[8 * ks2 + 1]); w.y = cvt_pk_bf16(v[8 * ks2 + 2], v[8 * ks2 + 3]); w.z = cvt_pk_bf16(v[8 * ks2 + 4], v[8 * ks2 + 5]); w.w = cvt_pk_bf16(v[8 * ks2 + 6], v[8 * ks2 + 7]); vb[2 + ks2] = __builtin_bit_cast(bf16x8, w); }
            }
            __builtin_amdgcn_sched_barrier(0);
#pragma unroll
            for (int dkb = 0; dkb < 4; ++dkb)
#pragma unroll
                for (int r = 0; r < 16; ++r) S[dkb][r] *= dl;
            {
                bf16x8 k0 = SC_K(0, 0), k1 = SC_K(1, 0), k2 = SC_K(2, 0), k3 = SC_K(3, 0), a0 = SC_A(0, 0), a1 = SC_A(1, 0);
#pragma unroll
                for (int ksj = 0; ksj < 4; ++ksj) {
                    const bf16x8 c0 = k0, c1 = k1, c2 = k2, c3 = k3, ca0 = a0, ca1 = a1;
                    if (ksj < 3) { k0 = SC_K(0, ksj + 1); k1 = SC_K(1, ksj + 1); k2 = SC_K(2, ksj + 1); k3 = SC_K(3, ksj + 1); a1 = SC_A(1, ksj + 1); if (ksj < 1) a0 = SC_A(0, ksj + 1); }
                    S[0] = MFMA32(c0, vb[ksj], S[0]); S[1] = MFMA32(c1, vb[ksj], S[1]); S[2] = MFMA32(c2, vb[ksj], S[2]); S[3] = MFMA32(c3, vb[ksj], S[3]);
                    O1 = MFMA32(ca1, vb[ksj], O1); if (ksj < 2) O0 = MFMA32(ca0, vb[ksj], O0);
                    __builtin_amdgcn_sched_barrier(0);
                }
            }
#undef SC_W
#undef SC_Q
#undef SC_K
#undef SC_A
        } else {
            if (n > 0) {
                const int i = lt >> 2, qd = lt & 3; f32x4 v[8]; float ss = 0.f;
#pragma unroll
                for (int k = 0; k < 4; ++k) { const v4u w = *(const LAS v4u*)(OT + i * 272 + k * 64 + qd * 16); unpack8(w, v[2 * k], v[2 * k + 1]); }
#pragma unroll
                for (int k = 0; k < 8; ++k) ss += (v[k][0] * v[k][0] + v[k][1] * v[k][1]) + (v[k][2] * v[k][2] + v[k][3] * v[k][3]);
                ss += dpp_mov<0xB1>(ss); ss += dpp_mov<0x4E>(ss);
                const float rs = rsqrtf(ss * (1.0f / 128.0f) + 1e-6f);
                bf16* dst = ON + ((size_t)b * SEQ + 64 * (n - 1) + i) * 1024 + h * 128 + qd * 8;
#pragma unroll
                for (int k = 0; k < 4; ++k) { const f32x4 g0 = *(const LAS f32x4*)(GT + 32 * k + 8 * qd), g1 = *(const LAS f32x4*)(GT + 32 * k + 8 * qd + 4); *(GAS v4u*)(dst + 32 * k) = pack8(v[2 * k] * rs * g0, v[2 * k + 1] * rs * g1); }
            }
        }
        asm volatile("s_waitcnt vmcnt(0)" ::: "memory");
        __syncthreads();
        if (wid < 4) {
#pragma unroll
            for (int r = 0; r < 16; ++r) { const unsigned w_ = cvt_pk_bf16(O0[r], O1[r]); LAS unsigned char* p_ = OT + (crow(r, 0)) * 272 + hi * (4 * 272) + (32 * wid + l32) * 2;
                *(LAS unsigned short*)p_ = (unsigned short)w_; *(LAS unsigned short*)(p_ + 32 * 272) = (unsigned short)(w_ >> 16); }
        }
        __syncthreads();
    }
    if (wid >= 4) {
        const int i = lt >> 2, qd = lt & 3; f32x4 v[8]; float ss = 0.f;
#pragma unroll
        for (int k = 0; k < 4; ++k) { const v4u w = *(const LAS v4u*)(OT + i * 272 + k * 64 + qd * 16); unpack8(w, v[2 * k], v[2 * k + 1]); }
#pragma unroll
        for (int k = 0; k < 8; ++k) ss += (v[k][0] * v[k][0] + v[k][1] * v[k][1]) + (v[k][2] * v[k][2] + v[k][3] * v[k][3]);
        ss += dpp_mov<0xB1>(ss); ss += dpp_mov<0x4E>(ss);
        const float rs = rsqrtf(ss * (1.0f / 128.0f) + 1e-6f);
        bf16* dst = ON + ((size_t)b * SEQ + 64 * 127 + i) * 1024 + h * 128 + qd * 8;
#pragma unroll
        for (int k = 0; k < 4; ++k) { const f32x4 g0 = *(const LAS f32x4*)(GT + 32 * k + 8 * qd), g1 = *(const LAS f32x4*)(GT + 32 * k + 8 * qd + 4); *(GAS v4u*)(dst + 32 * k) = pack8(v[2 * k] * rs * g0, v[2 * k + 1] * rs * g1); }
    }
}
__device__ __forceinline__ void combine_rows(const Ptrs& P, int first, int stride, int lane) {
    const bf16* OG = (const bf16*)((const unsigned char*)P.out + DO_OG); const float* LSE = (const float*)((const unsigned char*)P.out + DO_LSE);
    bf16* OA = (bf16*)(P.ws + WS_OA); bf16* HR = (bf16*)(P.ws + WS_HR);
    for (int m0 = first; m0 < T; m0 += 4 * stride) {
        const int hd = lane >> 3; float l0[4], l1[4], l2[4]; v4u g0[4], g1[4], g2[4];
#pragma unroll
        for (int k = 0; k < 4; ++k) { const int m = m0 + k * stride; if (m < T) { l0[k] = LSE[(size_t)m * 24 + hd]; l1[k] = LSE[(size_t)m * 24 + 8 + hd]; l2[k] = LSE[(size_t)m * 24 + 16 + hd];
            const bf16* og = OG + (size_t)m * 1536 + lane * 8; g0[k] = *(const GAS v4u*)og; g1[k] = *(const GAS v4u*)(og + 512); g2[k] = *(const GAS v4u*)(og + 1024); } }
#pragma unroll
        for (int k = 0; k < 4; ++k) { const int m = m0 + k * stride; if (m < T) {
            const float mx = fmaxf(l0[k], fmaxf(l1[k], l2[k])); float w0 = __builtin_amdgcn_exp2f(l0[k] - mx), w1 = __builtin_amdgcn_exp2f(l1[k] - mx), w2 = __builtin_amdgcn_exp2f(l2[k] - mx);
            const float inv = 1.0f / (w0 + w1 + w2); w0 *= inv; w1 *= inv; w2 *= inv;
            f32x4 a0, b0, a1, b1, a2, b2; unpack8(g0[k], a0, b0); unpack8(g1[k], a1, b1); unpack8(g2[k], a2, b2);
            *(GAS v4u*)(OA + (size_t)m * 512 + lane * 8) = pack8(a0 * w0 + a1 * w1 + a2 * w2, b0 * w0 + b1 * w1 + b2 * w2); } }
    }
#ifdef MORE_FP8
    rms_rows_to_both(P.in[0], P.in[2], HR, (unsigned char*)(P.ws + WS_HR8), first, stride, lane, 4.0f);
#else
    rms_rows_to_bf16(P.in[0], P.in[2], HR, first, stride, lane);
#endif
}

__device__ __forceinline__ void router_phase(const Ptrs& P, LAS unsigned char* lds, int G, int c, int wave, int lane_in) {
    (void)lane_in; const int lane = (int)__builtin_amdgcn_mbcnt_hi(~0u, __builtin_amdgcn_mbcnt_lo(~0u, 0u));
    LAS float* WrT = (LAS float*)lds; LAS unsigned* bcnt = (LAS unsigned*)(lds + 81920);
#ifdef D10_BF16
    const float* x1 = P.in[0]; const bf16* D10 = (const bf16*)(P.ws + WS_D10);
#else
    const float* x1 = P.out;
#endif
    bf16* H2 = (bf16*)(P.ws + WS_H2); int4* TOK = (int4*)(P.ws + WS_TOK); unsigned* cnt = (unsigned*)(P.ws + WS_CTL) + CW_CNT;
    __syncthreads();
    const int tid_r = wave * 64 + lane;
    for (int i = tid_r; i < 1024 * 4; i += 512) { const int k = i >> 2, cc = i & 3; WrT[cc * 1024 + k] = P.in[14][i]; }
    for (int i = tid_r; i < 1024 * 16; i += 512) { const int k = i >> 4, cc = i & 15; WrT[(4 + cc) * 1024 + k] = P.in[16][i]; }
    if (tid_r < 16) bcnt[tid_r] = 0u;
    __syncthreads();
    const GAS f32x4* gr = (const GAS f32x4*)P.in[13] + lane; f32x4 gn[4];
#pragma unroll
    for (int j = 0; j < 4; ++j) gn[j] = gr[64 * j];
    float bias[20];
#pragma unroll
    for (int q = 0; q < 4; ++q) bias[q] = P.in[15][q];
#pragma unroll
    for (int q = 0; q < 16; ++q) bias[4 + q] = P.in[17][q];
    unsigned mycnt = 0;
    const int gw = c * NWAVES + wave, NGW = G * NWAVES;
    f32x4 nxa[4], nxb[4]; v2u nda[4], ndb[4];
#define RT_LOAD2(mm) do { const GAS f32x4* xa_ = (const GAS f32x4*)(x1 + (size_t)(mm) * D) + lane; const GAS v2u* da_ = (const GAS v2u*)(D10 + (size_t)(mm) * D) + lane; \
        const GAS f32x4* xb_ = (const GAS f32x4*)(x1 + (size_t)((mm) + NGW) * D) + lane; const GAS v2u* db_ = (const GAS v2u*)(D10 + (size_t)((mm) + NGW) * D) + lane; \
        _Pragma("unroll") for (int j = 0; j < 4; ++j) { nxa[j] = xa_[64 * j]; nda[j] = da_[64 * j]; nxb[j] = xb_[64 * j]; ndb[j] = db_[64 * j]; } } while (0)
    auto route_row = [&](const float (&lg)[20], const int m) {
        int gi = 0; float gm = lg[0];
#pragma unroll
        for (int q = 1; q < 4; ++q) if (lg[q] > gm) { gm = lg[q]; gi = q; }
        float gs = 0.f;
#pragma unroll
        for (int q = 0; q < 4; ++q) gs += __expf(lg[q] - gm);
        const float pg = 1.0f / gs;
        float sl[4];
#pragma unroll
        for (int q = 0; q < 4; ++q) sl[q] = gi == 0 ? lg[4 + q] : (gi == 1 ? lg[8 + q] : (gi == 2 ? lg[12 + q] : lg[16 + q]));
        int i0 = 0; float m0 = sl[0];
#pragma unroll
        for (int q = 1; q < 4; ++q) if (sl[q] > m0) { m0 = sl[q]; i0 = q; }
        int i1 = -1; float m1 = -3.0e38f;
#pragma unroll
        for (int q = 0; q < 4; ++q) if (q != i0 && sl[q] > m1) { m1 = sl[q]; i1 = q; }
        const float e1 = __expf(m1 - m0); const float w0 = 1.0f / (1.0f + e1), w1 = e1 * w0;
        const int ex0 = 4 * gi + i0, ex1 = 4 * gi + i1;
        if (lane == 0) TOK[m] = make_int4(ex0, ex1, __float_as_int(pg * w0), __float_as_int(pg * w1));
        mycnt += (lane == ex0 ? 1u : 0u) + (lane == ex1 ? 1u : 0u);
    };
    if (gw < T) RT_LOAD2(gw);
    for (int m = gw; m < T; m += 2 * NGW) {
        asm volatile("" ::: "memory");
        f32x4 va[4], vb[4]; float sa = 0.f, sb = 0.f;
#pragma unroll
        for (int j = 0; j < 4; ++j) { va[j] = nxa[j] + (f32x4){bflo(nda[j].x), bfhi(nda[j].x), bflo(nda[j].y), bfhi(nda[j].y)}; vb[j] = nxb[j] + (f32x4){bflo(ndb[j].x), bfhi(ndb[j].x), bflo(ndb[j].y), bfhi(ndb[j].y)}; }
        if (m + 2 * NGW < T) RT_LOAD2(m + 2 * NGW);
        { GAS v2u* xa_ = (GAS v2u*)((bf16*)(P.ws + WS_X1) + (size_t)m * D) + lane; GAS v2u* xb_ = (GAS v2u*)((bf16*)(P.ws + WS_X1) + (size_t)(m + NGW) * D) + lane;
#pragma unroll
          for (int j = 0; j < 4; ++j) { v2u w; w.x = cvt_pk_bf16(va[j].x, va[j].y); w.y = cvt_pk_bf16(va[j].z, va[j].w); xa_[64 * j] = w; w.x = cvt_pk_bf16(vb[j].x, vb[j].y); w.y = cvt_pk_bf16(vb[j].z, vb[j].w); xb_[64 * j] = w; } }
#pragma unroll
        for (int j = 0; j < 4; ++j) { sa += (va[j].x * va[j].x + va[j].y * va[j].y) + (va[j].z * va[j].z + va[j].w * va[j].w); sb += (vb[j].x * vb[j].x + vb[j].y * vb[j].y) + (vb[j].z * vb[j].z + vb[j].w * vb[j].w); }
        const float rsa = rsqrtf(wave_sum(sa) * (1.f / D) + 1e-6f), rsb = rsqrtf(wave_sum(sb) * (1.f / D) + 1e-6f);
        { GAS unsigned* oa_ = (GAS unsigned*)((unsigned char*)H2 + (size_t)m * D) + lane; GAS unsigned* ob_ = (GAS unsigned*)((unsigned char*)H2 + (size_t)(m + NGW) * D) + lane;
#pragma unroll
          for (int j = 0; j < 4; ++j) { va[j] = va[j] * rsa * gn[j]; int w_ = __builtin_amdgcn_cvt_pk_fp8_f32(va[j].x * 4.f, va[j].y * 4.f, 0, false); w_ = __builtin_amdgcn_cvt_pk_fp8_f32(va[j].z * 4.f, va[j].w * 4.f, w_, true); oa_[64 * j] = (unsigned)w_;
              vb[j] = vb[j] * rsb * gn[j]; w_ = __builtin_amdgcn_cvt_pk_fp8_f32(vb[j].x * 4.f, vb[j].y * 4.f, 0, false); w_ = __builtin_amdgcn_cvt_pk_fp8_f32(vb[j].z * 4.f, vb[j].w * 4.f, w_, true); ob_[64 * j] = (unsigned)w_; } }
        float lga[20], lgb[20];
#pragma unroll
        for (int q = 0; q < 20; ++q) { float a = 0.f, b = 0.f;
#pragma unroll
            for (int j = 0; j < 4; ++j) { const f32x4 w = *(const LAS f32x4*)(WrT + q * 1024 + 4 * lane + 256 * j); a += (va[j].x * w.x + va[j].y * w.y) + (va[j].z * w.z + va[j].w * w.w); b += (vb[j].x * w.x + vb[j].y * w.y) + (vb[j].z * w.z + vb[j].w * w.w); }
            lga[q] = wave_sum(a) + bias[q]; lgb[q] = wave_sum(b) + bias[q]; }
        route_row(lga, m); route_row(lgb, m + NGW);
    }
#undef RT_LOAD2
    if (lane < 16 && mycnt) atomicAdd((unsigned*)&bcnt[lane], mycnt);
    __syncthreads();
    if (tid_r < 16 && bcnt[tid_r]) atomicAdd(&cnt[tid_r], bcnt[tid_r]);
}

__device__ __forceinline__ void place_phase(const Ptrs& P, LAS unsigned char* lds, int G, int c, int wave, int lane) {
    int* ROWS = (int*)(P.ws + WS_ROWS); const int4* TOK = (const int4*)(P.ws + WS_TOK); int2* SLOT = (int2*)(P.ws + WS_SLOT); float* CWv = (float*)(P.ws + WS_CW);
    const unsigned* cnt = (const unsigned*)(P.ws + WS_CTL) + CW_CNT; unsigned* cur = (unsigned*)(P.ws + WS_CTL) + CW_CUR;
    LAS unsigned* wc = (LAS unsigned*)lds;
    LAS unsigned* bb = (LAS unsigned*)(lds + 1024);
    for (int g = c; g < T / 512; g += G) {
        const int m = g * 512 + wave * 64 + lane; const int4 tk = TOK[m];
        __syncthreads();
        unsigned long long k0s = 0, k1s = 0;
#pragma unroll 1
        for (int e = 0; e < 16; ++e) { const unsigned long long k0 = __ballot(tk.x == e), k1 = __ballot(tk.y == e);
            if (tk.x == e) k0s = k0; if (tk.y == e) k1s = k1;
            if (lane == 0) { wc[(wave * 16 + e) * 2] = (unsigned)__popcll(k0); wc[(wave * 16 + e) * 2 + 1] = (unsigned)__popcll(k1); } }
        __syncthreads();
        if (threadIdx.x < 16) { const int e = threadIdx.x; unsigned tot = 0; for (int w = 0; w < 8; ++w) tot += wc[(w * 16 + e) * 2] + wc[(w * 16 + e) * 2 + 1];
            unsigned sb = 0; for (int q = 0; q < e; ++q) sb += ((cnt[q] + 255u) >> 8) * 256u;
            bb[e] = sb + (tot ? atomicAdd(&cur[e], tot) : 0u); }
        __syncthreads();
        unsigned o0 = bb[tk.x], o1 = bb[tk.y];
        for (int w = 0; w < wave; ++w) { o0 += wc[(w * 16 + tk.x) * 2] + wc[(w * 16 + tk.x) * 2 + 1]; o1 += wc[(w * 16 + tk.y) * 2] + wc[(w * 16 + tk.y) * 2 + 1]; }
        const unsigned long long lt = (1ull << lane) - 1ull;
        const int p0 = (int)(o0 + (unsigned)__popcll(k0s & lt));
        const int p1 = (int)(o1 + wc[(wave * 16 + tk.y) * 2] + (unsigned)__popcll(k1s & lt));
        SLOT[m] = make_int2(p0, p1); CWv[p0] = __int_as_float(tk.z); CWv[p1] = __int_as_float(tk.w); ROWS[p0] = m; ROWS[p1] = m;
    }
}

__device__ __forceinline__ void ple_norm_phase(const Ptrs& P, int G, int c, int wave, int lane) {
    float* xo = P.out; const bf16* Y = (const bf16*)(P.ws + WS_Y); const int2* SLOT = (const int2*)(P.ws + WS_SLOT); bf16* H3 = (bf16*)(P.ws + WS_H3); bf16* PB = (bf16*)(P.ws + WS_PB);
    const GAS f32x4* gr = (const GAS f32x4*)P.in[21] + lane; f32x4 gn[4];
#pragma unroll
    for (int j = 0; j < 4; ++j) gn[j] = gr[64 * j];
    const int gw = c * NWAVES + wave, NGW = G * NWAVES;
    f32x4 nx[4], npv; v2u ny0[4], ny1[4]; int2 sl2 = make_int2(0, 0);
    if (gw < T) { const int2 sl = SLOT[gw];
        const GAS f32x4* xr = (const GAS f32x4*)(xo + (size_t)gw * D) + lane; const GAS v2u* y0 = (const GAS v2u*)(Y + (size_t)sl.x * D) + lane; const GAS v2u* y1 = (const GAS v2u*)(Y + (size_t)sl.y * D) + lane;
#pragma unroll
        for (int j = 0; j < 4; ++j) { nx[j] = xr[64 * j]; ny0[j] = y0[64 * j]; ny1[j] = y1[64 * j]; }
        npv = *((const GAS f32x4*)(P.in[1] + (size_t)gw * 256) + lane);
        if (gw + NGW < T) sl2 = SLOT[gw + NGW]; }
    for (int m = gw; m < T; m += NGW) {
        f32x4 v[4]; v2u a[4], bq[4]; const f32x4 pv = npv; float s = 0.f;
#pragma unroll
        for (int j = 0; j < 4; ++j) { v[j] = nx[j]; a[j] = ny0[j]; bq[j] = ny1[j]; }
        if (m + NGW < T) { const int mn = m + NGW; const int2 sl = sl2;
            const GAS f32x4* xr = (const GAS f32x4*)(xo + (size_t)mn * D) + lane; const GAS v2u* y0 = (const GAS v2u*)(Y + (size_t)sl.x * D) + lane; const GAS v2u* y1 = (const GAS v2u*)(Y + (size_t)sl.y * D) + lane;
#pragma unroll
            for (int j = 0; j < 4; ++j) { nx[j] = xr[64 * j]; ny0[j] = y0[64 * j]; ny1[j] = y1[64 * j]; }
            npv = *((const GAS f32x4*)(P.in[1] + (size_t)mn * 256) + lane);
            if (mn + NGW < T) sl2 = SLOT[mn + NGW]; }
        GAS f32x4* xw = (GAS f32x4*)(xo + (size_t)m * D) + lane;
#pragma unroll
        for (int j = 0; j < 4; ++j) {
            v[j].x += bflo(a[j].x) + bflo(bq[j].x); v[j].y += bfhi(a[j].x) + bfhi(bq[j].x); v[j].z += bflo(a[j].y) + bflo(bq[j].y); v[j].w += bfhi(a[j].y) + bfhi(bq[j].y);
            xw[64 * j] = v[j]; s += (v[j].x * v[j].x + v[j].y * v[j].y) + (v[j].z * v[j].z + v[j].w * v[j].w); }
        const float rs = rsqrtf(wave_sum(s) * (1.f / D) + 1e-6f);
#ifdef MORE_FP8
        GAS unsigned* o4 = (GAS unsigned*)((unsigned char*)H3 + (size_t)m * D) + lane;
#pragma unroll
        for (int j = 0; j < 4; ++j) { const f32x4 q_ = v[j] * rs * gn[j] * 4.f; int w_ = __builtin_amdgcn_cvt_pk_fp8_f32(q_.x, q_.y, 0, false); w_ = __builtin_amdgcn_cvt_pk_fp8_f32(q_.z, q_.w, w_, true); o4[64 * j] = (unsigned)w_; }
#else
        GAS v2u* o8 = (GAS v2u*)(H3 + (size_t)m * D) + lane;
#pragma unroll
        for (int j = 0; j < 4; ++j) { f32x4 q_ = v[j] * rs * gn[j]; if (EMU2(4.f) != 0.f) { q_.x = fp8_rt(q_.x, 4.f); q_.y = fp8_rt(q_.y, 4.f); q_.z = fp8_rt(q_.z, 4.f); q_.w = fp8_rt(q_.w, 4.f); } v2u w; w.x = cvt_pk_bf16(q_.x, q_.y); w.y = cvt_pk_bf16(q_.z, q_.w); o8[64 * j] = w; }
#endif
        v2u pw; pw.x = cvt_pk_bf16(pv.x, pv.y); pw.y = cvt_pk_bf16(pv.z, pv.w);
        *((GAS v2u*)(PB + (size_t)m * 256) + lane) = pw;
    }
}

#ifdef MORE_FP8
struct PleRow { v2u nd[4]; unsigned y0[4], y1[4]; f32x4 pv; };
__device__ __forceinline__ void ple_norm_phase_f8(const Ptrs& P, int G, int c, int wave, int lane) {
    bf16* X12 = (bf16*)(P.ws + WS_X1); const unsigned char* Y = (const unsigned char*)(P.ws + WS_Y);
    const int2* SLOT = (const int2*)(P.ws + WS_SLOT); bf16* H3 = (bf16*)(P.ws + WS_H3); bf16* PB = (bf16*)(P.ws + WS_PB);
    const GAS f32x4* gr = (const GAS f32x4*)P.in[21] + lane; f32x4 gn[4];
#pragma unroll
    for (int j = 0; j < 4; ++j) gn[j] = gr[64 * j];
    const int gw = c * NWAVES + wave, NGW = G * NWAVES;
    auto load_row = [&](PleRow& r, const int m, const int2 sl) {
        const GAS v2u* xr = (const GAS v2u*)(X12 + (size_t)m * D) + lane; const GAS unsigned* y0 = (const GAS unsigned*)(Y + (size_t)sl.x * D) + lane; const GAS unsigned* y1 = (const GAS unsigned*)(Y + (size_t)sl.y * D) + lane;
#pragma unroll
        for (int j = 0; j < 4; ++j) { r.nd[j] = xr[64 * j]; r.y0[j] = y0[64 * j]; r.y1[j] = y1[64 * j]; }
        r.pv = *((const GAS f32x4*)(P.in[1] + (size_t)m * 256) + lane);
    };
    auto proc_row = [&](const PleRow& r, const int m) {
        f32x4 v[4]; float s = 0.f;
        GAS v2u* xw = (GAS v2u*)(X12 + (size_t)m * D) + lane;
#pragma unroll
        for (int j = 0; j < 4; ++j) { v[j] = (f32x4){bflo(r.nd[j].x), bfhi(r.nd[j].x), bflo(r.nd[j].y), bfhi(r.nd[j].y)}; const unsigned a = r.y0[j], bq = r.y1[j];
            v[j].x += (__builtin_amdgcn_cvt_f32_fp8((int)a, 0) + __builtin_amdgcn_cvt_f32_fp8((int)bq, 0)) * 0.0625f; v[j].y += (__builtin_amdgcn_cvt_f32_fp8((int)a, 1) + __builtin_amdgcn_cvt_f32_fp8((int)bq, 1)) * 0.0625f;
            v[j].z += (__builtin_amdgcn_cvt_f32_fp8((int)a, 2) + __builtin_amdgcn_cvt_f32_fp8((int)bq, 2)) * 0.0625f; v[j].w += (__builtin_amdgcn_cvt_f32_fp8((int)a, 3) + __builtin_amdgcn_cvt_f32_fp8((int)bq, 3)) * 0.0625f;
            { v2u w; w.x = cvt_pk_bf16(v[j].x, v[j].y); w.y = cvt_pk_bf16(v[j].z, v[j].w); xw[64 * j] = w; }
            s += (v[j].x * v[j].x + v[j].y * v[j].y) + (v[j].z * v[j].z + v[j].w * v[j].w); }
        const float rs = rsqrtf(wave_sum(s) * (1.f / D) + 1e-6f);
        GAS unsigned* o4 = (GAS unsigned*)((unsigned char*)H3 + (size_t)m * D) + lane;
#pragma unroll
        for (int j = 0; j < 4; ++j) { const f32x4 q_ = v[j] * rs * gn[j] * 4.f; int w_ = __builtin_amdgcn_cvt_pk_fp8_f32(q_.x, q_.y, 0, false); w_ = __builtin_amdgcn_cvt_pk_fp8_f32(q_.z, q_.w, w_, true); o4[64 * j] = (unsigned)w_; }
        v2u pw; pw.x = cvt_pk_bf16(r.pv.x, r.pv.y); pw.y = cvt_pk_bf16(r.pv.z, r.pv.w);
        *((GAS v2u*)(PB + (size_t)m * 256) + lane) = pw;
    };
    PleRow A, B; int2 slA = make_int2(0, 0), slB = make_int2(0, 0);
    { load_row(A, gw, SLOT[gw]); load_row(B, gw + NGW, SLOT[gw + NGW]); if (gw + 2 * NGW < T) { slA = SLOT[gw + 2 * NGW]; slB = SLOT[gw + 3 * NGW]; } }
    for (int m = gw; m < T; m += 2 * NGW) {
        const bool more = m + 2 * NGW < T; const bool more2 = m + 4 * NGW < T;
        { const PleRow cur = A; if (more) { load_row(A, m + 2 * NGW, slA); if (more2) slA = SLOT[m + 4 * NGW]; } proc_row(cur, m); }
        { const PleRow cur = B; if (more) { load_row(B, m + 3 * NGW, slB); if (more2) slB = SLOT[m + 5 * NGW]; } proc_row(cur, m + NGW); }
    }
}
#endif

struct Args { Ptrs p; int ph_lo, ph_hi, flags, pad; };
__global__ void __launch_bounds__(NWAVES * 64, 2) fwd_kernel(Args args) {
    extern __shared__ __attribute__((aligned(16))) unsigned char lds_raw[];
    LAS unsigned char* lds = (LAS unsigned char*)lds_raw;
    volatile LAS unsigned* MISC = (volatile LAS unsigned*)(lds + MISC_OFF);
    const int tid = threadIdx.x, lane = tid & 63, wave = __builtin_amdgcn_readfirstlane(tid >> 6);
    const int G = gridDim.x, c = blockIdx.x;
    const Ptrs& P = args.p;
    unsigned char* ws = P.ws;
    gu32* ctl = (gu32*)(ws + WS_CTL);
    for (int u = tid; u < 64; u += NWAVES * 64) MISC[u] = 0u;
    __syncthreads();
    XcdBarrier bar; bar.bar = (unsigned*)ctl + CW_BAR; bar.x = 0; bar.st = nullptr;
    if (N_LAUNCHES == 1) bar = xcd_barrier_post((unsigned*)ctl + CW_BAR, MISC + 8);
    const int lo = args.ph_lo, hi = args.ph_hi;
#ifdef DBG_STAMP
    unsigned long long* const stp = (unsigned long long*)(ws + 768 * 1024);
#define STAMP(i, blk) do { if (c == (blk) && tid == 0) stp[i] = __builtin_amdgcn_s_memrealtime(); } while (0)
#else
#define STAMP(i, blk) do {} while (0)
#endif
#ifndef PH_MASK
#define PH_MASK 0x3ffff
#endif
#define IN(k) (((PH_MASK >> (k)) & 1) && lo <= (k) && (k) < hi)
#define SEAM(k) do { if (IN(k) && IN((k) + 1)) xcd_barrier(bar); } while (0)

    STAMP(0, 0);
    if (IN(0)) { p0_prologue(P, lds, G, c, wave, lane); } SEAM(0);

    STAMP(1, 0);
    if (IN(1)) {
#ifdef STAGGER_P1
        for (int q = 0; q < ((c >> 3) & 3) * STAGGER_P1; ++q) __builtin_amdgcn_s_sleep(85);
#endif
#ifdef P1_FP8
        pg8::StaticOrder S; S.init((const unsigned char*)P.out + DO_H, ws + WS_BTP1, T, NP1, D / 2, G, c);
        pg8::EpiP1 E{(bf16*)(ws + WS_QA), (bf16*)(ws + WS_QB), (float*)(ws + WS_BG), P.in[4], P.in[5], P.in[7], P.in[8]};
        pg8::gemm_phase<pg8::EpiP1, pg8::StaticOrder, true, true, true>(lds + RING_OFF, D / 2, S, E);
#else
        pg8::StaticOrder S; S.init((const unsigned char*)P.out + DO_H, ws + WS_BTP1, T, NP1, D, G, c);
        pg8::EpiP1 E{(bf16*)(ws + WS_QA), (bf16*)(ws + WS_QB), (float*)(ws + WS_BG), P.in[4], P.in[5], P.in[7], P.in[8]};
        pg8::gemm_phase<pg8::EpiP1, pg8::StaticOrder, true, true>(lds + RING_OFF, D, S, E);
#endif
    } SEAM(1);

    STAMP(2, 0);
    if (IN(2)) { attn_phase(lds, (const bf16*)(ws + WS_QA), (bf16*)((unsigned char*)P.out + DO_OG), (float*)((unsigned char*)P.out + DO_LSE), G, c, args.flags); } SEAM(2);

    STAMP(3, 0);
    if (IN(3)) { prep_phase(lds, (const bf16*)(ws + WS_QB), (const float*)(ws + WS_BG), P.in[6], ws + WS_DNP, (float*)(ws + WS_DLB), G, c, args.flags); } SEAM(3);

    STAMP(4, 0);
    if (IN(4)) {
        unsigned* const sb = (unsigned*)ctl + CW_SUB;
        if ((args.flags & 16) && c >= 64) return; if ((args.flags & 32) && c < 64) return; if (args.flags & 64) { if (c < 64) scan_chain(lds, ws + WS_DNP, (const float*)(ws + WS_DLB), (bf16*)(ws + WS_ON), P.in[9], c); else combine_rows(P, (c - 64) * NWAVES + wave, (G - 64) * NWAVES, lane); return; }
        if (c < 64) { scan_chain(lds, ws + WS_DNP, (const float*)(ws + WS_DLB), (bf16*)(ws + WS_ON), P.in[9], c); STAMP(32, 0); }
        else { combine_rows(P, (c - 64) * NWAVES + wave, (G - 64) * NWAVES, lane); STAMP(33, 64); }
        asm volatile("s_waitcnt vmcnt(0)" ::: "memory"); __syncthreads();
        if (tid == 0) { if (c >= 64) { __builtin_amdgcn_fence(__ATOMIC_RELEASE, "agent"); asm volatile("s_waitcnt vmcnt(0)" ::: "memory"); __hip_atomic_fetch_add(sb, 1u, __ATOMIC_RELAXED, __HIP_MEMORY_SCOPE_AGENT); }
            unsigned sp = 0; while (__hip_atomic_load(sb, __ATOMIC_RELAXED, __HIP_MEMORY_SCOPE_AGENT) < (unsigned)(G - 64)) { __builtin_amdgcn_s_sleep(2); if (++sp > (1u << 22)) break; }
            __builtin_amdgcn_fence(__ATOMIC_ACQUIRE, "agent"); asm volatile("s_waitcnt vmcnt(0)" ::: "memory"); }
        __syncthreads();
#ifdef MORE_FP8
        { pg8::StaticOrder S; S.init(ws + WS_HR8, ws + WS_BTGA, T, 2048, D / 2, G, c);
#else
        { pg8::StaticOrder S; S.init(ws + WS_HR, ws + WS_BTGA, T, 2048, D, G, c);
#endif
          if (c >= 64) { S.G = G - 64; S.c = c - 64; } else { S.cap = 0; }
          pg8::EpiG12 E{(unsigned char*)P.out + DO_G1, (unsigned char*)P.out + DO_G2};
          STAMP(34, 64);
#ifdef MORE_FP8
          pg8::gemm_phase<pg8::EpiG12, pg8::StaticOrder, true, true, true>(lds + RING_OFF, D / 2, S, E); STAMP(35, 64); }
#else
          pg8::gemm_phase<pg8::EpiG12, pg8::StaticOrder, true, true>(lds + RING_OFF, D, S, E); STAMP(35, 64); }
#endif
        if (c >= 64) {
            asm volatile("s_waitcnt vmcnt(0)" ::: "memory"); __syncthreads();
            if (tid == 0) { unsigned* const sb2 = (unsigned*)ctl + CW_SUB2; __builtin_amdgcn_fence(__ATOMIC_RELEASE, "agent"); asm volatile("s_waitcnt vmcnt(0)" ::: "memory"); __hip_atomic_fetch_add(sb2, 1u, __ATOMIC_RELAXED, __HIP_MEMORY_SCOPE_AGENT);
                unsigned sp = 0; while (__hip_atomic_load(sb2, __ATOMIC_RELAXED, __HIP_MEMORY_SCOPE_AGENT) < (unsigned)(G - 64)) { __builtin_amdgcn_s_sleep(2); if (++sp > (1u << 22)) break; }
                __builtin_amdgcn_fence(__ATOMIC_ACQUIRE, "agent"); asm volatile("s_waitcnt vmcnt(0)" ::: "memory"); }
            __syncthreads();
            pg8::StaticOrder S; S.init(ws + WS_OA, ws + WS_BTA, T, D, 512, G - 64, c - 64); bf16* const m1 = (bf16*)((unsigned char*)P.out + DO_M1); pg8::EpiGateMul<false> E{(const unsigned char*)P.out + DO_G1, m1, m1};
            pg8::gemm_phase<pg8::EpiGateMul<false>, pg8::StaticOrder, true, true>(lds + RING_OFF, 512, S, E);
        }
    } SEAM(4);

    STAMP(5, 0);
    if (IN(5)) { pg8::StaticOrder S; S.init(ws + WS_HR, ws + WS_BTZ, T, D, D, G, c); pg8::EpiSiluMul E{(bf16*)(ws + WS_ON)};
        pg8::gemm_phase<pg8::EpiSiluMul, pg8::StaticOrder, true, true>(lds + RING_OFF, D, S, E); } SEAM(5);
    STAMP(9, 0);
    if (IN(9)) { pg8::StaticOrder S; S.init(ws + WS_ON, ws + WS_BTB, T, D, D, G, c); pg8::EpiGateMul<true> E{(const unsigned char*)P.out + DO_G2, (const bf16*)((const unsigned char*)P.out + DO_M1), (bf16*)(ws + WS_M)};
        pg8::gemm_phase<pg8::EpiGateMul<true>, pg8::StaticOrder, true, true>(lds + RING_OFF, D, S, E); } SEAM(9);
    STAMP(10, 0);
#ifdef D10_BF16
    if (IN(10)) { pg8::StaticOrder S; S.init(ws + WS_M, ws + WS_BTOUT, T, D, D, G, c); pg8::EpiBf16<0> E{(bf16*)(ws + WS_D10), D, 0};
        pg8::gemm_phase<pg8::EpiBf16<0>, pg8::StaticOrder, true, true>(lds + RING_OFF, D, S, E); } SEAM(10);
#else
    if (IN(10)) { pg8::StaticOrder S; S.init(ws + WS_M, ws + WS_BTOUT, T, D, D, G, c); pg8::EpiResF32 E{P.in[0], P.out, args.flags};
        pg8::gemm_phase<pg8::EpiResF32, pg8::StaticOrder, true, true>(lds + RING_OFF, D, S, E); } SEAM(10);
#endif
    STAMP(11, 0);
    if (IN(11)) { router_phase(P, lds, G, c, wave, lane); } SEAM(11);
    STAMP(12, 0);
    if (IN(12)) { place_phase(P, lds, G, c, wave, lane); } SEAM(12);
    STAMP(13, 0);
#ifdef MORE_FP8
    if (IN(13)) { pg8::ExpertOrder<true> S; S.init(ws + WS_H2, ws + WS_BTGU, (const unsigned*)ctl + CW_CNT, 512, D / 2, G, c); S.rows = (const int*)(ws + WS_ROWS); pg8::EpiGU E{(bf16*)(ws + WS_ACT), (const float*)(ws + WS_CW)};
        pg8::gemm_phase<pg8::EpiGU, pg8::ExpertOrder<true>, true, true, true>(lds + RING_OFF, D / 2, S, E); } SEAM(13);
#else
    if (IN(13)) { pg8::ExpertOrder<true> S; S.init(ws + WS_H2, ws + WS_BTGU, (const unsigned*)ctl + CW_CNT, 512, D, G, c); S.rows = (const int*)(ws + WS_ROWS); pg8::EpiGU E{(bf16*)(ws + WS_ACT), (const float*)(ws + WS_CW)};
        pg8::gemm_phase<pg8::EpiGU, pg8::ExpertOrder<true>, true, true>(lds + RING_OFF, D, S, E); } SEAM(13);
#endif
    STAMP(14, 0);
    if (IN(14)) { pg8::ExpertOrder<false> S; S.init(ws + WS_ACT, ws + WS_BTDN, (const unsigned*)ctl + CW_CNT, D, 256, G, c); S.rows = nullptr;
#ifdef MORE_FP8
        pg8::EpiF8 E{(unsigned char*)(ws + WS_Y), D, 16.0f};
        pg8::gemm_phase<pg8::EpiF8, pg8::ExpertOrder<false>, true, true>(lds + RING_OFF, 256, S, E); } SEAM(14);
#else
        pg8::EpiBf16<0> E{(bf16*)(ws + WS_Y), D, args.flags & 1};
        pg8::gemm_phase<pg8::EpiBf16<0>, pg8::ExpertOrder<false>, true, true>(lds + RING_OFF, 256, S, E); } SEAM(14);
#endif
    STAMP(15, 0);
#ifdef MORE_FP8
    if (IN(15)) { ple_norm_phase_f8(P, G, c, wave, lane); } SEAM(15);
#else
    if (IN(15)) { ple_norm_phase(P, G, c, wave, lane); } SEAM(15);
#endif
    STAMP(16, 0);
    if (IN(16)) { pg8::StaticOrder S; S.init(ws + WS_PB, ws + WS_BTPLE, T, D, 256, G, c); pg8::EpiBf16<0> E{(bf16*)(ws + WS_E1), D, args.flags & 1};
        pg8::gemm_phase<pg8::EpiBf16<0>, pg8::StaticOrder, true, true>(lds + RING_OFF, 256, S, E); }
    STAMP(17, 0);
#ifdef MORE_FP8
    if (IN(17)) { pg8::StaticOrder S; S.init(ws + WS_H3, ws + WS_BTPG, T, D, D / 2, G, c); pg8::EpiPleOut E{(const bf16*)(ws + WS_E1), (const bf16*)(ws + WS_X1), P.out};
        pg8::gemm_phase<pg8::EpiPleOut, pg8::StaticOrder, true, true, true>(lds + RING_OFF, D / 2, S, E); }
#else
    if (IN(17)) { pg8::StaticOrder S; S.init(ws + WS_H3, ws + WS_BTPG, T, D, D, G, c); pg8::EpiPleOut E{(const bf16*)(ws + WS_E1), (const bf16*)(ws + WS_X1), P.out};
        pg8::gemm_phase<pg8::EpiPleOut, pg8::StaticOrder, true, true>(lds + RING_OFF, D, S, E); }
#endif
    STAMP(18, 0);
#undef IN
#undef SEAM
}

#ifndef DBG_LAST
#define DBG_LAST (NPH - 1)
#endif
__global__ void dbg_sanitize(float* out, size_t n) {
    for (size_t i = (size_t)blockIdx.x * blockDim.x + threadIdx.x; i < n; i += (size_t)gridDim.x * blockDim.x) { const float v = out[i]; if (!(v - v == 0.f)) out[i] = 0.f; }
}
__global__ void dbg_copy(const float* x, float* out, size_t n) {
    for (size_t i = (size_t)blockIdx.x * blockDim.x + threadIdx.x; i < n; i += (size_t)gridDim.x * blockDim.x) out[i] = x[i];
}
#ifdef DBG_CHECK
__global__ void dbg_check(const void* p, size_t nbytes, int is_f32, unsigned id, unsigned* word) {
    const size_t n16 = nbytes / 16; const uint4* q = (const uint4*)p; bool bad = false;
    for (size_t i = (size_t)blockIdx.x * blockDim.x + threadIdx.x; i < n16; i += (size_t)gridDim.x * blockDim.x) { const uint4 v = q[i]; const unsigned w[4] = {v.x, v.y, v.z, v.w};
        for (int k = 0; k < 4; ++k) { if (is_f32) { if ((w[k] & 0x7f800000u) == 0x7f800000u) bad = true; } else { if ((w[k] & 0x7f80u) == 0x7f80u || (w[k] & 0x7f800000u) == 0x7f800000u) bad = true; } } }
    if (bad) atomicMin(word, id);
}
__global__ void dbg_check_dnp(const unsigned char* p, unsigned id, unsigned* word) {
    bool bad = false;
    for (size_t i = (size_t)blockIdx.x * blockDim.x + threadIdx.x; i < (size_t)8192 * (DNU / 16); i += (size_t)gridDim.x * blockDim.x) { const size_t rec = i / (DNU / 16), o = (i % (DNU / 16)) * 16;
        if (o >= 49152 + 2048 && o < 49152 + 4096) continue;
        const uint4 v = *(const uint4*)(p + rec * DNU + o); const unsigned w[4] = {v.x, v.y, v.z, v.w};
        for (int k = 0; k < 4; ++k) if ((w[k] & 0x7f80u) == 0x7f80u || (w[k] & 0x7f800000u) == 0x7f800000u) { const unsigned part = o < 16384 ? 0u : (o < 32768 ? 1u : (o < 49152 ? 2u : (o < 57344 ? 3u : 4u))); atomicAnd(word, ~(1u << part)); } }
    (void)bad;
}
__global__ void dbg_check_tmax(const unsigned char* p, unsigned* word) {
    for (size_t r = (size_t)blockIdx.x * blockDim.x + threadIdx.x; r < 8192; r += (size_t)gridDim.x * blockDim.x) { const float* d = (const float*)(p + r * DNU + 49152 + 2048);
        unsigned bits = 0; if (d[0] > 1e3f) bits |= 1u; if (d[2] != 0.f) bits |= 2u; if (d[1] > 1.5f) bits |= 4u; if (d[1] > 100.f) bits |= 8u; if (d[3] != 0.f) bits |= 16u;
        if (bits) atomicAnd(word, ~bits); }
}
__global__ void dbg_final(const float* x, float* out, const unsigned* word) {
    unsigned id = *word;
#ifdef DBG_BITS
    id = (~id) & 31u; if (id == 0) id = 0xffffffffu;
#endif
    const size_t nz = id == 0xffffffffu ? 0 : (size_t)id * (T / 32) * D; const size_t n = (size_t)T * D;
    for (size_t i = (size_t)blockIdx.x * blockDim.x + threadIdx.x; i < n; i += (size_t)gridDim.x * blockDim.x) out[i] = i < nz ? 0.f : x[i];
}
#endif
#ifdef DBG_STAMP
__global__ void dbg_stamp_out(const unsigned long long* st, float* out) {
#ifdef DBG_CAL
    const float delta = 0.1f;
#else
    const float delta = (float)(st[DBG_TA1] - st[DBG_TA0]) * 0.01f * (1.0f / 20000.0f);
#endif
    const size_t n = (size_t)T * D;
    for (size_t i = (size_t)blockIdx.x * blockDim.x + threadIdx.x; i < n; i += (size_t)gridDim.x * blockDim.x) out[i] += delta;
}
#endif
extern "C" void kernel_launch(void* const* d_in, const int* in_sizes, int n_in, void* d_out, int out_size, void* d_ws, size_t ws_size, hipStream_t stream) {
    static int grid = 0;
    if (grid == 0) {
        if (n_in != 24 || out_size != T * D || ws_size < WS_END) { fprintf(stderr, "kernel_launch: unexpected shapes (n_in %d, out %d, ws %zu)\n", n_in, out_size, ws_size); grid = -1; return; }
        int dev = 0, cus = 0;
        if (hipGetDevice(&dev) != hipSuccess || hipDeviceGetAttribute(&cus, hipDeviceAttributeMultiprocessorCount, dev) != hipSuccess) { grid = -1; return; }
        if (hipFuncSetAttribute((const void*)fwd_kernel, hipFuncAttributeMaxDynamicSharedMemorySize, LDS_BYTES) != hipSuccess) { grid = -1; return; }
        int per_cu = 0;
        if (hipOccupancyMaxActiveBlocksPerMultiprocessor(&per_cu, (const void*)fwd_kernel, NWAVES * 64, LDS_BYTES) != hipSuccess || per_cu < 1) { fprintf(stderr, "kernel_launch: occupancy query says %d\n", per_cu); }
        (void)hipGetLastError();
        grid = cus;
        if (grid != 256) { fprintf(stderr, "kernel_launch: built for 256 CUs, found %d\n", cus); grid = -1; return; }
    }
    if (grid < 0) return;
    if (hipMemsetAsync((char*)d_ws + WS_CTL, 0, CTL_ZERO_BYTES, stream) != hipSuccess) return;
    Args a{};
    for (int i = 0; i < 24; ++i) a.p.in[i] = (const float*)d_in[i];
    a.p.out = (float*)d_out; a.p.ws = (unsigned char*)d_ws;
    if (N_LAUNCHES == 1) { a.ph_lo = 0; a.ph_hi = NPH; hipLaunchKernelGGL(fwd_kernel, dim3(grid), dim3(NWAVES * 64), LDS_BYTES, stream, a);
#ifdef DBG_STAMP
        hipLaunchKernelGGL(dbg_stamp_out, dim3(1024), dim3(256), 0, stream, (const unsigned long long*)((unsigned char*)d_ws + 768 * 1024), (float*)d_out);
#endif
    }
    else for (int li = 0; li <= DBG_LAST; ++li) { a.ph_lo = li; a.ph_hi = li + 1;
#ifdef DUP_PH
#ifndef DUP_N
#define DUP_N 1
#endif
#ifndef DUP_FLAGS
#define DUP_FLAGS 0
#endif
        if (li == DUP_PH) { Args b = a; b.flags = DUP_FLAGS; if (li == 11 || li == 12) hipMemsetAsync((char*)d_ws + WS_CTL + CW_CNT * 4 + (li == 12 ? 256 : 0), 0, 64, stream);
            for (int r = 0; r < DUP_N; ++r) hipLaunchKernelGGL(fwd_kernel, dim3(grid), dim3(NWAVES * 64), LDS_BYTES, stream, b);
            if (li == 11 || li == 12) hipMemsetAsync((char*)d_ws + WS_CTL + CW_CNT * 4 + (li == 12 ? 256 : 0), 0, 64, stream);
            if (li == 4) hipMemsetAsync((char*)d_ws + WS_CTL + CW_SUB * 4, 0, 4, stream); }
#endif
        hipLaunchKernelGGL(fwd_kernel, dim3(grid), dim3(NWAVES * 64), LDS_BYTES, stream, a);
#ifdef DBG_CHECK
        unsigned char* W = (unsigned char*)d_ws; unsigned char* O = (unsigned char*)d_out; unsigned* word = (unsigned*)(W + 1022 * MiB + 512 * 1024);
        if (li == 0) hipMemsetAsync(word, 0xFF, 4, stream);
#define CHK(p, nb, f32, id) hipLaunchKernelGGL(dbg_check, dim3(1024), dim3(256), 0, stream, (const void*)(p), (size_t)(nb), f32, (unsigned)(id), word)
        if (li == 0) { CHK(O + DO_H, (size_t)T * D * 2, 0, 1); CHK(W + WS_BTP1, (size_t)NP1 * D * 2, 0, 2); CHK(W + WS_BTZ, 38 * MiB, 0, 3); }
        if (li == 1) { CHK(W + WS_QA, (size_t)T * 4608 * 2, 0, 4); CHK(W + WS_QB, (size_t)T * 3072 * 2, 0, 5); CHK(W + WS_BG, (size_t)T * 16 * 4, 1, 6); }
        if (li == 2) { CHK(O + DO_OG, (size_t)T * 1536 * 2, 0, 7); CHK(O + DO_LSE, (size_t)T * 24 * 4, 1, 8); }
#if defined(DBG_PREPCHK)
        if (li == 3) {
#elif defined(DBG_TMAX)
        if (li == 3) { hipLaunchKernelGGL(dbg_check_tmax, dim3(32), dim3(256), 0, stream, W + WS_DNP, word);
#else
        if (li == 3) { hipLaunchKernelGGL(dbg_check_dnp, dim3(1024), dim3(256), 0, stream, W + WS_DNP, 9u, word);
#endif
        CHK(W + WS_DLB, 8192 * 4, 1, 14); }
        if (li == 4) { CHK(W + WS_ON, (size_t)T * D * 2, 0, 11); CHK(W + WS_OA, (size_t)T * 512 * 2, 0, 12); CHK(W + WS_HR, (size_t)T * D * 2, 0, 13); }
        if (li == 5) CHK(W + WS_ON, (size_t)T * D * 2, 0, 14);
        if (li == 8) CHK(W + WS_M, (size_t)T * D * 2, 0, 17);
        if (li == 9) CHK(W + WS_M, (size_t)T * D * 2, 0, 18);
        if (li == 10) CHK(O, (size_t)T * D * 4, 1, 19);
        if (li == 11) { CHK(W + WS_H2, (size_t)T * D * 2, 0, 20); CHK(W + WS_TOK, (size_t)T * 16, 1, 21); }
        if (li == 15) { CHK(O, (size_t)T * D * 4, 1, 25); CHK(W + WS_H3, (size_t)T * D * 2, 0, 26); }
        if (li == 16) CHK(W + WS_E1, (size_t)T * D * 2, 0, 27);
        if (li == 17) CHK(O, (size_t)T * D * 4, 1, 28);
        if (li == DBG_LAST) hipLaunchKernelGGL(dbg_final, dim3(2048), dim3(256), 0, stream, (const float*)d_in[0], (float*)d_out, (const unsigned*)word);
#endif
    }
#ifdef DBG_COPYX
    hipLaunchKernelGGL(dbg_copy, dim3(2048), dim3(256), 0, stream, (const float*)d_in[0], (float*)d_out, (size_t)out_size);
#endif
#ifdef DBG_SANITIZE
    hipLaunchKernelGGL(dbg_sanitize, dim3(2048), dim3(256), 0, stream, (float*)d_out, (size_t)out_size);
#endif
}
```

```cpp
#ifndef MK_N_LAUNCHES
#define MK_N_LAUNCHES 1
#endif
#define P1_FP8 1
#define MORE_FP8 1
#define D10_BF16 1
#define X_BF16 1
#define STAGGER_P1 2
#define P1_NT 1
#include <hip/hip_runtime.h>
#include <cstdio>
#include <cstdint>
namespace pg8 {
#define PG8_LAS __attribute__((address_space(3)))
typedef unsigned short bf16_t;
typedef short bf16x8 __attribute__((ext_vector_type(8)));
typedef float f32x4 __attribute__((ext_vector_type(4)));
typedef unsigned u32x4 __attribute__((ext_vector_type(4)));
typedef unsigned u32x2 __attribute__((ext_vector_type(2)));
constexpr int BM = 256, BK = 64, HALF = 128, HTB = HALF * BK * 2  , STAGE_BYTES = 8 * HTB, NXCD = 8, WGM = 8;

constexpr int FP8_SCALE_A = 127 - 2, FP8_SCALE_B = 127 - 6;
__host__ __device__ __forceinline__ int lds_byte(int r, int c) { const int st = (r >> 4) * 2 + (c >> 5), rr = r & 15, cc = c & 31, ob = rr * 64 + cc * 2; return st * 1024 + (ob ^ (((ob >> 9) & 1) << 5)); }
__host__ __device__ __forceinline__ void stage_rc(int b, int& R, int& C) { const int st = b / 1024, sb = b % 1024, swz = sb ^ (((sb >> 9) & 1) << 5); R = (st >> 1) * 16 + swz / 64; C = (st & 1) * 32 + (swz % 64) / 2; }
__host__ __device__ __forceinline__ int perm32(int rho) { const int n = rho >> 4, i = rho & 15; return 8 * (i >> 2) + 4 * n + (i & 3); }

struct Unit { int pm, pn; const char* a; const char* b; };

struct StaticOrder {
    static constexpr bool GATHER = false; static constexpr int MAXU = 0;
    __device__ __forceinline__ int row_of(const Unit&, int) const { return 0; }
    const char* A; const char* Bt; size_t tstep; int nM, nN, nwg, G, c, cap;
    __device__ __forceinline__ void init(const void* A_, const void* Bt_, int M, int N, int K, int G_, int c_) { A = (const char*)A_; Bt = (const char*)Bt_; tstep = (size_t)BM * K * 2; nM = M / BM; nN = N / BM; nwg = nM * nN; G = G_; c = c_; cap = 0x7fffffff; }
    __device__ __forceinline__ bool next(int i, Unit& u) const {
        const long L = (long)i * G + c; if (L >= nwg || i >= cap) return false;
        int wgid = (int)L; { const int q = nwg / NXCD, r = nwg % NXCD, xcd = wgid % NXCD, off = wgid / NXCD; wgid = (xcd < r ? xcd * (q + 1) : r * (q + 1) + (xcd - r) * q) + off; }
        const int nig = WGM * nN, gid = wgid / nig, fm = gid * WGM, gsz = (nM - fm) < WGM ? (nM - fm) : WGM;
        u.pm = fm + ((wgid % nig) % gsz); u.pn = (wgid % nig) / gsz; u.a = A + (size_t)u.pm * tstep; u.b = Bt + (size_t)u.pn * tstep; return true;
    }
    __device__ __forceinline__ const char* a_ptr(const Unit& u) const { return u.a; }
    __device__ __forceinline__ const char* b_ptr(const Unit& u) const { return u.b; }
    __device__ __forceinline__ void a_ready(const Unit&) const {}
    __device__ __forceinline__ void done(const Unit&) const {}
};
template <bool GATHER_> struct ExpertOrder {
    static constexpr bool GATHER = GATHER_; static constexpr int MAXU = 14;
    const int* rows;
    __device__ __forceinline__ int row_of(const Unit& u, int r) const { return rows[u.pm * BM + r]; }
    const char* A; const char* Bt; const unsigned* cnt; size_t tstep, bstride; int nN, G, c; int te[16];
    __device__ __forceinline__ void init(const void* A_, const void* Bt_, const unsigned* cnt_, int N, int K, int G_, int c_) { A = (const char*)A_; Bt = (const char*)Bt_; cnt = cnt_; tstep = (size_t)BM * K * 2; bstride = (size_t)N * K * 2; nN = N / BM; G = G_; c = c_;
#pragma unroll
        for (int e = 0; e < 16; ++e) te[e] = (int)((cnt_[e] + 255u) >> 8); }
    __device__ __forceinline__ bool next(int i, Unit& u) const {
        const long L = (long)i * G + c; const int rt = (int)(L / nN), pn = (int)(L % nN);
        int acc = 0, found = -1;
#pragma unroll
        for (int e = 0; e < 16; ++e) { if (found < 0 && rt < acc + te[e]) found = e; acc += te[e]; }
        if (found < 0) return false;
        u.pm = rt; u.pn = pn; u.a = GATHER ? A : A + (size_t)rt * tstep; u.b = Bt + (size_t)found * bstride + (size_t)pn * tstep; return true;
    }
    __device__ __forceinline__ const char* a_ptr(const Unit& u) const { return u.a; }
    __device__ __forceinline__ const char* b_ptr(const Unit& u) const { return u.b; }
    __device__ __forceinline__ void a_ready(const Unit&) const {}
    __device__ __forceinline__ void done(const Unit&) const {}
};

typedef float f32x2_t __attribute__((ext_vector_type(2))); typedef __bf16 bf16x2_t __attribute__((ext_vector_type(2)));
__device__ __forceinline__ unsigned cvt_pk_bf16(float lo, float hi) { const f32x2_t v = {lo, hi}; const bf16x2_t b = __builtin_convertvector(v, bf16x2_t); return __builtin_bit_cast(unsigned, b); }
__device__ __forceinline__ float bflo(unsigned w) { return __uint_as_float(w << 16); }
__device__ __forceinline__ float bfhi(unsigned w) { return __uint_as_float(w & 0xffff0000u); }
__device__ __forceinline__ float sigm(float x) { return __builtin_amdgcn_rcpf(1.0f + __expf(-x)); }
__device__ __forceinline__ u32x4 pack8(const f32x4 a, const f32x4 b) { u32x4 w; w.x = cvt_pk_bf16(a[0], a[1]); w.y = cvt_pk_bf16(a[2], a[3]); w.z = cvt_pk_bf16(b[0], b[1]); w.w = cvt_pk_bf16(b[2], b[3]); return w; }
__device__ __forceinline__ int xq_src(int lane) { return (((lane & 3) << 4) + (lane >> 2)) << 2; }
__device__ __forceinline__ u32x4 xq(const int bp, const u32x4 w) { u32x4 o; o.x = (unsigned)__builtin_amdgcn_ds_bpermute(bp, (int)w.x); o.y = (unsigned)__builtin_amdgcn_ds_bpermute(bp, (int)w.y); o.z = (unsigned)__builtin_amdgcn_ds_bpermute(bp, (int)w.z); o.w = (unsigned)__builtin_amdgcn_ds_bpermute(bp, (int)w.w); return o; }
__device__ __forceinline__ f32x4 xqf(const int bp, const f32x4 v) { return __builtin_bit_cast(f32x4, xq(bp, __builtin_bit_cast(u32x4, v))); }
__device__ __forceinline__ void unpack8(const u32x4 w, f32x4& a, f32x4& b) { a = (f32x4){bflo(w.x), bfhi(w.x), bflo(w.y), bfhi(w.y)}; b = (f32x4){bflo(w.z), bfhi(w.z), bflo(w.w), bfhi(w.w)}; }

__device__ __forceinline__ u32x2 pack8_u8(const f32x4 a, const f32x4 b) { unsigned w0 = 0u, w1 = 0u;
    w0 = __builtin_amdgcn_cvt_pk_u8_f32(__builtin_rintf(a[0] * 255.f), 0, w0); w0 = __builtin_amdgcn_cvt_pk_u8_f32(__builtin_rintf(a[1] * 255.f), 1, w0); w0 = __builtin_amdgcn_cvt_pk_u8_f32(__builtin_rintf(a[2] * 255.f), 2, w0); w0 = __builtin_amdgcn_cvt_pk_u8_f32(__builtin_rintf(a[3] * 255.f), 3, w0);
    w1 = __builtin_amdgcn_cvt_pk_u8_f32(__builtin_rintf(b[0] * 255.f), 0, w1); w1 = __builtin_amdgcn_cvt_pk_u8_f32(__builtin_rintf(b[1] * 255.f), 1, w1); w1 = __builtin_amdgcn_cvt_pk_u8_f32(__builtin_rintf(b[2] * 255.f), 2, w1); w1 = __builtin_amdgcn_cvt_pk_u8_f32(__builtin_rintf(b[3] * 255.f), 3, w1);
    return (u32x2){w0, w1}; }
__device__ __forceinline__ void unpack8_u8(const u32x2 w, f32x4& a, f32x4& b) { const float s = 1.0f / 255.f;
    a = (f32x4){(float)(w.x & 0xffu), (float)((w.x >> 8) & 0xffu), (float)((w.x >> 16) & 0xffu), (float)(w.x >> 24)} * s; b = (f32x4){(float)(w.y & 0xffu), (float)((w.y >> 8) & 0xffu), (float)((w.y >> 16) & 0xffu), (float)(w.y >> 24)} * s; }
constexpr float QSCALE = 0.125f * 1.4426950408889634f;
constexpr float EPSN = 1e-6f;
constexpr int TOK_ROWS = 65536;
constexpr int QAP = 4608, QBP = 3072;

#ifdef P1_NT
#define P1_STORE(p, v) __builtin_nontemporal_store((v), (p))
#else
#define P1_STORE(p, v) (*(p) = (v))
#endif
struct EpiP1 {
    static constexpr bool PERM = true, AFTER_DRAIN = false;
    bf16_t* QA; bf16_t* QB; float* BG; const float* qn; const float* kn; const float* a_log; const float* dt_bias;
    __device__ __forceinline__ void operator()(const f32x4 (&acc)[2][2][4][2], const Unit& u, int wr, int wc, int fr, int fq) const {
        const int row0 = u.pm * BM + wr * 64 + fr;
        const int lane_ = 16 * fq + fr, r2 = lane_ >> 2, q2 = lane_ & 3, bp = xq_src(lane_), row0t = u.pm * BM + wr * 64 + r2;
        if (u.pn < 12) {
            const float* gn = (u.pn < 6) ? qn : kn; const float sc = (u.pn < 6) ? QSCALE : 1.0f;
            f32x4 gv[2][2];
#pragma unroll
            for (int bj = 0; bj < 2; ++bj)
#pragma unroll
                for (int n = 0; n < 2; ++n) gv[bj][n] = *(const f32x4*)(gn + 32 * bj + 8 * fq + 4 * n) * sc;
#pragma unroll
            for (int ai = 0; ai < 2; ++ai)
#pragma unroll
                for (int m = 0; m < 4; ++m) {
                    float ss = 0.f;
#pragma unroll
                    for (int bj = 0; bj < 2; ++bj)
#pragma unroll
                        for (int n = 0; n < 2; ++n) { const f32x4 x = acc[ai][bj][m][n]; ss += (x[0] * x[0] + x[1] * x[1]) + (x[2] * x[2] + x[3] * x[3]); }
                    ss += __shfl_xor(ss, 16); ss += __shfl_xor(ss, 32);
                    const float rs = rsqrtf(ss * (1.0f / 64.0f) + EPSN);
                    bf16_t* rowp = QA + ((size_t)(u.pn * 4 + wc) * TOK_ROWS + (size_t)(row0t + ai * HALF + m * 16)) * 64 + 8 * q2;
#pragma unroll
                    for (int bj = 0; bj < 2; ++bj) { const f32x4 v0 = acc[ai][bj][m][0] * rs * gv[bj][0], v1 = acc[ai][bj][m][1] * rs * gv[bj][1]; P1_STORE((u32x4*)(rowp + bj * 32), xq(bp, pack8(v0, v1))); }
                }
        } else if (u.pn < 30) {
#pragma unroll
            for (int ai = 0; ai < 2; ++ai)
#pragma unroll
                for (int m = 0; m < 4; ++m) { const size_t row = (size_t)(row0t + ai * HALF + m * 16);
#pragma unroll
                    for (int bj = 0; bj < 2; ++bj) { bf16_t* p = (u.pn < 18) ? QA + ((size_t)(u.pn * 4 + 2 * bj + (wc >> 1)) * TOK_ROWS + row) * 64 + 32 * (wc & 1) + 8 * q2
                                                                         : QB + ((size_t)((u.pn - 18) * 2 + bj) * TOK_ROWS + row) * 128 + 32 * wc + 8 * q2;
                        P1_STORE((u32x4*)p, xq(bp, pack8(acc[ai][bj][m][0], acc[ai][bj][m][1]))); } }
        } else {
            if (wc == 0 && fq < 2) {
                f32x4 al[2], db[2];
#pragma unroll
                for (int n = 0; n < 2; ++n) { al[n] = *(const f32x4*)(a_log + 4 * n); db[n] = *(const f32x4*)(dt_bias + 4 * n); }
#pragma unroll
                for (int ai = 0; ai < 2; ++ai)
#pragma unroll
                    for (int m = 0; m < 4; ++m) { float* rowp = BG + (size_t)(row0 + ai * HALF + m * 16) * 16 + 8 * fq;
#pragma unroll
                        for (int n = 0; n < 2; ++n) { const f32x4 x = acc[ai][0][m][n]; f32x4 o;
#pragma unroll
                            for (int e = 0; e < 4; ++e) { if (fq == 0) o[e] = sigm(x[e]); else { const float z = x[e] + db[n][e]; const float sp = z > 20.f ? z : log1pf(__expf(z)); o[e] = -__expf(al[n][e]) * sp; } }
                            *(f32x4*)(rowp + 4 * n) = o; } }
            }
        }
    }
};
struct EpiSiluMul {
    static constexpr bool PERM = true, AFTER_DRAIN = false;
    bf16_t* O;
    __device__ __forceinline__ void operator()(const f32x4 (&acc)[2][2][4][2], const Unit& u, int wr, int wc, int fr, int fq) const {
        const int lane_ = 16 * fq + fr, r2 = lane_ >> 2, q2 = lane_ & 3, bp = xq_src(lane_), row0t = u.pm * BM + wr * 64 + r2;
#pragma unroll
        for (int ai = 0; ai < 2; ++ai) {
            u32x4 ld[4][2];
#pragma unroll
            for (int m = 0; m < 4; ++m)
#pragma unroll
                for (int bj = 0; bj < 2; ++bj) ld[m][bj] = *(const u32x4*)(O + (size_t)(row0t + ai * HALF + m * 16) * 1024 + u.pn * BM + wc * 32 + 8 * q2 + bj * HALF);
#pragma unroll
            for (int m = 0; m < 4; ++m) { bf16_t* rowp = O + (size_t)(row0t + ai * HALF + m * 16) * 1024 + u.pn * BM + wc * 32 + 8 * q2;
#pragma unroll
                for (int bj = 0; bj < 2; ++bj) { f32x4 a, b; unpack8(ld[m][bj], a, b); const f32x4 z0 = xqf(bp, acc[ai][bj][m][0]), z1 = xqf(bp, acc[ai][bj][m][1]);
#pragma unroll
                    for (int e = 0; e < 4; ++e) { a[e] *= z0[e] * sigm(z0[e]); b[e] *= z1[e] * sigm(z1[e]); }
                    *(u32x4*)(rowp + bj * HALF) = pack8(a, b); } }
            asm volatile("" ::: "memory");
        }
    }
};
struct EpiZG {
    static constexpr bool PERM = true, AFTER_DRAIN = false;
    bf16_t* ON; bf16_t* G1; bf16_t* G2;
    __device__ __forceinline__ void operator()(const f32x4 (&acc)[2][2][4][2], const Unit& u, int wr, int wc, int fr, int fq) const {
        const int row0 = u.pm * BM + wr * 64 + fr; const int t = u.pn >> 2;
        const long dG1 = (const char*)G1 - (const char*)ON, dG2 = (const char*)G2 - (const char*)ON;
        bf16_t* const O = (bf16_t*)((char*)ON + (t == 1 ? dG1 : 0) + (t == 2 ? dG2 : 0));
#pragma unroll
        for (int ai = 0; ai < 2; ++ai)
#pragma unroll
            for (int m = 0; m < 4; ++m) { bf16_t* rowp = O + (size_t)(row0 + ai * HALF + m * 16) * 1024 + (u.pn & 3) * BM + wc * 32 + 8 * fq;
#pragma unroll
                for (int bj = 0; bj < 2; ++bj) { f32x4 a = acc[ai][bj][m][0], b = acc[ai][bj][m][1];
                    if (t == 0) { const u32x4 w = *(const u32x4*)(rowp + bj * HALF); f32x4 oa, ob; unpack8(w, oa, ob);
#pragma unroll
                        for (int e = 0; e < 4; ++e) { a[e] = oa[e] * a[e] * sigm(a[e]); b[e] = ob[e] * b[e] * sigm(b[e]); } }
                    else {
#pragma unroll
                        for (int e = 0; e < 4; ++e) { a[e] = sigm(a[e]); b[e] = sigm(b[e]); } }
                    *(u32x4*)(rowp + bj * HALF) = pack8(a, b); } }
    }
};
struct EpiG12 {
    static constexpr bool PERM = true, AFTER_DRAIN = false;
    unsigned char* G1; unsigned char* G2;
    __device__ __forceinline__ void operator()(const f32x4 (&acc)[2][2][4][2], const Unit& u, int wr, int wc, int fr, int fq) const {
        const int lane_ = 16 * fq + fr, r2 = lane_ >> 2, q2 = lane_ & 3, bp = xq_src(lane_), row0t = u.pm * BM + wr * 64 + r2;
        const long dG2 = G2 - G1;
        unsigned char* const O = G1 + ((u.pn >> 2) ? dG2 : 0);
#pragma unroll
        for (int ai = 0; ai < 2; ++ai)
#pragma unroll
            for (int m = 0; m < 4; ++m) { unsigned char* rowp = O + (size_t)(row0t + ai * HALF + m * 16) * 1024 + (u.pn & 3) * BM + wc * 32 + 8 * q2;
#pragma unroll
                for (int bj = 0; bj < 2; ++bj) { f32x4 a = acc[ai][bj][m][0], b = acc[ai][bj][m][1];
#pragma unroll
                    for (int e = 0; e < 4; ++e) { a[e] = sigm(a[e]); b[e] = sigm(b[e]); }
                    const u32x2 w = pack8_u8(a, b);
                    *(u32x2*)(rowp + bj * HALF) = (u32x2){(unsigned)__builtin_amdgcn_ds_bpermute(bp, (int)w.x), (unsigned)__builtin_amdgcn_ds_bpermute(bp, (int)w.y)}; } }
    }
};
template <int MODE> struct EpiBf16 {
    static constexpr bool PERM = true, AFTER_DRAIN = false;
    bf16_t* O; int ldc; int skip;
    __device__ __forceinline__ void operator()(const f32x4 (&acc)[2][2][4][2], const Unit& u, int wr, int wc, int fr, int fq) const {
        const int lane_ = 16 * fq + fr, r2 = lane_ >> 2, q2 = lane_ & 3, bp = xq_src(lane_), row0t = u.pm * BM + wr * 64 + r2;
#pragma unroll
        for (int ai = 0; ai < 2; ++ai)
#pragma unroll
            for (int m = 0; m < 4; ++m) { bf16_t* rowp = O + (size_t)(row0t + ai * HALF + m * 16) * ldc + u.pn * BM + wc * 32 + 8 * q2;
#pragma unroll
                for (int bj = 0; bj < 2; ++bj) { f32x4 a = acc[ai][bj][m][0], b = acc[ai][bj][m][1];
                    if (MODE == 1) {
#pragma unroll
                        for (int e = 0; e < 4; ++e) { a[e] = sigm(a[e]); b[e] = sigm(b[e]); } }
                    if (!skip) *(u32x4*)(rowp + bj * HALF) = xq(bp, pack8(a, b)); } }
    }
};
struct EpiF8 {
    static constexpr bool PERM = true, AFTER_DRAIN = false;
    unsigned char* O; int ldc; float sc;
    __device__ __forceinline__ void operator()(const f32x4 (&acc)[2][2][4][2], const Unit& u, int wr, int wc, int fr, int fq) const {
        const int lane_ = 16 * fq + fr, r2 = lane_ >> 2, q2 = lane_ & 3, bp = xq_src(lane_), row0t = u.pm * BM + wr * 64 + r2;
#pragma unroll
        for (int ai = 0; ai < 2; ++ai)
#pragma unroll
            for (int m = 0; m < 4; ++m) { unsigned char* rowp = O + (size_t)(row0t + ai * HALF + m * 16) * ldc + u.pn * BM + wc * 32 + 8 * q2;
#pragma unroll
                for (int bj = 0; bj < 2; ++bj) { const f32x4 a = acc[ai][bj][m][0] * sc, b = acc[ai][bj][m][1] * sc;
                    int w0 = __builtin_amdgcn_cvt_pk_fp8_f32(a[0], a[1], 0, false); w0 = __builtin_amdgcn_cvt_pk_fp8_f32(a[2], a[3], w0, true);
                    int w1 = __builtin_amdgcn_cvt_pk_fp8_f32(b[0], b[1], 0, false); w1 = __builtin_amdgcn_cvt_pk_fp8_f32(b[2], b[3], w1, true);
                    *(u32x2*)(rowp + bj * HALF) = (u32x2){(unsigned)__builtin_amdgcn_ds_bpermute(bp, w0), (unsigned)__builtin_amdgcn_ds_bpermute(bp, w1)}; } }
    }
};
template <bool ADD> struct EpiGateMul {
    static constexpr bool PERM = true, AFTER_DRAIN = false;
    const unsigned char* Gt; const bf16_t* Mi; bf16_t* Mo;
    __device__ __forceinline__ void operator()(const f32x4 (&acc)[2][2][4][2], const Unit& u, int wr, int wc, int fr, int fq) const {
        const int lane_ = 16 * fq + fr, r2 = lane_ >> 2, q2 = lane_ & 3, bp = xq_src(lane_), row0t = u.pm * BM + wr * 64 + r2;
#pragma unroll
        for (int ai = 0; ai < 2; ++ai) {
            u32x2 lg[4][2]; u32x4 lm[4][2];
#pragma unroll
            for (int m = 0; m < 4; ++m)
#pragma unroll
                for (int bj = 0; bj < 2; ++bj) { const size_t off = (size_t)(row0t + ai * HALF + m * 16) * 1024 + u.pn * BM + wc * 32 + 8 * q2 + bj * HALF;
                    lg[m][bj] = *(const u32x2*)(Gt + off); if (ADD) lm[m][bj] = *(const u32x4*)(Mi + off); }
#pragma unroll
            for (int m = 0; m < 4; ++m) { const size_t off = (size_t)(row0t + ai * HALF + m * 16) * 1024 + u.pn * BM + wc * 32 + 8 * q2;
#pragma unroll
                for (int bj = 0; bj < 2; ++bj) { f32x4 ga, gb; unpack8_u8(lg[m][bj], ga, gb);
                    f32x4 a = ga * xqf(bp, acc[ai][bj][m][0]), b = gb * xqf(bp, acc[ai][bj][m][1]);
                    if (ADD) { f32x4 ma, mb; unpack8(lm[m][bj], ma, mb); a += ma; b += mb; }
                    *(u32x4*)(Mo + off + bj * HALF) = pack8(a, b); } }
            asm volatile("" ::: "memory");
        }
    }
};
struct EpiResF32 {
    static constexpr bool PERM = false, AFTER_DRAIN = false;
    const float* base; float* out; int flags;
    __device__ __forceinline__ void operator()(const f32x4 (&acc)[2][2][4][2], const Unit& u, int wr, int wc, int fr, int fq) const {
        const int row0 = u.pm * BM + wr * 64 + fr, col0 = u.pn * BM + wc * 32 + 4 * fq;
#pragma unroll
        for (int ai = 0; ai < 2; ++ai) {
            f32x4 bs[4][2][2];
#pragma unroll
            for (int m = 0; m < 4; ++m)
#pragma unroll
                for (int bj = 0; bj < 2; ++bj)
#pragma unroll
                    for (int n = 0; n < 2; ++n) bs[m][bj][n] = (flags & 2) ? (f32x4){0.f, 0.f, 0.f, 0.f} : *(const f32x4*)(base + (size_t)(row0 + ai * HALF + m * 16) * 1024 + col0 + bj * HALF + n * 16);
#pragma unroll
            for (int m = 0; m < 4; ++m)
#pragma unroll
                for (int bj = 0; bj < 2; ++bj)
#pragma unroll
                    for (int n = 0; n < 2; ++n) { const f32x4 r_ = bs[m][bj][n] + acc[ai][bj][m][n]; if (!(flags & 1) || r_[0] == 12345.678f) *(f32x4*)(out + (size_t)(row0 + ai * HALF + m * 16) * 1024 + col0 + bj * HALF + n * 16) = r_; }
            asm volatile("" ::: "memory");
        }
    }
};
struct EpiPleOut {
    static constexpr bool PERM = false, AFTER_DRAIN = false;
    const bf16_t* E1; const bf16_t* X2; float* out;
    __device__ __forceinline__ void operator()(const f32x4 (&acc)[2][2][4][2], const Unit& u, int wr, int wc, int fr, int fq) const {
        const int lane_ = 16 * fq + fr, r2 = lane_ >> 2, q2 = lane_ & 3, bp = xq_src(lane_), row0t = u.pm * BM + wr * 64 + r2;
        const int col0 = u.pn * BM + wc * 32 + 4 * q2;
#pragma unroll
        for (int ai = 0; ai < 2; ++ai)
#pragma unroll
            for (int mh = 0; mh < 2; ++mh) {
                u32x2 xw[2][2][2], ew[2][2][2];
#pragma unroll
                for (int mm = 0; mm < 2; ++mm)
#pragma unroll
                    for (int bj = 0; bj < 2; ++bj)
#pragma unroll
                        for (int n = 0; n < 2; ++n) { const size_t o2 = (size_t)(row0t + ai * HALF + (2 * mh + mm) * 16) * 1024 + col0 + bj * HALF + n * 16; xw[mm][bj][n] = *(const u32x2*)(X2 + o2); ew[mm][bj][n] = *(const u32x2*)(E1 + o2); }
#pragma unroll
                for (int mm = 0; mm < 2; ++mm)
#pragma unroll
                    for (int bj = 0; bj < 2; ++bj)
#pragma unroll
                        for (int n = 0; n < 2; ++n) { const size_t o2 = (size_t)(row0t + ai * HALF + (2 * mh + mm) * 16) * 1024 + col0 + bj * HALF + n * 16; const u32x2 w = ew[mm][bj][n], xq_ = xw[mm][bj][n];
                            const f32x4 ev = (f32x4){bflo(w.x), bfhi(w.x), bflo(w.y), bfhi(w.y)}, xv = (f32x4){bflo(xq_.x), bfhi(xq_.x), bflo(xq_.y), bfhi(xq_.y)}; const f32x4 a = xqf(bp, acc[ai][bj][2 * mh + mm][n]); f32x4 r;
#pragma unroll
                            for (int e = 0; e < 4; ++e) r[e] = xv[e] + sigm(a[e]) * ev[e];
                            __builtin_nontemporal_store(r, (f32x4*)(out + o2)); }
                asm volatile("" ::: "memory");
            }
    }
};
struct EpiGU {
    static constexpr bool PERM = true, AFTER_DRAIN = false;
    bf16_t* ACT; const float* CW;
    __device__ __forceinline__ void operator()(const f32x4 (&acc)[2][2][4][2], const Unit& u, int wr, int wc, int fr, int fq) const {
        const int row0 = u.pm * BM + wr * 64 + fr;
        const int lane_ = 16 * fq + fr, r2 = lane_ >> 2, q2 = lane_ & 3, bp = xq_src(lane_), row0t = u.pm * BM + wr * 64 + r2;
#pragma unroll
        for (int ai = 0; ai < 2; ++ai)
#pragma unroll
            for (int m = 0; m < 4; ++m) { const int row = row0 + ai * HALF + m * 16; const float cw = CW[row];
                f32x4 a, b; const f32x4 g0 = acc[ai][0][m][0], g1 = acc[ai][0][m][1], u0 = acc[ai][1][m][0], u1 = acc[ai][1][m][1];
#pragma unroll
                for (int e = 0; e < 4; ++e) { a[e] = g0[e] * sigm(g0[e]) * u0[e] * cw; b[e] = g1[e] * sigm(g1[e]) * u1[e] * cw;
#ifdef FP8_EMU2
                    { const int w_ = __builtin_amdgcn_cvt_pk_fp8_f32(a[e] * 32.f, b[e] * 32.f, 0, false); a[e] = __builtin_amdgcn_cvt_f32_fp8(w_, 0) * (1.f / 32.f); b[e] = __builtin_amdgcn_cvt_f32_fp8(w_, 1) * (1.f / 32.f); }
#endif
                }
                *(u32x4*)(ACT + (size_t)(row0t + ai * HALF + m * 16) * 256 + u.pn * HALF + wc * 32 + 8 * q2) = xq(bp, pack8(a, b)); }
    }
};

__device__ __forceinline__ f32x4 zero4() { typedef unsigned long long u64x2_ __attribute__((ext_vector_type(2))); unsigned long long lo_, hi_;
    asm volatile("v_mov_b64 %0, 0\n\tv_mov_b64 %1, 0" : "=v"(lo_), "=v"(hi_)); return __builtin_bit_cast(f32x4, (u64x2_){lo_, hi_}); }
template <class Epi, class Sched, bool ALIGN_EPI = false, bool SP2 = false, bool FP8 = false>
__device__ __forceinline__ void gemm_phase(PG8_LAS unsigned char* lds, const int KK, const Sched& S, const Epi& E) {
    int tid_ = threadIdx.x; asm volatile("" : "+v"(tid_));
    const int tid = tid_, wid = __builtin_amdgcn_readfirstlane(tid >> 6), lane = tid & 63, wr = wid >> 2, wc = wid & 3, fr = lane & 15, fq = lane >> 4;
    int K_ = KK; asm volatile("" : "+s"(K_));
    const int K = K_, nt = K / BK;
    unsigned vA[2][2], vN[2][2], voffB[2]; int stR[2], stC[2];
#pragma unroll
    for (int i = 0; i < 2; ++i) { int R, C; stage_rc(tid * 16 + i * 8192, R, C); const int Rb = Epi::PERM ? ((R & ~31) + perm32(R & 31)) : R; stR[i] = R; stC[i] = C;
        voffB[i] = (unsigned)(Rb * K + C) * 2u;
#pragma unroll
        for (int h = 0; h < 2; ++h) { vA[h][i] = (unsigned)((h * HALF + R) * K + C) * 2u; if constexpr (Sched::GATHER) vN[h][i] = vA[h][i]; } }
    const size_t kstep = (size_t)(BK * 2);
    const size_t hstep = (size_t)HALF * K * 2;
    const size_t tstep = 2 * hstep;
    const unsigned ldsw = (unsigned)wid * 1024u;
    const int aoff = lds_byte(wr * 64 + fr, fq * 8), boff = lds_byte(wc * 32 + fr, fq * 8);
#define PG8_SA(b, h) (((b) * 2 + (h)) * HTB)
#define PG8_SB(b, h) ((4 + (b) * 2 + (h)) * HTB)
#define PG8_STAGE(bufoff, gbase, voff) do { _Pragma("unroll") for (int _i = 0; _i < 2; ++_i) \
        __builtin_amdgcn_global_load_lds((const unsigned*)((const char*)(gbase) + (voff)[_i]), (PG8_LAS unsigned*)(lds + (bufoff) + ldsw + _i * 8192), 16, 0, 0); } while (0)
    typedef int v8i_ __attribute__((ext_vector_type(8))); typedef int v4i_ __attribute__((ext_vector_type(4)));
#define PG8_LDA(dst, b, h) do { if constexpr (FP8) { _Pragma("unroll") for (int m = 0; m < 4; ++m) { const v4i_ lo_ = *(const PG8_LAS v4i_*)(lds + PG8_SA(b, h) + aoff + m * 2048), hi_ = *(const PG8_LAS v4i_*)(lds + PG8_SA(b, h) + aoff + m * 2048 + 1024); dst##8[m] = __builtin_shufflevector(lo_, hi_, 0, 1, 2, 3, 4, 5, 6, 7); } } \
        else { _Pragma("unroll") for (int m = 0; m < 4; ++m) _Pragma("unroll") for (int k = 0; k < 2; ++k) dst[m][k] = *(const PG8_LAS bf16x8*)(lds + PG8_SA(b, h) + aoff + m * 2048 + k * 1024); } } while (0)
#define PG8_LDB(dst, b, h) do { if constexpr (FP8) { _Pragma("unroll") for (int n = 0; n < 2; ++n) { const v4i_ lo_ = *(const PG8_LAS v4i_*)(lds + PG8_SB(b, h) + boff + n * 2048), hi_ = *(const PG8_LAS v4i_*)(lds + PG8_SB(b, h) + boff + n * 2048 + 1024); dst##8[n] = __builtin_shufflevector(lo_, hi_, 0, 1, 2, 3, 4, 5, 6, 7); } } \
        else { _Pragma("unroll") for (int n = 0; n < 2; ++n) _Pragma("unroll") for (int k = 0; k < 2; ++k) dst[n][k] = *(const PG8_LAS bf16x8*)(lds + PG8_SB(b, h) + boff + n * 2048 + k * 1024); } } while (0)
#define PG8_MMA(ai, bj, At, Bt) do { __builtin_amdgcn_s_setprio(1); \
        if constexpr (FP8) { _Pragma("unroll") for (int m = 0; m < 4; ++m) _Pragma("unroll") for (int n = 0; n < 2; ++n) \
            asm volatile("v_mfma_scale_f32_16x16x128_f8f6f4 %0, %1, %2, %0, %3, %4 op_sel_hi:[0,0,0]" : "+v"(acc[ai][bj][m][n]) : "v"(Bt##8[n]), "v"(At##8[m]), "v"(f8sb), "v"(f8sa)); } \
        else { _Pragma("unroll") for (int m = 0; m < 4; ++m) _Pragma("unroll") for (int n = 0; n < 2; ++n) _Pragma("unroll") for (int k = 0; k < 2; ++k) \
            acc[ai][bj][m][n] = __builtin_amdgcn_mfma_f32_16x16x32_bf16(Bt[n][k], At[m][k], acc[ai][bj][m][n], 0, 0, 0); } \
        __builtin_amdgcn_s_setprio(0); } while (0)
#define PG8_WAIT_V(n) asm volatile("s_waitcnt vmcnt(" #n ")" ::: "memory")
#define PG8_WAIT_L(n) asm volatile("s_waitcnt lgkmcnt(" #n ")" ::: "memory")
#define PG8_BAR __builtin_amdgcn_s_barrier()
#define PG8_SCHED __builtin_amdgcn_sched_barrier(0)
    Unit cur, nxt; int ui = 0;
    if (!S.next(0, cur)) return;
    f32x4 acc[2][2][4][2];
#pragma unroll
    for (int a = 0; a < 2; ++a)
#pragma unroll
        for (int b = 0; b < 2; ++b)
#pragma unroll
            for (int m = 0; m < 4; ++m)
#pragma unroll
                for (int n = 0; n < 2; ++n) acc[a][b][m][n] = (f32x4){0.f, 0.f, 0.f, 0.f};
    const int f8sa = FP8_SCALE_A, f8sb = FP8_SCALE_B;
    bf16x8 At[4][2], B0[2][2], B1[2][2]; v8i_ At8[4], B08[2], B18[2];
    const char* cA = S.a_ptr(cur); const char* cB = S.b_ptr(cur);
    if constexpr (Sched::GATHER) {
        PG8_LAS int* rid = (PG8_LAS int*)(lds + STAGE_BYTES);
        { Unit t_; for (int i = 0; i < Sched::MAXU && S.next(i, t_); ++i) if (tid < 256) rid[i * 256 + tid] = S.row_of(t_, tid); }
        asm volatile("s_waitcnt vmcnt(0) lgkmcnt(0)" ::: "memory"); PG8_BAR; asm volatile("" ::: "memory");
#pragma unroll
        for (int i = 0; i < 2; ++i)
#pragma unroll
            for (int h = 0; h < 2; ++h) vA[h][i] = (unsigned)(rid[h * HALF + stR[i]] * K + stC[i]) * 2u;
    }
    S.a_ready(cur);
    if constexpr (SP2) {
        PG8_STAGE(PG8_SB(0, 0), cB, voffB); PG8_STAGE(PG8_SB(0, 1), cB + hstep, voffB); PG8_STAGE(PG8_SA(0, 0), cA, vA[0]); PG8_STAGE(PG8_SA(0, 1), cA, vA[1]);
        if (wr == 1) PG8_BAR;
        PG8_WAIT_V(2); PG8_BAR;
        PG8_STAGE(PG8_SB(1, 0), cB + kstep, voffB); PG8_STAGE(PG8_SA(1, 0), cA + kstep, vA[0]); PG8_STAGE(PG8_SB(1, 1), cB + hstep + kstep, voffB);
        PG8_WAIT_V(6); PG8_BAR;
    } else {
        PG8_STAGE(PG8_SB(0, 0), cB, voffB); PG8_STAGE(PG8_SA(0, 0), cA, vA[0]); PG8_STAGE(PG8_SB(0, 1), cB + hstep, voffB); PG8_STAGE(PG8_SA(0, 1), cA, vA[1]);
        if (wr == 1) PG8_BAR;
        PG8_WAIT_V(4); PG8_BAR;
        PG8_STAGE(PG8_SB(1, 0), cB + kstep, voffB); PG8_STAGE(PG8_SA(1, 0), cA + kstep, vA[0]); PG8_STAGE(PG8_SB(1, 1), cB + hstep + kstep, voffB);
        PG8_WAIT_V(6); PG8_BAR;
    }
    for (;;) {
        const bool has_next = S.next(ui + 1, nxt);
        const char* nA = has_next ? S.a_ptr(nxt) : cA; const char* nB = has_next ? S.b_ptr(nxt) : cB;
        if constexpr (Sched::GATHER) { const PG8_LAS int* rid = (const PG8_LAS int*)(lds + STAGE_BYTES) + (has_next ? (ui + 1) : ui) * 256;
#pragma unroll
            for (int i = 0; i < 2; ++i)
#pragma unroll
                for (int h = 0; h < 2; ++h) vN[h][i] = (unsigned)(rid[h * HALF + stR[i]] * K + stC[i]) * 2u; }
        for (int t = 0; t < nt; t += 2) {
            const bool last = (t == nt - 2);
            const char* a1 = cA + (size_t)(t + 1) * kstep;
            const char* a2 = last ? nA : cA + (size_t)(t + 2) * kstep; const char* b2 = last ? nB : cB + (size_t)(t + 2) * kstep;
            const char* a3 = a2 + kstep; const char* b3 = b2 + kstep;
            unsigned vS[2][2];
#pragma unroll
            for (int i = 0; i < 2; ++i) { if constexpr (Sched::GATHER) { vS[0][i] = last ? vN[0][i] : vA[0][i]; vS[1][i] = last ? vN[1][i] : vA[1][i]; } else { vS[0][i] = vA[0][i]; vS[1][i] = vA[1][i]; } }
            if (last && has_next) S.a_ready(nxt);
            if constexpr (SP2) {
            PG8_LDB(B0, 0, 0); PG8_LDB(B1, 0, 1); PG8_SCHED; PG8_LDA(At, 0, 0); PG8_STAGE(PG8_SA(1, 1), a1, vA[1]);
            PG8_WAIT_V(8); PG8_WAIT_L(0); PG8_BAR; PG8_MMA(0, 0, At, B0); PG8_MMA(0, 1, At, B1); PG8_BAR; PG8_SCHED;
            PG8_LDA(At, 0, 1); PG8_STAGE(PG8_SB(0, 0), b2, voffB); PG8_STAGE(PG8_SB(0, 1), b2 + hstep, voffB); PG8_STAGE(PG8_SA(0, 0), a2, vS[0]);
            PG8_WAIT_V(8); PG8_WAIT_L(0); PG8_BAR; PG8_MMA(1, 0, At, B0); PG8_MMA(1, 1, At, B1); PG8_BAR; PG8_SCHED;
            PG8_LDB(B0, 1, 0); PG8_LDB(B1, 1, 1); PG8_SCHED; PG8_LDA(At, 1, 0); PG8_STAGE(PG8_SA(0, 1), a2, vS[1]);
            PG8_WAIT_V(8); PG8_WAIT_L(0); PG8_BAR; PG8_MMA(0, 0, At, B0); PG8_MMA(0, 1, At, B1); PG8_BAR; PG8_SCHED;
            PG8_LDA(At, 1, 1); PG8_STAGE(PG8_SB(1, 0), b3, voffB); PG8_STAGE(PG8_SB(1, 1), b3 + hstep, voffB); PG8_STAGE(PG8_SA(1, 0), a3, vS[0]);
            PG8_WAIT_V(8); PG8_WAIT_L(0); PG8_BAR; PG8_MMA(1, 0, At, B0); PG8_MMA(1, 1, At, B1); PG8_BAR; PG8_SCHED;
            } else {
            PG8_LDB(B0, 0, 0); PG8_SCHED; PG8_LDA(At, 0, 0); PG8_STAGE(PG8_SA(1, 1), a1, vA[1]);
            PG8_WAIT_L(8); PG8_BAR; PG8_WAIT_L(0); PG8_MMA(0, 0, At, B0); PG8_BAR; PG8_SCHED;
            PG8_LDB(B1, 0, 1); PG8_STAGE(PG8_SB(0, 0), b2, voffB);
            PG8_BAR; PG8_WAIT_L(0); PG8_MMA(0, 1, At, B1); PG8_BAR;
            PG8_LDA(At, 0, 1); PG8_STAGE(PG8_SA(0, 0), a2, vS[0]);
            PG8_BAR; PG8_WAIT_L(0); PG8_MMA(1, 0, At, B0); PG8_BAR; PG8_SCHED;
            PG8_STAGE(PG8_SB(0, 1), b2 + hstep, voffB);
            PG8_WAIT_V(6); PG8_BAR; PG8_MMA(1, 1, At, B1); PG8_BAR;
            PG8_LDB(B0, 1, 0); PG8_SCHED; PG8_LDA(At, 1, 0); PG8_STAGE(PG8_SA(0, 1), a2, vS[1]);
            PG8_WAIT_L(8); PG8_BAR; PG8_WAIT_L(0); PG8_MMA(0, 0, At, B0); PG8_BAR; PG8_SCHED;
            PG8_LDB(B1, 1, 1); PG8_STAGE(PG8_SB(1, 0), b3, voffB);
            PG8_BAR; PG8_WAIT_L(0); PG8_MMA(0, 1, At, B1); PG8_BAR;
            PG8_LDA(At, 1, 1); PG8_STAGE(PG8_SA(1, 0), a3, vS[0]);
            PG8_BAR; PG8_WAIT_L(0); PG8_MMA(1, 0, At, B0); PG8_BAR; PG8_SCHED;
            PG8_STAGE(PG8_SB(1, 1), b3 + hstep, voffB);
            PG8_WAIT_V(6); PG8_BAR; PG8_MMA(1, 1, At, B1); PG8_BAR;
            }
        }
        if constexpr (FP8) asm volatile("s_nop 15\n\ts_nop 15\n\ts_nop 15" ::: "memory");
        if constexpr (ALIGN_EPI) { if (wr == 0) PG8_BAR; }
        if constexpr (!Epi::AFTER_DRAIN) { E(acc, cur, wr, wc, fr, fq); S.done(cur); }
        if (!has_next) break;
#pragma unroll
        for (int a = 0; a < 2; ++a)
#pragma unroll
            for (int b = 0; b < 2; ++b)
#pragma unroll
                for (int m = 0; m < 4; ++m)
#pragma unroll
                    for (int n = 0; n < 2; ++n) acc[a][b][m][n] = zero4();
        cur = nxt; cA = nA; cB = nB; ++ui;
        if constexpr (Sched::GATHER) {
#pragma unroll
            for (int i = 0; i < 2; ++i) { vA[0][i] = vN[0][i]; vA[1][i] = vN[1][i]; } }
        if constexpr (ALIGN_EPI) { if (wr == 1) PG8_BAR; }
    }
    PG8_WAIT_V(0);
    if constexpr (!ALIGN_EPI) { if (wr == 0) PG8_BAR; }
    PG8_BAR;
    if constexpr (Epi::AFTER_DRAIN) { E.fused(acc, cur, wr, wc, fr, fq, lds, wid, lane); S.done(cur); }
#undef PG8_SA
#undef PG8_SB
#undef PG8_STAGE
#undef PG8_LDA
#undef PG8_LDB
#undef PG8_MMA
#undef PG8_WAIT_V
#undef PG8_WAIT_L
#undef PG8_BAR
#undef PG8_SCHED
}
}

constexpr int NWAVES = 8;
constexpr int BATCH = 8, SEQ = 8192, D = 1024, T = BATCH * SEQ;
constexpr int IN_TOTAL = 10768, NP1 = 7936;
constexpr int NSLOT = 2 * T + 4096;
constexpr int NPH = 18;
#ifndef MK_N_LAUNCHES
#define MK_N_LAUNCHES 1
#endif
constexpr int N_LAUNCHES = MK_N_LAUNCHES;
static_assert(N_LAUNCHES == 1 || N_LAUNCHES == NPH, "MK_N_LAUNCHES is 1 or NPH");
constexpr int DNU = 73728;

constexpr size_t MiB = 1u << 20;
constexpr size_t WS_CTL = 0, CTL_ZERO_BYTES = 1 * MiB;
constexpr size_t WS_ROWS = 131072;
constexpr size_t WS_BTP1 = 1 * MiB;
constexpr size_t WS_BTZ = 17 * MiB, WS_BTGA = 19 * MiB, WS_BTGB = 21 * MiB, WS_BTB = 23 * MiB, WS_BTOUT = 25 * MiB, WS_BTPG = 27 * MiB;
constexpr size_t WS_BTA = 29 * MiB;
constexpr size_t WS_BTPLE = 30 * MiB;
constexpr size_t WS_BTGU = 31 * MiB;
constexpr size_t WS_BTDN = 47 * MiB;
constexpr size_t WS_QA = 56 * MiB;
constexpr size_t WS_DNP = 56 * MiB;
constexpr size_t WS_M = 56 * MiB;
constexpr size_t WS_H3 = 56 * MiB;
constexpr size_t WS_H2 = 184 * MiB;
constexpr size_t WS_PB = 184 * MiB;
constexpr size_t WS_E1 = 216 * MiB;
constexpr size_t WS_D10 = 312 * MiB;
constexpr size_t WS_HX = 312 * MiB;
constexpr size_t WS_ACT = 576 * MiB;
constexpr size_t WS_Y = 642 * MiB;
constexpr size_t WS_QB = 632 * MiB;
constexpr size_t WS_ON = 632 * MiB;
constexpr size_t WS_OA = 760 * MiB;
constexpr size_t WS_HR8 = 952 * MiB;
constexpr size_t WS_X1 = 824 * MiB;
constexpr size_t WS_HR = 824 * MiB;
constexpr size_t WS_BG = 1016 * MiB;
constexpr size_t WS_TOK = 1020 * MiB;
constexpr size_t WS_SLOT = 1021 * MiB;
constexpr size_t WS_CW = 1021 * MiB + 512 * 1024;
constexpr size_t WS_DLB = 1022 * MiB + 256 * 1024;
constexpr size_t WS_END = 1024 * MiB;
static_assert(WS_ROWS + (size_t)NSLOT * 4 <= CTL_ZERO_BYTES && WS_Y + (size_t)NSLOT * 2048 <= WS_BG && WS_HX + (size_t)NSLOT * 2048 <= WS_ACT && WS_ACT + (size_t)NSLOT * 512 <= WS_Y && WS_HR + (size_t)T * 2048 <= WS_BG && WS_CW + (size_t)NSLOT * 4 <= WS_DLB, "d_ws map");
constexpr size_t DO_H = 0, DO_OG = 0, DO_LSE = 192 * MiB, DO_G1 = 0, DO_G2 = 64 * MiB, DO_M1 = 128 * MiB;
constexpr int CW_BAR = 4096;
constexpr int CW_CNT = 16384;
constexpr int CW_CUR = 16384 + 64;
constexpr int CW_SUB2 = 16384 + 320;
constexpr int CW_SUB = 16384 + 256;
constexpr int RING_OFF = 0, RING_BYTES = 131072;
constexpr int LDS_BYTES = 147456;
constexpr int MISC_OFF = LDS_BYTES - 256;

#define GAS __attribute__((address_space(1)))
#define LAS __attribute__((address_space(3)))
typedef unsigned short bf16;
typedef unsigned v4u __attribute__((ext_vector_type(4)));
typedef unsigned v2u __attribute__((ext_vector_type(2)));
typedef float f32x4 __attribute__((ext_vector_type(4)));
typedef float f32x16 __attribute__((ext_vector_type(16)));
typedef short bf16x8 __attribute__((ext_vector_type(8)));
typedef short s16x4 __attribute__((ext_vector_type(4)));
typedef GAS unsigned gu32;
#define RLX_AGENT __ATOMIC_RELAXED, __HIP_MEMORY_SCOPE_AGENT
using pg8::cvt_pk_bf16; using pg8::bflo; using pg8::bfhi; using pg8::pack8; using pg8::unpack8; using pg8::sigm;
__device__ __forceinline__ float bf2f(unsigned short b) { return __uint_as_float(((unsigned)b) << 16); }
__device__ __forceinline__ unsigned short f2bf(float f) { return (unsigned short)(cvt_pk_bf16(f, 0.f) & 0xffffu); }
__device__ __forceinline__ int crow(int r, int hi) { return (r & 3) + 8 * (r >> 2) + 4 * hi; }
template <int CTRL> __device__ __forceinline__ float dpp_mov(float v) { return __builtin_bit_cast(float, __builtin_amdgcn_update_dpp(0, __builtin_bit_cast(int, v), CTRL, 0xF, 0xF, true)); }
__device__ __forceinline__ f32x16 zero16() { typedef unsigned long long u64x8_ __attribute__((ext_vector_type(8))); unsigned long long z0, z1, z2, z3, z4, z5, z6, z7;
    asm volatile("v_mov_b64 %0, 0\n\tv_mov_b64 %1, 0\n\tv_mov_b64 %2, 0\n\tv_mov_b64 %3, 0\n\tv_mov_b64 %4, 0\n\tv_mov_b64 %5, 0\n\tv_mov_b64 %6, 0\n\tv_mov_b64 %7, 0" : "=v"(z0), "=v"(z1), "=v"(z2), "=v"(z3), "=v"(z4), "=v"(z5), "=v"(z6), "=v"(z7));
    return __builtin_bit_cast(f32x16, (u64x8_){z0, z1, z2, z3, z4, z5, z6, z7}); }
__device__ __forceinline__ float wave_sum(float v) {
    v += dpp_mov<0xB1>(v); v += dpp_mov<0x4E>(v); v += dpp_mov<0x141>(v); v += dpp_mov<0x140>(v);
    const int iv = __builtin_bit_cast(int, v);
    const float r0 = __builtin_bit_cast(float, __builtin_amdgcn_readlane(iv, 0)), r1 = __builtin_bit_cast(float, __builtin_amdgcn_readlane(iv, 16)), r2 = __builtin_bit_cast(float, __builtin_amdgcn_readlane(iv, 32)), r3 = __builtin_bit_cast(float, __builtin_amdgcn_readlane(iv, 48));
    return (r0 + r1) + (r2 + r3);
}
__device__ __forceinline__ s16x4 ldtr(const LAS unsigned char* p) { return __builtin_bit_cast(s16x4, __builtin_amdgcn_ds_read_tr16_b64_v4i16((LAS s16x4*)p)); }
#define MFMA32(a, b, c) __builtin_amdgcn_mfma_f32_32x32x16_bf16((a), (b), (c), 0, 0, 0)

#define XB_TMO      128
#define XB_XCNT(j)  (256  + 64 * (j))
#define XB_XSUB(j)  (1280 + 64 * (j))
#define XB_XGEN(j)  (2304 + 64 * (j))
#define XB_TOP      3328
#define XB_TOPGEN   3392
#define XCD_BAR_WORDS 3456
#define XB_SPIN_CAP (1u << 18)

__device__ __forceinline__ unsigned xb_ld(unsigned* p)              { return __hip_atomic_load(p, __ATOMIC_RELAXED, __HIP_MEMORY_SCOPE_AGENT); }
__device__ __forceinline__ unsigned xb_add(unsigned* p, unsigned v) { return __hip_atomic_fetch_add(p, v, __ATOMIC_RELAXED, __HIP_MEMORY_SCOPE_AGENT); }
__device__ __forceinline__ unsigned xb_xcc_id() { return (unsigned)__builtin_amdgcn_s_getreg((3 << 11) | 20) & 0xFu; }
#define XB_SPIN(cond, bar) do { unsigned _sp = 0; while (cond) { __builtin_amdgcn_s_sleep(1); \
    if ((++_sp & 255u) == 0u) { if (xb_ld(&(bar)[XB_TMO])) break; if (_sp > XB_SPIN_CAP) { atomicAdd(&(bar)[XB_TMO], 1u); break; } } } } while (0)

struct XcdBarrier {
    unsigned* bar; unsigned x;
    volatile LAS unsigned* st;
};

__device__ __forceinline__ XcdBarrier xcd_barrier_post(unsigned* bar, volatile LAS unsigned* st) {
    XcdBarrier b; b.bar = bar; b.x = xb_xcc_id(); b.st = st;
    if (threadIdx.x == 0) (void)xb_add(&bar[XB_XCNT(b.x)], 1u);
    return b;
}
__device__ __forceinline__ void xcd_barrier_complete(unsigned* bar, unsigned x, unsigned& nloc, unsigned& nx) {
    const unsigned G = gridDim.x * gridDim.y * gridDim.z;
    unsigned sum, cnt, mine, sp = 0u;
    for (;;) {
        sum = 0u; cnt = 0u; mine = 0u;
#pragma unroll
        for (unsigned j = 0; j < 16; ++j) { const unsigned c = xb_ld(&bar[XB_XCNT(j)]); sum += c; cnt += (c > 0u) ? 1u : 0u; mine = (j == x) ? c : mine; }
        if (sum == G) break;
        __builtin_amdgcn_s_sleep(1);
        if ((++sp & 255u) == 0u) { if (xb_ld(&bar[XB_TMO])) break; if (sp > XB_SPIN_CAP) { atomicAdd(&bar[XB_TMO], 1u); break; } }
    }
    nloc = mine > 0u ? mine : 1u; nx = cnt > 0u ? cnt : 1u;
}

__device__ __forceinline__ void xcd_barrier(const XcdBarrier& b) {
    asm volatile("s_waitcnt vmcnt(0)" ::: "memory");
    __syncthreads();
    if (threadIdx.x == 0) {
        unsigned* bar = b.bar;
        __builtin_amdgcn_s_waitcnt(0);
        unsigned nloc = b.st[0], nx = b.st[1];
        if (nloc == 0u) { xcd_barrier_complete(bar, b.x, nloc, nx); b.st[0] = nloc; b.st[1] = nx; }
        const unsigned old = xb_add(&bar[XB_XSUB(b.x)], 1u);
        const unsigned gen = old / nloc;
        if (old + 1u == (gen + 1u) * nloc) {
            __builtin_amdgcn_fence(__ATOMIC_RELEASE, "agent");
            asm volatile("s_waitcnt vmcnt(0)" ::: "memory");
            const unsigned og = xb_add(&bar[XB_TOP], 1u);
            const unsigned tg = og / nx;
            if (og + 1u == (tg + 1u) * nx) xb_add(&bar[XB_TOPGEN], 1u);
            else XB_SPIN(xb_ld(&bar[XB_TOPGEN]) == tg, bar);
            __builtin_amdgcn_fence(__ATOMIC_ACQUIRE, "agent");
            xb_add(&bar[XB_XGEN(b.x)], 1u);
            asm volatile("s_waitcnt vmcnt(0)" ::: "memory");
        } else {
            XB_SPIN(xb_ld(&bar[XB_XGEN(b.x)]) == gen, bar);
            __builtin_amdgcn_fence(__ATOMIC_ACQUIRE, "agent");
            asm volatile("s_waitcnt vmcnt(0)" ::: "memory");
        }
    }
    __syncthreads();
}

#ifdef FP8_EMU2
#define EMU2(x) (x)
#else
#define EMU2(x) 0.f
#endif
#ifndef FP8_EMU_W
#define FP8_EMU_W 0.f
#endif
#ifndef FP8_EMU_H
#define FP8_EMU_H 0.f
#endif
__device__ __forceinline__ float fp8_rt(float v, float sc) { const int w = __builtin_amdgcn_cvt_pk_fp8_f32(v * sc, 0.f, 0, false); return __builtin_amdgcn_cvt_f32_fp8(w, 0) / sc; }
__device__ __forceinline__ void p0_tr_item(const float* W, int ld, int K, int scol, bf16* WT, int drow, int k0, LAS float* scr, int lane, float emu = 0.f) {
    { f32x4 wv[8]; const int r8 = lane >> 3, c4 = (lane & 7) * 4;
#pragma unroll
      for (int i = 0; i < 8; ++i) wv[i] = *(const GAS f32x4*)(W + (size_t)(k0 + r8 + 8 * i) * ld + scol + c4);
#pragma unroll
      for (int i = 0; i < 8; ++i) {
#pragma unroll
          for (int e = 0; e < 4; ++e) { float x_ = wv[i][e]; if (emu != 0.f) x_ = fp8_rt(x_, emu); scr[(r8 + 8 * i) * 33 + c4 + e] = x_; } } }
    asm volatile("s_waitcnt lgkmcnt(0)" ::: "memory");
    const int c = lane & 7;
#pragma unroll
    for (int j = 0; j < 4; ++j) { const int n = (lane >> 3) + 8 * j; const LAS float* s = scr + (8 * c) * 33 + n;
        v4u o; o.x = cvt_pk_bf16(s[0 * 33], s[1 * 33]); o.y = cvt_pk_bf16(s[2 * 33], s[3 * 33]); o.z = cvt_pk_bf16(s[4 * 33], s[5 * 33]); o.w = cvt_pk_bf16(s[6 * 33], s[7 * 33]);
        *(GAS v4u*)(WT + (size_t)(drow + n) * K + k0 + 8 * c) = o; }
    asm volatile("s_waitcnt lgkmcnt(0)" ::: "memory");
}
__device__ __forceinline__ void p0_tr_item_f8(const float* W, int ld, int K, int scol, unsigned char* WT, int drow, int k0, LAS float* scr, int lane, float sc) {
    { f32x4 wv[8]; const int r8 = lane >> 3, c4 = (lane & 7) * 4;
#pragma unroll
      for (int i = 0; i < 8; ++i) wv[i] = *(const GAS f32x4*)(W + (size_t)(k0 + r8 + 8 * i) * ld + scol + c4);
#pragma unroll
      for (int i = 0; i < 8; ++i) {
#pragma unroll
          for (int e = 0; e < 4; ++e) scr[(r8 + 8 * i) * 33 + c4 + e] = wv[i][e] * sc; } }
    asm volatile("s_waitcnt lgkmcnt(0)" ::: "memory");
    const int c = lane & 7;
#pragma unroll
    for (int j = 0; j < 4; ++j) { const int n = (lane >> 3) + 8 * j; const LAS float* s = scr + (8 * c) * 33 + n;
        int w0 = __builtin_amdgcn_cvt_pk_fp8_f32(s[0 * 33], s[1 * 33], 0, false); w0 = __builtin_amdgcn_cvt_pk_fp8_f32(s[2 * 33], s[3 * 33], w0, true);
        int w1 = __builtin_amdgcn_cvt_pk_fp8_f32(s[4 * 33], s[5 * 33], 0, false); w1 = __builtin_amdgcn_cvt_pk_fp8_f32(s[6 * 33], s[7 * 33], w1, true);
        *(GAS v2u*)(WT + (size_t)(drow + n) * K + k0 + 8 * c) = (v2u){(unsigned)w0, (unsigned)w1}; }
    asm volatile("s_waitcnt lgkmcnt(0)" ::: "memory");
}
__device__ __forceinline__ void rms_rows_to_f8(const float* X, const float* gain, unsigned char* O, int first, int stride, int lane, float sc) {
    const GAS f32x4* gr = (const GAS f32x4*)gain + lane; f32x4 g[4];
#pragma unroll
    for (int j = 0; j < 4; ++j) g[j] = gr[64 * j] * sc;
    auto load_row = [&](f32x4 (&n)[4], const int m) { const GAS f32x4* xr = (const GAS f32x4*)(X + (size_t)m * D) + lane;
#pragma unroll
        for (int j = 0; j < 4; ++j) n[j] = xr[64 * j]; };
    auto proc_row = [&](const f32x4 (&v)[4], const int m) { float s = 0.f;
#pragma unroll
        for (int j = 0; j < 4; ++j) s += (v[j].x * v[j].x + v[j].y * v[j].y) + (v[j].z * v[j].z + v[j].w * v[j].w);
        const float rs = rsqrtf(wave_sum(s) * (1.f / D) + 1e-6f);
        GAS unsigned* o4 = (GAS unsigned*)(O + (size_t)m * D) + lane;
#pragma unroll
        for (int j = 0; j < 4; ++j) { int w = __builtin_amdgcn_cvt_pk_fp8_f32(v[j].x * rs * g[j].x, v[j].y * rs * g[j].y, 0, false); w = __builtin_amdgcn_cvt_pk_fp8_f32(v[j].z * rs * g[j].z, v[j].w * rs * g[j].w, w, true); o4[64 * j] = (unsigned)w; } };
    f32x4 nA[4], nB[4];
    if (first < T) load_row(nA, first);
    if (first + stride < T) load_row(nB, first + stride);
    for (int m = first; m < T; m += 2 * stride) {
        { f32x4 v[4];
#pragma unroll
          for (int j = 0; j < 4; ++j) v[j] = nA[j];
          if (m + 2 * stride < T) load_row(nA, m + 2 * stride);
          proc_row(v, m); }
        if (m + stride < T) { f32x4 v[4];
#pragma unroll
          for (int j = 0; j < 4; ++j) v[j] = nB[j];
          if (m + 3 * stride < T) load_row(nB, m + 3 * stride);
          proc_row(v, m + stride); }
    }
}
__device__ __forceinline__ void rms_rows_to_both(const float* X, const float* gain, bf16* O, unsigned char* O8, int first, int stride, int lane, float sc) {
    const GAS f32x4* gr = (const GAS f32x4*)gain + lane; f32x4 g[4];
#pragma unroll
    for (int j = 0; j < 4; ++j) g[j] = gr[64 * j];
    auto load_row = [&](f32x4 (&n)[4], const int m) { const GAS f32x4* xr = (const GAS f32x4*)(X + (size_t)m * D) + lane;
#pragma unroll
        for (int j = 0; j < 4; ++j) n[j] = xr[64 * j]; };
    auto proc_row = [&](const f32x4 (&v)[4], const int m) { float s = 0.f;
#pragma unroll
        for (int j = 0; j < 4; ++j) s += (v[j].x * v[j].x + v[j].y * v[j].y) + (v[j].z * v[j].z + v[j].w * v[j].w);
        const float rs = rsqrtf(wave_sum(s) * (1.f / D) + 1e-6f);
        GAS v2u* o8 = (GAS v2u*)(O + (size_t)m * D) + lane; GAS unsigned* o4 = (GAS unsigned*)(O8 + (size_t)m * D) + lane;
#pragma unroll
        for (int j = 0; j < 4; ++j) { const f32x4 q_ = v[j] * rs * g[j]; v2u w; w.x = cvt_pk_bf16(q_.x, q_.y); w.y = cvt_pk_bf16(q_.z, q_.w); o8[64 * j] = w;
            int w8 = __builtin_amdgcn_cvt_pk_fp8_f32(q_.x * sc, q_.y * sc, 0, false); w8 = __builtin_amdgcn_cvt_pk_fp8_f32(q_.z * sc, q_.w * sc, w8, true); o4[64 * j] = (unsigned)w8; } };
    f32x4 nA[4], nB[4];
    if (first < T) load_row(nA, first);
    if (first + stride < T) load_row(nB, first + stride);
    for (int m = first; m < T; m += 2 * stride) {
        { f32x4 v[4];
#pragma unroll
          for (int j = 0; j < 4; ++j) v[j] = nA[j];
          if (m + 2 * stride < T) load_row(nA, m + 2 * stride);
          proc_row(v, m); }
        if (m + stride < T) { f32x4 v[4];
#pragma unroll
          for (int j = 0; j < 4; ++j) v[j] = nB[j];
          if (m + 3 * stride < T) load_row(nB, m + 3 * stride);
          proc_row(v, m + stride); }
    }
}
__device__ __forceinline__ void rms_row_to_bf16(const float* xrow, const float* gain, bf16* orow, int lane) {
    const GAS f32x4* xr = (const GAS f32x4*)xrow + lane; const GAS f32x4* gr = (const GAS f32x4*)gain + lane;
    f32x4 v[4]; float s = 0.f;
#pragma unroll
    for (int j = 0; j < 4; ++j) { v[j] = xr[64 * j]; s += (v[j].x * v[j].x + v[j].y * v[j].y) + (v[j].z * v[j].z + v[j].w * v[j].w); }
    const float rs = rsqrtf(wave_sum(s) * (1.f / D) + 1e-6f);
    GAS v2u* o8 = (GAS v2u*)orow + lane;
#pragma unroll
    for (int j = 0; j < 4; ++j) { const f32x4 g = gr[64 * j]; v2u w; w.x = cvt_pk_bf16(v[j].x * rs * g.x, v[j].y * rs * g.y); w.y = cvt_pk_bf16(v[j].z * rs * g.z, v[j].w * rs * g.w); o8[64 * j] = w; }
}

__device__ __forceinline__ void rms_rows_to_bf16(const float* X, const float* gain, bf16* O, int first, int stride, int lane, float emu = 0.f) {
    const GAS f32x4* gr = (const GAS f32x4*)gain + lane; f32x4 g[4];
#pragma unroll
    for (int j = 0; j < 4; ++j) g[j] = gr[64 * j];
    f32x4 nx[4];
    if (first < T) { const GAS f32x4* xr = (const GAS f32x4*)(X + (size_t)first * D) + lane;
#pragma unroll
        for (int j = 0; j < 4; ++j) nx[j] = xr[64 * j]; }
    for (int m = first; m < T; m += stride) {
        f32x4 v[4]; float s = 0.f;
#pragma unroll
        for (int j = 0; j < 4; ++j) v[j] = nx[j];
        if (m + stride < T) { const GAS f32x4* xr = (const GAS f32x4*)(X + (size_t)(m + stride) * D) + lane;
#pragma unroll
            for (int j = 0; j < 4; ++j) nx[j] = xr[64 * j]; }
#pragma unroll
        for (int j = 0; j < 4; ++j) s += (v[j].x * v[j].x + v[j].y * v[j].y) + (v[j].z * v[j].z + v[j].w * v[j].w);
        const float rs = rsqrtf(wave_sum(s) * (1.f / D) + 1e-6f);
        GAS v2u* o8 = (GAS v2u*)(O + (size_t)m * D) + lane;
#pragma unroll
        for (int j = 0; j < 4; ++j) { float a0 = v[j].x * rs * g[j].x, a1 = v[j].y * rs * g[j].y, a2 = v[j].z * rs * g[j].z, a3 = v[j].w * rs * g[j].w;
            if (emu != 0.f) { a0 = fp8_rt(a0, emu); a1 = fp8_rt(a1, emu); a2 = fp8_rt(a2, emu); a3 = fp8_rt(a3, emu); }
            v2u w; w.x = cvt_pk_bf16(a0, a1); w.y = cvt_pk_bf16(a2, a3); o8[64 * j] = w; }
    }
}

struct Ptrs {
    const float* in[24]; float* out; unsigned char* ws;
};

__device__ __forceinline__ void p0_prologue(const Ptrs& P, LAS unsigned char* lds, int G, int c, int wave, int lane) {
    LAS float* scr = (LAS float*)(lds + wave * 16384);
    const int gw = c * NWAVES + wave, NGW = G * NWAVES;
    const float* w_in = P.in[3];
    bf16* BTP1 = (bf16*)(P.ws + WS_BTP1);
#ifdef P1_FP8
#define P1_TR(scol, drow, k0) p0_tr_item_f8(w_in, IN_TOTAL, D, (scol), (unsigned char*)BTP1, (drow), (k0), scr, lane, 64.0f)
#else
#define P1_TR(scol, drow, k0) p0_tr_item(w_in, IN_TOTAL, D, (scol), BTP1, (drow), (k0), scr, lane, FP8_EMU_W)
#endif
    constexpr int I_QK = 16 * 96, I_VB = 16 * 144, I_BA = 16, I_Z = 16 * 32, I_A = 8 * 32, I_SQ = 16 * 32, I_PLE = 4 * 32, I_EG = 16 * 16 * 8, I_ED = 16 * 4 * 32;
    constexpr int NITEMS = I_QK + I_VB + I_BA + 3 * I_Z + I_A + 3 * I_SQ + I_PLE + 2 * I_EG + I_ED;
    for (int it = gw; it < NITEMS; it += NGW) {
        int r = it;
        if (r < I_QK) { const int kb = r / 96, nb = r % 96, n0 = 32 * nb, pn = n0 >> 8, w = n0 & 255, wc = w >> 6, bj = (w >> 5) & 1;
            P1_TR(n0, 256 * pn + 128 * bj + 32 * wc, 64 * kb); continue; } r -= I_QK;
        if (r < I_VB) { const int kb = r / 144, nb = r % 144, n0 = 3072 + 32 * nb; P1_TR(n0, n0, 64 * kb); continue; } r -= I_VB;
        if (r < I_BA) { P1_TR(8704, 7680, 64 * r); continue; } r -= I_BA;
        if (r < I_Z) { const int kb = r / 32, nb = r % 32; p0_tr_item(w_in, IN_TOTAL, D, 7680 + 32 * nb, (bf16*)(P.ws + WS_BTZ), 32 * nb, 64 * kb, scr, lane); continue; } r -= I_Z;
#ifdef MORE_FP8
        if (r < I_Z) { const int kb = r / 32, nb = r % 32; p0_tr_item_f8(w_in, IN_TOTAL, D, 8720 + 32 * nb, (unsigned char*)(P.ws + WS_BTGA), 32 * nb, 64 * kb, scr, lane, 64.0f); continue; } r -= I_Z;
#else
        if (r < I_Z) { const int kb = r / 32, nb = r % 32; p0_tr_item(w_in, IN_TOTAL, D, 8720 + 32 * nb, (bf16*)(P.ws + WS_BTGA), 32 * nb, 64 * kb, scr, lane); continue; } r -= I_Z;
#endif
#ifdef MORE_FP8
        if (r < I_Z) { const int kb = r / 32, nb = r % 32; p0_tr_item_f8(w_in, IN_TOTAL, D, 9744 + 32 * nb, (unsigned char*)(P.ws + WS_BTGA) + (size_t)1024 * D, 32 * nb, 64 * kb, scr, lane, 64.0f); continue; } r -= I_Z;
#else
        if (r < I_Z) { const int kb = r / 32, nb = r % 32; p0_tr_item(w_in, IN_TOTAL, D, 9744 + 32 * nb, (bf16*)(P.ws + WS_BTGB), 32 * nb, 64 * kb, scr, lane); continue; } r -= I_Z;
#endif
        if (r < I_A) { const int kb = r / 32, nb = r % 32; p0_tr_item(P.in[10], D, 512, 32 * nb, (bf16*)(P.ws + WS_BTA), 32 * nb, 64 * kb, scr, lane); continue; } r -= I_A;
        if (r < I_SQ) { const int kb = r / 32, nb = r % 32; p0_tr_item(P.in[11], D, D, 32 * nb, (bf16*)(P.ws + WS_BTB), 32 * nb, 64 * kb, scr, lane); continue; } r -= I_SQ;
        if (r < I_SQ) { const int kb = r / 32, nb = r % 32; p0_tr_item(P.in[12], D, D, 32 * nb, (bf16*)(P.ws + WS_BTOUT), 32 * nb, 64 * kb, scr, lane); continue; } r -= I_SQ;
#ifdef MORE_FP8
        if (r < I_SQ) { const int kb = r / 32, nb = r % 32; p0_tr_item_f8(P.in[23], D, D, 32 * nb, (unsigned char*)(P.ws + WS_BTPG), 32 * nb, 64 * kb, scr, lane, 64.0f); continue; } r -= I_SQ;
#else
        if (r < I_SQ) { const int kb = r / 32, nb = r % 32; p0_tr_item(P.in[23], D, D, 32 * nb, (bf16*)(P.ws + WS_BTPG), 32 * nb, 64 * kb, scr, lane, EMU2(64.f)); continue; } r -= I_SQ;
#endif
        if (r < I_PLE) { const int kb = r / 32, nb = r % 32; p0_tr_item(P.in[22], D, 256, 32 * nb, (bf16*)(P.ws + WS_BTPLE), 32 * nb, 64 * kb, scr, lane); continue; } r -= I_PLE;
#ifdef MORE_FP8
        if (r < I_EG) { const int e = r / 128, q = r % 128, kb = q / 8, nb = q % 8, f0 = 32 * nb;
            p0_tr_item_f8(P.in[18] + (size_t)e * 1024 * 256, 256, D, f0, (unsigned char*)(P.ws + WS_BTGU) + (size_t)e * 512 * 1024, 256 * (f0 >> 7) + (f0 & 127), 64 * kb, scr, lane, 64.0f); continue; } r -= I_EG;
        if (r < I_EG) { const int e = r / 128, q = r % 128, kb = q / 8, nb = q % 8, f0 = 32 * nb;
            p0_tr_item_f8(P.in[19] + (size_t)e * 1024 * 256, 256, D, f0, (unsigned char*)(P.ws + WS_BTGU) + (size_t)e * 512 * 1024, 256 * (f0 >> 7) + 128 + (f0 & 127), 64 * kb, scr, lane, 64.0f); continue; } r -= I_EG;
#else
        if (r < I_EG) { const int e = r / 128, q = r % 128, kb = q / 8, nb = q % 8, f0 = 32 * nb;
            p0_tr_item(P.in[18] + (size_t)e * 1024 * 256, 256, D, f0, (bf16*)(P.ws + WS_BTGU) + (size_t)e * 512 * 1024, 256 * (f0 >> 7) + (f0 & 127), 64 * kb, scr, lane, EMU2(64.f)); continue; } r -= I_EG;
        if (r < I_EG) { const int e = r / 128, q = r % 128, kb = q / 8, nb = q % 8, f0 = 32 * nb;
            p0_tr_item(P.in[19] + (size_t)e * 1024 * 256, 256, D, f0, (bf16*)(P.ws + WS_BTGU) + (size_t)e * 512 * 1024, 256 * (f0 >> 7) + 128 + (f0 & 127), 64 * kb, scr, lane, EMU2(64.f)); continue; } r -= I_EG;
#endif
        { const int e = r / 128, q = r % 128, kb = q / 32, nb = q % 32;
            p0_tr_item(P.in[20] + (size_t)e * 256 * 1024, D, 256, 32 * nb, (bf16*)(P.ws + WS_BTDN) + (size_t)e * 1024 * 256, 32 * nb, 64 * kb, scr, lane, EMU2(32.f)); }
    }
#ifdef P1_FP8
    { GAS v4u* z = (GAS v4u*)((unsigned char*)BTP1 + (size_t)7712 * D); const int nz = 224 * D / 16; for (int i = gw * 64 + lane; i < nz; i += NGW * 64) z[i] = (v4u){0u, 0u, 0u, 0u}; }
#else
    { GAS v4u* z = (GAS v4u*)(BTP1 + (size_t)7712 * D); const int nz = 224 * D / 8; for (int i = gw * 64 + lane; i < nz; i += NGW * 64) z[i] = (v4u){0u, 0u, 0u, 0u}; }
#endif
    bf16* H = (bf16*)((unsigned char*)P.out + DO_H);
#ifdef P1_FP8
    rms_rows_to_f8(P.in[0], P.in[2], (unsigned char*)H, gw, NGW, lane, 4.0f);
#else
    rms_rows_to_bf16(P.in[0], P.in[2], H, gw, NGW, lane, FP8_EMU_H);
#endif
}

struct AttnU { int b, g, h, r, pr, dil; };
__device__ __forceinline__ AttnU attn_decode(int u) {
    AttnU a; a.b = u / 768; int rem = u % 768;
    if (rem < 256) { a.g = 0; a.h = rem >> 5; a.r = 0; a.pr = rem & 31; }
    else if (rem < 512) { rem -= 256; a.g = 1; a.h = rem >> 5; a.r = (rem & 31) >> 3; a.pr = rem & 7; }
    else { rem -= 512; a.g = 2; a.h = rem >> 5; a.r = (rem & 31) >> 1; a.pr = rem & 1; }
    a.dil = 1 << (2 * a.g); return a;
}
__device__ __forceinline__ void attn_issue(const bf16* QA, int u, bool cont, int tid, int wid, int l32, int hi, v4u (&pk)[6], v4u (&pv)[6], bf16x8 (&pq)[4]) {
    const AttnU a = attn_decode(u); const size_t rowb = (size_t)a.b * SEQ; const bf16* Qg = QA + (size_t)(a.g * 8 + a.h) * T * 64;
#pragma unroll
    for (int k = 0; k < 6; ++k) {
        const int ci = tid + 512 * k, j = (ci >> 3) + (cont ? 128 : 0), ch = ci & 7, sidx = 256 * a.pr - 128 + j;
        v4u kv = (v4u){0u, 0u, 0u, 0u}, vv = (v4u){0u, 0u, 0u, 0u};
        if (sidx >= 0 && !(cont && k >= 4)) { const bf16* p = Qg + (rowb + (size_t)(sidx * a.dil + a.r)) * 64 + ch * 8; kv = *(const GAS v4u*)(p + (size_t)24 * T * 64); vv = *(const GAS v4u*)(p + (size_t)48 * T * 64); }
        pk[k] = kv; pv[k] = vv;
    }
    const int qi = 32 * wid + l32; const size_t mq = rowb + (size_t)((256 * a.pr + qi) * a.dil + a.r);
#pragma unroll
    for (int ks = 0; ks < 4; ++ks) pq[ks] = *(const GAS bf16x8*)(Qg + mq * 64 + 16 * ks + 8 * hi);
}
__device__ __forceinline__ bool attn_continues(int uprev, int u) {
    const AttnU a = attn_decode(uprev), b = attn_decode(u); return a.b == b.b && a.g == b.g && a.h == b.h && a.r == b.r && b.pr == a.pr + 1;
}
__device__ __forceinline__ void attn_phase(LAS unsigned char* lds, const bf16* QA, bf16* OG, float* LSE, int G, int c, int flags) {
    int tid_ = threadIdx.x; asm volatile("" : "+v"(tid_));
    const int tid = tid_, lane = tid & 63, wid = __builtin_amdgcn_readfirstlane(tid >> 6), l32 = lane & 31, hi = lane >> 5;
    LAS unsigned char* KS = lds; LAS unsigned char* VS = lds + 55296;
    v4u pk[6], pv[6]; bf16x8 pq[4];
    const int upb = 6144 / G, ubeg = c * upb, uend = ubeg + upb;
    if (ubeg < uend) attn_issue(QA, ubeg, false, tid, wid, l32, hi, pk, pv, pq);
    int base = 0; bool cont = false;
    for (int u = ubeg; u < uend; ++u) {
        const AttnU au = attn_decode(u); const int g = au.g, h = au.h, pr = au.pr;
        const size_t rowb = (size_t)au.b * SEQ;
        if (cont) base = (base + 2) % 3; else base = 0;
        __syncthreads();
#pragma unroll
        for (int k = 0; k < 6; ++k) { const int ci = tid + 512 * k, j = (ci >> 3) + (cont ? 128 : 0), ch = ci & 7;
            if (!(cont && k >= 4)) { const int prow = ((base + (j >> 7)) % 3) * 128 + (j & 127); *(LAS v4u*)(KS + prow * 144 + ch * 16) = pk[k]; *(LAS v4u*)(VS + prow * 144 + ch * 16) = pv[k]; } }
        const int qi = 32 * wid + l32; const size_t mq = rowb + (size_t)((256 * pr + qi) * au.dil + au.r);
        bf16x8 qf[4];
#pragma unroll
        for (int ks = 0; ks < 4; ++ks) qf[ks] = pq[ks];
        __syncthreads();
        const bool cont_next = (u + 1 < uend) && attn_continues(u, u + 1);
        if (u + 1 < uend && !(flags & 256)) attn_issue(QA, u + 1, cont_next, tid, wid, l32, hi, pk, pv, pq);
        if (flags & 128) { cont = cont_next; continue; }
        int prow5[5];
#pragma unroll
        for (int kb = 0; kb < 5; ++kb) { const int jb = 32 * wid + 32 * kb; prow5[kb] = ((base + (jb >> 7)) % 3) * 128 + (jb & 127); }
        f32x16 sc[5];
#pragma unroll
        for (int kb = 0; kb < 5; ++kb) {
            f32x16 a = zero16();
#pragma unroll
            for (int ks = 0; ks < 4; ++ks) { const bf16x8 kf = *(const LAS bf16x8*)(KS + (prow5[kb] + l32) * 144 + (16 * ks + 8 * hi) * 2); a = MFMA32(kf, qf[ks], a); }
            sc[kb] = a;
        }
        const float NEG = -1e30f;
#pragma unroll
        for (int rr = 0; rr < 16; ++rr) { const int cc = crow(rr, hi); if (cc < l32) sc[0][rr] = NEG; if (cc > l32) sc[4][rr] = NEG; }
        if (pr == 0) {
#pragma unroll
            for (int kb = 0; kb < 4; ++kb) if (wid + kb < 4) {
#pragma unroll
                for (int rr = 0; rr < 16; ++rr) sc[kb][rr] = NEG; }
        }
        float mx = NEG;
#pragma unroll
        for (int kb = 0; kb < 5; ++kb)
#pragma unroll
            for (int rr = 0; rr < 16; ++rr) mx = fmaxf(mx, sc[kb][rr]);
        mx = fmaxf(mx, __shfl_xor(mx, 32));
        float l = 0.f;
#pragma unroll
        for (int kb = 0; kb < 5; ++kb)
#pragma unroll
            for (int rr = 0; rr < 16; ++rr) { const float p = __builtin_amdgcn_exp2f(sc[kb][rr] - mx); sc[kb][rr] = p; l += p; }
        l += __shfl_xor(l, 32);
        f32x16 o[2]; o[0] = zero16(); o[1] = zero16();
        const int traddr = ((lane & 15) >> 2) * 144 + (16 * ((lane >> 4) & 1) + 4 * (lane & 3)) * 2;
#pragma unroll
        for (int kb = 0; kb < 5; ++kb)
#pragma unroll
            for (int ks2 = 0; ks2 < 2; ++ks2) {
                v4u pw; pw.x = cvt_pk_bf16(sc[kb][8 * ks2 + 0], sc[kb][8 * ks2 + 1]); pw.y = cvt_pk_bf16(sc[kb][8 * ks2 + 2], sc[kb][8 * ks2 + 3]);
                pw.z = cvt_pk_bf16(sc[kb][8 * ks2 + 4], sc[kb][8 * ks2 + 5]); pw.w = cvt_pk_bf16(sc[kb][8 * ks2 + 6], sc[kb][8 * ks2 + 7]);
                const bf16x8 pf = __builtin_bit_cast(bf16x8, pw);
                const int kv0 = prow5[kb] + 16 * ks2 + 4 * hi;
#pragma unroll
                for (int db = 0; db < 2; ++db) {
                    const LAS unsigned char* vp = VS + kv0 * 144 + traddr + db * 64;
                    const s16x4 lo = ldtr(vp), h4 = ldtr(vp + 8 * 144);
                    const bf16x8 vf = (bf16x8){lo[0], lo[1], lo[2], lo[3], h4[0], h4[1], h4[2], h4[3]};
                    o[db] = MFMA32(vf, pf, o[db]);
                }
            }
        const float inv = 1.0f / l;
        LAS unsigned char* stg = lds + 110592 + wid * 4096;
#pragma unroll
        for (int db = 0; db < 2; ++db)
#pragma unroll
            for (int rq = 0; rq < 4; ++rq) { v2u w; w.x = cvt_pk_bf16(o[db][4 * rq] * inv, o[db][4 * rq + 1] * inv); w.y = cvt_pk_bf16(o[db][4 * rq + 2] * inv, o[db][4 * rq + 3] * inv);
                *(LAS v2u*)(stg + l32 * 128 + (((4 * db + rq) ^ (l32 & 7)) * 16) + hi * 8) = w; }
        {
            const int rr = lane >> 3, cch = lane & 7;
#pragma unroll
            for (int i = 0; i < 4; ++i) { const int row = rr + 8 * i; const v4u w = *(const LAS v4u*)(stg + row * 128 + ((cch ^ (row & 7)) * 16));
                const int qrow = 32 * wid + row; const size_t mrow = rowb + (size_t)((256 * pr + qrow) * au.dil + au.r);
                *(GAS v4u*)(OG + mrow * 1536 + g * 512 + h * 64 + cch * 8) = w; }
        }
        if (hi == 0) LSE[mq * 24 + g * 8 + h] = mx + __builtin_amdgcn_logf(l);
        cont = cont_next;
    }
}

constexpr int PREP_RAW_PITCH = 784;
__device__ __forceinline__ void prep_issue_raw(const bf16* QB, int u, int tid, v4u (&pf)[7]) {
    const int bh = u >> 7, n = u & 127, b = bh >> 3, h = bh & 7;
#pragma unroll
    for (int k = 0; k < 7; ++k) { const int q = tid + 512 * k, rr = q / 48, cc = q % 48, tt = 64 * n - 3 + rr;
        v4u v = (v4u){0u, 0u, 0u, 0u};
        if (q < 67 * 48 && tt >= 0) v = *(const GAS v4u*)(QB + ((size_t)((cc >> 4) * 8 + h) * T + (size_t)b * SEQ + tt) * 128 + (cc & 15) * 8);
        pf[k] = v; }
}
__device__ __forceinline__ void prep_phase(LAS unsigned char* lds, const bf16* QB, const float* BG, const float* conv_w, unsigned char* DNP, float* DLB, int G, int c, int flags) {
    const int tid0 = threadIdx.x, wid = __builtin_amdgcn_readfirstlane(tid0 >> 6);
    LAS unsigned char* QS = lds; LAS unsigned char* KS = lds + 17408; LAS unsigned char* VS = lds + 34816;
    LAS float* AS = (LAS float*)(lds + 52224); LAS unsigned char* TS = lds + 69632; LAS unsigned char* AB = lds + 78848; LAS unsigned char* DT = lds + 88064;
    LAS float* gcT = (LAS float*)(lds + 104768); LAS float* btT = (LAS float*)(lds + 105024); LAS float* cwT = (LAS float*)(lds + 105280);
    LAS unsigned char* RAW = lds + 52224;
    LAS float* egT = (LAS float*)(lds + 128832);
    LAS unsigned char* KB = lds + 111424;
    v4u pf[7];
    const int upb = 8192 / G, ubeg = c * upb, uend = ubeg + upb;
    float gnx = 0.f, bnx = 0.f;
    if (ubeg < uend) { prep_issue_raw(QB, ubeg, tid0, pf);
        if (wid == 0) { const int bh0 = ubeg >> 7, n0 = ubeg & 127; const size_t mm = (size_t)(bh0 >> 3) * SEQ + 64 * n0 + (tid0 & 63); gnx = BG[mm * 16 + 8 + (bh0 & 7)]; bnx = BG[mm * 16 + (bh0 & 7)]; } }
    { const int h0 = (ubeg >> 7) & 7; __syncthreads();
      if (tid0 < 384) {
#pragma unroll
        for (int j = 0; j < 4; ++j) cwT[j * 384 + tid0] = conv_w[j * 3072 + (tid0 >> 7) * 1024 + h0 * 128 + (tid0 & 127)]; } }
    for (int u = ubeg; u < uend; ++u) {
        int tid = tid0; asm volatile("" : "+v"(tid));
        const int lane = tid & 63, l32 = lane & 31, hi = lane >> 5;
        const int bh = u >> 7, n = u & 127, b = bh >> 3, h = bh & 7; const size_t m0 = (size_t)b * SEQ + 64 * n;
        unsigned char* rec = DNP + (size_t)u * DNU;
        __syncthreads();
#pragma unroll
        for (int k = 0; k < 7; ++k) { const int q = tid + 512 * k; if (q < 67 * 48) *(LAS v4u*)(RAW + (q / 48) * PREP_RAW_PITCH + (q % 48) * 16) = pf[k]; }
        if (wid == 0) {
            float gv = gnx; const float bv = bnx;
            gv += dpp_mov<0x111>(gv); gv += dpp_mov<0x112>(gv); gv += dpp_mov<0x114>(gv); gv += dpp_mov<0x118>(gv);
            { const int iv = __builtin_bit_cast(int, gv);
              const float r0 = __builtin_bit_cast(float, __builtin_amdgcn_readlane(iv, 15)), r1 = __builtin_bit_cast(float, __builtin_amdgcn_readlane(iv, 31)), r2 = __builtin_bit_cast(float, __builtin_amdgcn_readlane(iv, 47));
              gv += (lane >= 16 ? r0 : 0.f) + (lane >= 32 ? r1 : 0.f) + (lane >= 48 ? r2 : 0.f); }
            const float glast_ = __builtin_bit_cast(float, __builtin_amdgcn_readlane(__builtin_bit_cast(int, gv), 63));
            gcT[lane] = gv; btT[lane] = bv; egT[lane] = __expf(glast_ - gv); if (lane == 63) DLB[u] = __expf(gv);
        }
        __syncthreads();
        if (u + 1 < uend) { prep_issue_raw(QB, u + 1, tid, pf);
            if (wid == 0) { gnx = BG[(m0 + 64 + lane) * 16 + 8 + h]; bnx = BG[(m0 + 64 + lane) * 16 + h]; } }
        if (tid < 384 && !(flags & 512)) {
            const int cg = tid & 15, rg = (tid >> 4) & 7, ten = tid >> 7;
            f32x4 w0[4], w1[4];
#pragma unroll
            for (int j = 0; j < 4; ++j) { w0[j] = *(const LAS f32x4*)(cwT + j * 384 + ten * 128 + cg * 8); w1[j] = *(const LAS f32x4*)(cwT + j * 384 + ten * 128 + cg * 8 + 4); }
            const LAS unsigned char* rp = RAW + (rg * 8) * PREP_RAW_PITCH + (ten * 16 + cg) * 16;
            f32x4 wa[4], wb[4];
#pragma unroll
            for (int j = 0; j < 3; ++j) unpack8(*(const LAS v4u*)(rp + j * PREP_RAW_PITCH), wa[j], wb[j]);
            LAS unsigned char* dstb = (ten == 0 ? QS : (ten == 1 ? KS : VS)) + (rg * 8) * 272 + cg * 16;
#pragma unroll
            for (int ii = 0; ii < 8; ++ii) {
                unpack8(*(const LAS v4u*)(rp + (ii + 3) * PREP_RAW_PITCH), wa[(ii + 3) & 3], wb[(ii + 3) & 3]);
                f32x4 y0 = {0.f, 0.f, 0.f, 0.f}, y1 = {0.f, 0.f, 0.f, 0.f};
#pragma unroll
                for (int j = 0; j < 4; ++j) { y0 += wa[(ii + j) & 3] * w0[j]; y1 += wb[(ii + j) & 3] * w1[j]; }
#pragma unroll
                for (int e = 0; e < 4; ++e) { y0[e] = y0[e] * sigm(y0[e]); y1[e] = y1[e] * sigm(y1[e]); }
                float scl;
                if (ten < 2) { float ss = (y0[0] * y0[0] + y0[1] * y0[1]) + (y0[2] * y0[2] + y0[3] * y0[3]) + (y1[0] * y1[0] + y1[1] * y1[1]) + (y1[2] * y1[2] + y1[3] * y1[3]);
                    ss += dpp_mov<0xB1>(ss); ss += dpp_mov<0x4E>(ss); ss += dpp_mov<0x141>(ss); ss += dpp_mov<0x140>(ss);
                    scl = rsqrtf(ss + 1e-6f) * (ten == 0 ? 0.08838834764831845f : 1.0f); }
                else scl = btT[rg * 8 + ii];
                *(LAS v4u*)(dstb + ii * 272) = pack8(y0 * scl, y1 * scl);
                if (ten == 1) { const float s2 = scl * btT[rg * 8 + ii] * __expf(gcT[rg * 8 + ii]); *(LAS v4u*)(KB + (rg * 8 + ii) * 272 + cg * 16) = pack8(y0 * s2, y1 * s2); }
            }
        }
        __syncthreads();
        if (wid < 6 && !(flags & 8)) {
            const int kind = wid / 3, pi = wid % 3, ib = pi ? 1 : 0, jb = (pi == 2) ? 1 : 0;
            f32x16 a = {};
            if (kind == 0) {
#pragma unroll
                for (int ks = 0; ks < 8; ++ks) { const bf16x8 af = *(const LAS bf16x8*)(KS + (32 * ib + l32) * 272 + (16 * ks + 8 * hi) * 2), bf = *(const LAS bf16x8*)(KS + (32 * jb + l32) * 272 + (16 * ks + 8 * hi) * 2); a = MFMA32(af, bf, a); }
                const int j = 32 * jb + l32; const float gj = gcT[j];
#pragma unroll
                for (int rr = 0; rr < 16; ++rr) { const int i = 32 * ib + crow(rr, hi); const float v = (j < i) ? btT[i] * a[rr] * __expf(gcT[i] - gj) : 0.f; AS[i * 68 + j] = v; *(LAS unsigned short*)(AB + i * 144 + j * 2) = f2bf(v); }
            } else {
#pragma unroll
                for (int ks = 0; ks < 8; ++ks) { const bf16x8 af = *(const LAS bf16x8*)(KS + (32 * jb + l32) * 272 + (16 * ks + 8 * hi) * 2), bf = *(const LAS bf16x8*)(QS + (32 * ib + l32) * 272 + (16 * ks + 8 * hi) * 2); a = MFMA32(af, bf, a); }
                const int i = 32 * ib + l32; const float gi = gcT[i];
#pragma unroll
                for (int rr = 0; rr < 16; ++rr) { const int j = 32 * jb + crow(rr, hi); a[rr] = (j <= i) ? a[rr] * __expf(gi - gcT[j]) : 0.f; }
#pragma unroll
                for (int ks2 = 0; ks2 < 2; ++ks2) { v4u w; w.x = cvt_pk_bf16(a[8 * ks2], a[8 * ks2 + 1]); w.y = cvt_pk_bf16(a[8 * ks2 + 2], a[8 * ks2 + 3]); w.z = cvt_pk_bf16(a[8 * ks2 + 4], a[8 * ks2 + 5]); w.w = cvt_pk_bf16(a[8 * ks2 + 6], a[8 * ks2 + 7]);
                    __builtin_nontemporal_store(w, (GAS v4u*)(rec + 49152 + ((ib * 4 + 2 * jb + ks2) * 64 + lane) * 16)); }
            }
        }
        __syncthreads();
        if (wid == 0) { if (!(flags & 2)) {
            const int blk = lane >> 4, cc = lane & 15; const float fcc = (float)cc;
            float x[16];
#pragma unroll
            for (int i = 0; i < 16; ++i) {
                float a0 = fmaxf(0.f, 1.f - fabsf(fcc - (float)i)), a1 = 0.f;
#pragma unroll
                for (int j4 = 0; j4 < (i + 3) / 4; ++j4) { const f32x4 av = *(const LAS f32x4*)(AS + (16 * blk + i) * 68 + 16 * blk + 4 * j4);
                    if (4 * j4 + 0 < i) a0 -= av[0] * x[4 * j4 + 0]; if (4 * j4 + 1 < i) a1 -= av[1] * x[4 * j4 + 1];
                    if (4 * j4 + 2 < i) a0 -= av[2] * x[4 * j4 + 2]; if (4 * j4 + 3 < i) a1 -= av[3] * x[4 * j4 + 3]; }
                x[i] = a0 + a1;
            }
            {
                unsigned xp[8];
#pragma unroll
                for (int q = 0; q < 8; ++q) xp[q] = cvt_pk_bf16(x[2 * q], x[2 * q + 1]);
#pragma unroll
                for (int q = 0; q < 8; ++q) { v4u w = (v4u){0u, 0u, 0u, 0u};
                    if ((q >> 1) == blk) { if (q & 1) w = (v4u){xp[4], xp[5], xp[6], xp[7]}; else w = (v4u){xp[0], xp[1], xp[2], xp[3]}; }
                    *(LAS v4u*)(DT + lane * 144 + q * 16) = w; }
#pragma unroll
                for (int m = 0; m < 64; ++m) { const int i = m & 15; float v = 0.f;
                    if ((m >> 4) == blk) v = x[i];
                    *(LAS unsigned short*)(TS + m * 144 + lane * 2) = f2bf(v); }
            }
            f32x16 Dp[2];
#pragma unroll
            for (int p = 0; p < 2; ++p) {
                bf16x8 af = *(const LAS bf16x8*)(AB + (32 * p + l32) * 144 + (32 * p + 8 * hi) * 2); if (l32 < 16) af = (bf16x8){0, 0, 0, 0, 0, 0, 0, 0};
                const bf16x8 bfr = *(const LAS bf16x8*)(DT + (32 * p + l32) * 144 + (32 * p + 8 * hi) * 2);
                f32x16 Y = {}; Y = MFMA32(af, bfr, Y);
                v4u yw; yw.x = cvt_pk_bf16(Y[8], Y[9]); yw.y = cvt_pk_bf16(Y[10], Y[11]); yw.z = cvt_pk_bf16(Y[12], Y[13]); yw.w = cvt_pk_bf16(Y[14], Y[15]);
                const v2u d0 = *(const LAS v2u*)(TS + (32 * p + l32) * 144 + (32 * p + 16 + 4 * hi) * 2), d1 = *(const LAS v2u*)(TS + (32 * p + l32) * 144 + (32 * p + 24 + 4 * hi) * 2);
                const v4u dw = (v4u){d0.x, d0.y, d1.x, d1.y};
                f32x16 Z = {}; Z = MFMA32(__builtin_bit_cast(bf16x8, dw), __builtin_bit_cast(bf16x8, yw), Z);
#pragma unroll
                for (int rq = 0; rq < 4; ++rq) { const v2u g = *(const LAS v2u*)(DT + (32 * p + l32) * 144 + (32 * p + 8 * rq + 4 * hi) * 2);
                    Z[4 * rq + 0] = bflo(g.x) - Z[4 * rq + 0]; Z[4 * rq + 1] = bfhi(g.x) - Z[4 * rq + 1]; Z[4 * rq + 2] = bflo(g.y) - Z[4 * rq + 2]; Z[4 * rq + 3] = bfhi(g.y) - Z[4 * rq + 3]; }
                Dp[p] = Z;
#pragma unroll
                for (int r = 0; r < 16; ++r) *(LAS unsigned short*)(TS + (32 * p + crow(r, hi)) * 144 + (32 * p + l32) * 2) = f2bf(Z[r]);
            }
            {
                f32x16 Y = {};
#pragma unroll
                for (int ks = 0; ks < 2; ++ks) {
                    const v2u a0 = *(const LAS v2u*)(AB + (32 + l32) * 144 + (16 * ks + 4 * hi) * 2), a1 = *(const LAS v2u*)(AB + (32 + l32) * 144 + (16 * ks + 8 + 4 * hi) * 2);
                    const v4u aw = (v4u){a0.x, a0.y, a1.x, a1.y};
                    v4u bw; bw.x = cvt_pk_bf16(Dp[0][8 * ks + 0], Dp[0][8 * ks + 1]); bw.y = cvt_pk_bf16(Dp[0][8 * ks + 2], Dp[0][8 * ks + 3]); bw.z = cvt_pk_bf16(Dp[0][8 * ks + 4], Dp[0][8 * ks + 5]); bw.w = cvt_pk_bf16(Dp[0][8 * ks + 6], Dp[0][8 * ks + 7]);
                    Y = MFMA32(__builtin_bit_cast(bf16x8, aw), __builtin_bit_cast(bf16x8, bw), Y);
                }
                f32x16 L = {};
#pragma unroll
                for (int ks = 0; ks < 2; ++ks) {
                    const v2u a0 = *(const LAS v2u*)(TS + (32 + l32) * 144 + (32 + 16 * ks + 4 * hi) * 2), a1 = *(const LAS v2u*)(TS + (32 + l32) * 144 + (32 + 16 * ks + 8 + 4 * hi) * 2);
                    const v4u aw = (v4u){a0.x, a0.y, a1.x, a1.y};
                    v4u bw; bw.x = cvt_pk_bf16(Y[8 * ks + 0], Y[8 * ks + 1]); bw.y = cvt_pk_bf16(Y[8 * ks + 2], Y[8 * ks + 3]); bw.z = cvt_pk_bf16(Y[8 * ks + 4], Y[8 * ks + 5]); bw.w = cvt_pk_bf16(Y[8 * ks + 6], Y[8 * ks + 7]);
                    L = MFMA32(__builtin_bit_cast(bf16x8, aw), __builtin_bit_cast(bf16x8, bw), L);
                }
#pragma unroll
                for (int r = 0; r < 16; ++r) *(LAS unsigned short*)(TS + (32 + crow(r, hi)) * 144 + l32 * 2) = f2bf(-L[r]);
            }
        } } else if (!(flags & 1024)) {
            const float glast = gcT[63];
            for (int f = wid - 1; f < 32; f += 7) {
                if (f < 16) { const int ib = f >> 3, ks = f & 7, i = 32 * ib + l32; const float eg = __expf(gcT[i]);
                    const v2u lo = *(const LAS v2u*)(QS + i * 272 + (16 * ks + 4 * hi) * 2), h2 = *(const LAS v2u*)(QS + i * 272 + (16 * ks + 8 + 4 * hi) * 2);
                    v4u w; w.x = cvt_pk_bf16(bflo(lo.x) * eg, bfhi(lo.x) * eg); w.y = cvt_pk_bf16(bflo(lo.y) * eg, bfhi(lo.y) * eg); w.z = cvt_pk_bf16(bflo(h2.x) * eg, bfhi(h2.x) * eg); w.w = cvt_pk_bf16(bflo(h2.y) * eg, bfhi(h2.y) * eg);
                    __builtin_nontemporal_store(w, (GAS v4u*)(rec + 16384 + ((ib * 8 + ks) * 64 + lane) * 16));
                } else { const int dkb = (f - 16) >> 2, ksj = (f - 16) & 3, dk = 32 * dkb + l32; float v[8];
#pragma unroll
                    for (int jj = 0; jj < 8; ++jj) { const int j = 16 * ksj + 4 * hi + (jj & 3) + 8 * (jj >> 2); v[jj] = bf2f(*(const LAS unsigned short*)(KS + j * 272 + dk * 2)) * egT[j]; }
                    v4u w; w.x = cvt_pk_bf16(v[0], v[1]); w.y = cvt_pk_bf16(v[2], v[3]); w.z = cvt_pk_bf16(v[4], v[5]); w.w = cvt_pk_bf16(v[6], v[7]);
                    __builtin_nontemporal_store(w, (GAS v4u*)(rec + 32768 + ((dkb * 4 + ksj) * 64 + lane) * 16)); }
            }
        }
        __syncthreads();
        if (!(flags & 4)) {
            const int eb = wid & 3, ib = wid >> 2; f32x16 a = {};
            for (int ks = 0; ks < (ib ? 4 : 2); ++ks) {
                const bf16x8 tf = *(const LAS bf16x8*)(TS + (32 * ib + l32) * 144 + (16 * ks + 8 * hi) * 2);
                bf16x8 vf;
#pragma unroll
                for (int jj = 0; jj < 8; ++jj) vf[jj] = (short)*(const LAS unsigned short*)(VS + (16 * ks + 8 * hi + jj) * 272 + (32 * eb + l32) * 2);
                a = MFMA32(tf, vf, a);
#ifdef DBG_PREPCHK
                { bool b0 = false, b1 = false; for (int jj = 0; jj < 8; ++jj) { if ((((unsigned short)tf[jj]) & 0x7f80u) == 0x7f80u) b0 = true; if ((((unsigned short)vf[jj]) & 0x7f80u) == 0x7f80u) b1 = true; }
                  if (b0 || b1) atomicAnd(DBGW, ~1u); }
#endif
            }
#ifdef DBG_PREPCHK
            { bool b2 = false; for (int r = 0; r < 16; ++r) if (!(a[r] - a[r] == 0.f)) b2 = true; if (b2) atomicAnd(DBGW, ~4u); }
#endif
            v4u w0, w1; w0.x = cvt_pk_bf16(a[0], a[1]); w0.y = cvt_pk_bf16(a[2], a[3]); w0.z = cvt_pk_bf16(a[4], a[5]); w0.w = cvt_pk_bf16(a[6], a[7]);
            w1.x = cvt_pk_bf16(a[8], a[9]); w1.y = cvt_pk_bf16(a[10], a[11]); w1.z = cvt_pk_bf16(a[12], a[13]); w1.w = cvt_pk_bf16(a[14], a[15]);
            GAS v4u* up = (GAS v4u*)(rec + 57344 + ((eb * 2 + ib) * 64 + lane) * 32); __builtin_nontemporal_store(w0, up); __builtin_nontemporal_store(w1, up + 1);
#ifdef DBG_PREPCHK
            { bool bb = false; const unsigned ww[8] = {w0.x, w0.y, w0.z, w0.w, w1.x, w1.y, w1.z, w1.w}; for (int k = 0; k < 8; ++k) if ((ww[k] & 0x7f80u) == 0x7f80u || (ww[k] & 0x7f800000u) == 0x7f800000u) bb = true;
              if (bb) atomicAnd(DBGW, ~2u); if (u == 5 && tid == 0) atomicAnd(DBGW, ~8u); }
#endif
        }
        if (!(flags & 4)) {
            const int dkb = wid & 3, ib = wid >> 2; f32x16 a = {};
            for (int ks = 0; ks < (ib ? 4 : 2); ++ks) {
                bf16x8 kf;
#pragma unroll
                for (int jj = 0; jj < 8; ++jj) kf[jj] = (short)*(const LAS unsigned short*)(KB + (16 * ks + 8 * hi + jj) * 272 + (32 * dkb + l32) * 2);
                const bf16x8 tf = *(const LAS bf16x8*)(TS + (32 * ib + l32) * 144 + (16 * ks + 8 * hi) * 2);
                a = MFMA32(kf, tf, a);
#ifdef DBG_PREPCHK
                { bool b3 = false; for (int jj = 0; jj < 8; ++jj) if ((((unsigned short)kf[jj]) & 0x7f80u) == 0x7f80u) b3 = true; if (b3) atomicAnd(DBGW, ~1u); }
#endif
            }
#ifdef DBG_PREPCHK
            { bool b4 = false; for (int r = 0; r < 16; ++r) if (!(a[r] - a[r] == 0.f)) b4 = true; if (b4) atomicAnd(DBGW, ~16u); }
#endif
#pragma unroll
            for (int ks2 = 0; ks2 < 2; ++ks2) { v4u w; w.x = cvt_pk_bf16(a[8 * ks2], a[8 * ks2 + 1]); w.y = cvt_pk_bf16(a[8 * ks2 + 2], a[8 * ks2 + 3]); w.z = cvt_pk_bf16(a[8 * ks2 + 4], a[8 * ks2 + 5]); w.w = cvt_pk_bf16(a[8 * ks2 + 6], a[8 * ks2 + 7]);
                __builtin_nontemporal_store(w, (GAS v4u*)(rec + ((ib * 8 + 2 * dkb + ks2) * 64 + lane) * 16)); }
        }
    }
}

__device__ __forceinline__ void scan_chain(LAS unsigned char* lds, const unsigned char* DNP, const float* DLB, bf16* ON, const float* dn_gain, int bh) {
    int tid_ = threadIdx.x; asm volatile("" : "+v"(tid_));
    const int tid = tid_, lane = tid & 63, wid = __builtin_amdgcn_readfirstlane(tid >> 6), l32 = lane & 31, hi = lane >> 5;
    LAS unsigned char* OT = lds + 114688; LAS float* GT = (LAS float*)(lds + 132096);
    const int b = bh >> 3, h = bh & 7; const size_t u0 = (size_t)bh * 128;
    __syncthreads();
    if (tid < 128) GT[tid] = dn_gain[tid];
    const int lt = tid - 256;
#define SCAN_DMA(recp, dstoff) do { _Pragma("unroll") for (int k_ = 0; k_ < 7; ++k_) { const int p_ = wid * 7 + k_; \
        __builtin_amdgcn_global_load_lds((const unsigned*)((recp) + p_ * 1024 + lane * 16), (LAS unsigned*)(lds + (dstoff) + p_ * 1024), 16, 0, 0); } } while (0)
    SCAN_DMA(DNP + u0 * DNU, 0);
    f32x16 S[4]; S[0] = f32x16{}; S[1] = f32x16{}; S[2] = f32x16{}; S[3] = f32x16{};
    v4u un[4] = {}; float dln = 0.f;
    if (wid < 4) { const GAS v4u* up = (const GAS v4u*)(DNP + u0 * DNU + 57344 + (wid * 2 * 64 + lane) * 32);
        un[0] = up[0]; un[1] = up[1]; un[2] = up[128]; un[3] = up[129]; dln = DLB[u0]; }
    asm volatile("s_waitcnt vmcnt(0)" ::: "memory");
    __syncthreads();
#pragma unroll 1
    for (int n = 0; n < 128; ++n) {
        const LAS unsigned char* Pb = lds + (n & 1) * 57344;
        f32x16 O0 = zero16(), O1 = zero16();
        if (n + 1 < 128) SCAN_DMA(DNP + (u0 + n + 1) * DNU, ((n + 1) & 1) * 57344);
        if (wid < 4) {
            const v4u uc[4] = {un[0], un[1], un[2], un[3]}; const float dl = dln;
            if (n + 1 < 128) { const GAS v4u* up = (const GAS v4u*)(DNP + (u0 + n + 1) * DNU + 57344 + (wid * 2 * 64 + lane) * 32);
              un[0] = up[0]; un[1] = up[1]; un[2] = up[128]; un[3] = up[129]; dln = DLB[u0 + n + 1]; }
            bf16x8 vb[4];
#define SC_W(ib, ks) (*(const LAS bf16x8*)(Pb + (((ib) * 8 + (ks)) * 64 + lane) * 16))
#define SC_Q(ib, ks) (*(const LAS bf16x8*)(Pb + 16384 + (((ib) * 8 + (ks)) * 64 + lane) * 16))
#define SC_K(dkb, ksj) (*(const LAS bf16x8*)(Pb + 32768 + (((dkb) * 4 + (ksj)) * 64 + lane) * 16))
#define SC_A(ib, ksj) (*(const LAS bf16x8*)(Pb + 49152 + (((ib) * 4 + (ksj)) * 64 + lane) * 16))
            {
                f32x16 W0 = zero16(), W1 = zero16();
                bf16x8 fw0 = SC_W(0, 0), fw1 = SC_W(1, 0), fq0 = SC_Q(0, 0), fq1 = SC_Q(1, 0);
#pragma unroll
                for (int ks = 0; ks < 8; ++ks) {
                    const bf16x8 cw0 = fw0, cw1 = fw1, cq0 = fq0, cq1 = fq1;
                    if (ks < 7) { fw0 = SC_W(0, ks + 1); fw1 = SC_W(1, ks + 1); fq0 = SC_Q(0, ks + 1); fq1 = SC_Q(1, ks + 1); }
                    const int dkb = ks >> 1, o8 = 8 * (ks & 1);
                    v4u sw; sw.x = cvt_pk_bf16(S[dkb][o8 + 0], S[dkb][o8 + 1]); sw.y = cvt_pk_bf16(S[dkb][o8 + 2], S[dkb][o8 + 3]); sw.z = cvt_pk_bf16(S[dkb][o8 + 4], S[dkb][o8 + 5]); sw.w = cvt_pk_bf16(S[dkb][o8 + 6], S[dkb][o8 + 7]);
                    const bf16x8 sb = __builtin_bit_cast(bf16x8, sw);
                    W0 = MFMA32(cw0, sb, W0); W1 = MFMA32(cw1, sb, W1); O0 = MFMA32(cq0, sb, O0); O1 = MFMA32(cq1, sb, O1);
                    __builtin_amdgcn_sched_barrier(0);
                }
                float v[16];
#pragma unroll
                for (int q = 0; q < 2; ++q) { const v4u w = uc[q];
                    v[8 * q + 0] = bflo(w.x); v[8 * q + 1] = bfhi(w.x); v[8 * q + 2] = bflo(w.y); v[8 * q + 3] = bfhi(w.y); v[8 * q + 4] = bflo(w.z); v[8 * q + 5] = bfhi(w.z); v[8 * q + 6] = bflo(w.w); v[8 * q + 7] = bfhi(w.w); }
#pragma unroll
                for (int r = 0; r < 16; ++r) v[r] -= W0[r];
#pragma unroll
                for (int ks2 = 0; ks2 < 2; ++ks2) { v4u w; w.x = cvt_pk_bf16(v[8 * ks2], v[8 * ks2 + 1]); w.y = cvt_pk_bf16(v[8 * ks2 + 2], v[8 * ks2 + 3]); w.z = cvt_pk_bf16(v[8 * ks2 + 4], v[8 * ks2 + 5]); w.w = cvt_pk_bf16(v[8 * ks2 + 6], v[8 * ks2 + 7]); vb[ks2] = __builtin_bit_cast(bf16x8, w); }
#pragma unroll
                for (int q = 0; q < 2; ++q) { const v4u w = uc[2 + q];
                    v[8 * q + 0] = bflo(w.x); v[8 * q + 1] = bfhi(w.x); v[8 * q + 2] = bflo(w.y); v[8 * q + 3] = bfhi(w.y); v[8 * q + 4] = bflo(w.z); v[8 * q + 5] = bfhi(w.z); v[8 * q + 6] = bflo(w.w); v[8 * q + 7] = bfhi(w.w); }
#pragma unroll
                for (int r = 0; r < 16; ++r) v[r] -= W1[r];
#pragma unroll
                for (int ks2 = 0; ks2 < 2; ++ks2) { v4u w; w.x = cvt_pk_bf16(v[8 * ks2], v[8 * ks2 + 1]); w.y = cvt_pk_bf16(v[8 * ks2 + 2], v[8 * ks2 + 3]); w.z = cvt_pk_bf16(v[8 * ks2 + 4], v[8 * ks2 + 5]); w.w = cvt_pk_bf16(v[8 * ks2 + 6], v[8 * ks2 + 7]); vb[2 + ks2] = __builtin_bit_cast(bf16x8, w); }
            }
            __builtin_amdgcn_sched_barrier(0);
#pragma unroll
            for (int dkb = 0; dkb < 4; ++dkb)
#pragma unroll
                for (int r = 0; r < 16; ++r) S[dkb][r] *= dl;
            {
                bf16x8 k0 = SC_K(0, 0), k1 = SC_K(1, 0), k2 = SC_K(2, 0), k3 = SC_K(3, 0), a0 = SC_A(0, 0), a1 = SC_A(1, 0);
#pragma unroll
                for (int ksj = 0; ksj < 4; ++ksj) {
                    const bf16x8 c0 = k0, c1 = k1, c2 = k2, c3 = k3, ca0 = a0, ca1 = a1;
                    if (ksj < 3) { k0 = SC_K(0, ksj + 1); k1 = SC_K(1, ksj + 1); k2 = SC_K(2, ksj + 1); k3 = SC_K(3, ksj + 1); a1 = SC_A(1, ksj + 1); if (ksj < 1) a0 = SC_A(0, ksj + 1); }
                    S[0] = MFMA32(c0, vb[ksj], S[0]); S[1] = MFMA32(c1, vb[ksj], S[1]); S[2] = MFMA32(c2, vb[ksj], S[2]); S[3] = MFMA32(c3, vb[ksj], S[3]);
                    O1 = MFMA32(ca1, vb[ksj], O1); if (ksj < 2) O0 = MFMA32(ca0, vb[ksj], O0);
                    __builtin_amdgcn_sched_barrier(0);
                }
            }
#undef SC_W
#undef SC_Q
#undef SC_K
#undef SC_A
        } else {
            if (n > 0) {
                const int i = lt >> 2, qd = lt & 3; f32x4 v[8]; float ss = 0.f;
#pragma unroll
                for (int k = 0; k < 4; ++k) { const v4u w = *(const LAS v4u*)(OT + i * 272 + k * 64 + qd * 16); unpack8(w, v[2 * k], v[2 * k + 1]); }
#pragma unroll
                for (int k = 0; k < 8; ++k) ss += (v[k][0] * v[k][0] + v[k][1] * v[k][1]) + (v[k][2] * v[k][2] + v[k][3] * v[k][3]);
                ss += dpp_mov<0xB1>(ss); ss += dpp_mov<0x4E>(ss);
                const float rs = rsqrtf(ss * (1.0f / 128.0f) + 1e-6f);
                bf16* dst = ON + ((size_t)b * SEQ + 64 * (n - 1) + i) * 1024 + h * 128 + qd * 8;
#pragma unroll
                for (int k = 0; k < 4; ++k) { const f32x4 g0 = *(const LAS f32x4*)(GT + 32 * k + 8 * qd), g1 = *(const LAS f32x4*)(GT + 32 * k + 8 * qd + 4); *(GAS v4u*)(dst + 32 * k) = pack8(v[2 * k] * rs * g0, v[2 * k + 1] * rs * g1); }
            }
        }
        asm volatile("s_waitcnt vmcnt(0)" ::: "memory");
        __syncthreads();
        if (wid < 4) {
#pragma unroll
            for (int r = 0; r < 16; ++r) { const unsigned w_ = cvt_pk_bf16(O0[r], O1[r]); LAS unsigned char* p_ = OT + (crow(r, 0)) * 272 + hi * (4 * 272) + (32 * wid + l32) * 2;
                *(LAS unsigned short*)p_ = (unsigned short)w_; *(LAS unsigned short*)(p_ + 32 * 272) = (unsigned short)(w_ >> 16); }
        }
        __syncthreads();
    }
    if (wid >= 4) {
        const int i = lt >> 2, qd = lt & 3; f32x4 v[8]; float ss = 0.f;
#pragma unroll
        for (int k = 0; k < 4; ++k) { const v4u w = *(const LAS v4u*)(OT + i * 272 + k * 64 + qd * 16); unpack8(w, v[2 * k], v[2 * k + 1]); }
#pragma unroll
        for (int k = 0; k < 8; ++k) ss += (v[k][0] * v[k][0] + v[k][1] * v[k][1]) + (v[k][2] * v[k][2] + v[k][3] * v[k][3]);
        ss += dpp_mov<0xB1>(ss); ss += dpp_mov<0x4E>(ss);
        const float rs = rsqrtf(ss * (1.0f / 128.0f) + 1e-6f);
        bf16* dst = ON + ((size_t)b * SEQ + 64 * 127 + i) * 1024 + h * 128 + qd * 8;
#pragma unroll
        for (int k = 0; k < 4; ++k) { const f32x4 g0 = *(const LAS f32x4*)(GT + 32 * k + 8 * qd), g1 = *(const LAS f32x4*)(GT + 32 * k + 8 * qd + 4); *(GAS v4u*)(dst + 32 * k) = pack8(v[2 * k] * rs * g0, v[2 * k + 1] * rs * g1); }
    }
}
__device__ __forceinline__ void combine_rows(const Ptrs& P, int first, int stride, int lane) {
    const bf16* OG = (const bf16*)((const unsigned char*)P.out + DO_OG); const float* LSE = (const float*)((const unsigned char*)P.out + DO_LSE);
    bf16* OA = (bf16*)(P.ws + WS_OA); bf16* HR = (bf16*)(P.ws + WS_HR);
    for (int m0 = first; m0 < T; m0 += 4 * stride) {
        const int hd = lane >> 3; float l0[4], l1[4], l2[4]; v4u g0[4], g1[4], g2[4];
#pragma unroll
        for (int k = 0; k < 4; ++k) { const int m = m0 + k * stride; if (m < T) { l0[k] = LSE[(size_t)m * 24 + hd]; l1[k] = LSE[(size_t)m * 24 + 8 + hd]; l2[k] = LSE[(size_t)m * 24 + 16 + hd];
            const bf16* og = OG + (size_t)m * 1536 + lane * 8; g0[k] = *(const GAS v4u*)og; g1[k] = *(const GAS v4u*)(og + 512); g2[k] = *(const GAS v4u*)(og + 1024); } }
#pragma unroll
        for (int k = 0; k < 4; ++k) { const int m = m0 + k * stride; if (m < T) {
            const float mx = fmaxf(l0[k], fmaxf(l1[k], l2[k])); float w0 = __builtin_amdgcn_exp2f(l0[k] - mx), w1 = __builtin_amdgcn_exp2f(l1[k] - mx), w2 = __builtin_amdgcn_exp2f(l2[k] - mx);
            const float inv = 1.0f / (w0 + w1 + w2); w0 *= inv; w1 *= inv; w2 *= inv;
            f32x4 a0, b0, a1, b1, a2, b2; unpack8(g0[k], a0, b0); unpack8(g1[k], a1, b1); unpack8(g2[k], a2, b2);
            *(GAS v4u*)(OA + (size_t)m * 512 + lane * 8) = pack8(a0 * w0 + a1 * w1 + a2 * w2, b0 * w0 + b1 * w1 + b2 * w2); } }
    }
#ifdef MORE_FP8
    rms_rows_to_both(P.in[0], P.in[2], HR, (unsigned char*)(P.ws + WS_HR8), first, stride, lane, 4.0f);
#else
    rms_rows_to_bf16(P.in[0], P.in[2], HR, first, stride, lane);
#endif
}

__device__ __forceinline__ void router_phase(const Ptrs& P, LAS unsigned char* lds, int G, int c, int wave, int lane_in) {
    (void)lane_in; const int lane = (int)__builtin_amdgcn_mbcnt_hi(~0u, __builtin_amdgcn_mbcnt_lo(~0u, 0u));
    LAS float* WrT = (LAS float*)lds; LAS unsigned* bcnt = (LAS unsigned*)(lds + 81920);
#ifdef D10_BF16
    const float* x1 = P.in[0]; const bf16* D10 = (const bf16*)(P.ws + WS_D10);
#else
    const float* x1 = P.out;
#endif
    bf16* H2 = (bf16*)(P.ws + WS_H2); int4* TOK = (int4*)(P.ws + WS_TOK); unsigned* cnt = (unsigned*)(P.ws + WS_CTL) + CW_CNT;
    __syncthreads();
    const int tid_r = wave * 64 + lane;
    {
        f32x4 wg[2], we[8];
#pragma unroll
        for (int j = 0; j < 2; ++j) wg[j] = ((const GAS f32x4*)P.in[14])[tid_r + 512 * j];
#pragma unroll
        for (int j = 0; j < 8; ++j) we[j] = ((const GAS f32x4*)P.in[16])[tid_r + 512 * j];
#pragma unroll
        for (int j = 0; j < 2; ++j) { const int k = tid_r + 512 * j;
#pragma unroll
            for (int e = 0; e < 4; ++e) WrT[e * 1024 + k] = wg[j][e]; }
#pragma unroll
        for (int j = 0; j < 8; ++j) { const int i = (tid_r + 512 * j) * 4, k = i >> 4, cc = i & 15;
#pragma unroll
            for (int e = 0; e < 4; ++e) WrT[(4 + cc + e) * 1024 + k] = we[j][e]; }
    }
    if (tid_r < 16) bcnt[tid_r] = 0u;
    __syncthreads();
    const GAS f32x4* gr = (const GAS f32x4*)P.in[13] + lane; f32x4 gn[4];
#pragma unroll
    for (int j = 0; j < 4; ++j) gn[j] = gr[64 * j];
    float bias[20];
#pragma unroll
    for (int q = 0; q < 4; ++q) bias[q] = P.in[15][q];
#pragma unroll
    for (int q = 0; q < 16; ++q) bias[4 + q] = P.in[17][q];
    unsigned mycnt = 0;
    const int gw = c * NWAVES + wave, NGW = G * NWAVES;
    f32x4 nxa[4], nxb[4]; v2u nda[4], ndb[4];
#define RT_LOAD2(mm) do { const GAS f32x4* xa_ = (const GAS f32x4*)(x1 + (size_t)(mm) * D) + lane; const GAS v2u* da_ = (const GAS v2u*)(D10 + (size_t)(mm) * D) + lane; \
        const GAS f32x4* xb_ = (const GAS f32x4*)(x1 + (size_t)((mm) + NGW) * D) + lane; const GAS v2u* db_ = (const GAS v2u*)(D10 + (size_t)((mm) + NGW) * D) + lane; \
        _Pragma("unroll") for (int j = 0; j < 4; ++j) { nxa[j] = xa_[64 * j]; nda[j] = da_[64 * j]; nxb[j] = xb_[64 * j]; ndb[j] = db_[64 * j]; } } while (0)
    auto route_group = [&](const float (&lg)[4], int& gi, float& pg) {
        gi = 0; float gm = lg[0];
#pragma unroll
        for (int q = 1; q < 4; ++q) if (lg[q] > gm) { gm = lg[q]; gi = q; }
        float gs = 0.f;
#pragma unroll
        for (int q = 0; q < 4; ++q) gs += __expf(lg[q] - gm);
        pg = 1.0f / gs;
    };
    auto route_experts = [&](const float (&sl)[4], const int gi, const float pg, const int m) {
        int i0 = 0; float m0 = sl[0];
#pragma unroll
        for (int q = 1; q < 4; ++q) if (sl[q] > m0) { m0 = sl[q]; i0 = q; }
        int i1 = -1; float m1 = -3.0e38f;
#pragma unroll
        for (int q = 0; q < 4; ++q) if (q != i0 && sl[q] > m1) { m1 = sl[q]; i1 = q; }
        const float e1 = __expf(m1 - m0); const float w0 = 1.0f / (1.0f + e1), w1 = e1 * w0;
        const int ex0 = 4 * gi + i0, ex1 = 4 * gi + i1;
        if (lane == 0) TOK[m] = make_int4(ex0, ex1, __float_as_int(pg * w0), __float_as_int(pg * w1));
        mycnt += (lane == ex0 ? 1u : 0u) + (lane == ex1 ? 1u : 0u);
    };
    if (gw < T) RT_LOAD2(gw);
    for (int m = gw; m < T; m += 2 * NGW) {
        asm volatile("" ::: "memory");
        f32x4 va[4], vb[4]; float sa = 0.f, sb = 0.f;
#pragma unroll
        for (int j = 0; j < 4; ++j) { va[j] = nxa[j] + (f32x4){bflo(nda[j].x), bfhi(nda[j].x), bflo(nda[j].y), bfhi(nda[j].y)}; vb[j] = nxb[j] + (f32x4){bflo(ndb[j].x), bfhi(ndb[j].x), bflo(ndb[j].y), bfhi(ndb[j].y)}; }
        if (m + 2 * NGW < T) RT_LOAD2(m + 2 * NGW);
        { GAS v2u* xa_ = (GAS v2u*)((bf16*)(P.ws + WS_X1) + (size_t)m * D) + lane; GAS v2u* xb_ = (GAS v2u*)((bf16*)(P.ws + WS_X1) + (size_t)(m + NGW) * D) + lane;
#pragma unroll
          for (int j = 0; j < 4; ++j) { v2u w; w.x = cvt_pk_bf16(va[j].x, va[j].y); w.y = cvt_pk_bf16(va[j].z, va[j].w); xa_[64 * j] = w; w.x = cvt_pk_bf16(vb[j].x, vb[j].y); w.y = cvt_pk_bf16(vb[j].z, vb[j].w); xb_[64 * j] = w; } }
#pragma unroll
        for (int j = 0; j < 4; ++j) { sa += (va[j].x * va[j].x + va[j].y * va[j].y) + (va[j].z * va[j].z + va[j].w * va[j].w); sb += (vb[j].x * vb[j].x + vb[j].y * vb[j].y) + (vb[j].z * vb[j].z + vb[j].w * vb[j].w); }
        const float rsa = rsqrtf(wave_sum(sa) * (1.f / D) + 1e-6f), rsb = rsqrtf(wave_sum(sb) * (1.f / D) + 1e-6f);
        { GAS unsigned* oa_ = (GAS unsigned*)((unsigned char*)H2 + (size_t)m * D) + lane; GAS unsigned* ob_ = (GAS unsigned*)((unsigned char*)H2 + (size_t)(m + NGW) * D) + lane;
#pragma unroll
          for (int j = 0; j < 4; ++j) { va[j] = va[j] * rsa * gn[j]; int w_ = __builtin_amdgcn_cvt_pk_fp8_f32(va[j].x * 4.f, va[j].y * 4.f, 0, false); w_ = __builtin_amdgcn_cvt_pk_fp8_f32(va[j].z * 4.f, va[j].w * 4.f, w_, true); oa_[64 * j] = (unsigned)w_;
              vb[j] = vb[j] * rsb * gn[j]; w_ = __builtin_amdgcn_cvt_pk_fp8_f32(vb[j].x * 4.f, vb[j].y * 4.f, 0, false); w_ = __builtin_amdgcn_cvt_pk_fp8_f32(vb[j].z * 4.f, vb[j].w * 4.f, w_, true); ob_[64 * j] = (unsigned)w_; } }
        float lga[4], lgb[4];
#pragma unroll
        for (int q = 0; q < 4; ++q) { float a = 0.f, b = 0.f;
#pragma unroll
            for (int j = 0; j < 4; ++j) { const f32x4 w = *(const LAS f32x4*)(WrT + q * 1024 + 4 * lane + 256 * j); a += (va[j].x * w.x + va[j].y * w.y) + (va[j].z * w.z + va[j].w * w.w); b += (vb[j].x * w.x + vb[j].y * w.y) + (vb[j].z * w.z + vb[j].w * w.w); }
            lga[q] = wave_sum(a) + bias[q]; lgb[q] = wave_sum(b) + bias[q]; }
        int gia, gib; float pga, pgb; route_group(lga, gia, pga); route_group(lgb, gib, pgb);
        gia = __builtin_amdgcn_readfirstlane(gia); gib = __builtin_amdgcn_readfirstlane(gib);
        float sla[4], slb[4];
#pragma unroll
        for (int q = 0; q < 4; ++q) { float a = 0.f, b = 0.f; const LAS float* wa_ = WrT + (4 + 4 * gia + q) * 1024 + 4 * lane; const LAS float* wb_ = WrT + (4 + 4 * gib + q) * 1024 + 4 * lane;
#pragma unroll
            for (int j = 0; j < 4; ++j) { const f32x4 w = *(const LAS f32x4*)(wa_ + 256 * j), x = *(const LAS f32x4*)(wb_ + 256 * j);
                a += (va[j].x * w.x + va[j].y * w.y) + (va[j].z * w.z + va[j].w * w.w); b += (vb[j].x * x.x + vb[j].y * x.y) + (vb[j].z * x.z + vb[j].w * x.w); }
            const float ba_ = gia == 0 ? bias[4 + q] : (gia == 1 ? bias[8 + q] : (gia == 2 ? bias[12 + q] : bias[16 + q])), bb_ = gib == 0 ? bias[4 + q] : (gib == 1 ? bias[8 + q] : (gib == 2 ? bias[12 + q] : bias[16 + q]));
            sla[q] = wave_sum(a) + ba_; slb[q] = wave_sum(b) + bb_; }
        route_experts(sla, gia, pga, m); route_experts(slb, gib, pgb, m + NGW);
    }
#undef RT_LOAD2
    if (lane < 16 && mycnt) atomicAdd((unsigned*)&bcnt[lane], mycnt);
    __syncthreads();
    if (tid_r < 16 && bcnt[tid_r]) atomicAdd(&cnt[tid_r], bcnt[tid_r]);
}

__device__ __forceinline__ void place_phase(const Ptrs& P, LAS unsigned char* lds, int G, int c, int wave, int lane) {
    int* ROWS = (int*)(P.ws + WS_ROWS); const int4* TOK = (const int4*)(P.ws + WS_TOK); int2* SLOT = (int2*)(P.ws + WS_SLOT); float* CWv = (float*)(P.ws + WS_CW);
    const unsigned* cnt = (const unsigned*)(P.ws + WS_CTL) + CW_CNT; unsigned* cur = (unsigned*)(P.ws + WS_CTL) + CW_CUR;
    LAS unsigned* wc = (LAS unsigned*)lds;
    LAS unsigned* bb = (LAS unsigned*)(lds + 1024);
    for (int g = c; g < T / 512; g += G) {
        const int m = g * 512 + wave * 64 + lane; const int4 tk = TOK[m];
        __syncthreads();
        unsigned long long k0s = 0, k1s = 0;
#pragma unroll 1
        for (int e = 0; e < 16; ++e) { const unsigned long long k0 = __ballot(tk.x == e), k1 = __ballot(tk.y == e);
            if (tk.x == e) k0s = k0; if (tk.y == e) k1s = k1;
            if (lane == 0) { wc[(wave * 16 + e) * 2] = (unsigned)__popcll(k0); wc[(wave * 16 + e) * 2 + 1] = (unsigned)__popcll(k1); } }
        __syncthreads();
        if (threadIdx.x < 16) { const int e = threadIdx.x; unsigned tot = 0; for (int w = 0; w < 8; ++w) tot += wc[(w * 16 + e) * 2] + wc[(w * 16 + e) * 2 + 1];
            unsigned sb = 0; for (int q = 0; q < e; ++q) sb += ((cnt[q] + 255u) >> 8) * 256u;
            bb[e] = sb + (tot ? atomicAdd(&cur[e], tot) : 0u); }
        __syncthreads();
        unsigned o0 = bb[tk.x], o1 = bb[tk.y];
        for (int w = 0; w < wave; ++w) { o0 += wc[(w * 16 + tk.x) * 2] + wc[(w * 16 + tk.x) * 2 + 1]; o1 += wc[(w * 16 + tk.y) * 2] + wc[(w * 16 + tk.y) * 2 + 1]; }
        const unsigned long long lt = (1ull << lane) - 1ull;
        const int p0 = (int)(o0 + (unsigned)__popcll(k0s & lt));
        const int p1 = (int)(o1 + wc[(wave * 16 + tk.y) * 2] + (unsigned)__popcll(k1s & lt));
        SLOT[m] = make_int2(p0, p1); CWv[p0] = __int_as_float(tk.z); CWv[p1] = __int_as_float(tk.w); ROWS[p0] = m; ROWS[p1] = m;
    }
}

__device__ __forceinline__ void ple_norm_phase(const Ptrs& P, int G, int c, int wave, int lane) {
    float* xo = P.out; const bf16* Y = (const bf16*)(P.ws + WS_Y); const int2* SLOT = (const int2*)(P.ws + WS_SLOT); bf16* H3 = (bf16*)(P.ws + WS_H3); bf16* PB = (bf16*)(P.ws + WS_PB);
    const GAS f32x4* gr = (const GAS f32x4*)P.in[21] + lane; f32x4 gn[4];
#pragma unroll
    for (int j = 0; j < 4; ++j) gn[j] = gr[64 * j];
    const int gw = c * NWAVES + wave, NGW = G * NWAVES;
    f32x4 nx[4], npv; v2u ny0[4], ny1[4]; int2 sl2 = make_int2(0, 0);
    if (gw < T) { const int2 sl = SLOT[gw];
        const GAS f32x4* xr = (const GAS f32x4*)(xo + (size_t)gw * D) + lane; const GAS v2u* y0 = (const GAS v2u*)(Y + (size_t)sl.x * D) + lane; const GAS v2u* y1 = (const GAS v2u*)(Y + (size_t)sl.y * D) + lane;
#pragma unroll
        for (int j = 0; j < 4; ++j) { nx[j] = xr[64 * j]; ny0[j] = y0[64 * j]; ny1[j] = y1[64 * j]; }
        npv = *((const GAS f32x4*)(P.in[1] + (size_t)gw * 256) + lane);
        if (gw + NGW < T) sl2 = SLOT[gw + NGW]; }
    for (int m = gw; m < T; m += NGW) {
        f32x4 v[4]; v2u a[4], bq[4]; const f32x4 pv = npv; float s = 0.f;
#pragma unroll
        for (int j = 0; j < 4; ++j) { v[j] = nx[j]; a[j] = ny0[j]; bq[j] = ny1[j]; }
        if (m + NGW < T) { const int mn = m + NGW; const int2 sl = sl2;
            const GAS f32x4* xr = (const GAS f32x4*)(xo + (size_t)mn * D) + lane; const GAS v2u* y0 = (const GAS v2u*)(Y + (size_t)sl.x * D) + lane; const GAS v2u* y1 = (const GAS v2u*)(Y + (size_t)sl.y * D) + lane;
#pragma unroll
            for (int j = 0; j < 4; ++j) { nx[j] = xr[64 * j]; ny0[j] = y0[64 * j]; ny1[j] = y1[64 * j]; }
            npv = *((const GAS f32x4*)(P.in[1] + (size_t)mn * 256) + lane);
            if (mn + NGW < T) sl2 = SLOT[mn + NGW]; }
        GAS f32x4* xw = (GAS f32x4*)(xo + (size_t)m * D) + lane;
#pragma unroll
        for (int j = 0; j < 4; ++j) {
            v[j].x += bflo(a[j].x) + bflo(bq[j].x); v[j].y += bfhi(a[j].x) + bfhi(bq[j].x); v[j].z += bflo(a[j].y) + bflo(bq[j].y); v[j].w += bfhi(a[j].y) + bfhi(bq[j].y);
            xw[64 * j] = v[j]; s += (v[j].x * v[j].x + v[j].y * v[j].y) + (v[j].z * v[j].z + v[j].w * v[j].w); }
        const float rs = rsqrtf(wave_sum(s) * (1.f / D) + 1e-6f);
#ifdef MORE_FP8
        GAS unsigned* o4 = (GAS unsigned*)((unsigned char*)H3 + (size_t)m * D) + lane;
#pragma unroll
        for (int j = 0; j < 4; ++j) { const f32x4 q_ = v[j] * rs * gn[j] * 4.f; int w_ = __builtin_amdgcn_cvt_pk_fp8_f32(q_.x, q_.y, 0, false); w_ = __builtin_amdgcn_cvt_pk_fp8_f32(q_.z, q_.w, w_, true); o4[64 * j] = (unsigned)w_; }
#else
        GAS v2u* o8 = (GAS v2u*)(H3 + (size_t)m * D) + lane;
#pragma unroll
        for (int j = 0; j < 4; ++j) { f32x4 q_ = v[j] * rs * gn[j]; if (EMU2(4.f) != 0.f) { q_.x = fp8_rt(q_.x, 4.f); q_.y = fp8_rt(q_.y, 4.f); q_.z = fp8_rt(q_.z, 4.f); q_.w = fp8_rt(q_.w, 4.f); } v2u w; w.x = cvt_pk_bf16(q_.x, q_.y); w.y = cvt_pk_bf16(q_.z, q_.w); o8[64 * j] = w; }
#endif
        v2u pw; pw.x = cvt_pk_bf16(pv.x, pv.y); pw.y = cvt_pk_bf16(pv.z, pv.w);
        *((GAS v2u*)(PB + (size_t)m * 256) + lane) = pw;
    }
}

#ifdef MORE_FP8
struct PleRow { v2u nd[4]; unsigned y0[4], y1[4]; f32x4 pv; };
__device__ __forceinline__ void ple_norm_phase_f8(const Ptrs& P, int G, int c, int wave, int lane) {
    bf16* X12 = (bf16*)(P.ws + WS_X1); const unsigned char* Y = (const unsigned char*)(P.ws + WS_Y);
    const int2* SLOT = (const int2*)(P.ws + WS_SLOT); bf16* H3 = (bf16*)(P.ws + WS_H3); bf16* PB = (bf16*)(P.ws + WS_PB);
    const GAS f32x4* gr = (const GAS f32x4*)P.in[21] + lane; f32x4 gn[4];
#pragma unroll
    for (int j = 0; j < 4; ++j) gn[j] = gr[64 * j];
    const int gw = c * NWAVES + wave, NGW = G * NWAVES;
    auto load_row = [&](PleRow& r, const int m, const int2 sl) {
        const GAS v2u* xr = (const GAS v2u*)(X12 + (size_t)m * D) + lane; const GAS unsigned* y0 = (const GAS unsigned*)(Y + (size_t)sl.x * D) + lane; const GAS unsigned* y1 = (const GAS unsigned*)(Y + (size_t)sl.y * D) + lane;
#pragma unroll
        for (int j = 0; j < 4; ++j) { r.nd[j] = xr[64 * j]; r.y0[j] = y0[64 * j]; r.y1[j] = y1[64 * j]; }
        r.pv = *((const GAS f32x4*)(P.in[1] + (size_t)m * 256) + lane);
    };
    auto proc_row = [&](const PleRow& r, const int m) {
        f32x4 v[4]; float s = 0.f;
        GAS v2u* xw = (GAS v2u*)(X12 + (size_t)m * D) + lane;
#pragma unroll
        for (int j = 0; j < 4; ++j) { v[j] = (f32x4){bflo(r.nd[j].x), bfhi(r.nd[j].x), bflo(r.nd[j].y), bfhi(r.nd[j].y)}; const unsigned a = r.y0[j], bq = r.y1[j];
            v[j].x += (__builtin_amdgcn_cvt_f32_fp8((int)a, 0) + __builtin_amdgcn_cvt_f32_fp8((int)bq, 0)) * 0.0625f; v[j].y += (__builtin_amdgcn_cvt_f32_fp8((int)a, 1) + __builtin_amdgcn_cvt_f32_fp8((int)bq, 1)) * 0.0625f;
            v[j].z += (__builtin_amdgcn_cvt_f32_fp8((int)a, 2) + __builtin_amdgcn_cvt_f32_fp8((int)bq, 2)) * 0.0625f; v[j].w += (__builtin_amdgcn_cvt_f32_fp8((int)a, 3) + __builtin_amdgcn_cvt_f32_fp8((int)bq, 3)) * 0.0625f;
            { v2u w; w.x = cvt_pk_bf16(v[j].x, v[j].y); w.y = cvt_pk_bf16(v[j].z, v[j].w); xw[64 * j] = w; }
            s += (v[j].x * v[j].x + v[j].y * v[j].y) + (v[j].z * v[j].z + v[j].w * v[j].w); }
        const float rs = rsqrtf(wave_sum(s) * (1.f / D) + 1e-6f);
        GAS unsigned* o4 = (GAS unsigned*)((unsigned char*)H3 + (size_t)m * D) + lane;
#pragma unroll
        for (int j = 0; j < 4; ++j) { const f32x4 q_ = v[j] * rs * gn[j] * 4.f; int w_ = __builtin_amdgcn_cvt_pk_fp8_f32(q_.x, q_.y, 0, false); w_ = __builtin_amdgcn_cvt_pk_fp8_f32(q_.z, q_.w, w_, true); o4[64 * j] = (unsigned)w_; }
        v2u pw; pw.x = cvt_pk_bf16(r.pv.x, r.pv.y); pw.y = cvt_pk_bf16(r.pv.z, r.pv.w);
        *((GAS v2u*)(PB + (size_t)m * 256) + lane) = pw;
    };
    PleRow A, B; int2 slA = make_int2(0, 0), slB = make_int2(0, 0);
    { load_row(A, gw, SLOT[gw]); load_row(B, gw + NGW, SLOT[gw + NGW]); if (gw + 2 * NGW < T) { slA = SLOT[gw + 2 * NGW]; slB = SLOT[gw + 3 * NGW]; } }
    for (int m = gw; m < T; m += 2 * NGW) {
        const bool more = m + 2 * NGW < T; const bool more2 = m + 4 * NGW < T;
        { const PleRow cur = A; if (more) { load_row(A, m + 2 * NGW, slA); if (more2) slA = SLOT[m + 4 * NGW]; } proc_row(cur, m); }
        { const PleRow cur = B; if (more) { load_row(B, m + 3 * NGW, slB); if (more2) slB = SLOT[m + 5 * NGW]; } proc_row(cur, m + NGW); }
    }
}
#endif

struct Args { Ptrs p; int ph_lo, ph_hi, flags, pad; };
__global__ void __launch_bounds__(NWAVES * 64, 2) fwd_kernel(Args args) {
    extern __shared__ __attribute__((aligned(16))) unsigned char lds_raw[];
    LAS unsigned char* lds = (LAS unsigned char*)lds_raw;
    volatile LAS unsigned* MISC = (volatile LAS unsigned*)(lds + MISC_OFF);
    const int tid = threadIdx.x, lane = tid & 63, wave = __builtin_amdgcn_readfirstlane(tid >> 6);
    const int G = gridDim.x, c = blockIdx.x;
    const Ptrs& P = args.p;
    unsigned char* ws = P.ws;
    gu32* ctl = (gu32*)(ws + WS_CTL);
    for (int u = tid; u < 64; u += NWAVES * 64) MISC[u] = 0u;
    __syncthreads();
    XcdBarrier bar; bar.bar = (unsigned*)ctl + CW_BAR; bar.x = 0; bar.st = nullptr;
    if (N_LAUNCHES == 1) bar = xcd_barrier_post((unsigned*)ctl + CW_BAR, MISC + 8);
    const int lo = args.ph_lo, hi = args.ph_hi;
#ifdef DBG_STAMP
    unsigned long long* const stp = (unsigned long long*)(ws + 768 * 1024);
#define STAMP(i, blk) do { if (c == (blk) && tid == 0) stp[i] = __builtin_amdgcn_s_memrealtime(); } while (0)
#else
#define STAMP(i, blk) do {} while (0)
#endif
#ifndef PH_MASK
#define PH_MASK 0x3ffff
#endif
#define IN(k) (((PH_MASK >> (k)) & 1) && lo <= (k) && (k) < hi)
#define SEAM(k) do { if (IN(k) && IN((k) + 1)) xcd_barrier(bar); } while (0)

    STAMP(0, 0);
    if (IN(0)) { p0_prologue(P, lds, G, c, wave, lane); } SEAM(0);

    STAMP(1, 0);
    if (IN(1)) {
#ifdef STAGGER_P1
        for (int q = 0; q < ((c >> 3) & 3) * STAGGER_P1; ++q) __builtin_amdgcn_s_sleep(85);
#endif
#ifdef P1_FP8
        pg8::StaticOrder S; S.init((const unsigned char*)P.out + DO_H, ws + WS_BTP1, T, NP1, D / 2, G, c);
        pg8::EpiP1 E{(bf16*)(ws + WS_QA), (bf16*)(ws + WS_QB), (float*)(ws + WS_BG), P.in[4], P.in[5], P.in[7], P.in[8]};
        pg8::gemm_phase<pg8::EpiP1, pg8::StaticOrder, true, true, true>(lds + RING_OFF, D / 2, S, E);
#else
        pg8::StaticOrder S; S.init((const unsigned char*)P.out + DO_H, ws + WS_BTP1, T, NP1, D, G, c);
        pg8::EpiP1 E{(bf16*)(ws + WS_QA), (bf16*)(ws + WS_QB), (float*)(ws + WS_BG), P.in[4], P.in[5], P.in[7], P.in[8]};
        pg8::gemm_phase<pg8::EpiP1, pg8::StaticOrder, true, true>(lds + RING_OFF, D, S, E);
#endif
    } SEAM(1);

    STAMP(2, 0);
    if (IN(2)) { attn_phase(lds, (const bf16*)(ws + WS_QA), (bf16*)((unsigned char*)P.out + DO_OG), (float*)((unsigned char*)P.out + DO_LSE), G, c, args.flags); } SEAM(2);

    STAMP(3, 0);
    if (IN(3)) { prep_phase(lds, (const bf16*)(ws + WS_QB), (const float*)(ws + WS_BG), P.in[6], ws + WS_DNP, (float*)(ws + WS_DLB), G, c, args.flags); } SEAM(3);

    STAMP(4, 0);
    if (IN(4)) {
        unsigned* const sb = (unsigned*)ctl + CW_SUB;
        if ((args.flags & 16) && c >= 64) return; if ((args.flags & 32) && c < 64) return; if (args.flags & 64) { if (c < 64) scan_chain(lds, ws + WS_DNP, (const float*)(ws + WS_DLB), (bf16*)(ws + WS_ON), P.in[9], c); else combine_rows(P, (c - 64) * NWAVES + wave, (G - 64) * NWAVES, lane); return; }
        if (c < 64) { scan_chain(lds, ws + WS_DNP, (const float*)(ws + WS_DLB), (bf16*)(ws + WS_ON), P.in[9], c); STAMP(32, 0); }
        else { combine_rows(P, (c - 64) * NWAVES + wave, (G - 64) * NWAVES, lane); STAMP(33, 64); }
        asm volatile("s_waitcnt vmcnt(0)" ::: "memory"); __syncthreads();
        if (tid == 0) { if (c >= 64) { __builtin_amdgcn_fence(__ATOMIC_RELEASE, "agent"); asm volatile("s_waitcnt vmcnt(0)" ::: "memory"); __hip_atomic_fetch_add(sb, 1u, __ATOMIC_RELAXED, __HIP_MEMORY_SCOPE_AGENT); }
            unsigned sp = 0; while (__hip_atomic_load(sb, __ATOMIC_RELAXED, __HIP_MEMORY_SCOPE_AGENT) < (unsigned)(G - 64)) { __builtin_amdgcn_s_sleep(2); if (++sp > (1u << 22)) break; }
            __builtin_amdgcn_fence(__ATOMIC_ACQUIRE, "agent"); asm volatile("s_waitcnt vmcnt(0)" ::: "memory"); }
        __syncthreads();
#ifdef MORE_FP8
        { pg8::StaticOrder S; S.init(ws + WS_HR8, ws + WS_BTGA, T, 2048, D / 2, G, c);
#else
        { pg8::StaticOrder S; S.init(ws + WS_HR, ws + WS_BTGA, T, 2048, D, G, c);
#endif
          if (c >= 64) { S.G = G - 64; S.c = c - 64; } else { S.cap = 0; }
          pg8::EpiG12 E{(unsigned char*)P.out + DO_G1, (unsigned char*)P.out + DO_G2};
          STAMP(34, 64);
#ifdef MORE_FP8
          pg8::gemm_phase<pg8::EpiG12, pg8::StaticOrder, true, true, true>(lds + RING_OFF, D / 2, S, E); STAMP(35, 64); }
#else
          pg8::gemm_phase<pg8::EpiG12, pg8::StaticOrder, true, true>(lds + RING_OFF, D, S, E); STAMP(35, 64); }
#endif
        if (c >= 64) {
            asm volatile("s_waitcnt vmcnt(0)" ::: "memory"); __syncthreads();
            if (tid == 0) { unsigned* const sb2 = (unsigned*)ctl + CW_SUB2; __builtin_amdgcn_fence(__ATOMIC_RELEASE, "agent"); asm volatile("s_waitcnt vmcnt(0)" ::: "memory"); __hip_atomic_fetch_add(sb2, 1u, __ATOMIC_RELAXED, __HIP_MEMORY_SCOPE_AGENT);
                unsigned sp = 0; while (__hip_atomic_load(sb2, __ATOMIC_RELAXED, __HIP_MEMORY_SCOPE_AGENT) < (unsigned)(G - 64)) { __builtin_amdgcn_s_sleep(2); if (++sp > (1u << 22)) break; }
                __builtin_amdgcn_fence(__ATOMIC_ACQUIRE, "agent"); asm volatile("s_waitcnt vmcnt(0)" ::: "memory"); }
            __syncthreads();
            pg8::StaticOrder S; S.init(ws + WS_OA, ws + WS_BTA, T, D, 512, G - 64, c - 64); bf16* const m1 = (bf16*)((unsigned char*)P.out + DO_M1); pg8::EpiGateMul<false> E{(const unsigned char*)P.out + DO_G1, m1, m1};
            pg8::gemm_phase<pg8::EpiGateMul<false>, pg8::StaticOrder, true, true>(lds + RING_OFF, 512, S, E);
        }
    } SEAM(4);

    STAMP(5, 0);
    if (IN(5)) { pg8::StaticOrder S; S.init(ws + WS_HR, ws + WS_BTZ, T, D, D, G, c); pg8::EpiSiluMul E{(bf16*)(ws + WS_ON)};
        pg8::gemm_phase<pg8::EpiSiluMul, pg8::StaticOrder, true, true>(lds + RING_OFF, D, S, E); } SEAM(5);
    STAMP(9, 0);
    if (IN(9)) { pg8::StaticOrder S; S.init(ws + WS_ON, ws + WS_BTB, T, D, D, G, c); pg8::EpiGateMul<true> E{(const unsigned char*)P.out + DO_G2, (const bf16*)((const unsigned char*)P.out + DO_M1), (bf16*)(ws + WS_M)};
        pg8::gemm_phase<pg8::EpiGateMul<true>, pg8::StaticOrder, true, true>(lds + RING_OFF, D, S, E); } SEAM(9);
    STAMP(10, 0);
#ifdef D10_BF16
    if (IN(10)) { pg8::StaticOrder S; S.init(ws + WS_M, ws + WS_BTOUT, T, D, D, G, c); pg8::EpiBf16<0> E{(bf16*)(ws + WS_D10), D, 0};
        pg8::gemm_phase<pg8::EpiBf16<0>, pg8::StaticOrder, true, true>(lds + RING_OFF, D, S, E); } SEAM(10);
#else
    if (IN(10)) { pg8::StaticOrder S; S.init(ws + WS_M, ws + WS_BTOUT, T, D, D, G, c); pg8::EpiResF32 E{P.in[0], P.out, args.flags};
        pg8::gemm_phase<pg8::EpiResF32, pg8::StaticOrder, true, true>(lds + RING_OFF, D, S, E); } SEAM(10);
#endif
    STAMP(11, 0);
    if (IN(11)) { router_phase(P, lds, G, c, wave, lane); } SEAM(11);
    STAMP(12, 0);
    if (IN(12)) { place_phase(P, lds, G, c, wave, lane); } SEAM(12);
    STAMP(13, 0);
#ifdef MORE_FP8
    if (IN(13)) { pg8::ExpertOrder<true> S; S.init(ws + WS_H2, ws + WS_BTGU, (const unsigned*)ctl + CW_CNT, 512, D / 2, G, c); S.rows = (const int*)(ws + WS_ROWS); pg8::EpiGU E{(bf16*)(ws + WS_ACT), (const float*)(ws + WS_CW)};
        pg8::gemm_phase<pg8::EpiGU, pg8::ExpertOrder<true>, true, true, true>(lds + RING_OFF, D / 2, S, E); } SEAM(13);
#else
    if (IN(13)) { pg8::ExpertOrder<true> S; S.init(ws + WS_H2, ws + WS_BTGU, (const unsigned*)ctl + CW_CNT, 512, D, G, c); S.rows = (const int*)(ws + WS_ROWS); pg8::EpiGU E{(bf16*)(ws + WS_ACT), (const float*)(ws + WS_CW)};
        pg8::gemm_phase<pg8::EpiGU, pg8::ExpertOrder<true>, true, true>(lds + RING_OFF, D, S, E); } SEAM(13);
#endif
    STAMP(14, 0);
    if (IN(14)) { pg8::ExpertOrder<false> S; S.init(ws + WS_ACT, ws + WS_BTDN, (const unsigned*)ctl + CW_CNT, D, 256, G, c); S.rows = nullptr;
#ifdef MORE_FP8
        pg8::EpiF8 E{(unsigned char*)(ws + WS_Y), D, 16.0f};
        pg8::gemm_phase<pg8::EpiF8, pg8::ExpertOrder<false>, true, true>(lds + RING_OFF, 256, S, E); } SEAM(14);
#else
        pg8::EpiBf16<0> E{(bf16*)(ws + WS_Y), D, args.flags & 1};
        pg8::gemm_phase<pg8::EpiBf16<0>, pg8::ExpertOrder<false>, true, true>(lds + RING_OFF, 256, S, E); } SEAM(14);
#endif
    STAMP(15, 0);
#ifdef MORE_FP8
    if (IN(15)) { ple_norm_phase_f8(P, G, c, wave, lane); } SEAM(15);
#else
    if (IN(15)) { ple_norm_phase(P, G, c, wave, lane); } SEAM(15);
#endif
    STAMP(16, 0);
    if (IN(16)) { pg8::StaticOrder S; S.init(ws + WS_PB, ws + WS_BTPLE, T, D, 256, G, c); pg8::EpiBf16<0> E{(bf16*)(ws + WS_E1), D, args.flags & 1};
        pg8::gemm_phase<pg8::EpiBf16<0>, pg8::StaticOrder, true, true>(lds + RING_OFF, 256, S, E); }
    STAMP(17, 0);
#ifdef MORE_FP8
    if (IN(17)) { pg8::StaticOrder S; S.init(ws + WS_H3, ws + WS_BTPG, T, D, D / 2, G, c); pg8::EpiPleOut E{(const bf16*)(ws + WS_E1), (const bf16*)(ws + WS_X1), P.out};
        pg8::gemm_phase<pg8::EpiPleOut, pg8::StaticOrder, true, true, true>(lds + RING_OFF, D / 2, S, E); }
#else
    if (IN(17)) { pg8::StaticOrder S; S.init(ws + WS_H3, ws + WS_BTPG, T, D, D, G, c); pg8::EpiPleOut E{(const bf16*)(ws + WS_E1), (const bf16*)(ws + WS_X1), P.out};
        pg8::gemm_phase<pg8::EpiPleOut, pg8::StaticOrder, true, true>(lds + RING_OFF, D, S, E); }
#endif
    STAMP(18, 0);
#undef IN
#undef SEAM
}

#ifndef DBG_LAST
#define DBG_LAST (NPH - 1)
#endif
__global__ void dbg_sanitize(float* out, size_t n) {
    for (size_t i = (size_t)blockIdx.x * blockDim.x + threadIdx.x; i < n; i += (size_t)gridDim.x * blockDim.x) { const float v = out[i]; if (!(v - v == 0.f)) out[i] = 0.f; }
}
__global__ void dbg_copy(const float* x, float* out, size_t n) {
    for (size_t i = (size_t)blockIdx.x * blockDim.x + threadIdx.x; i < n; i += (size_t)gridDim.x * blockDim.x) out[i] = x[i];
}
#ifdef DBG_CHECK
__global__ void dbg_check(const void* p, size_t nbytes, int is_f32, unsigned id, unsigned* word) {
    const size_t n16 = nbytes / 16; const uint4* q = (const uint4*)p; bool bad = false;
    for (size_t i = (size_t)blockIdx.x * blockDim.x + threadIdx.x; i < n16; i += (size_t)gridDim.x * blockDim.x) { const uint4 v = q[i]; const unsigned w[4] = {v.x, v.y, v.z, v.w};
        for (int k = 0; k < 4; ++k) { if (is_f32) { if ((w[k] & 0x7f800000u) == 0x7f800000u) bad = true; } else { if ((w[k] & 0x7f80u) == 0x7f80u || (w[k] & 0x7f800000u) == 0x7f800000u) bad = true; } } }
    if (bad) atomicMin(word, id);
}
__global__ void dbg_check_dnp(const unsigned char* p, unsigned id, unsigned* word) {
    bool bad = false;
    for (size_t i = (size_t)blockIdx.x * blockDim.x + threadIdx.x; i < (size_t)8192 * (DNU / 16); i += (size_t)gridDim.x * blockDim.x) { const size_t rec = i / (DNU / 16), o = (i % (DNU / 16)) * 16;
        if (o >= 49152 + 2048 && o < 49152 + 4096) continue;
        const uint4 v = *(const uint4*)(p + rec * DNU + o); const unsigned w[4] = {v.x, v.y, v.z, v.w};
        for (int k = 0; k < 4; ++k) if ((w[k] & 0x7f80u) == 0x7f80u || (w[k] & 0x7f800000u) == 0x7f800000u) { const unsigned part = o < 16384 ? 0u : (o < 32768 ? 1u : (o < 49152 ? 2u : (o < 57344 ? 3u : 4u))); atomicAnd(word, ~(1u << part)); } }
    (void)bad;
}
__global__ void dbg_check_tmax(const unsigned char* p, unsigned* word) {
    for (size_t r = (size_t)blockIdx.x * blockDim.x + threadIdx.x; r < 8192; r += (size_t)gridDim.x * blockDim.x) { const float* d = (const float*)(p + r * DNU + 49152 + 2048);
        unsigned bits = 0; if (d[0] > 1e3f) bits |= 1u; if (d[2] != 0.f) bits |= 2u; if (d[1] > 1.5f) bits |= 4u; if (d[1] > 100.f) bits |= 8u; if (d[3] != 0.f) bits |= 16u;
        if (bits) atomicAnd(word, ~bits); }
}
__global__ void dbg_final(const float* x, float* out, const unsigned* word) {
    unsigned id = *word;
#ifdef DBG_BITS
    id = (~id) & 31u; if (id == 0) id = 0xffffffffu;
#endif
    const size_t nz = id == 0xffffffffu ? 0 : (size_t)id * (T / 32) * D; const size_t n = (size_t)T * D;
    for (size_t i = (size_t)blockIdx.x * blockDim.x + threadIdx.x; i < n; i += (size_t)gridDim.x * blockDim.x) out[i] = i < nz ? 0.f : x[i];
}
#endif
#ifdef DBG_STAMP
__global__ void dbg_stamp_out(const unsigned long long* st, float* out) {
#ifdef DBG_CAL
    const float delta = 0.1f;
#else
    const float delta = (float)(st[DBG_TA1] - st[DBG_TA0]) * 0.01f * (1.0f / 20000.0f);
#endif
    const size_t n = (size_t)T * D;
    for (size_t i = (size_t)blockIdx.x * blockDim.x + threadIdx.x; i < n; i += (size_t)gridDim.x * blockDim.x) out[i] += delta;
}
#endif
extern "C" void kernel_launch(void* const* d_in, const int* in_sizes, int n_in, void* d_out, int out_size, void* d_ws, size_t ws_size, hipStream_t stream) {
    static int grid = 0;
    if (grid == 0) {
        if (n_in != 24 || out_size != T * D || ws_size < WS_END) { fprintf(stderr, "kernel_launch: unexpected shapes (n_in %d, out %d, ws %zu)\n", n_in, out_size, ws_size); grid = -1; return; }
        int dev = 0, cus = 0;
        if (hipGetDevice(&dev) != hipSuccess || hipDeviceGetAttribute(&cus, hipDeviceAttributeMultiprocessorCount, dev) != hipSuccess) { grid = -1; return; }
        if (hipFuncSetAttribute((const void*)fwd_kernel, hipFuncAttributeMaxDynamicSharedMemorySize, LDS_BYTES) != hipSuccess) { grid = -1; return; }
        int per_cu = 0;
        if (hipOccupancyMaxActiveBlocksPerMultiprocessor(&per_cu, (const void*)fwd_kernel, NWAVES * 64, LDS_BYTES) != hipSuccess || per_cu < 1) { fprintf(stderr, "kernel_launch: occupancy query says %d\n", per_cu); }
        (void)hipGetLastError();
        grid = cus;
        if (grid != 256) { fprintf(stderr, "kernel_launch: built for 256 CUs, found %d\n", cus); grid = -1; return; }
    }
    if (grid < 0) return;
    if (hipMemsetAsync((char*)d_ws + WS_CTL, 0, CTL_ZERO_BYTES, stream) != hipSuccess) return;
    Args a{};
    for (int i = 0; i < 24; ++i) a.p.in[i] = (const float*)d_in[i];
    a.p.out = (float*)d_out; a.p.ws = (unsigned char*)d_ws;
    if (N_LAUNCHES == 1) { a.ph_lo = 0; a.ph_hi = NPH; hipLaunchKernelGGL(fwd_kernel, dim3(grid), dim3(NWAVES * 64), LDS_BYTES, stream, a);
#ifdef DBG_STAMP
        hipLaunchKernelGGL(dbg_stamp_out, dim3(1024), dim3(256), 0, stream, (const unsigned long long*)((unsigned char*)d_ws + 768 * 1024), (float*)d_out);
#endif
    }
    else for (int li = 0; li <= DBG_LAST; ++li) { a.ph_lo = li; a.ph_hi = li + 1;
#ifdef DUP_PH
#ifndef DUP_N
#define DUP_N 1
#endif
#ifndef DUP_FLAGS
#define DUP_FLAGS 0
#endif
        if (li == DUP_PH) { Args b = a; b.flags = DUP_FLAGS; if (li == 11 || li == 12) hipMemsetAsync((char*)d_ws + WS_CTL + CW_CNT * 4 + (li == 12 ? 256 : 0), 0, 64, stream);
            for (int r = 0; r < DUP_N; ++r) hipLaunchKernelGGL(fwd_kernel, dim3(grid), dim3(NWAVES * 64), LDS_BYTES, stream, b);
            if (li == 11 || li == 12) hipMemsetAsync((char*)d_ws + WS_CTL + CW_CNT * 4 + (li == 12 ? 256 : 0), 0, 64, stream);
            if (li == 4) hipMemsetAsync((char*)d_ws + WS_CTL + CW_SUB * 4, 0, 4, stream); }
#endif
        hipLaunchKernelGGL(fwd_kernel, dim3(grid), dim3(NWAVES * 64), LDS_BYTES, stream, a);
#ifdef DBG_CHECK
        unsigned char* W = (unsigned char*)d_ws; unsigned char* O = (unsigned char*)d_out; unsigned* word = (unsigned*)(W + 1022 * MiB + 512 * 1024);
        if (li == 0) hipMemsetAsync(word, 0xFF, 4, stream);
#define CHK(p, nb, f32, id) hipLaunchKernelGGL(dbg_check, dim3(1024), dim3(256), 0, stream, (const void*)(p), (size_t)(nb), f32, (unsigned)(id), word)
        if (li == 0) { CHK(O + DO_H, (size_t)T * D * 2, 0, 1); CHK(W + WS_BTP1, (size_t)NP1 * D * 2, 0, 2); CHK(W + WS_BTZ, 38 * MiB, 0, 3); }
        if (li == 1) { CHK(W + WS_QA, (size_t)T * 4608 * 2, 0, 4); CHK(W + WS_QB, (size_t)T * 3072 * 2, 0, 5); CHK(W + WS_BG, (size_t)T * 16 * 4, 1, 6); }
        if (li == 2) { CHK(O + DO_OG, (size_t)T * 1536 * 2, 0, 7); CHK(O + DO_LSE, (size_t)T * 24 * 4, 1, 8); }
#if defined(DBG_PREPCHK)
        if (li == 3) {
#elif defined(DBG_TMAX)
        if (li == 3) { hipLaunchKernelGGL(dbg_check_tmax, dim3(32), dim3(256), 0, stream, W + WS_DNP, word);
#else
        if (li == 3) { hipLaunchKernelGGL(dbg_check_dnp, dim3(1024), dim3(256), 0, stream, W + WS_DNP, 9u, word);
#endif
        CHK(W + WS_DLB, 8192 * 4, 1, 14); }
        if (li == 4) { CHK(W + WS_ON, (size_t)T * D * 2, 0, 11); CHK(W + WS_OA, (size_t)T * 512 * 2, 0, 12); CHK(W + WS_HR, (size_t)T * D * 2, 0, 13); }
        if (li == 5) CHK(W + WS_ON, (size_t)T * D * 2, 0, 14);
        if (li == 8) CHK(W + WS_M, (size_t)T * D * 2, 0, 17);
        if (li == 9) CHK(W + WS_M, (size_t)T * D * 2, 0, 18);
        if (li == 10) CHK(O, (size_t)T * D * 4, 1, 19);
        if (li == 11) { CHK(W + WS_H2, (size_t)T * D * 2, 0, 20); CHK(W + WS_TOK, (size_t)T * 16, 1, 21); }
        if (li == 15) { CHK(O, (size_t)T * D * 4, 1, 25); CHK(W + WS_H3, (size_t)T * D * 2, 0, 26); }
        if (li == 16) CHK(W + WS_E1, (size_t)T * D * 2, 0, 27);
        if (li == 17) CHK(O, (size_t)T * D * 4, 1, 28);
        if (li == DBG_LAST) hipLaunchKernelGGL(dbg_final, dim3(2048), dim3(256), 0, stream, (const float*)d_in[0], (float*)d_out, (const unsigned*)word);
#endif
    }
#ifdef DBG_COPYX
    hipLaunchKernelGGL(dbg_copy, dim3(2048), dim3(256), 0, stream, (const float*)d_in[0], (float*)d_out, (size_t)out_size);
#endif
#ifdef DBG_SANITIZE
    hipLaunchKernelGGL(dbg_sanitize, dim3(2048), dim3(256), 0, stream, (float*)d_out, (size_t)out_size);
#endif
}
```
